# Optimizing an MI355X kernel written in HIP

```python
import math
import jax, jax.numpy as jnp
from jax import lax
import numpy as np

D_MODEL = 2048
BATCH = 4
SEQ = 2048
DEPTH = 2

N_MIXERS = 2
NORM_EPS = 1e-6
NEG_INF = -1e30
ROPE_THETA = 10000.0
NSA_HEADS = 16
NSA_KV_HEADS = 4
NSA_HEAD_DIM = D_MODEL // NSA_HEADS
NSA_Q_PER_KV = NSA_HEADS // NSA_KV_HEADS
CMP_BLOCK = 32
CMP_STRIDE = 16
CMP_HIDDEN = 256
SLC_BLOCK = 64
SLC_TOPK = 16
SLC_LOCAL = 2
SLC_FORCE = 1e4
WINDOW = 512
WIN_Q_BLOCK = 128
SLC_Q_CHUNK = 32
NSA_QD = NSA_HEADS * NSA_HEAD_DIM
NSA_KVD = NSA_KV_HEADS * NSA_HEAD_DIM
NSA_PROJ = NSA_QD + 6 * NSA_KVD + 3 * NSA_HEADS
SSD_D_INNER = 2 * D_MODEL
SSD_HEAD_DIM = 64
SSD_HEADS = SSD_D_INNER // SSD_HEAD_DIM
SSD_GROUPS = 8
SSD_HEADS_PER_GROUP = SSD_HEADS // SSD_GROUPS
SSD_D_STATE = 128
SSD_CONV = 4
SSD_CHUNK = 128
SSD_CONV_CH = SSD_D_INNER + 2 * SSD_GROUPS * SSD_D_STATE
SSD_PROJ = SSD_D_INNER + SSD_CONV_CH + SSD_HEADS
MOE_GROUPS = 4
MOE_EXPERTS_PER_GROUP = 8
MOE_EXPERTS = MOE_GROUPS * MOE_EXPERTS_PER_GROUP
MOE_TOPK = 2
MOE_D_FF = 512

kernel_name = 'hybrid_nsa_ssd_hier_moe'


def rms_norm(x, g):
    xf = x.astype(jnp.float32)
    y = xf * lax.rsqrt(jnp.mean(xf * xf, axis=-1, keepdims=True) + NORM_EPS)
    return (y * g.astype(jnp.float32)).astype(x.dtype)


def rope_tables(seq_len):
    pos = jnp.arange(seq_len, dtype=jnp.float32)
    inv = 1.0 / (ROPE_THETA ** (jnp.arange(0, NSA_HEAD_DIM, 2, dtype=jnp.float32) / NSA_HEAD_DIM))
    ang = pos[:, None] * inv[None, :]
    return jnp.cos(ang), jnp.sin(ang)


def apply_rope(x, cos, sin):
    half = x.shape[-1] // 2
    x1, x2 = x[..., :half], x[..., half:]
    c = cos[None, :, None, :].astype(x.dtype)
    s = sin[None, :, None, :].astype(x.dtype)
    return jnp.concatenate([x1 * c - x2 * s, x2 * c + x1 * s], axis=-1)


def compress_blocks(kv, pe, w1, w2):
    B, S, G, Dh = kv.shape
    n_cmp = (S - CMP_BLOCK) // CMP_STRIDE + 1
    idx = jnp.arange(n_cmp)[:, None] * CMP_STRIDE + jnp.arange(CMP_BLOCK)[None, :]
    blk = kv[:, idx] + pe[None, None, :, None, :]
    blk = jnp.swapaxes(blk, 2, 3).reshape(B, n_cmp, G, CMP_BLOCK * Dh)
    return jax.nn.gelu(blk @ w1) @ w2


def nsa_mixer(h, w_in, cmp_pe, cmp_w1, cmp_w2, w_out, cos, sin):
    B, S, _ = h.shape
    G, R, Dh = NSA_KV_HEADS, NSA_Q_PER_KV, NSA_HEAD_DIM
    scale = Dh ** -0.5
    proj = h @ w_in
    cuts = [NSA_QD + i * NSA_KVD for i in range(7)]
    q, k_c, v_c, k_s, v_s, k_w, v_w, g_lin = jnp.split(proj, cuts, axis=-1)
    q = apply_rope(q.reshape(B, S, NSA_HEADS, Dh), cos, sin).reshape(B, S, G, R, Dh)
    kvs = (B, S, G, Dh)
    k_c = apply_rope(k_c.reshape(kvs), cos, sin)
    k_s = apply_rope(k_s.reshape(kvs), cos, sin)
    k_w = apply_rope(k_w.reshape(kvs), cos, sin)
    v_c, v_s, v_w = v_c.reshape(kvs), v_s.reshape(kvs), v_w.reshape(kvs)
    t = jnp.arange(S)

    n_cmp = (S - CMP_BLOCK) // CMP_STRIDE + 1
    kc = compress_blocks(k_c, cmp_pe[0], cmp_w1[0], cmp_w2[0])
    vc = compress_blocks(v_c, cmp_pe[1], cmp_w1[1], cmp_w2[1])
    s_cmp = jnp.einsum('bsgrd,bcgd->bgrsc', q, kc).astype(jnp.float32) * scale
    cmp_ok = (jnp.arange(n_cmp) * CMP_STRIDE + CMP_BLOCK - 1)[None, :] <= t[:, None]
    p_cmp = jax.nn.softmax(jnp.where(cmp_ok, s_cmp, NEG_INF), axis=-1) * cmp_ok
    o_cmp = jnp.einsum('bgrsc,bcgd->bsgrd', p_cmp.astype(vc.dtype), vc)

    n_slc = S // SLC_BLOCK
    cmp_start = jnp.arange(n_cmp) * CMP_STRIDE
    slc_start = jnp.arange(n_slc) * SLC_BLOCK
    overlap = jnp.clip(jnp.minimum(cmp_start[:, None] + CMP_BLOCK, slc_start[None, :] + SLC_BLOCK)
                       - jnp.maximum(cmp_start[:, None], slc_start[None, :]), 0, None).astype(jnp.float32) / CMP_BLOCK
    imp = jnp.einsum('bgrsc,cj->bgsj', p_cmp, overlap)
    dist = (t // SLC_BLOCK)[:, None] - jnp.arange(n_slc)[None, :]
    forced = (jnp.arange(n_slc)[None, :] == 0) | ((dist >= 0) & (dist < SLC_LOCAL))
    imp = jnp.where(forced, SLC_FORCE, imp)
    imp = jnp.where(dist >= 0, imp, -jnp.inf)
    _, sel = lax.top_k(imp, min(SLC_TOPK, n_slc))
    n_sel = sel.shape[-1]
    ks_flat = k_s.reshape(B, n_slc, SLC_BLOCK, G, Dh).transpose(0, 3, 1, 2, 4).reshape(B * G * n_slc, SLC_BLOCK, Dh)
    vs_flat = v_s.reshape(B, n_slc, SLC_BLOCK, G, Dh).transpose(0, 3, 1, 2, 4).reshape(B * G * n_slc, SLC_BLOCK, Dh)
    base = (jnp.arange(B)[:, None, None, None] * G + jnp.arange(G)[None, :, None, None]) * n_slc
    n_chunk = S // SLC_Q_CHUNK
    q_ch = jnp.moveaxis(q.reshape(B, n_chunk, SLC_Q_CHUNK, G, R, Dh), 1, 0)
    sel_ch = jnp.moveaxis(sel.reshape(B, G, n_chunk, SLC_Q_CHUNK, n_sel), 2, 0)
    t_ch = t.reshape(n_chunk, SLC_Q_CHUNK)
    tok = jnp.arange(SLC_BLOCK)

    def select_chunk(args):
        qc, sc, tc = args
        kg = ks_flat[base + sc]
        vg = vs_flat[base + sc]
        s = jnp.einsum('bqgrd,bgqkld->bgrqkl', qc, kg).astype(jnp.float32) * scale
        ok = (sc[..., None] * SLC_BLOCK + tok) <= tc[None, None, :, None, None]
        s = jnp.where(ok[:, :, None], s, NEG_INF)
        p = jax.nn.softmax(s.reshape(s.shape[:4] + (-1,)), axis=-1).reshape(s.shape)
        return jnp.einsum('bgrqkl,bgqkld->bqgrd', p.astype(vg.dtype), vg)

    o_slc = jnp.moveaxis(lax.map(select_chunk, (q_ch, sel_ch, t_ch)), 0, 1).reshape(B, S, G, R, Dh)

    nqb = S // WIN_Q_BLOCK
    nwb = WINDOW // WIN_Q_BLOCK
    kw_len = (nwb + 1) * WIN_Q_BLOCK

    def band(kv):
        kp = jnp.pad(kv, ((0, 0), (WINDOW, 0), (0, 0), (0, 0))).reshape(B, nqb + nwb, WIN_Q_BLOCK, G, Dh)
        return jnp.concatenate([kp[:, i:i + nqb] for i in range(nwb + 1)], axis=2)

    kwin, vwin = band(k_w), band(v_w)
    qb = q.reshape(B, nqb, WIN_Q_BLOCK, G, R, Dh)
    s_w = jnp.einsum('bnqgrd,bnkgd->bngrqk', qb, kwin).astype(jnp.float32) * scale
    qpos = jnp.arange(nqb)[:, None] * WIN_Q_BLOCK + jnp.arange(WIN_Q_BLOCK)[None, :]
    kpos = jnp.arange(nqb)[:, None] * WIN_Q_BLOCK - WINDOW + jnp.arange(kw_len)[None, :]
    kq = kpos[:, None, :]
    qq = qpos[:, :, None]
    win_ok = (kq <= qq) & (kq > qq - WINDOW) & (kq >= 0)
    p_w = jax.nn.softmax(jnp.where(win_ok[None, :, None, None], s_w, NEG_INF), axis=-1)
    o_win = jnp.einsum('bngrqk,bnkgd->bnqgrd', p_w.astype(vwin.dtype), vwin).reshape(B, S, G, R, Dh)

    gate = jax.nn.sigmoid(g_lin.astype(jnp.float32)).astype(h.dtype).reshape(B, S, G, R, 3)
    o = gate[..., 0:1] * o_cmp + gate[..., 1:2] * o_slc + gate[..., 2:3] * o_win
    return o.reshape(B, S, NSA_QD) @ w_out


def ssd_chunked_scan(xdt, a_dt, b_mat, c_mat):
    B, S, H, P = xdt.shape
    Gs, R, N, L = SSD_GROUPS, SSD_HEADS_PER_GROUP, SSD_D_STATE, SSD_CHUNK
    nc = S // L
    x = xdt.reshape(B, nc, L, Gs, R, P)
    a = a_dt.reshape(B, nc, L, Gs, R).transpose(0, 3, 4, 1, 2)
    bc = b_mat.reshape(B, nc, L, Gs, N)
    cc = c_mat.reshape(B, nc, L, Gs, N)
    a_cum = jnp.cumsum(a, axis=-1)
    seg = a_cum[..., :, None] - a_cum[..., None, :]
    causal = jnp.tril(jnp.ones((L, L), dtype=bool))
    decay = jnp.where(causal, jnp.exp(jnp.where(causal, seg, 0.0)), 0.0)
    cb = jnp.einsum('bclgn,bcsgn->bgcls', cc, bc)
    y_diag = jnp.einsum('bgcls,bgrcls,bcsgrp->bclgrp', cb, decay, x)
    state_decay = jnp.exp(a_cum[..., -1:] - a_cum)
    states = jnp.einsum('bclgn,bgrcl,bclgrp->bcgrpn', bc, state_decay, x)
    chunk_decay = jnp.exp(a_cum[..., -1])

    def step(carry, inp):
        st, dec = inp
        return carry * dec[..., None, None] + st, carry

    init = jnp.zeros((B, Gs, R, P, N), dtype=jnp.float32)
    _, prev = lax.scan(step, init, (jnp.moveaxis(states, 1, 0), jnp.moveaxis(chunk_decay, -1, 0)))
    prev = jnp.moveaxis(prev, 0, 1)
    y_off = jnp.einsum('bclgn,bcgrpn,bgrcl->bclgrp', cc, prev, jnp.exp(a_cum))
    return (y_diag + y_off).reshape(B, S, H, P)


def ssd_mixer(h, w_in, conv_w, conv_b, dt_bias, a_log, d_skip, norm_g, w_out):
    B, S, _ = h.shape
    f32 = jnp.float32
    proj = h @ w_in
    z, xbc, dt = jnp.split(proj, [SSD_D_INNER, SSD_D_INNER + SSD_CONV_CH], axis=-1)
    xpad = jnp.pad(xbc, ((0, 0), (SSD_CONV - 1, 0), (0, 0)))
    conv = conv_b
    for k in range(SSD_CONV):
        conv = conv + xpad[:, k:k + S] * conv_w[k]
    xbc = jax.nn.silu(conv)
    xs, b_mat, c_mat = jnp.split(xbc, [SSD_D_INNER, SSD_D_INNER + SSD_GROUPS * SSD_D_STATE], axis=-1)
    xs = xs.reshape(B, S, SSD_HEADS, SSD_HEAD_DIM).astype(f32)
    b_mat = b_mat.reshape(B, S, SSD_GROUPS, SSD_D_STATE).astype(f32)
    c_mat = c_mat.reshape(B, S, SSD_GROUPS, SSD_D_STATE).astype(f32)
    dt = jax.nn.softplus(dt.astype(f32) + dt_bias.astype(f32))
    a = -jnp.exp(a_log.astype(f32))
    y = ssd_chunked_scan(xs * dt[..., None], dt * a, b_mat, c_mat)
    y = y + xs * d_skip.astype(f32)[:, None]
    y = y.reshape(B, S, SSD_D_INNER) * jax.nn.silu(z.astype(f32))
    yg = y.reshape(B, S, SSD_GROUPS, SSD_D_INNER // SSD_GROUPS)
    yg = yg * lax.rsqrt(jnp.mean(yg * yg, axis=-1, keepdims=True) + NORM_EPS)
    y = (yg.reshape(B, S, SSD_D_INNER) * norm_g.astype(f32)).astype(h.dtype)
    return y @ w_out


def hier_moe(h, w_group, b_group, w_expert, b_expert, w_gate, w_up, w_down):
    B, S, D = h.shape
    T = B * S
    f32 = jnp.float32
    hf = h.reshape(T, D)
    g_logits = (hf @ w_group + b_group).astype(f32)
    g_prob = jax.nn.softmax(g_logits, axis=-1)
    g_sel = jnp.argmax(g_logits, axis=-1)
    g_w = jnp.take_along_axis(g_prob, g_sel[:, None], axis=1)
    e_logits = (hf @ w_expert + b_expert).astype(f32).reshape(T, MOE_GROUPS, MOE_EXPERTS_PER_GROUP)
    e_in = jnp.take_along_axis(e_logits, g_sel[:, None, None], axis=1)[:, 0]
    top_v, top_i = lax.top_k(e_in, MOE_TOPK)
    w = jax.nn.softmax(top_v, axis=-1) * g_w
    eid = g_sel[:, None] * MOE_EXPERTS_PER_GROUP + top_i
    combine = jnp.einsum('tk,tke->te', w, jax.nn.one_hot(eid, MOE_EXPERTS, dtype=f32)).astype(h.dtype)
    y = jnp.zeros((T, D), dtype=h.dtype)
    for grp in range(MOE_GROUPS):
        sl = slice(grp * MOE_EXPERTS_PER_GROUP, (grp + 1) * MOE_EXPERTS_PER_GROUP)
        act = jax.nn.silu(jnp.einsum('td,edf->tef', hf, w_gate[sl])) * jnp.einsum('td,edf->tef', hf, w_up[sl])
        y = y + jnp.einsum('tef,te,efd->td', act, combine[:, sl], w_down[sl])
    return y.reshape(B, S, D)


def setup_inputs(seed: int = 0) -> dict:
    key = jax.random.key(seed)
    ks = jax.random.split(key, 24)
    f32 = jnp.float32
    n_nsa = (DEPTH + N_MIXERS - 1) // N_MIXERS
    n_ssd = DEPTH // N_MIXERS
    Dh = NSA_HEAD_DIM

    def nrm(k, shape, s):
        return jax.random.normal(k, shape, f32) * s

    dt0 = jnp.exp(jax.random.uniform(ks[12], (n_ssd, SSD_HEADS), f32, math.log(1e-3), math.log(1e-1)))
    return {
        'x': nrm(ks[0], (BATCH, SEQ, D_MODEL), 1.0),
        'ln_mix': 1.0 + nrm(ks[1], (DEPTH, D_MODEL), 0.02),
        'ln_ffn': 1.0 + nrm(ks[2], (DEPTH, D_MODEL), 0.02),
        'ln_final': 1.0 + nrm(ks[3], (D_MODEL,), 0.02),
        'nsa_w_in': nrm(ks[4], (n_nsa, D_MODEL, NSA_PROJ), D_MODEL ** -0.5),
        'nsa_cmp_pe': nrm(ks[5], (n_nsa, 2, CMP_BLOCK, Dh), 0.1),
        'nsa_cmp_w1': nrm(ks[6], (n_nsa, 2, CMP_BLOCK * Dh, CMP_HIDDEN), (CMP_BLOCK * Dh) ** -0.5),
        'nsa_cmp_w2': nrm(ks[7], (n_nsa, 2, CMP_HIDDEN, Dh), CMP_HIDDEN ** -0.5),
        'nsa_w_out': nrm(ks[8], (n_nsa, NSA_QD, D_MODEL), NSA_QD ** -0.5),
        'ssd_w_in': nrm(ks[9], (n_ssd, D_MODEL, SSD_PROJ), D_MODEL ** -0.5),
        'ssd_conv_w': nrm(ks[10], (n_ssd, SSD_CONV, SSD_CONV_CH), SSD_CONV ** -0.5),
        'ssd_conv_b': nrm(ks[11], (n_ssd, SSD_CONV_CH), 0.01),
        'ssd_dt_bias': dt0 + jnp.log(-jnp.expm1(-dt0)),
        'ssd_a_log': jnp.log(jax.random.uniform(ks[13], (n_ssd, SSD_HEADS), f32, 1.0, 16.0)),
        'ssd_d': 1.0 + nrm(ks[14], (n_ssd, SSD_HEADS), 0.1),
        'ssd_norm': 1.0 + nrm(ks[15], (n_ssd, SSD_D_INNER), 0.02),
        'ssd_w_out': nrm(ks[16], (n_ssd, SSD_D_INNER, D_MODEL), SSD_D_INNER ** -0.5),
        'moe_w_group': nrm(ks[17], (DEPTH, D_MODEL, MOE_GROUPS), D_MODEL ** -0.5),
        'moe_b_group': nrm(ks[18], (DEPTH, MOE_GROUPS), 0.01),
        'moe_w_expert': nrm(ks[19], (DEPTH, D_MODEL, MOE_EXPERTS), D_MODEL ** -0.5),
        'moe_b_expert': nrm(ks[20], (DEPTH, MOE_EXPERTS), 0.01),
        'moe_w_gate': nrm(ks[21], (DEPTH, MOE_EXPERTS, D_MODEL, MOE_D_FF), D_MODEL ** -0.5),
        'moe_w_up': nrm(ks[22], (DEPTH, MOE_EXPERTS, D_MODEL, MOE_D_FF), D_MODEL ** -0.5),
        'moe_w_down': nrm(ks[23], (DEPTH, MOE_EXPERTS, MOE_D_FF, D_MODEL), MOE_D_FF ** -0.5),
    }


def reference(x, ln_mix, ln_ffn, ln_final, nsa_w_in, nsa_cmp_pe, nsa_cmp_w1, nsa_cmp_w2, nsa_w_out,
              ssd_w_in, ssd_conv_w, ssd_conv_b, ssd_dt_bias, ssd_a_log, ssd_d, ssd_norm, ssd_w_out,
              moe_w_group, moe_b_group, moe_w_expert, moe_b_expert, moe_w_gate, moe_w_up, moe_w_down):
    cos, sin = rope_tables(x.shape[1])
    for i in range(DEPTH):
        j = i // N_MIXERS
        h = rms_norm(x, ln_mix[i])
        if i % N_MIXERS == 0:
            mix = nsa_mixer(h, nsa_w_in[j], nsa_cmp_pe[j], nsa_cmp_w1[j], nsa_cmp_w2[j], nsa_w_out[j], cos, sin)
        else:
            mix = ssd_mixer(h, ssd_w_in[j], ssd_conv_w[j], ssd_conv_b[j], ssd_dt_bias[j], ssd_a_log[j],
                            ssd_d[j], ssd_norm[j], ssd_w_out[j])
        x = x + mix
        x = x + hier_moe(rms_norm(x, ln_ffn[i]), moe_w_group[i], moe_b_group[i], moe_w_expert[i],
                         moe_b_expert[i], moe_w_gate[i], moe_w_up[i], moe_w_down[i])
    return rms_norm(x, ln_final)
```

```cpp
#include <hip/hip_runtime.h>
#include <stdint.h>
#include <math.h>

#define DEV __device__ __forceinline__

constexpr int D_MODEL = 2048, BATCH = 4, SEQ = 2048, T = BATCH * SEQ;
constexpr int NH = 16, NKV = 4, DH = 128;
constexpr int NCMP = 127, CMP_HIDDEN = 256;
constexpr int NSLC = 32;
constexpr int WINDOW = 512;
constexpr int NSA_PROJ = 5168;
constexpr int OFF_Q = 0, OFF_KC = 2048, OFF_VC = 2560, OFF_KS = 3072, OFF_VS = 3584, OFF_KW = 4096, OFF_VW = 4608, OFF_G = 5120;
constexpr int SSD_DI = 4096, SSD_P = 64, SSD_H = 64, SSD_G = 8, SSD_N = 128, SSD_CONVCH = 6144, SSD_PROJ = 10304;
constexpr int OFF_Z = 0, OFF_XBC = 4096, OFF_DT = 10240;
constexpr int MOE_G = 4, MOE_EPG = 8, MOE_E = 32, MOE_FF = 512;
constexpr float NORM_EPS = 1e-6f;
constexpr int NTHREADS = 512;

struct P {
    const float *x, *ln_mix, *ln_ffn, *ln_final, *nsa_w_in, *nsa_cmp_pe, *nsa_cmp_w1, *nsa_cmp_w2, *nsa_w_out;
    const float *ssd_w_in, *ssd_conv_w, *ssd_conv_b, *ssd_dt_bias, *ssd_a_log, *ssd_d, *ssd_norm, *ssd_w_out;
    const float *moe_w_group, *moe_b_group, *moe_w_expert, *moe_b_expert, *moe_w_gate, *moe_w_up, *moe_w_down;
    float* out;
    float *xA, *xB, *hbuf, *proj, *r4, *r5;
    float* rope;
    float* h1;
    float* kvc;
    unsigned* selmask;
    int* cnt;
    int* list;
    float* ew;
    float* dtb;
};

DEV float wave_sum(float v) { for (int o = 32; o >= 1; o >>= 1) v += __shfl_xor(v, o); return v; }
DEV float wave_max(float v) { for (int o = 32; o >= 1; o >>= 1) v = fmaxf(v, __shfl_xor(v, o)); return v; }
DEV float siluf(float v) { return v / (1.f + expf(-v)); }
DEV float gelu_tanh(float v) { return 0.5f * v * (1.f + tanhf(0.7978845608028654f * (v + 0.044715f * v * v * v))); }

template <class CF, class AF, class BF, class EF>
DEV void ngemm(int ngroups, CF cntf, int N, int K, AF af, BF bf, EF ef, float* lds, int bid, int nb) {
    float* As = lds;
    float* Bs = lds + 16 * 132;
    int* pre = (int*)(lds + 16 * 132 + 16 * 68);
    const int tid = threadIdx.x, tx = tid & 15, ty = tid >> 4;
    const int tilesN = (N + 63) / 64;
    __syncthreads();
    if (tid == 0) { int s = 0; for (int g = 0; g < ngroups; ++g) { pre[g] = s; s += ((cntf(g) + 127) / 128) * tilesN; } pre[ngroups] = s; }
    __syncthreads();
    const int total = pre[ngroups];
    for (int tile = bid; tile < total; tile += nb) {
        int g = 0; while (g + 1 < ngroups && pre[g + 1] <= tile) ++g;
        const int lt = tile - pre[g], tm = lt / tilesN, tn = lt % tilesN, M = cntf(g);
        float acc[4][4];
#pragma unroll
        for (int i = 0; i < 4; ++i)
#pragma unroll
            for (int j = 0; j < 4; ++j) acc[i][j] = 0.f;
        for (int k0 = 0; k0 < K; k0 += 16) {
#pragma unroll
            for (int it = 0; it < 4; ++it) { const int i = tid + it * 512, m = i >> 4, k = i & 15, gm = tm * 128 + m; As[k * 132 + m] = (gm < M) ? af(g, gm, k0 + k) : 0.f; }
#pragma unroll
            for (int it = 0; it < 2; ++it) { const int i = tid + it * 512, k = i >> 6, n = i & 63, gn = tn * 64 + n; Bs[k * 68 + n] = (gn < N) ? bf(g, k0 + k, gn) : 0.f; }
            __syncthreads();
#pragma unroll
            for (int k = 0; k < 16; ++k) {
                const float4 a = *(const float4*)(As + k * 132 + ty * 4), b = *(const float4*)(Bs + k * 68 + tx * 4);
                const float av[4] = {a.x, a.y, a.z, a.w}, bv[4] = {b.x, b.y, b.z, b.w};
#pragma unroll
                for (int i = 0; i < 4; ++i)
#pragma unroll
                    for (int j = 0; j < 4; ++j) acc[i][j] = fmaf(av[i], bv[j], acc[i][j]);
            }
            __syncthreads();
        }
#pragma unroll
        for (int i = 0; i < 4; ++i)
#pragma unroll
            for (int j = 0; j < 4; ++j) { const int gm = tm * 128 + ty * 4 + i, gn = tn * 64 + tx * 4 + j; if (gm < M && gn < N) ef(g, gm, gn, acc[i][j]); }
    }
}

DEV void rows_norm(const float* src, const float* add0, const float* add1, float* sumdst, const float* g, float* dst, int bid, int nb) {
    const int lane = threadIdx.x & 63, wid = threadIdx.x >> 6;
    for (int row = bid * 8 + wid; row < T; row += nb * 8) {
        float4 v[8]; float ss = 0.f;
#pragma unroll
        for (int i = 0; i < 8; ++i) {
            const size_t o = (size_t)row * D_MODEL + i * 256 + lane * 4;
            float4 a = *(const float4*)(src + o);
            if (add0) { const float4 b = *(const float4*)(add0 + o), c = *(const float4*)(add1 + o); a.x += b.x + c.x; a.y += b.y + c.y; a.z += b.z + c.z; a.w += b.w + c.w; }
            if (sumdst) *(float4*)(sumdst + o) = a;
            v[i] = a; ss += a.x * a.x + a.y * a.y + a.z * a.z + a.w * a.w;
        }
        ss = wave_sum(ss);
        const float rinv = rsqrtf(ss * (1.f / D_MODEL) + NORM_EPS);
#pragma unroll
        for (int i = 0; i < 8; ++i) {
            const int c = i * 256 + lane * 4; const float4 gg = *(const float4*)(g + c);
            float4 o; o.x = v[i].x * rinv * gg.x; o.y = v[i].y * rinv * gg.y; o.z = v[i].z * rinv * gg.z; o.w = v[i].w * rinv * gg.w;
            *(float4*)(dst + (size_t)row * D_MODEL + c) = o;
        }
    }
}

DEV void ph_rope_table(const P& p, int bid, int nb) {
    for (int i = bid * NTHREADS + threadIdx.x; i < SEQ * 64; i += nb * NTHREADS) {
        const int pos = i >> 6, j = i & 63;
        const double inv = exp(-log(10000.0) * (double)j / 64.0);
        const float invf = (float)inv;
        const float ang = (float)pos * invf;
        p.rope[i * 2] = (float)cos((double)ang); p.rope[i * 2 + 1] = (float)sin((double)ang);
    }
}

DEV void ph_rope_apply(const P& p, int bid, int nb) {
    const int total = T * 28 * 64;
    for (int i = bid * NTHREADS + threadIdx.x; i < total; i += nb * NTHREADS) {
        const int j = i & 63, slot = (i >> 6) % 28, tok = i / (64 * 28), pos = tok % SEQ;
        int off;
        if (slot < 16) off = slot * 128; else if (slot < 20) off = OFF_KC + (slot - 16) * 128; else if (slot < 24) off = OFF_KS + (slot - 20) * 128; else off = OFF_KW + (slot - 24) * 128;
        float* r = p.proj + (size_t)tok * NSA_PROJ + off;
        const float c = p.rope[(pos * 64 + j) * 2], s = p.rope[(pos * 64 + j) * 2 + 1];
        const float x1 = r[j], x2 = r[j + 64];
        r[j] = x1 * c - x2 * s; r[j + 64] = x2 * c + x1 * s;
    }
}

DEV void ph_cmp_attn(const P& p, float* lds, int bid, int nb) {
    const int lane = threadIdx.x & 63, wid = threadIdx.x >> 6;
    float* qs = lds + wid * 640; float* ps = qs + 512;
    float* ocmp = p.r4;
    const float scale = 0.08838834764831845f;
    const float* kc = p.kvc; const float* vc = p.kvc + (size_t)2032 * 128;
    for (int u = bid * 8 + wid; u < T * NKV; u += nb * 8) {
        const int g = u & 3, tok = u >> 2, b = tok / SEQ, t = tok % SEQ;
        const int ncv = t >= 31 ? (t - 31) / 16 + 1 : 0;
        const float* qrow = p.proj + (size_t)tok * NSA_PROJ + g * 4 * 128;
#pragma unroll
        for (int i = 0; i < 8; ++i) qs[lane + 64 * i] = qrow[lane + 64 * i];
        float psum0 = 0.f, psum1 = 0.f;
        for (int r = 0; r < 4; ++r) {
            float s0 = -INFINITY, s1 = -INFINITY;
            if (lane < ncv) { const float* kr = kc + ((size_t)(b * NCMP + lane) * 4 + g) * 128; float a = 0.f; for (int d = 0; d < 128; ++d) a = fmaf(qs[r * 128 + d], kr[d], a); s0 = a * scale; }
            if (lane + 64 < ncv) { const float* kr = kc + ((size_t)(b * NCMP + lane + 64) * 4 + g) * 128; float a = 0.f; for (int d = 0; d < 128; ++d) a = fmaf(qs[r * 128 + d], kr[d], a); s1 = a * scale; }
            float p0 = 0.f, p1 = 0.f;
            if (ncv > 0) {
                const float m = wave_max(fmaxf(s0, s1));
                const float e0 = lane < ncv ? expf(s0 - m) : 0.f, e1 = lane + 64 < ncv ? expf(s1 - m) : 0.f;
                const float sum = wave_sum(e0 + e1);
                p0 = e0 / sum; p1 = e1 / sum;
            }
            psum0 += p0; psum1 += p1;
            float o0 = 0.f, o1 = 0.f;
            for (int c = 0; c < ncv; ++c) {
                const float pc = c < 64 ? __shfl(p0, c) : __shfl(p1, c - 64);
                const float* vr = vc + ((size_t)(b * NCMP + c) * 4 + g) * 128;
                o0 = fmaf(pc, vr[lane], o0); o1 = fmaf(pc, vr[lane + 64], o1);
            }
            float* orow = ocmp + (size_t)tok * 2048 + (g * 4 + r) * 128;
            orow[lane] = o0; orow[lane + 64] = o1;
        }
        ps[lane] = psum0; ps[lane + 64] = psum1;
        float val = -INFINITY;
        const int j = lane;
        if (j < 32) {
            float imp = ps[4 * j] + ps[4 * j + 1] + ps[4 * j + 2] + 0.5f * ps[4 * j + 3] + (j > 0 ? 0.5f * ps[4 * j - 1] : 0.f);
            const int dist = (t >> 6) - j;
            const bool forced = (j == 0) || (dist >= 0 && dist < 2);
            val = forced ? 1e4f : imp;
            if (dist < 0) val = -INFINITY;
        }
        int rank = 0;
        for (int i = 0; i < 32; ++i) { const float vi = __shfl(val, i); rank += (vi > val || (vi == val && i < j)) ? 1 : 0; }
        const unsigned long long bal = __ballot(j < 32 && rank < 16);
        if (lane == 0) p.selmask[(size_t)(b * NKV + g) * SEQ + t] = (unsigned)bal;
    }
}

DEV void attend_wave(const float* proj, const float* qs, int b, int g, int koff, int voff, unsigned bmask, int lo, int hi, int lane, float& o0, float& o1) {
    const float scale = 0.08838834764831845f;
    float m = -INFINITY, l = 0.f; o0 = 0.f; o1 = 0.f;
    for (int j = lo >> 6; j <= (hi >> 6); ++j) {
        if (!((bmask >> j) & 1u)) continue;
        const int key = j * 64 + lane; const bool valid = key >= lo && key <= hi;
        float s = -INFINITY;
        if (valid) { const float* kr = proj + (size_t)(b * SEQ + key) * NSA_PROJ + koff + g * 128; float a = 0.f;
            for (int d = 0; d < 128; d += 4) { const float4 kv = *(const float4*)(kr + d); a = fmaf(qs[d], kv.x, a); a = fmaf(qs[d + 1], kv.y, a); a = fmaf(qs[d + 2], kv.z, a); a = fmaf(qs[d + 3], kv.w, a); }
            s = a * scale; }
        const float bm = wave_max(s);
        if (bm == -INFINITY) continue;
        const float mn = fmaxf(m, bm), alpha = expf(m - mn);
        const float pr = valid ? expf(s - mn) : 0.f;
        l = l * alpha + wave_sum(pr); o0 *= alpha; o1 *= alpha; m = mn;
        for (int kk = 0; kk < 64; ++kk) {
            const float pk = __shfl(pr, kk);
            if (pk != 0.f) { const float* vr = proj + (size_t)(b * SEQ + j * 64 + kk) * NSA_PROJ + voff + g * 128; o0 = fmaf(pk, vr[lane], o0); o1 = fmaf(pk, vr[lane + 64], o1); }
        }
    }
    const float inv = 1.f / l; o0 *= inv; o1 *= inv;
}

DEV void ph_attn_sw(const P& p, float* lds, int bid, int nb) {
    const int lane = threadIdx.x & 63, wid = threadIdx.x >> 6;
    float* qs = lds + wid * 128;
    const float* ocmp = p.r4; float* obuf = p.r4 + (size_t)T * 2048;
    for (int u = bid * 8 + wid; u < T * NH; u += nb * 8) {
        const int h = u & 15, tok = u >> 4, b = tok / SEQ, t = tok % SEQ, g = h >> 2;
        const float* qrow = p.proj + (size_t)tok * NSA_PROJ + h * 128;
        qs[lane] = qrow[lane]; qs[lane + 64] = qrow[lane + 64];
        const unsigned sm = p.selmask[(size_t)(b * NKV + g) * SEQ + t];
        float s0, s1, w0, w1;
        attend_wave(p.proj, qs, b, g, OFF_KS, OFF_VS, sm, 0, t, lane, s0, s1);
        attend_wave(p.proj, qs, b, g, OFF_KW, OFF_VW, 0xffffffffu, t - (WINDOW - 1) > 0 ? t - (WINDOW - 1) : 0, t, lane, w0, w1);
        const float* gl = p.proj + (size_t)tok * NSA_PROJ + OFF_G + h * 3;
        const float g0 = 1.f / (1.f + expf(-gl[0])), g1 = 1.f / (1.f + expf(-gl[1])), g2 = 1.f / (1.f + expf(-gl[2]));
        const float* oc = ocmp + (size_t)tok * 2048 + h * 128;
        float* ob = obuf + (size_t)tok * 2048 + h * 128;
        ob[lane] = g0 * oc[lane] + g1 * s0 + g2 * w0;
        ob[lane + 64] = g0 * oc[lane + 64] + g1 * s1 + g2 * w1;
    }
}

DEV void ph_moe_route(const P& p, int layer, const float* xin, float* lds, int bid, int nb) {
    const int lane = threadIdx.x & 63, wid = threadIdx.x >> 6;
    float* hs = lds + wid * 2048;
    const float* g = p.ln_ffn + layer * D_MODEL;
    const float* wgrp = p.moe_w_group + (size_t)layer * D_MODEL * MOE_G; const float* wexp = p.moe_w_expert + (size_t)layer * D_MODEL * MOE_E;
    const float* bgrp = p.moe_b_group + layer * MOE_G; const float* bexp = p.moe_b_expert + layer * MOE_E;
    int* cnt = p.cnt + layer * MOE_E;
    for (int tok = bid * 8 + wid; tok < T; tok += nb * 8) {
        float4 v[8]; float ss = 0.f;
#pragma unroll
        for (int i = 0; i < 8; ++i) { v[i] = *(const float4*)(xin + (size_t)tok * D_MODEL + i * 256 + lane * 4); ss += v[i].x * v[i].x + v[i].y * v[i].y + v[i].z * v[i].z + v[i].w * v[i].w; }
        ss = wave_sum(ss);
        const float rinv = rsqrtf(ss * (1.f / D_MODEL) + NORM_EPS);
#pragma unroll
        for (int i = 0; i < 8; ++i) { const int c = i * 256 + lane * 4; const float4 gg = *(const float4*)(g + c);
            float4 o; o.x = v[i].x * rinv * gg.x; o.y = v[i].y * rinv * gg.y; o.z = v[i].z * rinv * gg.z; o.w = v[i].w * rinv * gg.w;
            *(float4*)(p.hbuf + (size_t)tok * D_MODEL + c) = o; *(float4*)(hs + c) = o; }
        float acc = 0.f;
        if (lane < 36) {
            const float* w = lane < 32 ? wexp + lane : wgrp + (lane - 32); const int st = lane < 32 ? MOE_E : MOE_G;
            for (int d = 0; d < D_MODEL; ++d) acc = fmaf(hs[d], w[(size_t)d * st], acc);
            acc += lane < 32 ? bexp[lane] : bgrp[lane - 32];
        }
        float gl[4]; for (int i = 0; i < 4; ++i) gl[i] = __shfl(acc, 32 + i);
        int gs = 0; float gm = gl[0]; for (int i = 1; i < 4; ++i) if (gl[i] > gm) { gm = gl[i]; gs = i; }
        float gsum = 0.f; for (int i = 0; i < 4; ++i) gsum += expf(gl[i] - gm);
        const float gw = 1.f / gsum;
        float ev[8]; for (int i = 0; i < 8; ++i) ev[i] = __shfl(acc, gs * 8 + i);
        int i1 = 0; for (int i = 1; i < 8; ++i) if (ev[i] > ev[i1]) i1 = i;
        int i2 = i1 == 0 ? 1 : 0; for (int i = 0; i < 8; ++i) if (i != i1 && ev[i] > ev[i2]) i2 = i;
        const float e2 = expf(ev[i2] - ev[i1]); const float w1 = gw / (1.f + e2), w2 = gw * e2 / (1.f + e2);
        if (lane == 0) {
            const int ea = gs * 8 + i1, eb = gs * 8 + i2;
            int pos = atomicAdd(&cnt[ea], 1); p.list[ea * T + pos] = tok * 2; p.ew[tok * 2] = w1;
            pos = atomicAdd(&cnt[eb], 1); p.list[eb * T + pos] = tok * 2 + 1; p.ew[tok * 2 + 1] = w2;
        }
    }
}

DEV void ph_conv(const P& p, int bid, int nb) {
    float* xbc = p.r4;
    const size_t total = (size_t)T * SSD_CONVCH;
    for (size_t i = (size_t)bid * NTHREADS + threadIdx.x; i < total; i += (size_t)nb * NTHREADS) {
        const int ch = (int)(i % SSD_CONVCH), tok = (int)(i / SSD_CONVCH), t = tok % SEQ;
        float a = p.ssd_conv_b[ch];
#pragma unroll
        for (int k = 0; k < 4; ++k) { const int tt = t - 3 + k; if (tt >= 0) a = fmaf(p.proj[(size_t)(tok - 3 + k) * SSD_PROJ + OFF_XBC + ch], p.ssd_conv_w[k * SSD_CONVCH + ch], a); }
        xbc[i] = siluf(a);
    }
    for (int i = bid * NTHREADS + threadIdx.x; i < T * SSD_H; i += nb * NTHREADS) {
        const int h = i & 63, tok = i >> 6;
        const float v = p.proj[(size_t)tok * SSD_PROJ + OFF_DT + h] + p.ssd_dt_bias[h];
        p.dtb[i] = v > 20.f ? v : log1pf(expf(v));
    }
}

DEV void ph_scan(const P& p, int bid, int nb) {
    const int lane = threadIdx.x & 63, wid = threadIdx.x >> 6;
    const float* xbc = p.r4; float* ybuf = p.r5;
    for (int u = bid * 8 + wid; u < BATCH * SSD_H * SSD_P; u += nb * 8) {
        const int pp = u & 63, h = (u >> 6) & 63, b = u >> 12, g = h >> 3;
        const float A = -expf(p.ssd_a_log[h]), Dh = p.ssd_d[h];
        float s0 = 0.f, s1 = 0.f;
        for (int t = 0; t < SEQ; ++t) {
            const size_t tok = (size_t)b * SEQ + t; const float* row = xbc + tok * SSD_CONVCH;
            const float dt = p.dtb[tok * 64 + h], xv = row[h * 64 + pp], dA = expf(dt * A), xdt = xv * dt;
            const float* Br = row + SSD_DI + g * 128; const float* Cr = row + SSD_DI + 1024 + g * 128;
            s0 = fmaf(s0, dA, xdt * Br[lane]); s1 = fmaf(s1, dA, xdt * Br[lane + 64]);
            float y = wave_sum(Cr[lane] * s0 + Cr[lane + 64] * s1);
            if (lane == 0) ybuf[tok * SSD_DI + h * 64 + pp] = y + Dh * xv;
        }
    }
}

DEV void ph_gatenorm(const P& p, int bid, int nb) {
    const int lane = threadIdx.x & 63, wid = threadIdx.x >> 6;
    float* ybuf = p.r5;
    for (int u = bid * 8 + wid; u < T * SSD_G; u += nb * 8) {
        const int g = u & 7, tok = u >> 3;
        float* yr = ybuf + (size_t)tok * SSD_DI + g * 512; const float* zr = p.proj + (size_t)tok * SSD_PROJ + OFF_Z + g * 512;
        float v[8]; float ss = 0.f;
#pragma unroll
        for (int i = 0; i < 8; ++i) { const int c = lane + 64 * i; v[i] = yr[c] * siluf(zr[c]); ss += v[i] * v[i]; }
        ss = wave_sum(ss);
        const float rinv = rsqrtf(ss * (1.f / 512.f) + NORM_EPS);
#pragma unroll
        for (int i = 0; i < 8; ++i) { const int c = lane + 64 * i; yr[c] = v[i] * rinv * p.ssd_norm[g * 512 + c]; }
    }
}

constexpr int NPHASE = 21;
template <int PH> DEV void run_phase(const P& p, float* lds, int bid, int nb) {
    auto one = [](int) { return T; };
    if constexpr (PH == 0) {
        ph_rope_table(p, bid, nb);
        if (bid == 0 && threadIdx.x < 64) p.cnt[threadIdx.x] = 0;
        rows_norm(p.x, nullptr, nullptr, nullptr, p.ln_mix, p.hbuf, bid, nb);
    } else if constexpr (PH == 1) {
        const float* h = p.hbuf; const float* w = p.nsa_w_in; float* o = p.proj;
        ngemm(1, one, NSA_PROJ, D_MODEL, [=](int, int m, int k) { return h[(size_t)m * D_MODEL + k]; }, [=](int, int k, int n) { return w[(size_t)k * NSA_PROJ + n]; },
              [=](int, int m, int n, float v) { o[(size_t)m * NSA_PROJ + n] = v; }, lds, bid, nb);
    } else if constexpr (PH == 2) {
        ph_rope_apply(p, bid, nb);
    } else if constexpr (PH == 3) {
        const float* pr = p.proj; const float* pe = p.nsa_cmp_pe; const float* w1 = p.nsa_cmp_w1; float* h1 = p.h1;
        ngemm(2, [](int) { return 2032; }, CMP_HIDDEN, 4096,
              [=](int g, int m, int k) { const int b = m / 508, rem = m % 508, c = rem >> 2, kvh = rem & 3, l = k >> 7, d = k & 127;
                  return pr[(size_t)(b * SEQ + 16 * c + l) * NSA_PROJ + (g ? OFF_VC : OFF_KC) + kvh * 128 + d] + pe[g * 4096 + k]; },
              [=](int g, int k, int n) { return w1[((size_t)g * 4096 + k) * CMP_HIDDEN + n]; },
              [=](int g, int m, int n, float v) { h1[((size_t)g * 2032 + m) * CMP_HIDDEN + n] = gelu_tanh(v); }, lds, bid, nb);
    } else if constexpr (PH == 4) {
        const float* h1 = p.h1; const float* w2 = p.nsa_cmp_w2; float* kvc = p.kvc;
        ngemm(2, [](int) { return 2032; }, 128, CMP_HIDDEN,
              [=](int g, int m, int k) { return h1[((size_t)g * 2032 + m) * CMP_HIDDEN + k]; },
              [=](int g, int k, int n) { return w2[((size_t)g * CMP_HIDDEN + k) * 128 + n]; },
              [=](int g, int m, int n, float v) { kvc[((size_t)g * 2032 + m) * 128 + n] = v; }, lds, bid, nb);
    } else if constexpr (PH == 5) {
        ph_cmp_attn(p, lds, bid, nb);
    } else if constexpr (PH == 6) {
        ph_attn_sw(p, lds, bid, nb);
    } else if constexpr (PH == 7) {
        const float* a = p.r4 + (size_t)T * 2048; const float* w = p.nsa_w_out; const float* xin = p.x; float* o = p.xB;
        ngemm(1, one, D_MODEL, 2048, [=](int, int m, int k) { return a[(size_t)m * 2048 + k]; }, [=](int, int k, int n) { return w[(size_t)k * D_MODEL + n]; },
              [=](int, int m, int n, float v) { o[(size_t)m * D_MODEL + n] = xin[(size_t)m * D_MODEL + n] + v; }, lds, bid, nb);
    } else if constexpr (PH == 8 || PH == 17) {
        ph_moe_route(p, PH == 8 ? 0 : 1, p.xB, lds, bid, nb);
    } else if constexpr (PH == 9 || PH == 18) {
        constexpr int L = PH == 9 ? 0 : 1;
        const int* cnt = p.cnt + L * MOE_E; const int* list = p.list; const float* h = p.hbuf; float* gu = p.r4;
        const float* wg = p.moe_w_gate + (size_t)L * MOE_E * D_MODEL * MOE_FF; const float* wu = p.moe_w_up + (size_t)L * MOE_E * D_MODEL * MOE_FF;
        auto rowbase = [=](int e) { int s = 0; for (int i = 0; i < e; ++i) s += cnt[i]; return s; };
        ngemm(MOE_E, [=](int e) { return cnt[e]; }, 2 * MOE_FF, D_MODEL,
              [=](int e, int m, int k) { return h[(size_t)(list[e * T + m] >> 1) * D_MODEL + k]; },
              [=](int e, int k, int n) { return n < MOE_FF ? wg[((size_t)e * D_MODEL + k) * MOE_FF + n] : wu[((size_t)e * D_MODEL + k) * MOE_FF + n - MOE_FF]; },
              [=](int e, int m, int n, float v) { gu[(size_t)(rowbase(e) + m) * (2 * MOE_FF) + n] = v; }, lds, bid, nb);
    } else if constexpr (PH == 10 || PH == 19) {
        constexpr int L = PH == 10 ? 0 : 1;
        const int* cnt = p.cnt + L * MOE_E; const int* list = p.list; const float* gu = p.r4; float* ys = p.r5; const float* ew = p.ew;
        const float* wd = p.moe_w_down + (size_t)L * MOE_E * MOE_FF * D_MODEL;
        auto rowbase = [=](int e) { int s = 0; for (int i = 0; i < e; ++i) s += cnt[i]; return s; };
        ngemm(MOE_E, [=](int e) { return cnt[e]; }, D_MODEL, MOE_FF,
              [=](int e, int m, int k) { const float* r = gu + (size_t)(rowbase(e) + m) * (2 * MOE_FF); return siluf(r[k]) * r[MOE_FF + k]; },
              [=](int e, int k, int n) { return wd[((size_t)e * MOE_FF + k) * D_MODEL + n]; },
              [=](int e, int m, int n, float v) { const int idx = list[e * T + m]; ys[(size_t)idx * D_MODEL + n] = v * ew[idx]; }, lds, bid, nb);
    } else if constexpr (PH == 11) {
        const float* ys = p.r5;
        const int lane = threadIdx.x & 63, wid = threadIdx.x >> 6;
        for (int row = bid * 8 + wid; row < T; row += nb * 8) {
            float4 v[8]; float ss = 0.f;
#pragma unroll
            for (int i = 0; i < 8; ++i) { const int c = i * 256 + lane * 4; float4 a = *(const float4*)(p.xB + (size_t)row * D_MODEL + c);
                const float4 y0 = *(const float4*)(ys + (size_t)(2 * row) * D_MODEL + c), y1 = *(const float4*)(ys + (size_t)(2 * row + 1) * D_MODEL + c);
                a.x += y0.x + y1.x; a.y += y0.y + y1.y; a.z += y0.z + y1.z; a.w += y0.w + y1.w;
                *(float4*)(p.xA + (size_t)row * D_MODEL + c) = a; v[i] = a; ss += a.x * a.x + a.y * a.y + a.z * a.z + a.w * a.w; }
            ss = wave_sum(ss); const float rinv = rsqrtf(ss * (1.f / D_MODEL) + NORM_EPS);
#pragma unroll
            for (int i = 0; i < 8; ++i) { const int c = i * 256 + lane * 4; const float4 gg = *(const float4*)(p.ln_mix + D_MODEL + c);
                float4 o; o.x = v[i].x * rinv * gg.x; o.y = v[i].y * rinv * gg.y; o.z = v[i].z * rinv * gg.z; o.w = v[i].w * rinv * gg.w;
                *(float4*)(p.hbuf + (size_t)row * D_MODEL + c) = o; }
        }
    } else if constexpr (PH == 12) {
        const float* h = p.hbuf; const float* w = p.ssd_w_in; float* o = p.proj;
        ngemm(1, one, SSD_PROJ, D_MODEL, [=](int, int m, int k) { return h[(size_t)m * D_MODEL + k]; }, [=](int, int k, int n) { return w[(size_t)k * SSD_PROJ + n]; },
              [=](int, int m, int n, float v) { o[(size_t)m * SSD_PROJ + n] = v; }, lds, bid, nb);
    } else if constexpr (PH == 13) {
        ph_conv(p, bid, nb);
    } else if constexpr (PH == 14) {
        ph_scan(p, bid, nb);
    } else if constexpr (PH == 15) {
        ph_gatenorm(p, bid, nb);
    } else if constexpr (PH == 16) {
        const float* a = p.r5; const float* w = p.ssd_w_out; const float* xin = p.xA; float* o = p.xB;
        ngemm(1, one, D_MODEL, SSD_DI, [=](int, int m, int k) { return a[(size_t)m * SSD_DI + k]; }, [=](int, int k, int n) { return w[(size_t)k * D_MODEL + n]; },
              [=](int, int m, int n, float v) { o[(size_t)m * D_MODEL + n] = xin[(size_t)m * D_MODEL + n] + v; }, lds, bid, nb);
    } else if constexpr (PH == 20) {
        const float* ys = p.r5;
        const int lane = threadIdx.x & 63, wid = threadIdx.x >> 6;
        for (int row = bid * 8 + wid; row < T; row += nb * 8) {
            float4 v[8]; float ss = 0.f;
#pragma unroll
            for (int i = 0; i < 8; ++i) { const int c = i * 256 + lane * 4; float4 a = *(const float4*)(p.xB + (size_t)row * D_MODEL + c);
                const float4 y0 = *(const float4*)(ys + (size_t)(2 * row) * D_MODEL + c), y1 = *(const float4*)(ys + (size_t)(2 * row + 1) * D_MODEL + c);
                a.x += y0.x + y1.x; a.y += y0.y + y1.y; a.z += y0.z + y1.z; a.w += y0.w + y1.w;
                v[i] = a; ss += a.x * a.x + a.y * a.y + a.z * a.z + a.w * a.w; }
            ss = wave_sum(ss); const float rinv = rsqrtf(ss * (1.f / D_MODEL) + NORM_EPS);
#pragma unroll
            for (int i = 0; i < 8; ++i) { const int c = i * 256 + lane * 4; const float4 gg = *(const float4*)(p.ln_final + c);
                float4 o; o.x = v[i].x * rinv * gg.x; o.y = v[i].y * rinv * gg.y; o.z = v[i].z * rinv * gg.z; o.w = v[i].w * rinv * gg.w;
                *(float4*)(p.out + (size_t)row * D_MODEL + c) = o; }
        }
    }
}

constexpr int LDS_BYTES = 8 * 2048 * 4;

template <int PH> __global__ __launch_bounds__(NTHREADS, 2) void k_phase(P p) {
    extern __shared__ __attribute__((aligned(16))) float lds[];
    run_phase<PH>(p, lds, blockIdx.x, gridDim.x);
}

template <int PH> static void launch_all(const P& p, hipStream_t stream) {
    if constexpr (PH < NPHASE) {
        hipLaunchKernelGGL(k_phase<PH>, dim3(1024), dim3(NTHREADS), LDS_BYTES, stream, p);
        launch_all<PH + 1>(p, stream);
    }
}

extern "C" void kernel_launch(void* const* d_in, const int* in_sizes, int n_in, void* d_out, int out_size, void* d_ws, size_t ws_size, hipStream_t stream) {
    P p{};
    const float* const* in = (const float* const*)d_in;
    p.x = in[0]; p.ln_mix = in[1]; p.ln_ffn = in[2]; p.ln_final = in[3]; p.nsa_w_in = in[4]; p.nsa_cmp_pe = in[5]; p.nsa_cmp_w1 = in[6]; p.nsa_cmp_w2 = in[7]; p.nsa_w_out = in[8];
    p.ssd_w_in = in[9]; p.ssd_conv_w = in[10]; p.ssd_conv_b = in[11]; p.ssd_dt_bias = in[12]; p.ssd_a_log = in[13]; p.ssd_d = in[14]; p.ssd_norm = in[15]; p.ssd_w_out = in[16];
    p.moe_w_group = in[17]; p.moe_b_group = in[18]; p.moe_w_expert = in[19]; p.moe_b_expert = in[20]; p.moe_w_gate = in[21]; p.moe_w_up = in[22]; p.moe_w_down = in[23];
    p.out = (float*)d_out;
    char* w = (char*)d_ws; size_t off = 0;
    auto take = [&](size_t bytes) { char* r = w + off; off += (bytes + 255) & ~(size_t)255; return r; };
    p.xA = (float*)take((size_t)T * D_MODEL * 4);
    p.xB = (float*)take((size_t)T * D_MODEL * 4);
    p.hbuf = (float*)take((size_t)T * D_MODEL * 4);
    p.proj = (float*)take((size_t)T * SSD_PROJ * 4);
    p.r4 = (float*)take((size_t)T * SSD_CONVCH * 4);
    p.r5 = (float*)take((size_t)T * SSD_DI * 4);
    p.rope = (float*)take((size_t)SEQ * 64 * 2 * 4);
    p.h1 = (float*)take((size_t)2 * 2032 * CMP_HIDDEN * 4);
    p.kvc = (float*)take((size_t)2 * 2032 * 128 * 4);
    p.selmask = (unsigned*)take((size_t)BATCH * NKV * SEQ * 4);
    p.cnt = (int*)take(64 * 4);
    p.list = (int*)take((size_t)MOE_E * T * 4);
    p.ew = (float*)take((size_t)T * 2 * 4);
    p.dtb = (float*)take((size_t)T * 64 * 4);
    static bool attr = false;
    if (!attr) { attr = true; }
    launch_all<0>(p, stream);
}
```

```cpp
#include <hip/hip_runtime.h>
#include <stdint.h>
#include <math.h>
#include <cstdio>

#define DEV __device__ __forceinline__

constexpr int D_MODEL = 2048, BATCH = 4, SEQ = 2048, T = BATCH * SEQ;
constexpr int NH = 16, NKV = 4, DH = 128;
constexpr int NCMP = 127, CMP_HIDDEN = 256;
constexpr int NSLC = 32;
constexpr int WINDOW = 512;
constexpr int NSA_PROJ = 5168, NSA_PROJ_P = 5376;
constexpr int OFF_Q = 0, OFF_KC = 2048, OFF_VC = 2560, OFF_KS = 3072, OFF_VS = 3584, OFF_KW = 4096, OFF_VW = 4608, OFF_G = 5120;
constexpr int SSD_DI = 4096, SSD_P = 64, SSD_H = 64, SSD_G = 8, SSD_N = 128, SSD_CONVCH = 6144, SSD_PROJ = 10304, SSD_PROJ_P = 10496;
constexpr int OFF_Z = 0, OFF_XBC = 4096, OFF_DT = 10240;
constexpr int MOE_G = 4, MOE_EPG = 8, MOE_E = 32, MOE_FF = 512;
constexpr float NORM_EPS = 1e-6f;
constexpr int NTHREADS = 512;
typedef unsigned short bf16_t;


struct P {
    const float *x, *ln_mix, *ln_ffn, *ln_final, *nsa_w_in, *nsa_cmp_pe, *nsa_cmp_w1, *nsa_cmp_w2, *nsa_w_out;
    const float *ssd_w_in, *ssd_conv_w, *ssd_conv_b, *ssd_dt_bias, *ssd_a_log, *ssd_d, *ssd_norm, *ssd_w_out;
    const float *moe_w_group, *moe_b_group, *moe_w_expert, *moe_b_expert, *moe_w_gate, *moe_w_up, *moe_w_down;
    float* out;
    bf16_t *wt_nsa_in, *wt_nsa_out, *wt_ssd_in, *wt_ssd_out, *wt_gu, *wt_d, *wt_cmp1, *wt_cmp2;
    float *xA, *xB; bf16_t* hb16;
    char* big;
    float* rope;
    float* h1;
    float* kvc;
    unsigned* selmask;
    int* cnt;
    int* list;
    float* ew;
    float* dtb;
    float *wr, *wgq;
    unsigned* bar;
};
constexpr size_t BIG_NSA_Q = 0, BIG_NSA_KS = (size_t)T * 2048 * 2, BIG_NSA_VS = BIG_NSA_KS + (size_t)T * 512 * 2, BIG_NSA_KW = BIG_NSA_VS + (size_t)T * 512 * 2, BIG_NSA_VW = BIG_NSA_KW + (size_t)T * 512 * 2,
    BIG_NSA_ACMP = BIG_NSA_VW + (size_t)T * 512 * 2, BIG_NSA_H1 = BIG_NSA_ACMP + (size_t)2 * 2048 * 4096 * 2, BIG_NSA_KVC = BIG_NSA_H1 + (size_t)2 * 2048 * 256 * 2,
    BIG_NSA_GATE = BIG_NSA_KVC + (size_t)2 * 2048 * 128 * 2, BIG_NSA_OCMP = BIG_NSA_GATE + (size_t)T * 48 * 4, BIG_NSA_OBUF = BIG_NSA_OCMP + (size_t)T * 2048 * 4;
constexpr size_t BIG_MOE_ACT = 0, BIG_MOE_YS = (size_t)(2 * T + 256) * MOE_FF * 2;
constexpr size_t BIG_SSD_Z = 0, BIG_SSD_XBCP = (size_t)T * SSD_DI * 2, BIG_SSD_YN = BIG_SSD_XBCP + (size_t)T * SSD_CONVCH * 2, BIG_SSD_BC = BIG_SSD_YN + (size_t)T * SSD_DI * 2;
constexpr size_t BIG_SSD_TABG = BIG_SSD_BC + (size_t)T * 2048 * 2;
constexpr size_t BIG_BYTES = BIG_SSD_TABG + (size_t)256 * 16 * 640 * 4;
static_assert(BIG_NSA_OBUF + (size_t)T * 2048 * 2 <= BIG_BYTES && BIG_MOE_YS + (size_t)2 * T * D_MODEL * 4 <= BIG_BYTES, "big region");

DEV int tidx() { int t = threadIdx.x; asm volatile("" : "+v"(t)); return t; }
DEV float swap_pair(float v) { return __int_as_float(__builtin_amdgcn_mov_dpp(__float_as_int(v), 0xB1, 0xF, 0xF, true)); }
DEV float wave_sum(float v) { for (int o = 32; o >= 1; o >>= 1) v += __shfl_xor(v, o); return v; }
DEV float wave_max(float v) { for (int o = 32; o >= 1; o >>= 1) v = fmaxf(v, __shfl_xor(v, o)); return v; }
DEV float siluf(float v) { return v / (1.f + expf(-v)); }
DEV float gelu_tanh(float v) { return 0.5f * v * (1.f + tanhf(0.7978845608028654f * (v + 0.044715f * v * v * v))); }
DEV float bf2f(bf16_t b) { return __uint_as_float(((unsigned)b) << 16); }
DEV bf16_t f2bf(float f) { unsigned u = __float_as_uint(f); u += 0x7FFFu + ((u >> 16) & 1u); return (bf16_t)(u >> 16); }

template <class CF, class AF, class BF, class EF>
DEV void ngemm(int ngroups, CF cntf, int N, int K, AF af, BF bf, EF ef, float* lds, int bid, int nb) {
    float* As = lds;
    float* Bs = lds + 16 * 132;
    int* pre = (int*)(lds + 16 * 132 + 16 * 68);
    const int tid = tidx(), tx = tid & 15, ty = tid >> 4;
    const int tilesN = (N + 63) / 64;
    __syncthreads();
    if (tid == 0) { int s = 0; for (int g = 0; g < ngroups; ++g) { pre[g] = s; s += ((cntf(g) + 127) / 128) * tilesN; } pre[ngroups] = s; }
    __syncthreads();
    const int total = pre[ngroups];
    for (int tile = bid; tile < total; tile += nb) {
        int g = 0; while (g + 1 < ngroups && pre[g + 1] <= tile) ++g;
        const int lt = tile - pre[g], tm = lt / tilesN, tn = lt % tilesN, M = cntf(g);
        float acc[4][4];
#pragma unroll
        for (int i = 0; i < 4; ++i)
#pragma unroll
            for (int j = 0; j < 4; ++j) acc[i][j] = 0.f;
        for (int k0 = 0; k0 < K; k0 += 16) {
#pragma unroll
            for (int it = 0; it < 4; ++it) { const int i = tid + it * 512, m = i >> 4, k = i & 15, gm = tm * 128 + m; As[k * 132 + m] = (gm < M) ? af(g, gm, k0 + k) : 0.f; }
#pragma unroll
            for (int it = 0; it < 2; ++it) { const int i = tid + it * 512, k = i >> 6, n = i & 63, gn = tn * 64 + n; Bs[k * 68 + n] = (gn < N) ? bf(g, k0 + k, gn) : 0.f; }
            __syncthreads();
#pragma unroll
            for (int k = 0; k < 16; ++k) {
                const float4 a = *(const float4*)(As + k * 132 + ty * 4), b = *(const float4*)(Bs + k * 68 + tx * 4);
                const float av[4] = {a.x, a.y, a.z, a.w}, bv[4] = {b.x, b.y, b.z, b.w};
#pragma unroll
                for (int i = 0; i < 4; ++i)
#pragma unroll
                    for (int j = 0; j < 4; ++j) acc[i][j] = fmaf(av[i], bv[j], acc[i][j]);
            }
            __syncthreads();
        }
#pragma unroll
        for (int i = 0; i < 4; ++i)
#pragma unroll
            for (int j = 0; j < 4; ++j) { const int gm = tm * 128 + ty * 4 + i, gn = tn * 64 + tx * 4 + j; if (gm < M && gn < N) ef(g, gm, gn, acc[i][j]); }
    }
}

#define MG_LAS __attribute__((address_space(3)))

typedef short bf16x8 __attribute__((ext_vector_type(8)));
typedef float f32x4 __attribute__((ext_vector_type(4)));
typedef unsigned u32x4 __attribute__((ext_vector_type(4)));
typedef unsigned u32x2 __attribute__((ext_vector_type(2)));
typedef int i32x8 __attribute__((ext_vector_type(8)));
typedef int i32x4 __attribute__((ext_vector_type(4)));
DEV unsigned pk8(float a, float b, float c, float d) {
    a = __builtin_amdgcn_fmed3f(a, -448.f, 448.f); b = __builtin_amdgcn_fmed3f(b, -448.f, 448.f); c = __builtin_amdgcn_fmed3f(c, -448.f, 448.f); d = __builtin_amdgcn_fmed3f(d, -448.f, 448.f);
    int w = __builtin_amdgcn_cvt_pk_fp8_f32(a, b, 0, false); w = __builtin_amdgcn_cvt_pk_fp8_f32(c, d, w, true); return (unsigned)w; }
constexpr float F8_SX = 4.f, F8_SW = 256.f, F8_SACT = 8.f;
namespace mg {
constexpr int BM = 256, BK = 64, HALF = 128, HTB = HALF * BK * 2, STAGE_BYTES = 8 * HTB, NXCD = 8, WGM = 8;
DEV int lds_byte(int r, int c) { const int st = (r >> 4) * 2 + (c >> 5), rr = r & 15, cc = c & 31, ob = rr * 64 + cc * 2; return st * 1024 + (ob ^ (((ob >> 9) & 1) << 5)); }
DEV void stage_rc(int b, int& R, int& C) { const int st = b / 1024, sb = b % 1024, swz = sb ^ (((sb >> 9) & 1) << 5); R = (st >> 1) * 16 + swz / 64; C = (st & 1) * 32 + (swz % 64) / 2; }
DEV int perm32(int rho) { const int n = rho >> 4, i = rho & 15; return 8 * (i >> 2) + 4 * n + (i & 3); }
DEV unsigned cvt_pk_bf16(float lo, float hi) { unsigned r; asm volatile("v_cvt_pk_bf16_f32 %0, %1, %2" : "=v"(r) : "v"(lo), "v"(hi)); return r; }
struct Unit { int g, pm, pn; };

struct StaticOrder {
    int nM, nN, nwg, G, c;
    DEV void init(int M, int N, int G_, int c_) { nM = M / BM; nN = N / BM; nwg = nM * nN; G = G_; c = c_; }
    DEV bool next(int i, Unit& u) const {
        const long L = (long)i * G + c; if (L >= nwg) return false;
        int wgid = (int)L; { const int q = nwg / NXCD, r = nwg % NXCD, xcd = wgid % NXCD, off = wgid / NXCD; wgid = (xcd < r ? xcd * (q + 1) : r * (q + 1) + (xcd - r) * q) + off; }
        const int nig = WGM * nN, gid = wgid / nig, fm = gid * WGM, gsz = (nM - fm) < WGM ? (nM - fm) : WGM;
        u.g = 0; u.pm = fm + ((wgid % nig) % gsz); u.pn = (wgid % nig) / gsz; return true;
    }
};
struct GroupedOrder {
    const int* pre; int ng, nN, G, c;
    DEV bool next(int i, Unit& u) const {
        const int L = i * G + c; if (L >= pre[ng] * nN) return false;
        const int mt = L / nN; u.pn = L - mt * nN; int g = 0; while (g + 1 < ng && pre[g + 1] <= mt) ++g;
        u.g = __builtin_amdgcn_readfirstlane(g); u.pm = __builtin_amdgcn_readfirstlane(mt - pre[g]); u.pn = __builtin_amdgcn_readfirstlane(u.pn); return true;
    }
};
struct FixedGroups {
    int ng, mt, nN, G, c;
    DEV bool next(int i, Unit& u) const { const int L = i * G + c; if (L >= ng * mt * nN) return false; u.pn = L % nN; const int r = L / nN; u.pm = r % mt; u.g = r / mt; return true; }
};
struct AGrouped { static constexpr bool GATHER = false; const bf16_t* A; int lda; size_t gstride; DEV const char* ubase(const Unit& u) const { return (const char*)(A + (size_t)u.g * gstride + (size_t)u.pm * BM * lda); } DEV unsigned rowoff(const Unit&, int r) const { return (unsigned)(r * lda) * 2u; } };
struct APlain { static constexpr bool GATHER = false; const bf16_t* A; int lda; DEV const char* ubase(const Unit& u) const { return (const char*)(A + (size_t)u.pm * BM * lda); } DEV unsigned rowoff(const Unit&, int r) const { return (unsigned)(r * lda) * 2u; } };
struct BPlain { const bf16_t* Bt; int ldb; size_t gstride; DEV const char* base(const Unit& u) const { return (const char*)(Bt + (size_t)u.g * gstride + (size_t)u.pn * BM * ldb); } };

template <bool FP8 = false, int DS = 0  , class AOp, class BOp, class Epi, class Sched>
DEV void gemm_phase(MG_LAS unsigned char* lds, const int K, const AOp& aop, const BOp& bop, const Sched& S, const Epi& E) {
    int tid_ = tidx();
    const int tid = tid_, wid = __builtin_amdgcn_readfirstlane(tid >> 6), lane = tid & 63, wr = wid >> 2, wc = wid & 3, fr = lane & 15, fq = lane >> 4;
    int nt = K / BK; asm volatile("" : "+s"(nt));
    unsigned voffB[2];
#pragma unroll
    for (int i = 0; i < 2; ++i) { int R, C; stage_rc(tid * 16 + i * 8192, R, C); const int Rb = Epi::PERM ? ((R & ~31) + perm32(R & 31)) : R; voffB[i] = (unsigned)(Rb * bop.ldb + C) * 2u; }
#define MG_ROWOFFS(dst, unit) do { _Pragma("unroll") for (int _h = 0; _h < 2; ++_h) _Pragma("unroll") for (int _i = 0; _i < 2; ++_i) { int _R, _C; stage_rc(tid * 16 + _i * 8192, _R, _C); dst[_h][_i] = aop.rowoff(unit, _h * HALF + _R) + (unsigned)(_C * 2); } } while (0)
    const size_t kstep = (size_t)(BK * 2);
    const size_t hstepB = (size_t)HALF * bop.ldb * 2;
    const unsigned ldsw = (unsigned)wid * 1024u;
    const int aoff = lds_byte(wr * 64 + fr, fq * 8), boff = lds_byte(wc * 32 + fr, fq * 8);
#define MG_SA(b, h) (((b) * 2 + (h)) * HTB)
#define MG_SB(b, h) ((4 + (b) * 2 + (h)) * HTB)
#define MG_STAGE(bufoff, gbase, voff) do { _Pragma("unroll") for (int _i = 0; _i < 2; ++_i) \
        __builtin_amdgcn_global_load_lds((const unsigned*)((const char*)(gbase) + (voff)[_i]), (MG_LAS unsigned*)(lds + (bufoff) + ldsw + _i * 8192), 16, 0, 0); } while (0)
#define MG_LDA(dst, b, h) do { if constexpr (FP8) { _Pragma("unroll") for (int m = 0; m < 4; ++m) { dst##8[m].lo = *(const MG_LAS i32x4*)(lds + MG_SA(b, h) + aoff + m * 2048); dst##8[m].hi = *(const MG_LAS i32x4*)(lds + MG_SA(b, h) + aoff + m * 2048 + 1024); } } else { \
        _Pragma("unroll") for (int m = 0; m < 4; ++m) _Pragma("unroll") for (int k = 0; k < 2; ++k) dst[m][k] = *(const MG_LAS bf16x8*)(lds + MG_SA(b, h) + aoff + m * 2048 + k * 1024); } } while (0)
#define MG_LDB(dst, b, h) do { if constexpr (FP8) { _Pragma("unroll") for (int n = 0; n < 2; ++n) { dst##8[n].lo = *(const MG_LAS i32x4*)(lds + MG_SB(b, h) + boff + n * 2048); dst##8[n].hi = *(const MG_LAS i32x4*)(lds + MG_SB(b, h) + boff + n * 2048 + 1024); } } else { \
        _Pragma("unroll") for (int n = 0; n < 2; ++n) _Pragma("unroll") for (int k = 0; k < 2; ++k) dst[n][k] = *(const MG_LAS bf16x8*)(lds + MG_SB(b, h) + boff + n * 2048 + k * 1024); } } while (0)
#define MG_MMA(ai, bj, At, Bt) do { __builtin_amdgcn_s_setprio(1); if constexpr (FP8) { _Pragma("unroll") for (int m = 0; m < 4; ++m) _Pragma("unroll") for (int n = 0; n < 2; ++n) \
        asm volatile("v_mfma_f32_16x16x128_f8f6f4 %0, %1, %2, %0" : "+v"(acc[ai][bj][m][n]) : "v"(Bt##8[n]), "v"(At##8[m])); } else {     \
        _Pragma("unroll") for (int m = 0; m < 4; ++m) _Pragma("unroll") for (int n = 0; n < 2; ++n) _Pragma("unroll") for (int k = 0; k < 2; ++k) \
        acc[ai][bj][m][n] = __builtin_amdgcn_mfma_f32_16x16x32_bf16(Bt[n][k], At[m][k], acc[ai][bj][m][n], 0, 0, 0); } __builtin_amdgcn_s_setprio(0); } while (0)
#define MG_WAIT_V(n) asm volatile("s_waitcnt vmcnt(" #n ")" ::: "memory")
#define MG_WAIT_L(n) asm volatile("s_waitcnt lgkmcnt(" #n ")" ::: "memory")
#define MG_BAR __builtin_amdgcn_s_barrier()
#define MG_SCHED __builtin_amdgcn_sched_barrier(0)
    Unit cur, nxt; int ui = 0;
    if (!S.next(0, cur)) return;
    f32x4 acc[2][2][4][2];
#define MG_ACC_INIT(unit) do { if constexpr (Epi::ACC_INIT) E.init(acc, unit, wr, wc, fr, fq); else { \
        _Pragma("unroll") for (int a = 0; a < 2; ++a) _Pragma("unroll") for (int b = 0; b < 2; ++b) _Pragma("unroll") for (int m = 0; m < 4; ++m) _Pragma("unroll") for (int n = 0; n < 2; ++n) acc[a][b][m][n] = (f32x4){0.f, 0.f, 0.f, 0.f}; } } while (0)
    MG_ACC_INIT(cur);
    bf16x8 At[4][2], B0[2][2], B1[2][2];
    i32x8 At8[4], B08[2], B18[2];
    unsigned vAc[2][2], vAn[2][2];
    MG_ROWOFFS(vAc, cur);
    const char* cA = aop.ubase(cur); const char* cB = bop.base(cur);
    MG_STAGE(MG_SB(0, 0), cB, voffB); MG_STAGE(MG_SA(0, 0), cA, vAc[0]); MG_STAGE(MG_SB(0, 1), cB + hstepB, voffB); MG_STAGE(MG_SA(0, 1), cA, vAc[1]);
    if (wr == 1) MG_BAR;
    MG_WAIT_V(4); MG_BAR;
    MG_STAGE(MG_SB(1, 0), cB + kstep, voffB); MG_STAGE(MG_SA(1, 0), cA + kstep, vAc[0]); MG_STAGE(MG_SB(1, 1), cB + hstepB + kstep, voffB);
    MG_WAIT_V(6); MG_BAR;
    for (;;) {
        const bool has_next = S.next(ui + 1, nxt);
        const char* nB = has_next ? bop.base(nxt) : cB; const char* nA = has_next ? aop.ubase(nxt) : cA;
        if constexpr (AOp::GATHER) { if (has_next) MG_ROWOFFS(vAn, nxt); else {
#pragma unroll
            for (int h = 0; h < 2; ++h)
#pragma unroll
                for (int i = 0; i < 2; ++i) vAn[h][i] = vAc[h][i]; } }
        for (int t = 0; t < nt; t += 2) {
            const bool last = (t == nt - 2);
            const char* a1 = cA + (size_t)(t + 1) * kstep;
            const char* a2 = last ? nA : cA + (size_t)(t + 2) * kstep; const char* b2 = last ? nB : cB + (size_t)(t + 2) * kstep;
            const char* a3 = a2 + kstep; const char* b3 = b2 + kstep;
            MG_LDB(B0, 0, 0); MG_SCHED; MG_LDA(At, 0, 0); MG_STAGE(MG_SA(1, 1), a1, vAc[1]);
            if constexpr (AOp::GATHER) { if (last) {
#pragma unroll
                for (int h = 0; h < 2; ++h)
#pragma unroll
                    for (int i = 0; i < 2; ++i) vAc[h][i] = vAn[h][i]; } }
            MG_WAIT_L(8); MG_BAR; MG_WAIT_L(0); MG_MMA(0, 0, At, B0); MG_BAR; MG_SCHED;
            MG_LDB(B1, 0, 1); MG_STAGE(MG_SB(0, 0), b2, voffB);
            MG_BAR; MG_WAIT_L(0); MG_MMA(0, 1, At, B1); MG_BAR;
            MG_LDA(At, 0, 1); MG_STAGE(MG_SA(0, 0), a2, vAc[0]);
            MG_BAR; MG_WAIT_L(0); MG_MMA(1, 0, At, B0); MG_BAR; MG_SCHED;
            MG_STAGE(MG_SB(0, 1), b2 + hstepB, voffB);
            MG_WAIT_V(6); MG_BAR; MG_MMA(1, 1, At, B1); MG_BAR;
            MG_LDB(B0, 1, 0); MG_SCHED; MG_LDA(At, 1, 0); MG_STAGE(MG_SA(0, 1), a2, vAc[1]);
            MG_WAIT_L(8); MG_BAR; MG_WAIT_L(0); MG_MMA(0, 0, At, B0); MG_BAR; MG_SCHED;
            MG_LDB(B1, 1, 1); MG_STAGE(MG_SB(1, 0), b3, voffB);
            MG_BAR; MG_WAIT_L(0); MG_MMA(0, 1, At, B1); MG_BAR;
            MG_LDA(At, 1, 1); MG_STAGE(MG_SA(1, 0), a3, vAc[0]);
            MG_BAR; MG_WAIT_L(0); MG_MMA(1, 0, At, B0); MG_BAR; MG_SCHED;
            MG_STAGE(MG_SB(1, 1), b3 + hstepB, voffB);
            MG_WAIT_V(6); MG_BAR; MG_MMA(1, 1, At, B1); MG_BAR;
        }
        __builtin_amdgcn_sched_barrier(0); asm volatile("s_nop 15\n\ts_nop 15" ::: "memory"); __builtin_amdgcn_sched_barrier(0);
        if constexpr (DS != 0) {
#pragma unroll
            for (int a = 0; a < 2; ++a)
#pragma unroll
                for (int b = 0; b < 2; ++b)
#pragma unroll
                    for (int m = 0; m < 4; ++m)
#pragma unroll
                        for (int n = 0; n < 2; ++n) acc[a][b][m][n] *= (1.f / (float)(1 << DS)); }
        { int fr2 = fr, fq2 = fq; asm volatile("" : "+v"(fr2), "+v"(fq2));
          E(acc, cur, wr, wc, fr2, fq2); }
        if (!has_next) break;
        MG_ACC_INIT(nxt);
        cur = nxt; cB = nB; cA = nA; ++ui;
    }
    MG_WAIT_V(0);
    if (wr == 0) MG_BAR;
    MG_BAR;
#undef MG_ROWOFFS
#undef MG_ACC_INIT
#undef MG_SA
#undef MG_SB
#undef MG_STAGE
#undef MG_LDA
#undef MG_LDB
#undef MG_MMA
#undef MG_WAIT_V
#undef MG_WAIT_L
#undef MG_BAR
#undef MG_SCHED
}
}
#define EPI_ROWS_BEGIN _Pragma("unroll") for (int ai = 0; ai < 2; ++ai) _Pragma("unroll") for (int m = 0; m < 4; ++m) { const int rt = ai * 128 + wr * 64 + m * 16 + fr;
#define EPI_ROWS_END }
struct EpiF32 {
    static constexpr bool PERM = false, ACC_INIT = false;
    float* C; int ldc, nvalid;
    DEV void operator()(const f32x4 (&acc)[2][2][4][2], const mg::Unit& u, int wr, int wc, int fr, int fq) const {
        EPI_ROWS_BEGIN float* rowp = C + (size_t)(u.pm * 256 + rt) * ldc;
#pragma unroll
            for (int bj = 0; bj < 2; ++bj)
#pragma unroll
                for (int n = 0; n < 2; ++n) { const int col = u.pn * 256 + bj * 128 + wc * 32 + n * 16 + 4 * fq; if (col < nvalid) *(f32x4*)(rowp + col) = acc[ai][bj][m][n]; }
        EPI_ROWS_END
    }
};
template <bool RB16>
struct EpiResid {
    static constexpr bool PERM = true, ACC_INIT = true;
    const void* __restrict__ resid; bf16_t* __restrict__ out;
    DEV void init(f32x4 (&acc)[2][2][4][2], const mg::Unit& u, int wr, int wc, int fr, int fq) const {
#pragma unroll
        for (int ai = 0; ai < 2; ++ai)
#pragma unroll
            for (int m = 0; m < 4; ++m) { const size_t ro = (size_t)(u.pm * 256 + ai * 128 + wr * 64 + m * 16 + fr) * D_MODEL;
#pragma unroll
                for (int bj = 0; bj < 2; ++bj) { const size_t o = ro + u.pn * 256 + bj * 128 + wc * 32 + 8 * fq;
                    if constexpr (RB16) { const u32x4 w = __builtin_nontemporal_load((const u32x4*)((const bf16_t*)resid + o));
                        acc[ai][bj][m][0] = (f32x4){__uint_as_float(w.x << 16), __uint_as_float(w.x & 0xffff0000u), __uint_as_float(w.y << 16), __uint_as_float(w.y & 0xffff0000u)};
                        acc[ai][bj][m][1] = (f32x4){__uint_as_float(w.z << 16), __uint_as_float(w.z & 0xffff0000u), __uint_as_float(w.w << 16), __uint_as_float(w.w & 0xffff0000u)}; }
                    else { acc[ai][bj][m][0] = __builtin_nontemporal_load((const f32x4*)((const float*)resid + o)); acc[ai][bj][m][1] = __builtin_nontemporal_load((const f32x4*)((const float*)resid + o + 4)); } } }
    }
    DEV void operator()(const f32x4 (&acc)[2][2][4][2], const mg::Unit& u, int wr, int wc, int fr, int fq) const {
#pragma unroll
        for (int ai = 0; ai < 2; ++ai)
#pragma unroll
            for (int m = 0; m < 4; ++m) { const size_t ro = (size_t)(u.pm * 256 + ai * 128 + wr * 64 + m * 16 + fr) * D_MODEL;
#pragma unroll
                for (int bj = 0; bj < 2; ++bj) { const f32x4 v0 = acc[ai][bj][m][0], v1 = acc[ai][bj][m][1];
                    u32x4 w; w.x = mg::cvt_pk_bf16(v0[0], v0[1]); w.y = mg::cvt_pk_bf16(v0[2], v0[3]); w.z = mg::cvt_pk_bf16(v1[0], v1[1]); w.w = mg::cvt_pk_bf16(v1[2], v1[3]);
                    *(u32x4*)(out + ro + u.pn * 256 + bj * 128 + wc * 32 + 8 * fq) = w; } }
    }
};
struct EpiSsdIn {
    static constexpr bool PERM = true, ACC_INIT = false;
    bf16_t* z; bf16_t* xbc; float* dtb; const float* dt_bias;
    DEV void operator()(const f32x4 (&acc)[2][2][4][2], const mg::Unit& u, int wr, int wc, int fr, int fq) const {
        if (u.pn < OFF_DT / 256) {
            EPI_ROWS_BEGIN const int row = u.pm * 256 + rt;
#pragma unroll
                for (int bj = 0; bj < 2; ++bj) { const int col = u.pn * 256 + bj * 128 + wc * 32 + 8 * fq; const f32x4 v0 = acc[ai][bj][m][0], v1 = acc[ai][bj][m][1];
                    u32x4 w; w.x = mg::cvt_pk_bf16(v0[0], v0[1]); w.y = mg::cvt_pk_bf16(v0[2], v0[3]); w.z = mg::cvt_pk_bf16(v1[0], v1[1]); w.w = mg::cvt_pk_bf16(v1[2], v1[3]);
                    bf16_t* dst = col < OFF_XBC ? z + (size_t)row * SSD_DI + col : xbc + (size_t)row * SSD_CONVCH + (col - OFF_XBC); *(u32x4*)dst = w; }
            EPI_ROWS_END
        } else if (wc < 2) {
            const int hcol = wc * 32 + 8 * fq; float bb[8];
#pragma unroll
            for (int j = 0; j < 8; ++j) bb[j] = dt_bias[hcol + j];
            EPI_ROWS_BEGIN const int row = u.pm * 256 + rt; float o[8];
#pragma unroll
                for (int j = 0; j < 4; ++j) { o[j] = acc[ai][0][m][0][j] + bb[j]; o[4 + j] = acc[ai][0][m][1][j] + bb[4 + j]; }
#pragma unroll
                for (int j = 0; j < 8; ++j) { const float x = o[j], uu = __expf(-fabsf(x)); const float lg = uu < 0.01f ? uu * (1.f - uu * (0.5f - uu * 0.33333333f)) : __logf(1.f + uu); o[j] = fmaxf(x, 0.f) + lg; }
                *(f32x4*)(dtb + (size_t)row * 64 + hcol) = (f32x4){o[0], o[1], o[2], o[3]}; *(f32x4*)(dtb + (size_t)row * 64 + hcol + 4) = (f32x4){o[4], o[5], o[6], o[7]};
            EPI_ROWS_END
        }
    }
};
struct EpiNsaIn {
    static constexpr bool PERM = true, ACC_INIT = false;
    bf16_t *q, *ks, *vs, *kw, *vw, *acmp; float* gate; const float* rope; const float* pe;
    DEV static void st4(bf16_t* dst, const float* o) { u32x2 w; w.x = mg::cvt_pk_bf16(o[0], o[1]); w.y = mg::cvt_pk_bf16(o[2], o[3]); *(u32x2*)dst = w; }
    DEV void im2col4(int kv, int b, int t, int g, int d, const float* o) const {
        const int c1 = t >> 4, l1 = t & 15; const float* pk = pe + kv * 4096;
        if (c1 <= 126) { const int l = l1; float v[4];
#pragma unroll
            for (int j = 0; j < 4; ++j) v[j] = o[j] + pk[l * 128 + d + j];
            st4(acmp + (((size_t)kv * 2048 + (b * 4 + g) * 128 + c1) * 4096 + l * 128 + d), v); }
        if (c1 >= 1) { const int l = l1 + 16; float v[4];
#pragma unroll
            for (int j = 0; j < 4; ++j) v[j] = o[j] + pk[l * 128 + d + j];
            st4(acmp + (((size_t)kv * 2048 + (b * 4 + g) * 128 + c1 - 1) * 4096 + l * 128 + d), v); }
    }
    DEV void operator()(const f32x4 (&acc)[2][2][4][2], const mg::Unit& u, int wr, int wc, int fr, int fq) const {
        const int pn = u.pn; const bool is_rope = pn < 10 || pn == 12 || pn == 13 || pn == 16 || pn == 17;
#pragma unroll
        for (int ai = 0; ai < 2; ++ai) {
        f32x4 csv[4][2];
        if (is_rope) {
#pragma unroll
            for (int m = 0; m < 4; ++m) { const int t = (u.pm * 256 + ai * 128 + wr * 64 + m * 16 + fr) & (SEQ - 1); const float* rp = rope + (size_t)(t * 64 + 16 * wc + 4 * fq) * 2;
                csv[m][0] = *(const f32x4*)rp; csv[m][1] = *(const f32x4*)(rp + 4); } }
#pragma unroll
        for (int m = 0; m < 4; ++m) { const int rt = ai * 128 + wr * 64 + m * 16 + fr;
        const int row = u.pm * 256 + rt, t = row & (SEQ - 1), b = row >> 11;
#pragma unroll
            for (int bj = 0; bj < 2; ++bj) { const f32x4 v0 = acc[ai][bj][m][0], v1 = acc[ai][bj][m][1];
                if (is_rope) { const int d = 16 * wc + 4 * fq;
                    const f32x4 cs0 = csv[m][0], cs1 = csv[m][1];
                    const float c[4] = {cs0[0], cs0[2], cs1[0], cs1[2]}, sn[4] = {cs0[1], cs0[3], cs1[1], cs1[3]}; float o1[4], o2[4];
#pragma unroll
                    for (int j = 0; j < 4; ++j) { o1[j] = v0[j] * c[j] - v1[j] * sn[j]; o2[j] = v1[j] * c[j] + v0[j] * sn[j]; }
                    if (pn < 8) { bf16_t* dst = q + (size_t)row * 2048 + (2 * pn + bj) * 128 + d; st4(dst, o1); st4(dst + 64, o2); }
                    else if (pn < 10) { const int g = 2 * (pn - 8) + bj; im2col4(0, b, t, g, d, o1); im2col4(0, b, t, g, d + 64, o2); }
                    else { bf16_t* dst = (pn < 14 ? ks + (size_t)row * 512 + (2 * (pn - 12) + bj) * 128 : kw + (size_t)row * 512 + (2 * (pn - 16) + bj) * 128) + d; st4(dst, o1); st4(dst + 64, o2); }
                } else { const int c0 = 32 * wc + 8 * fq; const float o1[4] = {v0[0], v0[1], v0[2], v0[3]}, o2[4] = {v1[0], v1[1], v1[2], v1[3]};
                    if (pn < 12) { const int g = 2 * (pn - 10) + bj; im2col4(1, b, t, g, c0, o1); im2col4(1, b, t, g, c0 + 4, o2); }
                    else if (pn < 20) { bf16_t* dst = (pn < 16 ? vs + (size_t)row * 512 + (2 * (pn - 14) + bj) * 128 : vw + (size_t)row * 512 + (2 * (pn - 18) + bj) * 128) + c0; st4(dst, o1); st4(dst + 4, o2); }
                    else { const int col = bj * 128 + c0; if (col < 48) { float* gd = gate + (size_t)row * 48 + col;
#pragma unroll
                            for (int j = 0; j < 4; ++j) { gd[j] = 1.f / (1.f + __expf(-o1[j])); gd[4 + j] = 1.f / (1.f + __expf(-o2[j])); } } }
                } }
        } }
    }
};
struct EpiCmp1 {
    static constexpr bool PERM = true, ACC_INIT = false;
    bf16_t* h1;
    DEV void operator()(const f32x4 (&acc)[2][2][4][2], const mg::Unit& u, int wr, int wc, int fr, int fq) const {
        EPI_ROWS_BEGIN bf16_t* rowp = h1 + ((size_t)u.g * 2048 + u.pm * 256 + rt) * 256;
#pragma unroll
            for (int bj = 0; bj < 2; ++bj) { const int col = bj * 128 + wc * 32 + 8 * fq; float o[8];
#pragma unroll
                for (int j = 0; j < 4; ++j) { o[j] = acc[ai][bj][m][0][j]; o[4 + j] = acc[ai][bj][m][1][j]; }
#pragma unroll
                for (int j = 0; j < 8; ++j) { const float v = o[j], uu = 1.5957691216057308f * (v + 0.044715f * v * v * v); o[j] = v / (1.f + __expf(-uu)); }
                u32x4 w; w.x = mg::cvt_pk_bf16(o[0], o[1]); w.y = mg::cvt_pk_bf16(o[2], o[3]); w.z = mg::cvt_pk_bf16(o[4], o[5]); w.w = mg::cvt_pk_bf16(o[6], o[7]); *(u32x4*)(rowp + col) = w; }
        EPI_ROWS_END
    }
};
struct EpiCmp2 {
    static constexpr bool PERM = true, ACC_INIT = false;
    bf16_t* kvc;
    DEV void operator()(const f32x4 (&acc)[2][2][4][2], const mg::Unit& u, int wr, int wc, int fr, int fq) const {
        EPI_ROWS_BEGIN const int mrow = u.pm * 256 + rt; bf16_t* rowp = kvc + ((size_t)u.g * 2048 + mrow) * 128; const bool pad = (mrow & 127) == 127;
            { const int col = wc * 32 + 8 * fq; const f32x4 v0 = acc[ai][0][m][0], v1 = acc[ai][0][m][1];
              u32x4 w; w.x = mg::cvt_pk_bf16(v0[0], v0[1]); w.y = mg::cvt_pk_bf16(v0[2], v0[3]); w.z = mg::cvt_pk_bf16(v1[0], v1[1]); w.w = mg::cvt_pk_bf16(v1[2], v1[3]);
              if (pad) w = (u32x4){0u, 0u, 0u, 0u}; *(u32x4*)(rowp + col) = w; }
        EPI_ROWS_END
    }
};
DEV void cmp_gemm2_rows(const bf16_t* h1, const bf16_t* w2t  , bf16_t* kvc, int rowbase  ) {
    typedef float f32x16 __attribute__((ext_vector_type(16)));
    const int tid = tidx(), wid = tid >> 6, lane = tid & 63, r32 = lane & 31, hi = lane >> 5;
    const bf16_t* ap = h1 + (size_t)(rowbase + 32 * wid + r32) * 256 + hi * 8;
    const bf16_t* bp = w2t + (size_t)r32 * 256 + hi * 8;
    f32x16 acc[4] = {};
#pragma unroll 4
    for (int ks = 0; ks < 16; ++ks) { const bf16x8 a = *(const bf16x8*)(ap + ks * 16);
#pragma unroll
        for (int nbk = 0; nbk < 4; ++nbk) { const bf16x8 b = *(const bf16x8*)(bp + (size_t)nbk * 32 * 256 + ks * 16); acc[nbk] = __builtin_amdgcn_mfma_f32_32x32x16_bf16(a, b, acc[nbk], 0, 0, 0); } }
#pragma unroll
    for (int r = 0; r < 16; ++r) { const int row = rowbase + 32 * wid + (r & 3) + 8 * (r >> 2) + 4 * hi; const bool pad = (row & 127) == 127;
#pragma unroll
        for (int nbk = 0; nbk < 4; ++nbk) { const float v = pad ? 0.f : acc[nbk][r]; const float vn = swap_pair(v);
            if ((r32 & 1) == 0) *(unsigned*)(kvc + (size_t)row * 128 + nbk * 32 + r32) = mg::cvt_pk_bf16(v, vn); } }
}

struct AMoeGather { static constexpr bool GATHER = true; const bf16_t* A; const int* list; const int* cnt;
    DEV const char* ubase(const mg::Unit&) const { return (const char*)A; }
    DEV unsigned rowoff(const mg::Unit& u, int r) const { int idx = u.pm * 256 + r; const int c = cnt[u.g]; idx = idx < c ? idx : c - 1; return (unsigned)(list[u.g * T + idx] >> 1) * (unsigned)D_MODEL; } };
struct AMoeAct { static constexpr bool GATHER = false; const bf16_t* A; const int* tab;
    DEV const char* ubase(const mg::Unit& u) const { return (const char*)A + (size_t)(__builtin_amdgcn_readfirstlane(tab[64 + u.g]) + u.pm * 256) * MOE_FF; }
    DEV unsigned rowoff(const mg::Unit&, int r) const { return (unsigned)r * (unsigned)MOE_FF; } };
struct EpiMoeGU {
    static constexpr bool PERM = true, ACC_INIT = false;
    bf16_t* act; const int* cnt; const int* tab;
    DEV void operator()(const f32x4 (&acc)[2][2][4][2], const mg::Unit& u, int wr, int wc, int fr, int fq) const {
        const int c = cnt[u.g], rb = tab[64 + u.g];
        EPI_ROWS_BEGIN const int lr = u.pm * 256 + rt;
            if (lr < c) {
#pragma unroll
                for (int bj = 0; bj < 2; ++bj) { const int f = u.pn * 128 + bj * 64 + wc * 16 + 4 * fq; const f32x4 g = acc[ai][bj][m][0], up = acc[ai][bj][m][1]; float o[4];
#pragma unroll
                    for (int j = 0; j < 4; ++j) { const float gj = g[j] * (1.f / (F8_SX * F8_SW)); o[j] = gj / (1.f + __expf(-gj)) * (up[j] * (F8_SACT / (F8_SX * F8_SW))); }
                    *(unsigned*)((char*)act + (size_t)(rb + lr) * MOE_FF + f) = pk8(o[0], o[1], o[2], o[3]); } }
        EPI_ROWS_END
    }
};
struct EpiMoeDown {
    static constexpr bool PERM = true, ACC_INIT = false;
    bf16_t* ys; const int* list; const int* cnt; const float* ew;
    DEV void operator()(const f32x4 (&acc)[2][2][4][2], const mg::Unit& u, int wr, int wc, int fr, int fq) const {
        const int c = cnt[u.g];
#pragma unroll
        for (int ai = 0; ai < 2; ++ai) {
            int idxv[4]; float wv[4];
#pragma unroll
            for (int m = 0; m < 4; ++m) { const int lr = u.pm * 256 + ai * 128 + wr * 64 + m * 16 + fr; idxv[m] = lr < c ? list[u.g * T + lr] : -1; }
#pragma unroll
            for (int m = 0; m < 4; ++m) wv[m] = idxv[m] >= 0 ? ew[idxv[m]] * (1.f / (F8_SACT * F8_SW)) : 0.f;
#pragma unroll
            for (int m = 0; m < 4; ++m)
                if (idxv[m] >= 0) { const float w = wv[m]; bf16_t* rowp = ys + (size_t)idxv[m] * D_MODEL;
#pragma unroll
                    for (int bj = 0; bj < 2; ++bj) { const int col = u.pn * 256 + bj * 128 + wc * 32 + 8 * fq; const f32x4 v0 = acc[ai][bj][m][0] * w, v1 = acc[ai][bj][m][1] * w;
                        u32x4 pk; pk.x = mg::cvt_pk_bf16(v0[0], v0[1]); pk.y = mg::cvt_pk_bf16(v0[2], v0[3]); pk.z = mg::cvt_pk_bf16(v1[0], v1[1]); pk.w = mg::cvt_pk_bf16(v1[2], v1[3]);
                        *(u32x4*)(rowp + col) = pk; } }
        }
    }
};

template <bool F8 = false, class SF>
DEV void conv_wt(SF sf, int ngroups, int K, int Nphys, bf16_t* dst, float*  , int bid, int nb, int t0 = 0, int t1 = 0x7fffffff) {
    const int tid = tidx(), wid = tid >> 6, lane = tid & 63, kb = lane & 7, c4 = lane >> 3;
    const int ktn = K / 64, ntn = Nphys / 256, per = ktn * ntn, total = ngroups * per < t1 ? ngroups * per : t1;
    constexpr int NF = 4;
    (void)per; (void)total;
    const int ktq = ktn / 2, ntq = (ntn + 1) / 2, perq = ktq * ntq, totq = ngroups * perq;
    const int q0 = t0 / NF, q1 = (t1 == 0x7fffffff || t1 / NF > totq) ? totq : t1 / NF;
    for (int item = q0 + bid; item < q1; item += nb) {
        const int g = item / perq, rem = item - g * perq, kq = rem / ntq, nq = rem - kq * ntq;
        const int k0 = kq * 128 + kb * 16;
        f32x4 v[2][2][8];
#pragma unroll
        for (int un = 0; un < 2; ++un) { const int nt = nq * 2 + un; const int q = nt * 64 + wid * 8 + c4;
#pragma unroll
            for (int uk = 0; uk < 2; ++uk)
#pragma unroll
                for (int j = 0; j < 8; ++j) { const float* sp = nt < ntn ? sf(g, k0 + uk * 8 + j, q) : (const float*)nullptr; v[un][uk][j] = (f32x4){0.f, 0.f, 0.f, 0.f}; if (sp) v[un][uk][j] = __builtin_nontemporal_load((const f32x4*)sp); } }
#pragma unroll
        for (int un = 0; un < 2; ++un) { const int nt = nq * 2 + un; const int q = nt * 64 + wid * 8 + c4;
            if (nt < ntn) {
#pragma unroll
            for (int e = 0; e < 4; ++e) {
                if constexpr (F8) { u32x4 w;
                    w.x = pk8(v[un][0][0][e] * F8_SW, v[un][0][1][e] * F8_SW, v[un][0][2][e] * F8_SW, v[un][0][3][e] * F8_SW); w.y = pk8(v[un][0][4][e] * F8_SW, v[un][0][5][e] * F8_SW, v[un][0][6][e] * F8_SW, v[un][0][7][e] * F8_SW);
                    w.z = pk8(v[un][1][0][e] * F8_SW, v[un][1][1][e] * F8_SW, v[un][1][2][e] * F8_SW, v[un][1][3][e] * F8_SW); w.w = pk8(v[un][1][4][e] * F8_SW, v[un][1][5][e] * F8_SW, v[un][1][6][e] * F8_SW, v[un][1][7][e] * F8_SW);
                    __builtin_nontemporal_store(w, (u32x4*)((char*)dst + ((size_t)g * Nphys + 4 * q + e) * K + k0)); }
                else {
#pragma unroll
                    for (int uk = 0; uk < 2; ++uk) { u32x4 w; w.x = mg::cvt_pk_bf16(v[un][uk][0][e], v[un][uk][1][e]); w.y = mg::cvt_pk_bf16(v[un][uk][2][e], v[un][uk][3][e]); w.z = mg::cvt_pk_bf16(v[un][uk][4][e], v[un][uk][5][e]); w.w = mg::cvt_pk_bf16(v[un][uk][6][e], v[un][uk][7][e]);
                        __builtin_nontemporal_store(w, (u32x4*)(dst + ((size_t)g * Nphys + 4 * q + e) * K + k0 + uk * 8)); } } } } }
    }
}

template <bool F8 = false, bool X16 = false  >
DEV void rows_norm(const float* src, const bf16_t* add0, const bf16_t* add1, float* sumdst, const float* g, bf16_t* dst, int bid, int nb) {
    const int lane = tidx() & 63, wid = tidx() >> 6;
    for (int row = bid * 8 + wid; row < T; row += nb * 8) {
        float4 v[8]; float ss = 0.f;
#pragma unroll
        for (int i = 0; i < 8; ++i) {
            const size_t o = (size_t)row * D_MODEL + i * 256 + lane * 4;
            float4 a; if constexpr (X16) { const ushort4 s4 = *(const ushort4*)((const bf16_t*)src + o); a = make_float4(bf2f(s4.x), bf2f(s4.y), bf2f(s4.z), bf2f(s4.w)); } else a = *(const float4*)(src + o);
            if (add0) { const size_t o2 = (size_t)row * 2 * D_MODEL + i * 256 + lane * 4; const ushort4 b = *(const ushort4*)(add0 + o2), c = *(const ushort4*)(add1 + o2);
                a.x += bf2f(b.x) + bf2f(c.x); a.y += bf2f(b.y) + bf2f(c.y); a.z += bf2f(b.z) + bf2f(c.z); a.w += bf2f(b.w) + bf2f(c.w); }
            if (sumdst) { if constexpr (X16) { ushort4 q4; q4.x = f2bf(a.x); q4.y = f2bf(a.y); q4.z = f2bf(a.z); q4.w = f2bf(a.w); *(ushort4*)((bf16_t*)sumdst + o) = q4; } else *(float4*)(sumdst + o) = a; }
            v[i] = a; ss += a.x * a.x + a.y * a.y + a.z * a.z + a.w * a.w;
        }
        ss = wave_sum(ss);
        const float rinv = rsqrtf(ss * (1.f / D_MODEL) + NORM_EPS);
#pragma unroll
        for (int i = 0; i < 8; ++i) {
            const int c = i * 256 + lane * 4; const float4 gg = *(const float4*)(g + c);
            if constexpr (F8) { const float rs = rinv * F8_SX; *(unsigned*)((char*)dst + (size_t)row * D_MODEL + c) = pk8(v[i].x * rs * gg.x, v[i].y * rs * gg.y, v[i].z * rs * gg.z, v[i].w * rs * gg.w); }
            else { ushort4 o; o.x = f2bf(v[i].x * rinv * gg.x); o.y = f2bf(v[i].y * rinv * gg.y); o.z = f2bf(v[i].z * rinv * gg.z); o.w = f2bf(v[i].w * rinv * gg.w);
                *(ushort4*)(dst + (size_t)row * D_MODEL + c) = o; }
        }
    }
}

DEV void ph_rope_table(const P& p, int bid, int nb) {
    for (int i = bid * NTHREADS + tidx(); i < SEQ * 64; i += nb * NTHREADS) {
        const int pos = i >> 6, j = i & 63;
        const double inv = exp(-log(10000.0) * (double)j / 64.0);
        const float invf = (float)inv;
        const float ang = (float)pos * invf;
        p.rope[i * 2] = (float)cos((double)ang); p.rope[i * 2 + 1] = (float)sin((double)ang);
    }
}

DEV void ph_cmp_attn(const P& p, float* lds, int bid, int nb) {
    const int lane = tidx() & 63, wid = tidx() >> 6;
    float* qs = lds + wid * 640; float* ps = qs + 512;
    float* ocmp = (float*)(p.big + BIG_NSA_OCMP);
    const bf16_t* Q = (const bf16_t*)(p.big + BIG_NSA_Q);
    const float scale = 0.08838834764831845f;
    const bf16_t* kc = (const bf16_t*)(p.big + BIG_NSA_KVC); const bf16_t* vc = kc + (size_t)2048 * 128;
    for (int u = bid * 8 + wid; u < T * NKV; u += nb * 8) {
        const int g = u & 3, tok = u >> 2, b = tok / SEQ, t = tok % SEQ;
        const int ncv = t >= 31 ? (t - 31) / 16 + 1 : 0;
        const bf16_t* qrow = Q + (size_t)tok * 2048 + g * 4 * 128;
#pragma unroll
        for (int i = 0; i < 8; ++i) qs[lane + 64 * i] = bf2f(qrow[lane + 64 * i]);
        float psum0 = 0.f, psum1 = 0.f;
        for (int r = 0; r < 4; ++r) {
            float s0 = -INFINITY, s1 = -INFINITY;
            if (lane < ncv) { const bf16_t* kr = kc + ((size_t)((b * 4 + g) * 128 + lane)) * 128; float a = 0.f; for (int d = 0; d < 128; ++d) a = fmaf(qs[r * 128 + d], bf2f(kr[d]), a); s0 = a * scale; }
            if (lane + 64 < ncv) { const bf16_t* kr = kc + ((size_t)((b * 4 + g) * 128 + lane + 64)) * 128; float a = 0.f; for (int d = 0; d < 128; ++d) a = fmaf(qs[r * 128 + d], bf2f(kr[d]), a); s1 = a * scale; }
            float p0 = 0.f, p1 = 0.f;
            if (ncv > 0) {
                const float m = wave_max(fmaxf(s0, s1));
                const float e0 = lane < ncv ? expf(s0 - m) : 0.f, e1 = lane + 64 < ncv ? expf(s1 - m) : 0.f;
                const float sum = wave_sum(e0 + e1);
                p0 = e0 / sum; p1 = e1 / sum;
            }
            psum0 += p0; psum1 += p1;
            float o0 = 0.f, o1 = 0.f;
            for (int c = 0; c < ncv; ++c) {
                const float pc = c < 64 ? __shfl(p0, c) : __shfl(p1, c - 64);
                const bf16_t* vr = vc + ((size_t)((b * 4 + g) * 128 + c)) * 128;
                o0 = fmaf(pc, bf2f(vr[lane]), o0); o1 = fmaf(pc, bf2f(vr[lane + 64]), o1);
            }
            float* orow = ocmp + (size_t)tok * 2048 + (g * 4 + r) * 128;
            orow[lane] = o0; orow[lane + 64] = o1;
        }
        ps[lane] = psum0; ps[lane + 64] = psum1;
        float val = -INFINITY;
        const int j = lane;
        if (j < 32) {
            float imp = ps[4 * j] + ps[4 * j + 1] + ps[4 * j + 2] + 0.5f * ps[4 * j + 3] + (j > 0 ? 0.5f * ps[4 * j - 1] : 0.f);
            const int dist = (t >> 6) - j;
            const bool forced = (j == 0) || (dist >= 0 && dist < 2);
            val = forced ? 1e4f : imp;
            if (dist < 0) val = -INFINITY;
        }
        int rank = 0;
        for (int i = 0; i < 32; ++i) { const float vi = __shfl(val, i); rank += (vi > val || (vi == val && i < j)) ? 1 : 0; }
        const unsigned long long bal = __ballot(j < 32 && rank < 16);
        if (lane == 0) p.selmask[(size_t)(b * NKV + g) * SEQ + t] = (unsigned)bal;
    }
}

DEV void attend_wave(const bf16_t* Kb, const bf16_t* Vb, const float* qs, int b, int g, unsigned bmask, int lo, int hi, int lane, float& o0, float& o1) {
    const float scale = 0.08838834764831845f;
    float m = -INFINITY, l = 0.f; o0 = 0.f; o1 = 0.f;
    for (int j = lo >> 6; j <= (hi >> 6); ++j) {
        if (!((bmask >> j) & 1u)) continue;
        const int key = j * 64 + lane; const bool valid = key >= lo && key <= hi;
        float s = -INFINITY;
        if (valid) { const bf16_t* kr = Kb + (size_t)(b * SEQ + key) * 512 + g * 128; float a = 0.f;
            for (int d = 0; d < 128; d += 4) { const ushort4 kv = *(const ushort4*)(kr + d); a = fmaf(qs[d], bf2f(kv.x), a); a = fmaf(qs[d + 1], bf2f(kv.y), a); a = fmaf(qs[d + 2], bf2f(kv.z), a); a = fmaf(qs[d + 3], bf2f(kv.w), a); }
            s = a * scale; }
        const float bm = wave_max(s);
        if (bm == -INFINITY) continue;
        const float mn = fmaxf(m, bm), alpha = expf(m - mn);
        const float pr = valid ? expf(s - mn) : 0.f;
        l = l * alpha + wave_sum(pr); o0 *= alpha; o1 *= alpha; m = mn;
        for (int kk = 0; kk < 64; ++kk) {
            const float pk = __shfl(pr, kk);
            if (pk != 0.f) { const bf16_t* vr = Vb + (size_t)(b * SEQ + j * 64 + kk) * 512 + g * 128; o0 = fmaf(pk, bf2f(vr[lane]), o0); o1 = fmaf(pk, bf2f(vr[lane + 64]), o1); }
        }
    }
    const float inv = 1.f / l; o0 *= inv; o1 *= inv;
}

DEV void ph_attn_sw(const P& p, float* lds, int bid, int nb) {
    const int lane = tidx() & 63, wid = tidx() >> 6;
    float* qs = lds + wid * 128;
    const float* ocmp = (const float*)(p.big + BIG_NSA_OCMP); bf16_t* obuf = (bf16_t*)(p.big + BIG_NSA_OBUF);
    const bf16_t* Q = (const bf16_t*)(p.big + BIG_NSA_Q); const float* gate = (const float*)(p.big + BIG_NSA_GATE);
    const bf16_t* KS = (const bf16_t*)(p.big + BIG_NSA_KS); const bf16_t* VS = (const bf16_t*)(p.big + BIG_NSA_VS);
    const bf16_t* KW = (const bf16_t*)(p.big + BIG_NSA_KW); const bf16_t* VW = (const bf16_t*)(p.big + BIG_NSA_VW);
    for (int u = bid * 8 + wid; u < T * NH; u += nb * 8) {
        const int h = u & 15, tok = u >> 4, b = tok / SEQ, t = tok % SEQ, g = h >> 2;
        const bf16_t* qrow = Q + (size_t)tok * 2048 + h * 128;
        qs[lane] = bf2f(qrow[lane]); qs[lane + 64] = bf2f(qrow[lane + 64]);
        const unsigned sm = p.selmask[(size_t)(b * NKV + g) * SEQ + t];
        float s0, s1, w0, w1;
        attend_wave(KS, VS, qs, b, g, sm, 0, t, lane, s0, s1);
        attend_wave(KW, VW, qs, b, g, 0xffffffffu, t - (WINDOW - 1) > 0 ? t - (WINDOW - 1) : 0, t, lane, w0, w1);
        const float* gl = gate + (size_t)tok * 48 + h * 3;
        const float g0 = gl[0], g1 = gl[1], g2 = gl[2];
        const float* oc = ocmp + (size_t)tok * 2048 + h * 128;
        bf16_t* ob = obuf + (size_t)tok * 2048 + h * 128;
        ob[lane] = f2bf(g0 * oc[lane] + g1 * s0 + g2 * w0);
        ob[lane + 64] = f2bf(g0 * oc[lane + 64] + g1 * s1 + g2 * w1);
    }
}

namespace at {
typedef float f32x16 __attribute__((ext_vector_type(16)));
typedef short s16x4 __attribute__((ext_vector_type(4)));
constexpr int SHM = 16384;
constexpr float SCALE = 0.08838834764831845f, C2 = 1.4426950408889634f * SCALE, THR = 8.f;
#define AT_KSWZ(row, colB) ((row) * 256 + ((colB) ^ (((row) & 7) << 4)))
DEV int v_st(int k, int c) { const int kk = (k & ~0xC) | ((k & 4) << 1) | ((k & 8) >> 1); return ((kk >> 3) * 4 + (c >> 5)) * 512 + ((kk & 7) * 32 + (c & 31)) * 2; }
DEV int v_rd_base(int lane) { return ((lane & 3) << 3) | (((lane >> 2) & 3) << 6) | (((lane >> 4) & 1) << 5) | (((lane >> 5) & 1) << 8); }
DEV int crow(int r, int hi) { return (r & 3) + 8 * (r >> 2) + 4 * hi; }
DEV unsigned cvtpk(float lo, float hi) { unsigned r; asm volatile("v_cvt_pk_bf16_f32 %0, %1, %2" : "=v"(r) : "v"(lo), "v"(hi)); return r; }
DEV float swap_max(float x) { auto rr = __builtin_amdgcn_permlane32_swap(__float_as_uint(x), __float_as_uint(x), false, false); return fmaxf(__uint_as_float(rr[0]), __uint_as_float(rr[1])); }
DEV float swap_sum(float x) { auto rr = __builtin_amdgcn_permlane32_swap(__float_as_uint(x), __float_as_uint(x), false, false); return __uint_as_float(rr[0]) + __uint_as_float(rr[1]); }
#define AT_PK4(P, B_, OUT) do { unsigned a0 = cvtpk(P[B_+0], P[B_+1]), a1 = cvtpk(P[B_+2], P[B_+3]); unsigned b0 = cvtpk(P[B_+4], P[B_+5]), b1 = cvtpk(P[B_+6], P[B_+7]); \
        auto r0 = __builtin_amdgcn_permlane32_swap(a0, b0, false, false); auto r1 = __builtin_amdgcn_permlane32_swap(a1, b1, false, false); \
        u32x4 w = {r0[0], r1[0], r0[1], r1[1]}; OUT = *reinterpret_cast<bf16x8*>(&w); } while (0)
DEV void qkt(f32x16& p0, f32x16& p1, const char* Kl, int r32, int hi, const bf16x8* qr) {
    p0 = f32x16{}; p1 = f32x16{};
    const char* kb[4];
#pragma unroll
    for (int dd = 0; dd < 4; ++dd) kb[dd] = Kl + AT_KSWZ(r32, (dd * 16 + hi * 8) * 2);
#pragma unroll
    for (int d0 = 0; d0 < 8; ++d0) { const char* a = kb[d0 & 3] + (d0 >> 2) * 128;
        const bf16x8 b0 = *reinterpret_cast<const bf16x8*>(a), b1 = *reinterpret_cast<const bf16x8*>(a + 32 * 256);
        p0 = __builtin_amdgcn_mfma_f32_32x32x16_bf16(b0, qr[d0], p0, 0, 0, 0);
        p1 = __builtin_amdgcn_mfma_f32_32x32x16_bf16(b1, qr[d0], p1, 0, 0, 0); }
}
DEV void pv_tile(f32x16* o, int vb0, bf16x8 pa0, bf16x8 pa1, bf16x8 pa2, bf16x8 pa3) {
#define AT_TRRD(dst, off) asm volatile("ds_read_b64_tr_b16 %0, %1 offset:%2" : "=&v"(dst) : "v"(vb0), "i"(off) : "memory")
#define AT_RD8(S, d0) do { constexpr int b_ = (d0) * 512; AT_TRRD(S##l0, b_); AT_TRRD(S##h0, b_ + 2048); AT_TRRD(S##l1, b_ + 4096); AT_TRRD(S##h1, b_ + 6144); \
        AT_TRRD(S##l2, b_ + 8192); AT_TRRD(S##h2, b_ + 10240); AT_TRRD(S##l3, b_ + 12288); AT_TRRD(S##h3, b_ + 14336); } while (0)
#define AT_MM4(S, d0) do { \
        o[d0] = __builtin_amdgcn_mfma_f32_32x32x16_bf16(pa0, (bf16x8){S##l0[0], S##l0[1], S##l0[2], S##l0[3], S##h0[0], S##h0[1], S##h0[2], S##h0[3]}, o[d0], 0, 0, 0); \
        o[d0] = __builtin_amdgcn_mfma_f32_32x32x16_bf16(pa1, (bf16x8){S##l1[0], S##l1[1], S##l1[2], S##l1[3], S##h1[0], S##h1[1], S##h1[2], S##h1[3]}, o[d0], 0, 0, 0); \
        o[d0] = __builtin_amdgcn_mfma_f32_32x32x16_bf16(pa2, (bf16x8){S##l2[0], S##l2[1], S##l2[2], S##l2[3], S##h2[0], S##h2[1], S##h2[2], S##h2[3]}, o[d0], 0, 0, 0); \
        o[d0] = __builtin_amdgcn_mfma_f32_32x32x16_bf16(pa3, (bf16x8){S##l3[0], S##l3[1], S##l3[2], S##l3[3], S##h3[0], S##h3[1], S##h3[2], S##h3[3]}, o[d0], 0, 0, 0); } while (0)
#define AT_WAIT(n) do { asm volatile("s_waitcnt lgkmcnt(" #n ")" ::: "memory"); __builtin_amdgcn_sched_barrier(0); } while (0)
    s16x4 xl0, xl1, xl2, xl3, xh0, xh1, xh2, xh3, yl0, yl1, yl2, yl3, yh0, yh1, yh2, yh3;
    AT_RD8(x, 0); AT_RD8(y, 1);
    AT_WAIT(8); AT_MM4(x, 0);
    __builtin_amdgcn_sched_barrier(0); AT_RD8(x, 2);
    AT_WAIT(8); AT_MM4(y, 1);
    __builtin_amdgcn_sched_barrier(0); AT_RD8(y, 3);
    AT_WAIT(8); AT_MM4(x, 2);
    AT_WAIT(0); AT_MM4(y, 3);
#undef AT_WAIT
#undef AT_MM4
#undef AT_RD8
#undef AT_TRRD
}
DEV void mask_tile(f32x16& p0, f32x16& p1, int lo, int hi_, int hi) {
    const float NEG = -__builtin_inff(); const unsigned w = (unsigned)(hi_ - lo); const int base = 4 * hi - lo;
#pragma unroll
    for (int r = 0; r < 16; ++r) { const int cr = (r & 3) + 8 * (r >> 2);
        if ((unsigned)(cr + base) > w) p0[r] = NEG;
        if ((unsigned)(cr + 32 + base) > w) p1[r] = NEG; }
}
struct Ctx { char* L; int tid, wid, lane, r32, hi; unsigned ksrc[2], vsrc[2]; float* li_l; float* al_l; };
#define AT_STAGE(Kp, Vp, pitch, kb, vb) do { _Pragma("unroll") for (int _i = 0; _i < 2; ++_i) { unsigned ks_ = c.ksrc[_i], vs_ = c.vsrc[_i]; asm volatile("" : "+v"(ks_), "+v"(vs_));     \
        __builtin_amdgcn_global_load_lds((const unsigned*)((Kp) + (size_t)(ks_ >> 16) * (pitch) + (ks_ & 0xffffu)), (MG_LAS unsigned*)((MG_LAS char*)(c.L) + (kb) * SHM + c.wid * 1024 + _i * 8192), 16, 0, 0); \
        __builtin_amdgcn_global_load_lds((const unsigned*)((Vp) + (size_t)(vs_ >> 16) * (pitch) + (vs_ & 0xffffu)), (MG_LAS unsigned*)((MG_LAS char*)(c.L) + 2 * SHM + (vb) * SHM + c.wid * 1024 + _i * 8192), 16, 0, 0); } } while (0)
#define AT_RESC(a) do { if (__any((a) < 1.f)) { if (c.hi == 0) c.al_l[c.r32] = (a); asm volatile("s_waitcnt lgkmcnt(0)" ::: "memory"); \
        _Pragma("unroll") for (int d_ = 0; d_ < 4; ++d_) _Pragma("unroll") for (int r = 0; r < 16; ++r) o[d_][r] *= c.al_l[crow(r, c.hi)]; } } while (0)

template <int MODE>
DEV void branch(const Ctx& c, const bf16_t* Kb, const bf16_t* Vb  , unsigned tiles, int i, int tl, unsigned smask, const bf16x8* qr, f32x16* o, float& l_reg) {
    float m_reg = -1e30f; l_reg = 0.f;
#pragma unroll
    for (int d = 0; d < 4; ++d) o[d] = f32x16{};
    unsigned rem = tiles; int j = __builtin_ctz(rem); rem &= rem - 1; int buf = 0;
    AT_STAGE(Kb + (size_t)j * 64 * 512, Vb + (size_t)j * 64 * 512, 512, 0, 0);
    __syncthreads();
    for (;;) {
        const bool more = rem != 0u; int jn = j;
        if (more) { jn = __builtin_ctz(rem); rem &= rem - 1; AT_STAGE(Kb + (size_t)jn * 64 * 512, Vb + (size_t)jn * 64 * 512, 512, buf ^ 1, buf ^ 1); }
        int lo, hi_;
        if (MODE == 1) { const bool sel = (smask >> j) & 1u; lo = sel ? 0 : 100; hi_ = sel ? (j == i ? tl : 63) : 100; }
        else { const int a = tl + 64 * (i - j); hi_ = a < 63 ? a : 63; lo = a - 511 > 0 ? a - 511 : 0; if (lo > 63) { lo = 100; hi_ = 100; } }
        if (__any(lo <= 63)) {
        f32x16 p0, p1;
        qkt(p0, p1, c.L + buf * SHM, c.r32, c.hi, qr);
        if (!__all(lo <= 0 && hi_ >= 63)) {
            if (MODE == 1 && j != i) { const bool keep = lo == 0; const float NEG = -__builtin_inff();
#pragma unroll
                for (int r = 0; r < 16; ++r) { p0[r] = keep ? p0[r] : NEG; p1[r] = keep ? p1[r] : NEG; } }
            else mask_tile(p0, p1, lo, hi_, c.hi);
        }
        float pmax = p0[0];
#pragma unroll
        for (int r = 1; r < 16; ++r) pmax = fmaxf(pmax, p0[r]);
#pragma unroll
        for (int r = 0; r < 16; ++r) pmax = fmaxf(pmax, p1[r]);
        pmax = swap_max(pmax);
        float mn, alpha;
        if (__all((pmax - m_reg) * SCALE <= THR)) { mn = m_reg; alpha = 1.f; }
        else { mn = fmaxf(m_reg, pmax); alpha = __builtin_amdgcn_exp2f((m_reg - mn) * C2); m_reg = mn; }
        const float mnL = -mn * C2; float ps = 0.f;
#pragma unroll
        for (int r = 0; r < 16; ++r) { p0[r] = __builtin_amdgcn_exp2f(fmaf(p0[r], C2, mnL)); p1[r] = __builtin_amdgcn_exp2f(fmaf(p1[r], C2, mnL)); ps += p0[r] + p1[r]; }
        ps = swap_sum(ps);
        l_reg = l_reg * alpha + ps;
        bf16x8 pa0, pa1, pa2, pa3;
        AT_PK4(p0, 0, pa0); AT_PK4(p0, 8, pa1); AT_PK4(p1, 0, pa2); AT_PK4(p1, 8, pa3);
        AT_RESC(alpha);
        pv_tile(o, (int)(uintptr_t)(c.L + 2 * SHM + buf * SHM) + v_rd_base(c.lane), pa0, pa1, pa2, pa3);
        }
        __syncthreads();
        if (!more) break;
        j = jn; buf ^= 1;
    }
}
template <int MODE>
DEV void branch_acc(const Ctx& c, const f32x16* o, float rowscale, char* stash_w  , bf16_t* obuf, size_t orow0, const char* win_w = nullptr  ) {
    int hi = c.hi, r32 = c.r32, ln = c.lane; asm volatile("" : "+v"(hi), "+v"(r32), "+v"(ln));
    float* li = c.li_l; asm volatile("" : "+v"(li));
    float sc[16];
    if (MODE != 4) {
    if (hi == 0) li[r32] = rowscale;
    asm volatile("s_waitcnt lgkmcnt(0)" ::: "memory");
#pragma unroll
    for (int r = 0; r < 16; ++r) sc[r] = li[(r & 3) + 8 * (r >> 2) + 4 * hi]; }
    char* sp = stash_w + ln * 16;
    const size_t base = orow0 + (size_t)r32 + (size_t)(4 * hi) * 2048;
#pragma unroll
    for (int jg = 0; jg < 8; ++jg) {
        u32x4 w = {0u, 0u, 0u, 0u};
        if (MODE != 0) w = *(const u32x4*)(sp + jg * 1024);
        u32x4 wv = {0u, 0u, 0u, 0u}; if (MODE == 4) wv = *(const u32x4*)(win_w + ln * 16 + jg * 1024);
        const int d0 = jg >> 1;
#pragma unroll
        for (int k = 0; k < 4; ++k) { const int r = 8 * (jg & 1) + 2 * k;
            float t0, t1;
            if (MODE == 4) { t0 = __uint_as_float(wv[k] << 16); t1 = __uint_as_float(wv[k] & 0xffff0000u); } else { t0 = o[d0][r] * sc[r]; t1 = o[d0][r + 1] * sc[r + 1]; }
            if (MODE != 0) { t0 += __uint_as_float(w[k] << 16); t1 += __uint_as_float(w[k] & 0xffff0000u); }
            if (MODE != 2 && MODE != 4) w[k] = cvtpk(t0, t1);
            else { const float n0 = swap_pair(t0), n1 = swap_pair(t1);
                   if ((r32 & 1) == 0) { *(unsigned*)(obuf + base + (size_t)((r & 3) + 8 * (r >> 2)) * 2048 + d0 * 32) = cvtpk(t0, n0);
                                          *(unsigned*)(obuf + base + (size_t)(((r + 1) & 3) + 8 * ((r + 1) >> 2)) * 2048 + d0 * 32) = cvtpk(t1, n1); } } }
        if (MODE != 2 && MODE != 4) *(u32x4*)(sp + jg * 1024) = w;
    }
}
}

DEV void ph_attn_mfma(const P& p, char* L  , int bid, int nb) {
    using namespace at;
    Ctx c; c.L = L; c.tid = tidx(); c.wid = __builtin_amdgcn_readfirstlane(c.tid >> 6); c.lane = c.tid & 63; c.r32 = c.lane & 31; c.hi = c.lane >> 5;
#pragma unroll
    for (int i = 0; i < 2; ++i) { const int pos = c.tid * 16 + i * 8192;
        { const int row = pos >> 8, ch = ((pos >> 4) & 15) ^ (row & 7); c.ksrc[i] = (unsigned)(row << 16) | (unsigned)(ch * 8); }
        { const int sub = pos >> 9, w = (pos & 511) >> 1, kk = (sub >> 2) * 8 + (w >> 5), k = (kk & ~0xC) | ((kk & 4) << 1) | ((kk & 8) >> 1), col = (sub & 3) * 32 + (w & 31);
          c.vsrc[i] = (unsigned)(k << 16) | (unsigned)col; } }
    float* wsf = (float*)(L + 4 * SHM) + c.wid * 64; c.li_l = wsf; c.al_l = wsf + 32;
    unsigned* selm = (unsigned*)(L + 4 * SHM + 2048);
    unsigned* um = selm + 64;
    char* stash = L + 4 * SHM + 2560;
    float* impbuf = (float*)stash;
    float* impsum = impbuf + 4 * 64 * 33;
    const bf16_t* Q = (const bf16_t*)(p.big + BIG_NSA_Q); const float* gate = (const float*)(p.big + BIG_NSA_GATE);
    const bf16_t* KS = (const bf16_t*)(p.big + BIG_NSA_KS); const bf16_t* VS = (const bf16_t*)(p.big + BIG_NSA_VS);
    const bf16_t* KW = (const bf16_t*)(p.big + BIG_NSA_KW); const bf16_t* VW = (const bf16_t*)(p.big + BIG_NSA_VW);
    const bf16_t* KC = (const bf16_t*)(p.big + BIG_NSA_KVC); const bf16_t* VC = KC + (size_t)2048 * 128;
    bf16_t* obuf = (bf16_t*)(p.big + BIG_NSA_OBUF);
    const int rq = c.wid & 3, th = c.wid >> 2, tl = 32 * th + c.r32;
    for (int pr0 = bid; pr0 < 256; pr0 += nb) {
        const int pr = (nb == 256) ? ((pr0 & 7) * 32 + (pr0 >> 3)) : pr0;
        const int bg = pr >> 4, b = bg >> 2, g = bg & 3, ii = pr & 15;
#pragma unroll 1
        for (int pass = 0; pass < 2; ++pass) {
            const int i = pass == 0 ? 31 - ii : ii;
            const int hq = 4 * g + rq, tok0 = b * SEQ + 64 * i, tq = 64 * i + tl;
            bf16x8 qr[8];
            { int hiq = c.hi, tlq = tl; asm volatile("" : "+v"(hiq), "+v"(tlq));
              const bf16_t* qp = Q + (size_t)(tok0 + tlq) * 2048 + hq * 128 + hiq * 8;
#pragma unroll
              for (int d0 = 0; d0 < 8; ++d0) qr[d0] = *(const bf16x8*)(qp + d0 * 16); }
            f32x16 o[4]; float l_reg;
            const size_t orow0 = (size_t)(tok0 + 32 * th) * 2048 + hq * 128;
            {
                const bf16_t* kc = KC + (size_t)(bg * 128) * 128; const bf16_t* vc = VC + (size_t)(bg * 128) * 128;
                AT_STAGE(kc, vc, 128, 0, 0);
                AT_STAGE(kc + 64 * 128, vc + 64 * 128, 128, 1, 1);
                __syncthreads();
                f32x16 pA0, pA1, pB0, pB1;
                qkt(pA0, pA1, c.L, c.r32, c.hi, qr); qkt(pB0, pB1, c.L + SHM, c.r32, c.hi, qr);
                const int cmax = tq >= 31 ? (tq - 31) >> 4 : -1;
                { int lo = 0, hi_ = cmax < 63 ? cmax : 63; if (cmax < 0) { lo = 100; hi_ = 100; } mask_tile(pA0, pA1, lo, hi_, c.hi); }
                { int lo = 0, hi_ = cmax - 64 < 63 ? cmax - 64 : 63; if (cmax < 64) { lo = 100; hi_ = 100; } mask_tile(pB0, pB1, lo, hi_, c.hi); }
                float pmax = -1e30f;
#pragma unroll
                for (int r = 0; r < 16; ++r) pmax = fmaxf(fmaxf(pmax, fmaxf(pA0[r], pA1[r])), fmaxf(pB0[r], pB1[r]));
                pmax = swap_max(pmax);
                const float mnL = -pmax * C2; float ps = 0.f;
#pragma unroll
                for (int r = 0; r < 16; ++r) { pA0[r] = __builtin_amdgcn_exp2f(fmaf(pA0[r], C2, mnL)); pA1[r] = __builtin_amdgcn_exp2f(fmaf(pA1[r], C2, mnL));
                    pB0[r] = __builtin_amdgcn_exp2f(fmaf(pB0[r], C2, mnL)); pB1[r] = __builtin_amdgcn_exp2f(fmaf(pB1[r], C2, mnL)); ps += (pA0[r] + pA1[r]) + (pB0[r] + pB1[r]); }
                ps = swap_sum(ps); l_reg = ps;
                const float inv_l = l_reg > 0.f ? 1.f / l_reg : 0.f;
                { float prev = 0.f; float* ib = impbuf + (rq * 64 + tl) * 33;
#define AT_IMPG(P, G0) _Pragma("unroll") for (int rg = 0; rg < 4; ++rg) { const float car = 0.5f * P[4 * rg + 3] * inv_l, own = (P[4 * rg] + P[4 * rg + 1] + P[4 * rg + 2]) * inv_l + car; \
                        const float rc = __shfl_xor(car, 32); ib[2 * ((G0) + rg) + c.hi] = own + (c.hi ? rc : prev); prev = rc; }
                  AT_IMPG(pA0, 0) AT_IMPG(pA1, 4) AT_IMPG(pB0, 8) AT_IMPG(pB1, 12)
#undef AT_IMPG
                }
                bf16x8 pa0, pa1, pa2, pa3;
#pragma unroll
                for (int d = 0; d < 4; ++d) o[d] = f32x16{};
                AT_PK4(pA0, 0, pa0); AT_PK4(pA0, 8, pa1); AT_PK4(pA1, 0, pa2); AT_PK4(pA1, 8, pa3);
                pv_tile(o, (int)(uintptr_t)(c.L + 2 * SHM) + v_rd_base(c.lane), pa0, pa1, pa2, pa3);
                AT_PK4(pB0, 0, pa0); AT_PK4(pB0, 8, pa1); AT_PK4(pB1, 0, pa2); AT_PK4(pB1, 8, pa3);
                pv_tile(o, (int)(uintptr_t)(c.L + 3 * SHM) + v_rd_base(c.lane), pa0, pa1, pa2, pa3);
                __syncthreads();
                { const int tk = c.tid >> 3, q4 = c.tid & 7; float val[4];
#pragma unroll
                  for (int e = 0; e < 4; ++e) { const int j = 4 * q4 + e; float v = impbuf[(0 * 64 + tk) * 33 + j] + impbuf[(1 * 64 + tk) * 33 + j] + impbuf[(2 * 64 + tk) * 33 + j] + impbuf[(3 * 64 + tk) * 33 + j];
                      const int dist = i - j; const bool forced = (j == 0) || (dist >= 0 && dist < 2); v = forced ? 1e4f : v; if (dist < 0) v = -__builtin_inff(); val[e] = v; impsum[tk * 32 + j] = v; }
                  __syncthreads();
                  int rank[4] = {0, 0, 0, 0};
                  for (int i2 = 0; i2 < 32; ++i2) { const float x = impsum[tk * 32 + i2];
#pragma unroll
                      for (int e = 0; e < 4; ++e) rank[e] += (x > val[e] || (x == val[e] && i2 < 4 * q4 + e)) ? 1 : 0; }
                  unsigned bits = 0u;
#pragma unroll
                  for (int e = 0; e < 4; ++e) bits |= (rank[e] < 16 ? 1u : 0u) << (4 * q4 + e);
                  bits |= __shfl_xor(bits, 1); bits |= __shfl_xor(bits, 2); bits |= __shfl_xor(bits, 4);
                  if (q4 == 0) selm[tk] = bits;
                  unsigned u = bits; u |= __shfl_xor(u, 8); u |= __shfl_xor(u, 16); u |= __shfl_xor(u, 32);
                  if (c.lane == 0) um[c.wid] = u; }
                __syncthreads();
                branch_acc<0>(c, o, gate[(size_t)(tok0 + tl) * 48 + hq * 3 + 0] * inv_l, stash + c.wid * 8192, obuf, orow0);
            }
            const unsigned smask = selm[tl];
            unsigned umask = um[0] | um[1] | um[2] | um[3] | um[4] | um[5] | um[6] | um[7];
            umask = __builtin_amdgcn_readfirstlane(umask) & ((2u << i) - 1u);
            branch<1>(c, KS + (size_t)b * SEQ * 512 + g * 128, VS + (size_t)b * SEQ * 512 + g * 128, umask, i, tl, smask, qr, o, l_reg);
            branch_acc<1>(c, o, gate[(size_t)(tok0 + tl) * 48 + hq * 3 + 1] / l_reg, stash + c.wid * 8192, obuf, orow0);
            branch_acc<4>(c, o, 0.f, stash + c.wid * 8192, obuf, orow0, (const char*)(p.big + BIG_NSA_OCMP) + ((size_t)(pr * 2 + pass) * 8 + c.wid) * 8192);
            __syncthreads();
        }
    }
}

DEV void ph_attn_win(const P& p, char* L  , int pr0, int ps0, int ps1) {
    using namespace at;
    Ctx c; c.L = L; c.tid = tidx(); c.wid = __builtin_amdgcn_readfirstlane(c.tid >> 6); c.lane = c.tid & 63; c.r32 = c.lane & 31; c.hi = c.lane >> 5;
#pragma unroll
    for (int i = 0; i < 2; ++i) { const int pos = c.tid * 16 + i * 8192;
        { const int row = pos >> 8, ch = ((pos >> 4) & 15) ^ (row & 7); c.ksrc[i] = (unsigned)(row << 16) | (unsigned)(ch * 8); }
        { const int sub = pos >> 9, w = (pos & 511) >> 1, kk = (sub >> 2) * 8 + (w >> 5), k = (kk & ~0xC) | ((kk & 4) << 1) | ((kk & 8) >> 1), col = (sub & 3) * 32 + (w & 31);
          c.vsrc[i] = (unsigned)(k << 16) | (unsigned)col; } }
    float* wsf = (float*)(L + 4 * SHM) + c.wid * 64; c.li_l = wsf; c.al_l = wsf + 32;
    const bf16_t* Q = (const bf16_t*)(p.big + BIG_NSA_Q); const float* gate = (const float*)(p.big + BIG_NSA_GATE);
    const bf16_t* KW = (const bf16_t*)(p.big + BIG_NSA_KW); const bf16_t* VW = (const bf16_t*)(p.big + BIG_NSA_VW);
    char* owin = p.big + BIG_NSA_OCMP;
    const int rq = c.wid & 3, th = c.wid >> 2, tl = 32 * th + c.r32;
    const int pr = (pr0 & 7) * 32 + (pr0 >> 3);
    const int bg = pr >> 4, b = bg >> 2, g = bg & 3, ii = pr & 15;
#pragma unroll 1
    for (int pass = ps0; pass < ps1; ++pass) {
        const int i = pass == 0 ? 31 - ii : ii;
        const int hq = 4 * g + rq, tok0 = b * SEQ + 64 * i;
        bf16x8 qr[8];
        { int hiq = c.hi, tlq = tl; asm volatile("" : "+v"(hiq), "+v"(tlq));
          const bf16_t* qp = Q + (size_t)(tok0 + tlq) * 2048 + hq * 128 + hiq * 8;
#pragma unroll
          for (int d0 = 0; d0 < 8; ++d0) qr[d0] = *(const bf16x8*)(qp + d0 * 16); }
        f32x16 o[4]; float l_reg;
        { const int jlo = i - 8 > 0 ? i - 8 : 0; const unsigned wt = ((2u << i) - 1u) & ~((1u << jlo) - 1u);
          branch<2>(c, KW + (size_t)b * SEQ * 512 + g * 128, VW + (size_t)b * SEQ * 512 + g * 128, wt, i, tl, 0u, qr, o, l_reg); }
        branch_acc<0>(c, o, gate[(size_t)(tok0 + tl) * 48 + hq * 3 + 2] / l_reg, owin + ((size_t)(pr * 2 + pass) * 8 + c.wid) * 8192, nullptr, 0);
        __syncthreads();
    }
}

DEV void ph_moe_route(const P& p, int layer, const bf16_t* xin  , float* lds, int bid, int nb) {
    typedef float f32x16 __attribute__((ext_vector_type(16)));
    const int tid = tidx(), wid = __builtin_amdgcn_readfirstlane(tid >> 6), lane = tid & 63, i = lane & 31, kk = lane >> 5;
    float* part = lds;
    float* gpart = lds + 8192;
    float* spart = gpart + 1024;
    float* logit = spart + 256;
    float* rinv_l = logit + 32 * 36;
    int* lcnt = (int*)(rinv_l + 32);
    int* lbase = lcnt + 32;
    const float* wr = p.wr + (size_t)layer * D_MODEL * MOE_E; const float* wgq = p.wgq + (size_t)layer * D_MODEL * MOE_G;
    const float* g = p.ln_ffn + layer * D_MODEL;
    const float* bgrp = p.moe_b_group + layer * MOE_G; const float* bexp = p.moe_b_expert + layer * MOE_E;
    int* cnt = p.cnt + layer * MOE_E;
    for (int tb = bid; tb < T / 32; tb += nb) {
        const int tok0 = tb * 32;
        const bf16_t* xr = xin + (size_t)(tok0 + i) * D_MODEL + 256 * wid + 4 * kk;
        const float* wrow = wr + (size_t)(256 * wid + 4 * kk) * MOE_E + i;
        const float* wgrow = wgq + (size_t)(256 * wid + 4 * kk) * MOE_G;
        f32x16 acc = f32x16{}; float ss = 0.f; f32x4 ga = {0.f, 0.f, 0.f, 0.f};
#pragma unroll 4
        for (int j = 0; j < 32; ++j) {
            const u32x2 xw = *(const u32x2*)(xr + 8 * j); const f32x4 xv = {__uint_as_float(xw.x << 16), __uint_as_float(xw.x & 0xffff0000u), __uint_as_float(xw.y << 16), __uint_as_float(xw.y & 0xffff0000u)};
            const float* wp = wrow + (size_t)(8 * j) * MOE_E;
            const float b0 = wp[0], b1 = wp[MOE_E], b2 = wp[2 * MOE_E], b3 = wp[3 * MOE_E];
            const f32x4* gp = (const f32x4*)(wgrow + (size_t)(8 * j) * MOE_G);
            const f32x4 g0 = gp[0], g1 = gp[1], g2 = gp[2], g3 = gp[3];
            acc = __builtin_amdgcn_mfma_f32_32x32x2f32(xv[0], b0, acc, 0, 0, 0); acc = __builtin_amdgcn_mfma_f32_32x32x2f32(xv[1], b1, acc, 0, 0, 0);
            acc = __builtin_amdgcn_mfma_f32_32x32x2f32(xv[2], b2, acc, 0, 0, 0); acc = __builtin_amdgcn_mfma_f32_32x32x2f32(xv[3], b3, acc, 0, 0, 0);
            ss += xv[0] * xv[0] + xv[1] * xv[1] + xv[2] * xv[2] + xv[3] * xv[3];
            ga += g0 * xv[0] + g1 * xv[1] + g2 * xv[2] + g3 * xv[3];
        }
        ss += __shfl_xor(ss, 32);
#pragma unroll
        for (int q = 0; q < 4; ++q) ga[q] += __shfl_xor(ga[q], 32);
#pragma unroll
        for (int r = 0; r < 16; ++r) part[(wid * 32 + (r & 3) + 8 * (r >> 2) + 4 * kk) * 32 + i] = acc[r];
        if (kk == 0) { *(f32x4*)(gpart + (wid * 32 + i) * 4) = ga; spart[wid * 32 + i] = ss; }
        __syncthreads();
#pragma unroll
        for (int e = 0; e < 2; ++e) { const int idx = tid + e * 512, tk = idx >> 5, o = idx & 31; float sm = 0.f;
#pragma unroll
            for (int w = 0; w < 8; ++w) sm += part[(w * 32 + tk) * 32 + o];
            logit[tk * 36 + o] = sm; }
        if (tid < 128) { const int tk = tid >> 2, q = tid & 3; float sm = 0.f;
#pragma unroll
            for (int w = 0; w < 8; ++w) sm += gpart[(w * 32 + tk) * 4 + q];
            logit[tk * 36 + 32 + q] = sm; }
        if (tid < 32) { float sm = 0.f;
#pragma unroll
            for (int w = 0; w < 8; ++w) sm += spart[w * 32 + tid];
            rinv_l[tid] = rsqrtf(sm * (1.f / D_MODEL) + NORM_EPS); lcnt[tid] = 0; }
        __syncthreads();
        if (tid < 32) { const int tok = tok0 + tid; const float rinv = rinv_l[tid]; const float* lg = logit + tid * 36;
            float gl[4]; for (int q = 0; q < 4; ++q) gl[q] = lg[32 + q] * rinv + bgrp[q];
            int gs = 0; float gm = gl[0]; for (int q = 1; q < 4; ++q) if (gl[q] > gm) { gm = gl[q]; gs = q; }
            float gsum = 0.f; for (int q = 0; q < 4; ++q) gsum += expf(gl[q] - gm);
            const float gw = 1.f / gsum;
            float ev[8]; for (int q = 0; q < 8; ++q) ev[q] = lg[gs * 8 + q] * rinv + bexp[gs * 8 + q];
            int i1 = 0; for (int q = 1; q < 8; ++q) if (ev[q] > ev[i1]) i1 = q;
            int i2 = i1 == 0 ? 1 : 0; for (int q = 0; q < 8; ++q) if (q != i1 && ev[q] > ev[i2]) i2 = q;
            const float e2 = expf(ev[i2] - ev[i1]); const float w1 = gw / (1.f + e2), w2 = gw * e2 / (1.f + e2);
            const int ea = gs * 8 + i1, eb = gs * 8 + i2;
            const int ra = atomicAdd(&lcnt[ea], 1), rb = atomicAdd(&lcnt[eb], 1);
            asm volatile("s_waitcnt lgkmcnt(0)" ::: "memory");
            const int mine = lcnt[tid]; int base = 0; if (mine) base = atomicAdd(&cnt[tid], mine);
            lbase[tid] = base;
            asm volatile("s_waitcnt lgkmcnt(0)" ::: "memory");
            p.list[ea * T + lbase[ea] + ra] = tok * 2; p.ew[tok * 2] = w1;
            p.list[eb * T + lbase[eb] + rb] = tok * 2 + 1; p.ew[tok * 2 + 1] = w2; }
#pragma unroll
        for (int tt = 0; tt < 4; ++tt) { const int tok = tok0 + 4 * wid + tt; const float rinv = rinv_l[4 * wid + tt];
#pragma unroll
            for (int ii = 0; ii < 8; ++ii) { const int c = ii * 256 + lane * 4; const u32x2 xw = *(const u32x2*)(xin + (size_t)tok * D_MODEL + c); const f32x4 xv = {__uint_as_float(xw.x << 16), __uint_as_float(xw.x & 0xffff0000u), __uint_as_float(xw.y << 16), __uint_as_float(xw.y & 0xffff0000u)}, gg = *(const f32x4*)(g + c);
                const float rs = rinv * F8_SX;
                *(unsigned*)((char*)p.hb16 + (size_t)tok * D_MODEL + c) = pk8(xv[0] * rs * gg[0], xv[1] * rs * gg[1], xv[2] * rs * gg[2], xv[3] * rs * gg[3]); } }
        __syncthreads();
    }
}

namespace ssd {
using namespace at;
constexpr int OFF_CK = 0, OFF_BK = 32768, OFF_BV = 65536, OFF_XV = 98304, OFF_XS = 114688, OFF_PV = 131072, OFF_TB = 147456;
DEV int v64_st(int k, int c) { const int kk = (k & ~0xC) | ((k & 4) << 1) | ((k & 8) >> 1); return ((kk >> 3) * 2 + (c >> 5)) * 512 + ((kk & 7) * 32 + (c & 31)) * 2; }
#define SD_TRRD(dst, base, off) asm volatile("ds_read_b64_tr_b16 %0, %1 offset:%2" : "=&v"(dst) : "v"(base), "i"(off) : "memory")
#define SD_MK(lo, hi) ((bf16x8){lo[0], lo[1], lo[2], lo[3], hi[0], hi[1], hi[2], hi[3]})
DEV float conv8(const bf16x8& r0, const bf16x8& r1, const bf16x8& r2, const bf16x8& r3, const float (&w)[4][8], const float (&bias)[8], int j) {
    float a = bias[j]; a = fmaf(bf2f((bf16_t)r0[j]), w[0][j], a); a = fmaf(bf2f((bf16_t)r1[j]), w[1][j], a); a = fmaf(bf2f((bf16_t)r2[j]), w[2][j], a); a = fmaf(bf2f((bf16_t)r3[j]), w[3][j], a);
    return a / (1.f + __expf(-a));
}
}

DEV void ph_ssd_conv_bc(const P& p, int bid, int nb) {
    using namespace ssd;
    const bf16_t* xp = (const bf16_t*)(p.big + BIG_SSD_XBCP); bf16_t* bc = (bf16_t*)(p.big + BIG_SSD_BC);
    const bf16x8 zero8 = {0, 0, 0, 0, 0, 0, 0, 0};
    for (int it = bid * NTHREADS + tidx(); it < (T / 16) * 256; it += nb * NTHREADS) {
        const int cg = it & 255, tb = it >> 8, ch = SSD_DI + cg * 8, t0 = (tb * 16) & (SEQ - 1); const size_t tok0 = (size_t)tb * 16;
        float w[4][8], bias[8];
#pragma unroll
        for (int k = 0; k < 4; ++k) { const f32x4 w0 = *(const f32x4*)(p.ssd_conv_w + k * SSD_CONVCH + ch), w1 = *(const f32x4*)(p.ssd_conv_w + k * SSD_CONVCH + ch + 4);
#pragma unroll
            for (int j = 0; j < 4; ++j) { w[k][j] = w0[j]; w[k][4 + j] = w1[j]; } }
        { const f32x4 b0 = *(const f32x4*)(p.ssd_conv_b + ch), b1 = *(const f32x4*)(p.ssd_conv_b + ch + 4);
#pragma unroll
          for (int j = 0; j < 4; ++j) { bias[j] = b0[j]; bias[4 + j] = b1[j]; } }
        bf16x8 r0 = t0 >= 3 ? *(const bf16x8*)(xp + (tok0 - 3) * SSD_CONVCH + ch) : zero8, r1 = t0 >= 2 ? *(const bf16x8*)(xp + (tok0 - 2) * SSD_CONVCH + ch) : zero8,
               r2 = t0 >= 1 ? *(const bf16x8*)(xp + (tok0 - 1) * SSD_CONVCH + ch) : zero8;
#pragma unroll 8
        for (int i = 0; i < 16; ++i) { const bf16x8 r3 = *(const bf16x8*)(xp + (tok0 + i) * SSD_CONVCH + ch); float o[8];
#pragma unroll
            for (int j = 0; j < 8; ++j) o[j] = conv8(r0, r1, r2, r3, w, bias, j);
            u32x4 pk; pk.x = cvtpk(o[0], o[1]); pk.y = cvtpk(o[2], o[3]); pk.z = cvtpk(o[4], o[5]); pk.w = cvtpk(o[6], o[7]);
            *(u32x4*)(bc + (tok0 + i) * 2048 + cg * 8) = pk; r0 = r1; r1 = r2; r2 = r3; }
    }
}

DEV void ph_ssd_mfma(const P& p, char* L, int bid, int nb) {
    using namespace ssd;
    const int tid = tidx(), wid = __builtin_amdgcn_readfirstlane(tid >> 6), lane = tid & 63;
    const int lb = wid & 3, pb = wid >> 2, nbk = wid & 3;
    const bf16_t* xp = (const bf16_t*)(p.big + BIG_SSD_XBCP); const bf16_t* bc = (const bf16_t*)(p.big + BIG_SSD_BC);
    bf16_t* yb = (bf16_t*)(p.big + BIG_SSD_YN);
    float* tabs = (float*)(L + OFF_TB);
    const bf16x8 zero8 = {0, 0, 0, 0, 0, 0, 0, 0};
    unsigned ksrc[2], vsrc[2];
#pragma unroll
    for (int i = 0; i < 2; ++i) { const int pos = tid * 16 + i * 8192;
        { const int row = pos >> 8, ch = ((pos >> 4) & 15) ^ (row & 7); ksrc[i] = (unsigned)(row * 2048 + ch * 8); }
        { const int sub = pos >> 9, w = (pos & 511) >> 1, kk = (sub >> 2) * 8 + (w >> 5), k = (kk & ~0xC) | ((kk & 4) << 1) | ((kk & 8) >> 1), col = (sub & 3) * 32 + (w & 31); vsrc[i] = (unsigned)(k * 2048 + col); } }
    for (int u0 = bid; u0 < BATCH * SSD_H; u0 += nb) {
        const int u = (nb == 256) ? ((u0 & 7) * 32 + (u0 >> 3)) : u0;
        const int b = u >> 6, h = u & 63, g = h >> 3;
        const float Ah = -expf(p.ssd_a_log[h]), Dh = p.ssd_d[h];
        f32x16 st = f32x16{};
        for (int i = tid; i < 16384 / 16; i += NTHREADS) *(bf16x8*)(L + OFF_PV + i * 16) = zero8;
        float* tabg = (float*)(p.big + BIG_SSD_TABG) + (size_t)u * 16 * 640;
#pragma unroll 1
        for (int cc = 0; cc < 2; ++cc) { const int chunk = 2 * wid + cc; float* tb_ = tabg + chunk * 640; const size_t t0_ = (size_t)b * SEQ + chunk * 128 + 2 * lane;
            const float d0 = p.dtb[t0_ * 64 + h], d1 = p.dtb[(t0_ + 1) * 64 + h]; const float a0 = d0 * Ah, a1 = d1 * Ah; float c = a0 + a1;
#pragma unroll
            for (int o_ = 1; o_ < 64; o_ <<= 1) { const float v = __shfl_up(c, o_); if (lane >= o_) c += v; }
            const float e1 = c, e0 = c - a1, tot = __shfl(c, 63);
            tb_[2 * lane] = e0 * 1.4426950408889634f; tb_[2 * lane + 1] = e1 * 1.4426950408889634f; tb_[128 + 2 * lane] = __expf(e0); tb_[128 + 2 * lane + 1] = __expf(e1);
            tb_[256 + 2 * lane] = __expf(tot - e0); tb_[256 + 2 * lane + 1] = __expf(tot - e1); tb_[384 + 2 * lane] = Dh / fmaxf(d0, 1e-30f); tb_[384 + 2 * lane + 1] = Dh / fmaxf(d1, 1e-30f); tb_[512 + 2 * lane] = d0; tb_[512 + 2 * lane + 1] = d1; }
        __syncthreads();
#pragma unroll 1
        for (int ck = 0; ck < SEQ / 128; ++ck) {
            const float* tb = tabs;
            const float* tg = tabg + ck * 640;
            const size_t tok0 = (size_t)b * SEQ + ck * 128;
            { const float v0 = tg[tid]; tabs[tid] = v0; if (tid < 128) tabs[512 + tid] = tg[512 + tid]; }
            { const bf16_t* bsrc = bc + tok0 * 2048 + g * 128; const bf16_t* csrc = bsrc + 1024;
#pragma unroll
              for (int tile = 0; tile < 2; ++tile)
#pragma unroll
                  for (int i = 0; i < 2; ++i) {
                      __builtin_amdgcn_global_load_lds((const unsigned*)(csrc + (size_t)tile * 64 * 2048 + ksrc[i]), (MG_LAS unsigned*)((MG_LAS char*)L + OFF_CK + tile * 16384 + wid * 1024 + i * 8192), 16, 0, 0);
                      __builtin_amdgcn_global_load_lds((const unsigned*)(bsrc + (size_t)tile * 64 * 2048 + ksrc[i]), (MG_LAS unsigned*)((MG_LAS char*)L + OFF_BK + tile * 16384 + wid * 1024 + i * 8192), 16, 0, 0);
                      __builtin_amdgcn_global_load_lds((const unsigned*)(bsrc + (size_t)tile * 64 * 2048 + vsrc[i]), (MG_LAS unsigned*)((MG_LAS char*)L + OFF_BV + tile * 16384 + wid * 1024 + i * 8192), 16, 0, 0); } }
            { int tl_ = tid; asm volatile("" : "+v"(tl_));
              const int cgx = tl_ & 7, rsx = tl_ >> 3, chx = h * 64 + cgx * 8;
              float w[4][8], bias[8];
#pragma unroll
              for (int k = 0; k < 4; ++k) { const f32x4 w0 = *(const f32x4*)(p.ssd_conv_w + k * SSD_CONVCH + chx), w1 = *(const f32x4*)(p.ssd_conv_w + k * SSD_CONVCH + chx + 4);
#pragma unroll
                  for (int j = 0; j < 4; ++j) { w[k][j] = w0[j]; w[k][4 + j] = w1[j]; } }
              { const f32x4 b0 = *(const f32x4*)(p.ssd_conv_b + chx), b1 = *(const f32x4*)(p.ssd_conv_b + chx + 4);
#pragma unroll
                for (int j = 0; j < 4; ++j) { bias[j] = b0[j]; bias[4 + j] = b1[j]; } }
              bf16x8 rw[5];
#pragma unroll
              for (int i = 0; i < 5; ++i) { const int l = 2 * rsx - 3 + i; rw[i] = (ck * 128 + l >= 0) ? *(const bf16x8*)(xp + (tok0 + l) * SSD_CONVCH + chx) : zero8; }
#pragma unroll
              for (int i = 0; i < 2; ++i) { const int l = 2 * rsx + i; const float dtl = tg[512 + l], sdl = tg[256 + l]; float o[8];
#pragma unroll
                  for (int j = 0; j < 8; ++j) o[j] = conv8(rw[i], rw[i + 1], rw[i + 2], rw[i + 3], w, bias, j) * dtl;
                  u32x4 pk; pk.x = cvtpk(o[0], o[1]); pk.y = cvtpk(o[2], o[3]); pk.z = cvtpk(o[4], o[5]); pk.w = cvtpk(o[6], o[7]);
                  *(u32x4*)(L + OFF_XV + v64_st(l, cgx * 8)) = pk;
                  pk.x = cvtpk(o[0] * sdl, o[1] * sdl); pk.y = cvtpk(o[2] * sdl, o[3] * sdl); pk.z = cvtpk(o[4] * sdl, o[5] * sdl); pk.w = cvtpk(o[6] * sdl, o[7] * sdl);
                  *(u32x4*)(L + OFF_XS + v64_st(l, cgx * 8)) = pk; } }
            __syncthreads();
            int ln_ = lane; asm volatile("" : "+v"(ln_)); const int r32 = ln_ & 31, hi = ln_ >> 5, lane2 = ln_;
            bf16x8 qr[8];
            { const char* cb_ = L + OFF_CK + (lb >> 1) * 16384;
#pragma unroll
              for (int d0 = 0; d0 < 8; ++d0) qr[d0] = *(const bf16x8*)(cb_ + AT_KSWZ((lb & 1) * 32 + r32, (d0 * 16 + hi * 8) * 2)); }
            f32x16 o = f32x16{}, oo = f32x16{};
            const int l = 32 * lb + r32; const float al = tb[l], dl = tb[384 + l];
            const int xvb = (int)(uintptr_t)(L + OFF_XV) + v_rd_base(lane2) + pb * 512;
            for (int kt = 0; kt <= (lb >> 1); ++kt) {
                f32x16 p0, p1;
                qkt(p0, p1, L + OFF_BK + kt * 16384, r32, hi, qr);
                if (kt < (lb >> 1)) {
#pragma unroll
                    for (int r = 0; r < 16; ++r) { const int s0 = 64 * kt + crow(r, hi), s1 = s0 + 32; p0[r] *= __builtin_amdgcn_exp2f(al - tb[s0]); p1[r] *= __builtin_amdgcn_exp2f(al - tb[s1]); }
                } else {
#pragma unroll
                for (int r = 0; r < 16; ++r) { const int s0 = 64 * kt + crow(r, hi), s1 = s0 + 32;
                    float v0 = p0[r] * __builtin_amdgcn_exp2f(al - tb[s0]), v1 = p1[r] * __builtin_amdgcn_exp2f(al - tb[s1]);
                    v0 = s0 <= l ? v0 : 0.f; v1 = s1 <= l ? v1 : 0.f; v0 += s0 == l ? dl : 0.f; v1 += s1 == l ? dl : 0.f; p0[r] = v0; p1[r] = v1; }
                }
                bf16x8 pa0, pa1, pa2, pa3;
                AT_PK4(p0, 0, pa0); AT_PK4(p0, 8, pa1); AT_PK4(p1, 0, pa2); AT_PK4(p1, 8, pa3);
                { const int vb = xvb + kt * 8192; s16x4 l0, l1, l2, l3, h0, h1, h2, h3;
                  SD_TRRD(l0, vb, 0); SD_TRRD(h0, vb, 1024); SD_TRRD(l1, vb, 2048); SD_TRRD(h1, vb, 3072); SD_TRRD(l2, vb, 4096); SD_TRRD(h2, vb, 5120); SD_TRRD(l3, vb, 6144); SD_TRRD(h3, vb, 7168);
                  asm volatile("s_waitcnt lgkmcnt(0)" ::: "memory"); __builtin_amdgcn_sched_barrier(0);
                  o = __builtin_amdgcn_mfma_f32_32x32x16_bf16(pa0, SD_MK(l0, h0), o, 0, 0, 0); o = __builtin_amdgcn_mfma_f32_32x32x16_bf16(pa1, SD_MK(l1, h1), o, 0, 0, 0);
                  o = __builtin_amdgcn_mfma_f32_32x32x16_bf16(pa2, SD_MK(l2, h2), o, 0, 0, 0); o = __builtin_amdgcn_mfma_f32_32x32x16_bf16(pa3, SD_MK(l3, h3), o, 0, 0, 0); }
            }
            { const int vb = (int)(uintptr_t)(L + OFF_PV) + v_rd_base(lane2) + pb * 512;
#define SD_YOFF(K0) do { s16x4 l0, l1, l2, l3, h0, h1, h2, h3; \
                  SD_TRRD(l0, vb, (K0) * 2048); SD_TRRD(h0, vb, (K0) * 2048 + 1024); SD_TRRD(l1, vb, (K0) * 2048 + 2048); SD_TRRD(h1, vb, (K0) * 2048 + 3072); \
                  SD_TRRD(l2, vb, (K0) * 2048 + 4096); SD_TRRD(h2, vb, (K0) * 2048 + 5120); SD_TRRD(l3, vb, (K0) * 2048 + 6144); SD_TRRD(h3, vb, (K0) * 2048 + 7168); \
                  asm volatile("s_waitcnt lgkmcnt(0)" ::: "memory"); __builtin_amdgcn_sched_barrier(0); \
                  oo = __builtin_amdgcn_mfma_f32_32x32x16_bf16(qr[(K0)], SD_MK(l0, h0), oo, 0, 0, 0); oo = __builtin_amdgcn_mfma_f32_32x32x16_bf16(qr[(K0) + 1], SD_MK(l1, h1), oo, 0, 0, 0); \
                  oo = __builtin_amdgcn_mfma_f32_32x32x16_bf16(qr[(K0) + 2], SD_MK(l2, h2), oo, 0, 0, 0); oo = __builtin_amdgcn_mfma_f32_32x32x16_bf16(qr[(K0) + 3], SD_MK(l3, h3), oo, 0, 0, 0); } while (0)
              SD_YOFF(0); SD_YOFF(4);
#undef SD_YOFF
            }
            { const float dec = tb[128 + 127];
#pragma unroll
              for (int r = 0; r < 16; ++r) st[r] *= dec;
              const int xsb = (int)(uintptr_t)(L + OFF_XS) + v_rd_base(lane2) + pb * 512;
              const int bvb = (int)(uintptr_t)(L + OFF_BV) + v_rd_base(lane2) + nbk * 512;
#define SD_STATE(K0, BOFF) do { s16x4 a0, a1, a2, a3, a4, a5, a6, a7, b0, b1, b2, b3, b4, b5, b6, b7; \
                  SD_TRRD(a0, xsb, (K0) * 2048); SD_TRRD(a1, xsb, (K0) * 2048 + 1024); SD_TRRD(a2, xsb, (K0) * 2048 + 2048); SD_TRRD(a3, xsb, (K0) * 2048 + 3072); \
                  SD_TRRD(a4, xsb, (K0) * 2048 + 4096); SD_TRRD(a5, xsb, (K0) * 2048 + 5120); SD_TRRD(a6, xsb, (K0) * 2048 + 6144); SD_TRRD(a7, xsb, (K0) * 2048 + 7168); \
                  SD_TRRD(b0, bvb, (BOFF)); SD_TRRD(b1, bvb, (BOFF) + 2048); SD_TRRD(b2, bvb, (BOFF) + 4096); SD_TRRD(b3, bvb, (BOFF) + 6144); \
                  SD_TRRD(b4, bvb, (BOFF) + 8192); SD_TRRD(b5, bvb, (BOFF) + 10240); SD_TRRD(b6, bvb, (BOFF) + 12288); SD_TRRD(b7, bvb, (BOFF) + 14336); \
                  asm volatile("s_waitcnt lgkmcnt(0)" ::: "memory"); __builtin_amdgcn_sched_barrier(0); \
                  st = __builtin_amdgcn_mfma_f32_32x32x16_bf16(SD_MK(a0, a1), SD_MK(b0, b1), st, 0, 0, 0); st = __builtin_amdgcn_mfma_f32_32x32x16_bf16(SD_MK(a2, a3), SD_MK(b2, b3), st, 0, 0, 0); \
                  st = __builtin_amdgcn_mfma_f32_32x32x16_bf16(SD_MK(a4, a5), SD_MK(b4, b5), st, 0, 0, 0); st = __builtin_amdgcn_mfma_f32_32x32x16_bf16(SD_MK(a6, a7), SD_MK(b6, b7), st, 0, 0, 0); } while (0)
              SD_STATE(0, 0); SD_STATE(4, 16384);
              asm volatile("s_nop 15\n\ts_nop 15" : "+v"(st));
#undef SD_STATE
            }
            { const int colg = h * 64 + 32 * pb + r32;
#pragma unroll
              for (int r = 0; r < 16; ++r) { const int lr = 32 * lb + crow(r, hi); const size_t tok = tok0 + lr;
                  const float y = o[r] + tb[128 + lr] * oo[r]; const float yn = swap_pair(y); if ((r32 & 1) == 0) *(unsigned*)(yb + tok * SSD_DI + colg) = cvtpk(y, yn); } }
            __syncthreads();
#pragma unroll
            for (int rg = 0; rg < 4; ++rg) { u32x2 w2; w2.x = cvtpk(st[4 * rg], st[4 * rg + 1]); w2.y = cvtpk(st[4 * rg + 2], st[4 * rg + 3]);
                *(u32x2*)(L + OFF_PV + v64_st(32 * nbk + r32, 32 * pb + 8 * rg + 4 * hi)) = w2; }
        }
        __syncthreads();
    }
}

DEV void ph_ssd_norm(const P& p, int bid, int nb) {
    const int lane = tidx() & 63, wid = tidx() >> 6;
    bf16_t* yb = (bf16_t*)(p.big + BIG_SSD_YN); const bf16_t* zb = (const bf16_t*)(p.big + BIG_SSD_Z);
    for (int tok = bid * 8 + wid; tok < T; tok += nb * 8) {
        const int lo = (lane >> 3) * 512 + (lane & 7) * 8;
        bf16_t* yr = yb + (size_t)tok * SSD_DI + lo; const bf16_t* zr = zb + (size_t)tok * SSD_DI + lo; const float* ng = p.ssd_norm + lo;
        float v[64]; float ss = 0.f;
#pragma unroll
        for (int i = 0; i < 8; ++i) { const bf16x8 yv = *(const bf16x8*)(yr + i * 64), zv = *(const bf16x8*)(zr + i * 64);
#pragma unroll
            for (int j = 0; j < 8; ++j) { const float z = bf2f((bf16_t)zv[j]); const float t = bf2f((bf16_t)yv[j]) * (z / (1.f + __expf(-z))); v[i * 8 + j] = t; ss += t * t; } }
        ss += __shfl_xor(ss, 1); ss += __shfl_xor(ss, 2); ss += __shfl_xor(ss, 4);
        const float rinv = rsqrtf(ss * (1.f / 512.f) + NORM_EPS);
#pragma unroll
        for (int i = 0; i < 8; ++i) { float o[8];
#pragma unroll
            for (int j = 0; j < 8; ++j) o[j] = v[i * 8 + j] * rinv * ng[i * 64 + j];
            u32x4 w; w.x = at::cvtpk(o[0], o[1]); w.y = at::cvtpk(o[2], o[3]); w.z = at::cvtpk(o[4], o[5]); w.w = at::cvtpk(o[6], o[7]); *(u32x4*)(yr + i * 64) = w; }
    }
}

#define XB_TMO      128
#define XB_XCNT(j)  (256  + 64 * (j))
#define XB_XSUB(j)  (1280 + 64 * (j))
#define XB_XGEN(j)  (2304 + 64 * (j))
#define XB_TOP      3328
#define XB_TOPGEN   3392
#define XCD_BAR_WORDS 3456
#define XB_SPIN_CAP (1u << 22)
#define LAS __attribute__((address_space(3)))

__device__ __forceinline__ unsigned xb_ld(unsigned* p)              { return __hip_atomic_load(p, __ATOMIC_RELAXED, __HIP_MEMORY_SCOPE_AGENT); }
__device__ __forceinline__ unsigned xb_add(unsigned* p, unsigned v) { return __hip_atomic_fetch_add(p, v, __ATOMIC_RELAXED, __HIP_MEMORY_SCOPE_AGENT); }
__device__ __forceinline__ unsigned xb_xcc_id() { return (unsigned)__builtin_amdgcn_s_getreg((3 << 11) | 20) & 0xFu; }
#define XB_SPIN(cond, bar) do { unsigned _sp = 0; while (cond) { __builtin_amdgcn_s_sleep(1); \
    if ((++_sp & 255u) == 0u) { if (xb_ld(&(bar)[XB_TMO])) break; if (_sp > XB_SPIN_CAP) { atomicAdd(&(bar)[XB_TMO], 1u); break; } } } } while (0)

struct XcdBarrier {
    unsigned* bar; unsigned x;
    volatile LAS unsigned* st;
};

__device__ __forceinline__ XcdBarrier xcd_barrier_post(unsigned* bar, volatile LAS unsigned* st) {
    XcdBarrier b; b.bar = bar; b.x = xb_xcc_id(); b.st = st;
    if (threadIdx.x == 0) (void)xb_add(&bar[XB_XCNT(b.x)], 1u);
    return b;
}
__device__ __forceinline__ void xcd_barrier_complete(unsigned* bar, unsigned x, unsigned& nloc, unsigned& nx) {
    const unsigned G = gridDim.x * gridDim.y * gridDim.z;
    unsigned sum, cnt, mine, sp = 0u;
    for (;;) {
        sum = 0u; cnt = 0u; mine = 0u;
#pragma unroll
        for (unsigned j = 0; j < 16; ++j) { const unsigned c = xb_ld(&bar[XB_XCNT(j)]); sum += c; cnt += (c > 0u) ? 1u : 0u; mine = (j == x) ? c : mine; }
        if (sum == G) break;
        __builtin_amdgcn_s_sleep(1);
        if ((++sp & 255u) == 0u) { if (xb_ld(&bar[XB_TMO])) break; if (sp > XB_SPIN_CAP) { atomicAdd(&bar[XB_TMO], 1u); break; } }
    }
    nloc = mine > 0u ? mine : 1u; nx = cnt > 0u ? cnt : 1u;
}

__device__ __forceinline__ void xcd_barrier(const XcdBarrier& b) {
    asm volatile("s_waitcnt vmcnt(0)" ::: "memory");
    __syncthreads();
    if (threadIdx.x == 0) {
        unsigned* bar = b.bar;
        __builtin_amdgcn_s_waitcnt(0);
        unsigned nloc = b.st[0], nx = b.st[1];
        if (nloc == 0u) { xcd_barrier_complete(bar, b.x, nloc, nx); b.st[0] = nloc; b.st[1] = nx; }
        const unsigned old = xb_add(&bar[XB_XSUB(b.x)], 1u);
        const unsigned gen = old / nloc;
        if (old + 1u == (gen + 1u) * nloc) {
            __builtin_amdgcn_fence(__ATOMIC_RELEASE, "agent");
            asm volatile("s_waitcnt vmcnt(0)" ::: "memory");
            const unsigned og = xb_add(&bar[XB_TOP], 1u);
            const unsigned tg = og / nx;
            if (og + 1u == (tg + 1u) * nx) xb_add(&bar[XB_TOPGEN], 1u);
            else XB_SPIN(xb_ld(&bar[XB_TOPGEN]) == tg, bar);
            __builtin_amdgcn_fence(__ATOMIC_ACQUIRE, "agent");
            xb_add(&bar[XB_XGEN(b.x)], 1u);
            asm volatile("s_waitcnt vmcnt(0)" ::: "memory");
        } else {
            XB_SPIN(xb_ld(&bar[XB_XGEN(b.x)]) == gen, bar);
            __builtin_amdgcn_fence(__ATOMIC_ACQUIRE, "agent");
            asm volatile("s_waitcnt vmcnt(0)" ::: "memory");
        }
    }
    __syncthreads();
}


constexpr int LDS_STAGE_OFF = 16, LDS_TAB_OFF = 16 + mg::STAGE_BYTES, LDS_BYTES = 16 + 147456 + 5120;
constexpr int NPHASE = 21;

DEV void moe_tables(const int* cnt, int* tab) {
    __syncthreads();
    if (tidx() == 0) { int s = 0, r = 0; for (int e = 0; e < MOE_E; ++e) { tab[e] = s; tab[64 + e] = r; const int c = cnt[e]; s += (c + 255) >> 8; r += c; } tab[MOE_E] = s; tab[64 + MOE_E] = r; }
    __syncthreads();
}
constexpr int MOE_CT_GU = 4096, MOE_CT_D = 2048, MOE_CT_L = MOE_CT_GU + MOE_CT_D;
DEV void conv_moe_tiles(const P& p, float* ldsf, int f0, int f1, int w, int nw) {
    if (w < 0 || f0 >= f1) return;
#pragma unroll 1
    for (int L = 0; L < 2; ++L) {
        const float* wg = p.moe_w_gate + (size_t)L * MOE_E * D_MODEL * MOE_FF; const float* wu = p.moe_w_up + (size_t)L * MOE_E * D_MODEL * MOE_FF;
        const float* wd = p.moe_w_down + (size_t)L * MOE_E * MOE_FF * D_MODEL;
        { const int a = f0 - L * MOE_CT_L, b = f1 - L * MOE_CT_L; const int lo = a > 0 ? a : 0, hi = b < MOE_CT_GU ? b : MOE_CT_GU;
          if (lo < hi) conv_wt<true>([=](int g, int k, int q) { const float* sp = (q & 1) ? wu : wg; return sp + ((size_t)g * D_MODEL + k) * MOE_FF + (q >> 1) * 4; }, MOE_E, D_MODEL, 2 * MOE_FF,
                               p.wt_gu + (size_t)L * MOE_E * MOE_FF * D_MODEL, ldsf, w, nw, lo, hi); }
        { const int a = f0 - L * MOE_CT_L - MOE_CT_GU, b = f1 - L * MOE_CT_L - MOE_CT_GU; const int lo = a > 0 ? a : 0, hi = b < MOE_CT_D ? b : MOE_CT_D;
          if (lo < hi) conv_wt<true>([=](int g, int k, int q) { return wd + ((size_t)g * MOE_FF + k) * D_MODEL + q * 4; }, MOE_E, MOE_FF, D_MODEL,
                               p.wt_d + (size_t)L * MOE_E * D_MODEL * MOE_FF / 2, ldsf, w, nw, lo, hi); }
    }
}
constexpr int CT_A = 1536, CT_B = MOE_CT_L, CT_C = MOE_CT_L + 1920, CT_D = MOE_CT_L + MOE_CT_GU, CT_E = 2 * MOE_CT_L;

template <int PH> DEV void run_phase(const P& p, float* ldsraw, int bid, int nb) {
    float* lds = ldsraw + 4;
    MG_LAS unsigned char* stage = (MG_LAS unsigned char*)ldsraw + LDS_STAGE_OFF;
    int* tab = (int*)((char*)ldsraw + LDS_TAB_OFF);
    if constexpr (PH == 0) {
        ph_rope_table(p, bid, nb);
        for (int i = bid * NTHREADS + tidx(); i < 2 * D_MODEL * MOE_E; i += nb * NTHREADS) p.wr[i] = p.moe_w_expert[i] * p.ln_ffn[i >> 5];
        for (int i = bid * NTHREADS + tidx(); i < 2 * D_MODEL * MOE_G; i += nb * NTHREADS) p.wgq[i] = p.moe_w_group[i] * p.ln_ffn[i >> 2];
        if (bid == 0 && tidx() < 64) p.cnt[tidx()] = 0;
        rows_norm<true>(p.x, nullptr, nullptr, nullptr, p.ln_mix, p.hb16, bid, nb);
        { const float* w = p.nsa_w_in; conv_wt<true>([=](int, int k, int q) { const int c = q * 4, pn = c >> 8; int lg = c;
              if (pn < 10 || pn == 12 || pn == 13 || pn == 16 || pn == 17) { const int c128 = c & 127; lg = (c & ~127) + 16 * (c128 >> 5) + 4 * ((c128 >> 3) & 3) + 64 * ((c128 >> 2) & 1); }
              return lg < NSA_PROJ ? w + (size_t)k * NSA_PROJ + lg : (const float*)nullptr; }, 1, D_MODEL, NSA_PROJ_P, p.wt_nsa_in, lds, bid, nb); }
        { const float* w = p.nsa_cmp_w1; conv_wt([=](int g, int k, int q) { return w + ((size_t)g * 4096 + k) * CMP_HIDDEN + q * 4; }, 2, 4096, CMP_HIDDEN, p.wt_cmp1, lds, bid, nb); }
        { const float* w = p.nsa_cmp_w2; conv_wt([=](int g, int k, int q) { return q < 32 ? w + ((size_t)g * CMP_HIDDEN + k) * 128 + q * 4 : (const float*)nullptr; }, 2, CMP_HIDDEN, 256, p.wt_cmp2, lds, bid, nb); }
    } else if constexpr (PH == 1) {
        mg::StaticOrder S; S.init(T, NSA_PROJ_P, nb, bid);
        mg::gemm_phase<true, 10>(stage, D_MODEL / 2, mg::APlain{p.hb16, D_MODEL / 2}, mg::BPlain{p.wt_nsa_in, D_MODEL / 2, 0}, S,
                       EpiNsaIn{(bf16_t*)(p.big + BIG_NSA_Q), (bf16_t*)(p.big + BIG_NSA_KS), (bf16_t*)(p.big + BIG_NSA_VS), (bf16_t*)(p.big + BIG_NSA_KW), (bf16_t*)(p.big + BIG_NSA_VW),
                                (bf16_t*)(p.big + BIG_NSA_ACMP), (float*)(p.big + BIG_NSA_GATE), p.rope, p.nsa_cmp_pe});
        { const int nu = (T / 256) * (NSA_PROJ_P / 256), rem = nu % nb; __syncthreads();
          if (rem) conv_moe_tiles(p, lds, 0, CT_A, bid - rem, nb - rem); else conv_moe_tiles(p, lds, 0, CT_A, bid, nb); }
    } else if constexpr (PH == 2) {
    } else if constexpr (PH == 3) {
        mg::FixedGroups S{2, 8, 1, nb, bid};
        mg::gemm_phase(stage, 4096, mg::AGrouped{(const bf16_t*)(p.big + BIG_NSA_ACMP), 4096, (size_t)2048 * 4096}, mg::BPlain{p.wt_cmp1, 4096, (size_t)CMP_HIDDEN * 4096}, S, EpiCmp1{(bf16_t*)(p.big + BIG_NSA_H1)});
        __syncthreads();
        for (int L = bid; L < 16; L += nb) { const int g = L >> 3, pm = L & 7;
            cmp_gemm2_rows((const bf16_t*)(p.big + BIG_NSA_H1) + (size_t)g * 2048 * 256, p.wt_cmp2 + (size_t)g * 256 * CMP_HIDDEN, (bf16_t*)(p.big + BIG_NSA_KVC) + (size_t)g * 2048 * 128, pm * 256); }
        __syncthreads();
        { const int ntask = (bid >= 16 && bid < 32) ? 2 : 1; const bool conv_first = bid >= 16 && ((bid >> 3) & 1);
#pragma unroll 1
          for (int step = 0; step < 2; ++step) {
              if ((step == 0) == conv_first) {
                  if (bid >= 16) {
                      conv_moe_tiles(p, lds, CT_A, CT_A + 2304, bid - 16, nb - 16);
                      if (bid >= 32) { const int fb = bid - 32, fn = nb - 32;
                          conv_moe_tiles(p, lds, CT_A + 2304, CT_B, fb, fn);
                          { const float* w = p.ssd_w_out; conv_wt([=](int, int k, int q) { return w + (size_t)k * D_MODEL + q * 4; }, 1, SSD_DI, D_MODEL, p.wt_ssd_out, lds, fb, fn); }
                          { const float* w1 = p.nsa_w_out; conv_wt([=](int, int k, int q) { return w1 + (size_t)k * D_MODEL + q * 4; }, 1, 2048, D_MODEL, p.wt_nsa_out, lds, fb, fn); }
                          { const float* w2 = p.ssd_w_in; conv_wt([=](int, int k, int q) { const int c = q * 4; return c < SSD_PROJ ? w2 + (size_t)k * SSD_PROJ + c : (const float*)nullptr; }, 1, D_MODEL, SSD_PROJ_P, p.wt_ssd_in, lds, fb, fn); } } }
              } else {
#pragma unroll 1
                  for (int t = 0; t < ntask; ++t) ph_attn_win(p, (char*)ldsraw + LDS_STAGE_OFF, t == 0 ? bid : bid - 16, t == 1 ? 1 : 0, bid < 16 ? 1 : 2);
                  __syncthreads();
              }
          } }
    } else if constexpr (PH == 4) {
    } else if constexpr (PH == 5) {
        ph_attn_mfma(p, (char*)ldsraw + LDS_STAGE_OFF, bid, nb);
    } else if constexpr (PH == 6) {
    } else if constexpr (PH == 7) {
        mg::StaticOrder S; S.init(T, D_MODEL, nb, bid);
        mg::gemm_phase(stage, 2048, mg::APlain{(const bf16_t*)(p.big + BIG_NSA_OBUF), 2048}, mg::BPlain{p.wt_nsa_out, 2048, 0}, S, EpiResid<false>{p.x, (bf16_t*)p.xB});
    } else if constexpr (PH == 8 || PH == 17) {
        ph_moe_route(p, PH == 8 ? 0 : 1, (const bf16_t*)p.xB, lds, bid, nb);
    } else if constexpr (PH == 9 || PH == 18) {
        constexpr int L = PH == 9 ? 0 : 1; const int* cnt = p.cnt + L * MOE_E;
        moe_tables(cnt, tab);
        mg::GroupedOrder S{tab, MOE_E, 4, nb, bid};
        mg::gemm_phase<true>(stage, D_MODEL / 2, AMoeGather{p.hb16, p.list, cnt}, mg::BPlain{p.wt_gu + (size_t)L * MOE_E * MOE_FF * D_MODEL, D_MODEL / 2, (size_t)MOE_FF * D_MODEL}, S, EpiMoeGU{(bf16_t*)(p.big + BIG_MOE_ACT), cnt, tab});
        { const int rem = (tab[MOE_E] * 4) % nb; __syncthreads(); constexpr int f0 = L == 0 ? CT_B : CT_D + 384, f1 = L == 0 ? CT_C : CT_E;
            if (rem) conv_moe_tiles(p, lds, f0, f1, bid - rem, nb - rem); else conv_moe_tiles(p, lds, f0, f1, bid, nb); }
    } else if constexpr (PH == 10 || PH == 19) {
        constexpr int L = PH == 10 ? 0 : 1; const int* cnt = p.cnt + L * MOE_E;
        moe_tables(cnt, tab);
        mg::GroupedOrder S{tab, MOE_E, 8, nb, bid};
        mg::gemm_phase<true>(stage, MOE_FF / 2, AMoeAct{(const bf16_t*)(p.big + BIG_MOE_ACT), tab}, mg::BPlain{p.wt_d + (size_t)L * MOE_E * D_MODEL * MOE_FF / 2, MOE_FF / 2, (size_t)D_MODEL * MOE_FF / 2}, S, EpiMoeDown{(bf16_t*)(p.big + BIG_MOE_YS), p.list, cnt, p.ew});
        if constexpr (L == 0) { const int rem = (tab[MOE_E] * 8) % nb; __syncthreads();
            if (rem) conv_moe_tiles(p, lds, CT_D, CT_D + 384, bid - rem, nb - rem); else conv_moe_tiles(p, lds, CT_D, CT_D + 384, bid, nb); }
    } else if constexpr (PH == 11) {
        const bf16_t* ys = (const bf16_t*)(p.big + BIG_MOE_YS);
        rows_norm<false, true>(p.xB, ys, ys + D_MODEL, p.xA, p.ln_mix + D_MODEL, p.hb16, bid, nb);
    } else if constexpr (PH == 12) {
        mg::StaticOrder S; S.init(T, SSD_PROJ_P, nb, bid);
        mg::gemm_phase(stage, D_MODEL, mg::APlain{p.hb16, D_MODEL}, mg::BPlain{p.wt_ssd_in, D_MODEL, 0}, S,
                       EpiSsdIn{(bf16_t*)(p.big + BIG_SSD_Z), (bf16_t*)(p.big + BIG_SSD_XBCP), p.dtb, p.ssd_dt_bias});
        { const int nu = (T / 256) * (SSD_PROJ_P / 256), rem = nu % nb; __syncthreads();
          if (rem) conv_moe_tiles(p, lds, CT_C, CT_D, bid - rem, nb - rem); else conv_moe_tiles(p, lds, CT_C, CT_D, bid, nb); }
    } else if constexpr (PH == 13) {
        ph_ssd_conv_bc(p, bid, nb);
    } else if constexpr (PH == 14) {
        ph_ssd_mfma(p, (char*)ldsraw + LDS_STAGE_OFF, bid, nb);
    } else if constexpr (PH == 15) {
        ph_ssd_norm(p, bid, nb);
    } else if constexpr (PH == 16) {
        mg::StaticOrder S; S.init(T, D_MODEL, nb, bid);
        mg::gemm_phase(stage, SSD_DI, mg::APlain{(const bf16_t*)(p.big + BIG_SSD_YN), SSD_DI}, mg::BPlain{p.wt_ssd_out, SSD_DI, 0}, S, EpiResid<true>{p.xA, (bf16_t*)p.xB});
    } else if constexpr (PH == 20) {
        const bf16_t* ys = (const bf16_t*)(p.big + BIG_MOE_YS);
        const int lane = tidx() & 63, wid = tidx() >> 6;
        for (int row = bid * 8 + wid; row < T; row += nb * 8) {
            float4 v[8]; float ss = 0.f;
#pragma unroll
            for (int i = 0; i < 8; ++i) { const int c = i * 256 + lane * 4; const ushort4 s4 = *(const ushort4*)((const bf16_t*)p.xB + (size_t)row * D_MODEL + c); float4 a = make_float4(bf2f(s4.x), bf2f(s4.y), bf2f(s4.z), bf2f(s4.w));
                const ushort4 y0 = *(const ushort4*)(ys + (size_t)(2 * row) * D_MODEL + c), y1 = *(const ushort4*)(ys + (size_t)(2 * row + 1) * D_MODEL + c);
                a.x += bf2f(y0.x) + bf2f(y1.x); a.y += bf2f(y0.y) + bf2f(y1.y); a.z += bf2f(y0.z) + bf2f(y1.z); a.w += bf2f(y0.w) + bf2f(y1.w);
                v[i] = a; ss += a.x * a.x + a.y * a.y + a.z * a.z + a.w * a.w; }
            ss = wave_sum(ss); const float rinv = rsqrtf(ss * (1.f / D_MODEL) + NORM_EPS);
#pragma unroll
            for (int i = 0; i < 8; ++i) { const int c = i * 256 + lane * 4; const float4 gg = *(const float4*)(p.ln_final + c);
                float4 o; o.x = v[i].x * rinv * gg.x; o.y = v[i].y * rinv * gg.y; o.z = v[i].z * rinv * gg.z; o.w = v[i].w * rinv * gg.w;
                __builtin_nontemporal_store((f32x4){o.x, o.y, o.z, o.w}, (f32x4*)(p.out + (size_t)row * D_MODEL + c)); }
        }
    }
}

template <int PH> __global__ __launch_bounds__(NTHREADS, 2) void k_phase(P p) {
    extern __shared__ __attribute__((aligned(16))) float lds[];
    run_phase<PH>(p, lds, blockIdx.x, gridDim.x);
}
template <int PH> static void launch_all(const P& p, hipStream_t stream) {
    if constexpr (PH < NPHASE) {
        static bool attr = false; if (!attr) { attr = true; (void)hipFuncSetAttribute((const void*)k_phase<PH>, hipFuncAttributeMaxDynamicSharedMemorySize, LDS_BYTES); }
        hipLaunchKernelGGL(k_phase<PH>, dim3(256), dim3(NTHREADS), LDS_BYTES, stream, p);
        launch_all<PH + 1>(p, stream);
    }
}
constexpr bool phase_empty(int ph) { return ph == 2 || ph == 4 || ph == 6; }
#ifndef PROBE_DUP_MASK
#define PROBE_DUP_MASK 0u
#endif
constexpr bool phase_dup(int ph) { return (PROBE_DUP_MASK >> ph) & 1u; }
template <int PH> DEV void mega_phases(const P& p, float* lds, const XcdBarrier& bar) {
    if constexpr (PH < NPHASE) {
        if constexpr (!phase_empty(PH)) {
            run_phase<PH>(p, lds, blockIdx.x, gridDim.x);
            if constexpr (phase_dup(PH)) { xcd_barrier(bar); run_phase<PH>(p, lds, blockIdx.x, gridDim.x); }
            if constexpr (PH + 1 < NPHASE) xcd_barrier(bar);
        }
        mega_phases<PH + 1>(p, lds, bar);
    }
}
__global__ __launch_bounds__(NTHREADS, 2) void k_mega(P p) {
    extern __shared__ __attribute__((aligned(16))) float lds[];
    if (threadIdx.x < 4) ((unsigned*)lds)[threadIdx.x] = 0u;
    __syncthreads();
    XcdBarrier bar = xcd_barrier_post(p.bar, (volatile LAS unsigned*)lds);
    mega_phases<0>(p, lds, bar);
}

extern "C" void kernel_launch(void* const* d_in, const int* in_sizes, int n_in, void* d_out, int out_size, void* d_ws, size_t ws_size, hipStream_t stream) {
    P p{};
    const float* const* in = (const float* const*)d_in;
    p.x = in[0]; p.ln_mix = in[1]; p.ln_ffn = in[2]; p.ln_final = in[3]; p.nsa_w_in = in[4]; p.nsa_cmp_pe = in[5]; p.nsa_cmp_w1 = in[6]; p.nsa_cmp_w2 = in[7]; p.nsa_w_out = in[8];
    p.ssd_w_in = in[9]; p.ssd_conv_w = in[10]; p.ssd_conv_b = in[11]; p.ssd_dt_bias = in[12]; p.ssd_a_log = in[13]; p.ssd_d = in[14]; p.ssd_norm = in[15]; p.ssd_w_out = in[16];
    p.moe_w_group = in[17]; p.moe_b_group = in[18]; p.moe_w_expert = in[19]; p.moe_b_expert = in[20]; p.moe_w_gate = in[21]; p.moe_w_up = in[22]; p.moe_w_down = in[23];
    p.out = (float*)d_out;
    char* w = (char*)d_ws; size_t off = 0;
    auto take = [&](size_t bytes) { char* r = w + off; off += (bytes + 255) & ~(size_t)255; return r; };
    p.bar = (unsigned*)take(XCD_BAR_WORDS * 4);
    p.wt_nsa_in = (bf16_t*)take((size_t)NSA_PROJ_P * D_MODEL * 2);
    p.wt_nsa_out = (bf16_t*)take((size_t)D_MODEL * 2048 * 2);
    p.wt_ssd_in = (bf16_t*)take((size_t)SSD_PROJ_P * D_MODEL * 2);
    p.wt_ssd_out = (bf16_t*)take((size_t)D_MODEL * SSD_DI * 2);
    p.wt_gu = (bf16_t*)take((size_t)2 * MOE_E * 2 * MOE_FF * D_MODEL * 2);
    p.wt_d = (bf16_t*)take((size_t)2 * MOE_E * D_MODEL * MOE_FF * 2);
    p.wt_cmp1 = (bf16_t*)take((size_t)2 * CMP_HIDDEN * 4096 * 2);
    p.wt_cmp2 = (bf16_t*)take((size_t)2 * 256 * CMP_HIDDEN * 2);
    p.xA = (float*)take((size_t)T * D_MODEL * 4);
    p.xB = (float*)take((size_t)T * D_MODEL * 4);
    p.hb16 = (bf16_t*)take((size_t)T * D_MODEL * 2);
    p.big = take(BIG_BYTES);
    p.rope = (float*)take((size_t)SEQ * 64 * 2 * 4);
    p.h1 = (float*)take((size_t)2 * 2032 * CMP_HIDDEN * 4);
    p.kvc = (float*)take((size_t)2 * 2032 * 128 * 4);
    p.selmask = (unsigned*)take((size_t)BATCH * NKV * SEQ * 4);
    p.cnt = (int*)take(64 * 4);
    p.list = (int*)take((size_t)MOE_E * T * 4);
    p.ew = (float*)take((size_t)T * 2 * 4);
    p.dtb = (float*)take((size_t)T * 64 * 4);
    p.wr = (float*)take((size_t)2 * D_MODEL * MOE_E * 4);
    p.wgq = (float*)take((size_t)2 * D_MODEL * MOE_G * 4);
    if (off > ws_size) { fprintf(stderr, "workspace too small: need %zu have %zu\n", off, ws_size); return; }
#if defined(MK_MULTI)
    launch_all<0>(p, stream);
#else
    static int grid = 0;
    if (!grid) {
        int dev = 0, cus = 0, per_cu = 0;
        (void)hipGetDevice(&dev);
        (void)hipDeviceGetAttribute(&cus, hipDeviceAttributeMultiprocessorCount, dev);
        (void)hipFuncSetAttribute((const void*)k_mega, hipFuncAttributeMaxDynamicSharedMemorySize, LDS_BYTES);
        (void)hipOccupancyMaxActiveBlocksPerMultiprocessor(&per_cu, k_mega, NTHREADS, LDS_BYTES);
        if (per_cu < 1) per_cu = 1;
        grid = cus * (per_cu < 1 ? per_cu : 1);
    }
    (void)hipMemsetAsync(p.bar, 0, XCD_BAR_WORDS * sizeof(unsigned), stream);
    hipLaunchKernelGGL(k_mega, dim3(grid), dim3(NTHREADS), LDS_BYTES, stream, p);
#endif
}
```

```cpp
#include <hip/hip_runtime.h>
#include <stdint.h>
#include <math.h>
#include <cstdio>

#define DEV __device__ __forceinline__

constexpr int D_MODEL = 2048, BATCH = 4, SEQ = 2048, T = BATCH * SEQ;
constexpr int NH = 16, NKV = 4, DH = 128;
constexpr int NCMP = 127, CMP_HIDDEN = 256;
constexpr int NSLC = 32;
constexpr int WINDOW = 512;
constexpr int NSA_PROJ = 5168, NSA_PROJ_P = 5376;
constexpr int OFF_Q = 0, OFF_KC = 2048, OFF_VC = 2560, OFF_KS = 3072, OFF_VS = 3584, OFF_KW = 4096, OFF_VW = 4608, OFF_G = 5120;
constexpr int SSD_DI = 4096, SSD_P = 64, SSD_H = 64, SSD_G = 8, SSD_N = 128, SSD_CONVCH = 6144, SSD_PROJ = 10304, SSD_PROJ_P = 10496;
constexpr int OFF_Z = 0, OFF_XBC = 4096, OFF_DT = 10240;
constexpr int MOE_G = 4, MOE_EPG = 8, MOE_E = 32, MOE_FF = 512;
constexpr float NORM_EPS = 1e-6f;
constexpr int NTHREADS = 512;
typedef unsigned short bf16_t;


struct P {
    const float *x, *ln_mix, *ln_ffn, *ln_final, *nsa_w_in, *nsa_cmp_pe, *nsa_cmp_w1, *nsa_cmp_w2, *nsa_w_out;
    const float *ssd_w_in, *ssd_conv_w, *ssd_conv_b, *ssd_dt_bias, *ssd_a_log, *ssd_d, *ssd_norm, *ssd_w_out;
    const float *moe_w_group, *moe_b_group, *moe_w_expert, *moe_b_expert, *moe_w_gate, *moe_w_up, *moe_w_down;
    float* out;
    bf16_t *wt_nsa_in, *wt_nsa_out, *wt_ssd_in, *wt_ssd_out, *wt_gu, *wt_d, *wt_cmp1, *wt_cmp2;
    float *xA, *xB; bf16_t* hb16;
    char* big;
    float* rope;
    float* h1;
    float* kvc;
    unsigned* selmask;
    int* cnt;
    int* list;
    float* ew;
    float* dtb;
    float *wr, *wgq;
    unsigned* bar;
};
constexpr size_t BIG_NSA_Q = 0, BIG_NSA_KS = (size_t)T * 2048 * 2, BIG_NSA_VS = BIG_NSA_KS + (size_t)T * 512 * 2, BIG_NSA_KW = BIG_NSA_VS + (size_t)T * 512 * 2, BIG_NSA_VW = BIG_NSA_KW + (size_t)T * 512 * 2,
    BIG_NSA_ACMP = BIG_NSA_VW + (size_t)T * 512 * 2, BIG_NSA_H1 = BIG_NSA_ACMP + (size_t)2 * 2048 * 4096 * 2, BIG_NSA_KVC = BIG_NSA_H1 + (size_t)2 * 2048 * 256 * 2,
    BIG_NSA_GATE = BIG_NSA_KVC + (size_t)2 * 2048 * 128 * 2, BIG_NSA_OCMP = BIG_NSA_GATE + (size_t)T * 48 * 4, BIG_NSA_OBUF = BIG_NSA_OCMP + (size_t)T * 2048 * 4;
constexpr size_t BIG_MOE_ACT = 0, BIG_MOE_YS = (size_t)(2 * T + 256) * MOE_FF * 2;
constexpr size_t BIG_SSD_Z = 0, BIG_SSD_XBCP = (size_t)T * SSD_DI * 2, BIG_SSD_YN = BIG_SSD_XBCP + (size_t)T * SSD_CONVCH * 2, BIG_SSD_BC = BIG_SSD_YN + (size_t)T * SSD_DI * 2;
constexpr size_t BIG_SSD_TABG = BIG_SSD_BC + (size_t)T * 2048 * 2;
constexpr size_t BIG_BYTES = BIG_SSD_TABG + (size_t)256 * 16 * 640 * 4;
static_assert(BIG_NSA_OBUF + (size_t)T * 2048 * 2 <= BIG_BYTES && BIG_MOE_YS + (size_t)2 * T * D_MODEL * 4 <= BIG_BYTES, "big region");

DEV int tidx() { int t = threadIdx.x; asm volatile("" : "+v"(t)); return t; }
DEV float swap_pair(float v) { return __int_as_float(__builtin_amdgcn_mov_dpp(__float_as_int(v), 0xB1, 0xF, 0xF, true)); }
DEV float dpp_xor2(float v) { return __int_as_float(__builtin_amdgcn_mov_dpp(__float_as_int(v), 0x4E, 0xF, 0xF, true)); }
DEV void quad_transpose(float (&v)[4], int k) {
    { const bool up = (k & 2) != 0;
#pragma unroll
      for (int e = 0; e < 2; ++e) { const float snd = up ? v[e] : v[e + 2]; const float rcv = dpp_xor2(snd); if (up) v[e] = rcv; else v[e + 2] = rcv; } }
    { const bool od = (k & 1) != 0;
#pragma unroll
      for (int e = 0; e < 4; e += 2) { const float snd = od ? v[e] : v[e + 1]; const float rcv = swap_pair(snd); if (od) v[e] = rcv; else v[e + 1] = rcv; } }
}
DEV float wave_sum(float v) { for (int o = 32; o >= 1; o >>= 1) v += __shfl_xor(v, o); return v; }
DEV float wave_max(float v) { for (int o = 32; o >= 1; o >>= 1) v = fmaxf(v, __shfl_xor(v, o)); return v; }
DEV float siluf(float v) { return v / (1.f + expf(-v)); }
DEV float gelu_tanh(float v) { return 0.5f * v * (1.f + tanhf(0.7978845608028654f * (v + 0.044715f * v * v * v))); }
DEV float bf2f(bf16_t b) { return __uint_as_float(((unsigned)b) << 16); }
DEV bf16_t f2bf(float f) { unsigned u = __float_as_uint(f); u += 0x7FFFu + ((u >> 16) & 1u); return (bf16_t)(u >> 16); }

template <class CF, class AF, class BF, class EF>
DEV void ngemm(int ngroups, CF cntf, int N, int K, AF af, BF bf, EF ef, float* lds, int bid, int nb) {
    float* As = lds;
    float* Bs = lds + 16 * 132;
    int* pre = (int*)(lds + 16 * 132 + 16 * 68);
    const int tid = tidx(), tx = tid & 15, ty = tid >> 4;
    const int tilesN = (N + 63) / 64;
    __syncthreads();
    if (tid == 0) { int s = 0; for (int g = 0; g < ngroups; ++g) { pre[g] = s; s += ((cntf(g) + 127) / 128) * tilesN; } pre[ngroups] = s; }
    __syncthreads();
    const int total = pre[ngroups];
    for (int tile = bid; tile < total; tile += nb) {
        int g = 0; while (g + 1 < ngroups && pre[g + 1] <= tile) ++g;
        const int lt = tile - pre[g], tm = lt / tilesN, tn = lt % tilesN, M = cntf(g);
        float acc[4][4];
#pragma unroll
        for (int i = 0; i < 4; ++i)
#pragma unroll
            for (int j = 0; j < 4; ++j) acc[i][j] = 0.f;
        for (int k0 = 0; k0 < K; k0 += 16) {
#pragma unroll
            for (int it = 0; it < 4; ++it) { const int i = tid + it * 512, m = i >> 4, k = i & 15, gm = tm * 128 + m; As[k * 132 + m] = (gm < M) ? af(g, gm, k0 + k) : 0.f; }
#pragma unroll
            for (int it = 0; it < 2; ++it) { const int i = tid + it * 512, k = i >> 6, n = i & 63, gn = tn * 64 + n; Bs[k * 68 + n] = (gn < N) ? bf(g, k0 + k, gn) : 0.f; }
            __syncthreads();
#pragma unroll
            for (int k = 0; k < 16; ++k) {
                const float4 a = *(const float4*)(As + k * 132 + ty * 4), b = *(const float4*)(Bs + k * 68 + tx * 4);
                const float av[4] = {a.x, a.y, a.z, a.w}, bv[4] = {b.x, b.y, b.z, b.w};
#pragma unroll
                for (int i = 0; i < 4; ++i)
#pragma unroll
                    for (int j = 0; j < 4; ++j) acc[i][j] = fmaf(av[i], bv[j], acc[i][j]);
            }
            __syncthreads();
        }
#pragma unroll
        for (int i = 0; i < 4; ++i)
#pragma unroll
            for (int j = 0; j < 4; ++j) { const int gm = tm * 128 + ty * 4 + i, gn = tn * 64 + tx * 4 + j; if (gm < M && gn < N) ef(g, gm, gn, acc[i][j]); }
    }
}

#define MG_LAS __attribute__((address_space(3)))

typedef short bf16x8 __attribute__((ext_vector_type(8)));
typedef float f32x4 __attribute__((ext_vector_type(4)));
typedef unsigned u32x4 __attribute__((ext_vector_type(4)));
typedef unsigned u32x2 __attribute__((ext_vector_type(2)));
typedef int i32x8 __attribute__((ext_vector_type(8)));
typedef int i32x4 __attribute__((ext_vector_type(4)));
DEV unsigned pk8(float a, float b, float c, float d) {
    a = __builtin_amdgcn_fmed3f(a, -448.f, 448.f); b = __builtin_amdgcn_fmed3f(b, -448.f, 448.f); c = __builtin_amdgcn_fmed3f(c, -448.f, 448.f); d = __builtin_amdgcn_fmed3f(d, -448.f, 448.f);
    int w = __builtin_amdgcn_cvt_pk_fp8_f32(a, b, 0, false); w = __builtin_amdgcn_cvt_pk_fp8_f32(c, d, w, true); return (unsigned)w; }
constexpr float F8_SX = 4.f, F8_SW = 256.f, F8_SACT = 8.f, F8_SO = 16.f;
namespace mg {
constexpr int BM = 256, BK = 64, HALF = 128, HTB = HALF * BK * 2, STAGE_BYTES = 8 * HTB, NXCD = 8, WGM = 8;
DEV int lds_byte(int r, int c) { const int st = (r >> 4) * 2 + (c >> 5), rr = r & 15, cc = c & 31, ob = rr * 64 + cc * 2; return st * 1024 + (ob ^ (((ob >> 9) & 1) << 5)); }
DEV void stage_rc(int b, int& R, int& C) { const int st = b / 1024, sb = b % 1024, swz = sb ^ (((sb >> 9) & 1) << 5); R = (st >> 1) * 16 + swz / 64; C = (st & 1) * 32 + (swz % 64) / 2; }
DEV int perm32(int rho) { const int n = rho >> 4, i = rho & 15; return 8 * (i >> 2) + 4 * n + (i & 3); }
DEV unsigned cvt_pk_bf16(float lo, float hi) { unsigned r; asm volatile("v_cvt_pk_bf16_f32 %0, %1, %2" : "=v"(r) : "v"(lo), "v"(hi)); return r; }
struct Unit { int g, pm, pn; };

struct StaticOrder {
    int nM, nN, nwg, G, c;
    DEV void init(int M, int N, int G_, int c_) { nM = M / BM; nN = N / BM; nwg = nM * nN; G = G_; c = c_; }
    DEV bool next(int i, Unit& u) const {
        const long L = (long)i * G + c; if (L >= nwg) return false;
        int wgid = (int)L; { const int q = nwg / NXCD, r = nwg % NXCD, xcd = wgid % NXCD, off = wgid / NXCD; wgid = (xcd < r ? xcd * (q + 1) : r * (q + 1) + (xcd - r) * q) + off; }
        const int nig = WGM * nN, gid = wgid / nig, fm = gid * WGM, gsz = (nM - fm) < WGM ? (nM - fm) : WGM;
        u.g = 0; u.pm = fm + ((wgid % nig) % gsz); u.pn = (wgid % nig) / gsz; return true;
    }
};
struct GroupedOrder {
    const int* pre; int ng, nN, G, c;
    DEV bool next(int i, Unit& u) const {
        const int L = i * G + c; if (L >= pre[ng] * nN) return false;
        const int mt = L / nN; u.pn = L - mt * nN; int g = 0; while (g + 1 < ng && pre[g + 1] <= mt) ++g;
        u.g = __builtin_amdgcn_readfirstlane(g); u.pm = __builtin_amdgcn_readfirstlane(mt - pre[g]); u.pn = __builtin_amdgcn_readfirstlane(u.pn); return true;
    }
};
struct FixedGroups {
    int ng, mt, nN, G, c;
    DEV bool next(int i, Unit& u) const { const int L = i * G + c; if (L >= ng * mt * nN) return false; u.pn = L % nN; const int r = L / nN; u.pm = r % mt; u.g = r / mt; return true; }
};
struct AGrouped { static constexpr bool GATHER = false; const bf16_t* A; int lda; size_t gstride; DEV const char* ubase(const Unit& u) const { return (const char*)(A + (size_t)u.g * gstride + (size_t)u.pm * BM * lda); } DEV unsigned rowoff(const Unit&, int r) const { return (unsigned)(r * lda) * 2u; } };
struct APlain { static constexpr bool GATHER = false; const bf16_t* A; int lda; DEV const char* ubase(const Unit& u) const { return (const char*)(A + (size_t)u.pm * BM * lda); } DEV unsigned rowoff(const Unit&, int r) const { return (unsigned)(r * lda) * 2u; } };
struct BPlain { const bf16_t* Bt; int ldb; size_t gstride; DEV const char* base(const Unit& u) const { return (const char*)(Bt + (size_t)u.g * gstride + (size_t)u.pn * BM * ldb); } };

template <bool FP8 = false, int DS = 0  , class AOp, class BOp, class Epi, class Sched>
DEV void gemm_phase(MG_LAS unsigned char* lds, const int K, const AOp& aop, const BOp& bop, const Sched& S, const Epi& E) {
    int tid_ = tidx();
    const int tid = tid_, wid = __builtin_amdgcn_readfirstlane(tid >> 6), lane = tid & 63, wr = wid >> 2, wc = wid & 3, fr = lane & 15, fq = lane >> 4;
    int nt = K / BK; asm volatile("" : "+s"(nt));
    unsigned voffB[2];
#pragma unroll
    for (int i = 0; i < 2; ++i) { int R, C; stage_rc(tid * 16 + i * 8192, R, C); const int Rb = Epi::PERM ? ((R & ~31) + perm32(R & 31)) : R; voffB[i] = (unsigned)(Rb * bop.ldb + C) * 2u; }
#define MG_ROWOFFS(dst, unit) do { _Pragma("unroll") for (int _h = 0; _h < 2; ++_h) _Pragma("unroll") for (int _i = 0; _i < 2; ++_i) { int _R, _C; stage_rc(tid * 16 + _i * 8192, _R, _C); dst[_h][_i] = aop.rowoff(unit, _h * HALF + _R) + (unsigned)(_C * 2); } } while (0)
    const size_t kstep = (size_t)(BK * 2);
    const size_t hstepB = (size_t)HALF * bop.ldb * 2;
    const unsigned ldsw = (unsigned)wid * 1024u;
    const int aoff = lds_byte(wr * 64 + fr, fq * 8), boff = lds_byte(wc * 32 + fr, fq * 8);
#define MG_SA(b, h) (((b) * 2 + (h)) * HTB)
#define MG_SB(b, h) ((4 + (b) * 2 + (h)) * HTB)
#define MG_STAGE(bufoff, gbase, voff) do { _Pragma("unroll") for (int _i = 0; _i < 2; ++_i) \
        __builtin_amdgcn_global_load_lds((const unsigned*)((const char*)(gbase) + (voff)[_i]), (MG_LAS unsigned*)(lds + (bufoff) + ldsw + _i * 8192), 16, 0, 0); } while (0)
#define MG_LDA(dst, b, h) do { if constexpr (FP8) { _Pragma("unroll") for (int m = 0; m < 4; ++m) { dst##8[m].lo = *(const MG_LAS i32x4*)(lds + MG_SA(b, h) + aoff + m * 2048); dst##8[m].hi = *(const MG_LAS i32x4*)(lds + MG_SA(b, h) + aoff + m * 2048 + 1024); } } else { \
        _Pragma("unroll") for (int m = 0; m < 4; ++m) _Pragma("unroll") for (int k = 0; k < 2; ++k) dst[m][k] = *(const MG_LAS bf16x8*)(lds + MG_SA(b, h) + aoff + m * 2048 + k * 1024); } } while (0)
#define MG_LDB(dst, b, h) do { if constexpr (FP8) { _Pragma("unroll") for (int n = 0; n < 2; ++n) { dst##8[n].lo = *(const MG_LAS i32x4*)(lds + MG_SB(b, h) + boff + n * 2048); dst##8[n].hi = *(const MG_LAS i32x4*)(lds + MG_SB(b, h) + boff + n * 2048 + 1024); } } else { \
        _Pragma("unroll") for (int n = 0; n < 2; ++n) _Pragma("unroll") for (int k = 0; k < 2; ++k) dst[n][k] = *(const MG_LAS bf16x8*)(lds + MG_SB(b, h) + boff + n * 2048 + k * 1024); } } while (0)
#define MG_MMA(ai, bj, At, Bt) do { __builtin_amdgcn_s_setprio(1); if constexpr (FP8) { _Pragma("unroll") for (int m = 0; m < 4; ++m) _Pragma("unroll") for (int n = 0; n < 2; ++n) \
        asm volatile("v_mfma_f32_16x16x128_f8f6f4 %0, %1, %2, %0" : "+v"(acc[ai][bj][m][n]) : "v"(Bt##8[n]), "v"(At##8[m])); } else {     \
        _Pragma("unroll") for (int m = 0; m < 4; ++m) _Pragma("unroll") for (int n = 0; n < 2; ++n) _Pragma("unroll") for (int k = 0; k < 2; ++k) \
        acc[ai][bj][m][n] = __builtin_amdgcn_mfma_f32_16x16x32_bf16(Bt[n][k], At[m][k], acc[ai][bj][m][n], 0, 0, 0); } __builtin_amdgcn_s_setprio(0); } while (0)
#define MG_WAIT_V(n) asm volatile("s_waitcnt vmcnt(" #n ")" ::: "memory")
#define MG_WAIT_L(n) asm volatile("s_waitcnt lgkmcnt(" #n ")" ::: "memory")
#define MG_BAR __builtin_amdgcn_s_barrier()
#define MG_SCHED __builtin_amdgcn_sched_barrier(0)
    Unit cur, nxt; int ui = 0;
    if (!S.next(0, cur)) return;
    f32x4 acc[2][2][4][2];
#define MG_ACC_INIT(unit) do { if constexpr (Epi::ACC_INIT) E.init(acc, unit, wr, wc, fr, fq); else { \
        _Pragma("unroll") for (int a = 0; a < 2; ++a) _Pragma("unroll") for (int b = 0; b < 2; ++b) _Pragma("unroll") for (int m = 0; m < 4; ++m) _Pragma("unroll") for (int n = 0; n < 2; ++n) acc[a][b][m][n] = (f32x4){0.f, 0.f, 0.f, 0.f}; } } while (0)
    MG_ACC_INIT(cur);
    bf16x8 At[4][2], B0[2][2], B1[2][2];
    i32x8 At8[4], B08[2], B18[2];
    unsigned vAc[2][2], vAn[2][2];
    MG_ROWOFFS(vAc, cur);
    const char* cA = aop.ubase(cur); const char* cB = bop.base(cur);
    MG_STAGE(MG_SB(0, 0), cB, voffB); MG_STAGE(MG_SA(0, 0), cA, vAc[0]); MG_STAGE(MG_SB(0, 1), cB + hstepB, voffB); MG_STAGE(MG_SA(0, 1), cA, vAc[1]);
    if (wr == 1) MG_BAR;
    MG_WAIT_V(4); MG_BAR;
    MG_STAGE(MG_SB(1, 0), cB + kstep, voffB); MG_STAGE(MG_SA(1, 0), cA + kstep, vAc[0]); MG_STAGE(MG_SB(1, 1), cB + hstepB + kstep, voffB);
    MG_WAIT_V(6); MG_BAR;
    for (;;) {
        const bool has_next = S.next(ui + 1, nxt);
        const char* nB = has_next ? bop.base(nxt) : cB; const char* nA = has_next ? aop.ubase(nxt) : cA;
        if constexpr (AOp::GATHER) { if (has_next) MG_ROWOFFS(vAn, nxt); else {
#pragma unroll
            for (int h = 0; h < 2; ++h)
#pragma unroll
                for (int i = 0; i < 2; ++i) vAn[h][i] = vAc[h][i]; } }
        for (int t = 0; t < nt; t += 2) {
            const bool last = (t == nt - 2);
            const char* a1 = cA + (size_t)(t + 1) * kstep;
            const char* a2 = last ? nA : cA + (size_t)(t + 2) * kstep; const char* b2 = last ? nB : cB + (size_t)(t + 2) * kstep;
            const char* a3 = a2 + kstep; const char* b3 = b2 + kstep;
            MG_LDB(B0, 0, 0); MG_SCHED; MG_LDA(At, 0, 0); MG_STAGE(MG_SA(1, 1), a1, vAc[1]);
            if constexpr (AOp::GATHER) { if (last) {
#pragma unroll
                for (int h = 0; h < 2; ++h)
#pragma unroll
                    for (int i = 0; i < 2; ++i) vAc[h][i] = vAn[h][i]; } }
            MG_WAIT_L(8); MG_BAR; MG_WAIT_L(0); MG_MMA(0, 0, At, B0); MG_BAR; MG_SCHED;
            MG_LDB(B1, 0, 1); MG_STAGE(MG_SB(0, 0), b2, voffB);
            MG_BAR; MG_WAIT_L(0); MG_MMA(0, 1, At, B1); MG_BAR;
            MG_LDA(At, 0, 1); MG_STAGE(MG_SA(0, 0), a2, vAc[0]);
            MG_BAR; MG_WAIT_L(0); MG_MMA(1, 0, At, B0); MG_BAR; MG_SCHED;
            MG_STAGE(MG_SB(0, 1), b2 + hstepB, voffB);
            MG_WAIT_V(6); MG_BAR; MG_MMA(1, 1, At, B1); MG_BAR;
            MG_LDB(B0, 1, 0); MG_SCHED; MG_LDA(At, 1, 0); MG_STAGE(MG_SA(0, 1), a2, vAc[1]);
            MG_WAIT_L(8); MG_BAR; MG_WAIT_L(0); MG_MMA(0, 0, At, B0); MG_BAR; MG_SCHED;
            MG_LDB(B1, 1, 1); MG_STAGE(MG_SB(1, 0), b3, voffB);
            MG_BAR; MG_WAIT_L(0); MG_MMA(0, 1, At, B1); MG_BAR;
            MG_LDA(At, 1, 1); MG_STAGE(MG_SA(1, 0), a3, vAc[0]);
            MG_BAR; MG_WAIT_L(0); MG_MMA(1, 0, At, B0); MG_BAR; MG_SCHED;
            MG_STAGE(MG_SB(1, 1), b3 + hstepB, voffB);
            MG_WAIT_V(6); MG_BAR; MG_MMA(1, 1, At, B1); MG_BAR;
        }
        __builtin_amdgcn_sched_barrier(0); asm volatile("s_nop 15\n\ts_nop 15" ::: "memory"); __builtin_amdgcn_sched_barrier(0);
        if constexpr (DS != 0) {
#pragma unroll
            for (int a = 0; a < 2; ++a)
#pragma unroll
                for (int b = 0; b < 2; ++b)
#pragma unroll
                    for (int m = 0; m < 4; ++m)
#pragma unroll
                        for (int n = 0; n < 2; ++n) acc[a][b][m][n] *= (1.f / (float)(1 << DS)); }
        { int fr2 = fr, fq2 = fq; asm volatile("" : "+v"(fr2), "+v"(fq2));
          E(acc, cur, wr, wc, fr2, fq2); }
        if (!has_next) break;
        MG_ACC_INIT(nxt);
        cur = nxt; cB = nB; cA = nA; ++ui;
    }
    MG_WAIT_V(0);
    if (wr == 0) MG_BAR;
    MG_BAR;
#undef MG_ROWOFFS
#undef MG_ACC_INIT
#undef MG_SA
#undef MG_SB
#undef MG_STAGE
#undef MG_LDA
#undef MG_LDB
#undef MG_MMA
#undef MG_WAIT_V
#undef MG_WAIT_L
#undef MG_BAR
#undef MG_SCHED
}
}
#define EPI_ROWS_BEGIN _Pragma("unroll") for (int ai = 0; ai < 2; ++ai) _Pragma("unroll") for (int m = 0; m < 4; ++m) { const int rt = ai * 128 + wr * 64 + m * 16 + fr;
#define EPI_ROWS_END }
struct EpiF32 {
    static constexpr bool PERM = false, ACC_INIT = false;
    float* C; int ldc, nvalid;
    DEV void operator()(const f32x4 (&acc)[2][2][4][2], const mg::Unit& u, int wr, int wc, int fr, int fq) const {
        EPI_ROWS_BEGIN float* rowp = C + (size_t)(u.pm * 256 + rt) * ldc;
#pragma unroll
            for (int bj = 0; bj < 2; ++bj)
#pragma unroll
                for (int n = 0; n < 2; ++n) { const int col = u.pn * 256 + bj * 128 + wc * 32 + n * 16 + 4 * fq; if (col < nvalid) *(f32x4*)(rowp + col) = acc[ai][bj][m][n]; }
        EPI_ROWS_END
    }
};
template <bool RB16, int IS = 0  >
struct EpiResid {
    static constexpr bool PERM = true, ACC_INIT = true;
    const void* __restrict__ resid; bf16_t* __restrict__ out;
    DEV void init(f32x4 (&acc)[2][2][4][2], const mg::Unit& u, int wr, int wc, int fr, int fq) const {
#pragma unroll
        for (int ai = 0; ai < 2; ++ai)
#pragma unroll
            for (int m = 0; m < 4; ++m) { const size_t ro = (size_t)(u.pm * 256 + ai * 128 + wr * 64 + m * 16 + fr) * D_MODEL;
#pragma unroll
                for (int bj = 0; bj < 2; ++bj) { const size_t o = ro + u.pn * 256 + bj * 128 + wc * 32 + 8 * fq;
                    if constexpr (RB16) { const u32x4 w = __builtin_nontemporal_load((const u32x4*)((const bf16_t*)resid + o));
                        acc[ai][bj][m][0] = (f32x4){__uint_as_float(w.x << 16), __uint_as_float(w.x & 0xffff0000u), __uint_as_float(w.y << 16), __uint_as_float(w.y & 0xffff0000u)};
                        acc[ai][bj][m][1] = (f32x4){__uint_as_float(w.z << 16), __uint_as_float(w.z & 0xffff0000u), __uint_as_float(w.w << 16), __uint_as_float(w.w & 0xffff0000u)}; }
                    else { acc[ai][bj][m][0] = __builtin_nontemporal_load((const f32x4*)((const float*)resid + o)); acc[ai][bj][m][1] = __builtin_nontemporal_load((const f32x4*)((const float*)resid + o + 4)); }
                    if constexpr (IS != 0) { acc[ai][bj][m][0] *= (float)(1 << IS); acc[ai][bj][m][1] *= (float)(1 << IS); } } }
    }
    DEV void operator()(const f32x4 (&acc)[2][2][4][2], const mg::Unit& u, int wr, int wc, int fr, int fq) const {
#pragma unroll
        for (int ai = 0; ai < 2; ++ai)
#pragma unroll
            for (int m = 0; m < 4; ++m) { const size_t ro = (size_t)(u.pm * 256 + ai * 128 + wr * 64 + m * 16 + fr) * D_MODEL;
#pragma unroll
                for (int bj = 0; bj < 2; ++bj) { const f32x4 v0 = acc[ai][bj][m][0], v1 = acc[ai][bj][m][1];
                    u32x4 w; w.x = mg::cvt_pk_bf16(v0[0], v0[1]); w.y = mg::cvt_pk_bf16(v0[2], v0[3]); w.z = mg::cvt_pk_bf16(v1[0], v1[1]); w.w = mg::cvt_pk_bf16(v1[2], v1[3]);
                    *(u32x4*)(out + ro + u.pn * 256 + bj * 128 + wc * 32 + 8 * fq) = w; } }
    }
};
struct EpiSsdIn {
    static constexpr bool PERM = true, ACC_INIT = false;
    bf16_t* z; bf16_t* xbc; float* dtb; const float* dt_bias;
    DEV void operator()(const f32x4 (&acc)[2][2][4][2], const mg::Unit& u, int wr, int wc, int fr, int fq) const {
        if (u.pn < OFF_DT / 256) {
            EPI_ROWS_BEGIN const int row = u.pm * 256 + rt;
#pragma unroll
                for (int bj = 0; bj < 2; ++bj) { const int col = u.pn * 256 + bj * 128 + wc * 32 + 8 * fq; const f32x4 v0 = acc[ai][bj][m][0], v1 = acc[ai][bj][m][1];
                    u32x4 w; w.x = mg::cvt_pk_bf16(v0[0], v0[1]); w.y = mg::cvt_pk_bf16(v0[2], v0[3]); w.z = mg::cvt_pk_bf16(v1[0], v1[1]); w.w = mg::cvt_pk_bf16(v1[2], v1[3]);
                    bf16_t* dst = col < OFF_XBC ? z + (size_t)row * SSD_DI + col : xbc + (size_t)row * SSD_CONVCH + (col - OFF_XBC); *(u32x4*)dst = w; }
            EPI_ROWS_END
        } else if (wc < 2) {
            const int hcol = wc * 32 + 8 * fq; float bb[8];
#pragma unroll
            for (int j = 0; j < 8; ++j) bb[j] = dt_bias[hcol + j];
            EPI_ROWS_BEGIN const int row = u.pm * 256 + rt; float o[8];
#pragma unroll
                for (int j = 0; j < 4; ++j) { o[j] = acc[ai][0][m][0][j] + bb[j]; o[4 + j] = acc[ai][0][m][1][j] + bb[4 + j]; }
#pragma unroll
                for (int j = 0; j < 8; ++j) { const float x = o[j], uu = __expf(-fabsf(x)); const float lg = uu < 0.01f ? uu * (1.f - uu * (0.5f - uu * 0.33333333f)) : __logf(1.f + uu); o[j] = fmaxf(x, 0.f) + lg; }
                *(f32x4*)(dtb + (size_t)row * 64 + hcol) = (f32x4){o[0], o[1], o[2], o[3]}; *(f32x4*)(dtb + (size_t)row * 64 + hcol + 4) = (f32x4){o[4], o[5], o[6], o[7]};
            EPI_ROWS_END
        }
    }
};
struct EpiNsaIn {
    static constexpr bool PERM = true, ACC_INIT = false;
    bf16_t *q, *ks, *vs, *kw, *vw, *acmp; float* gate; const float* rope; const float* pe;
    DEV static void st4(bf16_t* dst, const float* o) { u32x2 w; w.x = mg::cvt_pk_bf16(o[0], o[1]); w.y = mg::cvt_pk_bf16(o[2], o[3]); *(u32x2*)dst = w; }
    DEV void im2col4(int kv, int b, int t, int g, int d, const float* o) const {
        const int c1 = t >> 4, l1 = t & 15; const float* pk = pe + kv * 4096;
        if (c1 <= 126) { const int l = l1; float v[4];
#pragma unroll
            for (int j = 0; j < 4; ++j) v[j] = o[j] + pk[l * 128 + d + j];
            st4(acmp + (((size_t)kv * 2048 + (b * 4 + g) * 128 + c1) * 4096 + l * 128 + d), v); }
        if (c1 >= 1) { const int l = l1 + 16; float v[4];
#pragma unroll
            for (int j = 0; j < 4; ++j) v[j] = o[j] + pk[l * 128 + d + j];
            st4(acmp + (((size_t)kv * 2048 + (b * 4 + g) * 128 + c1 - 1) * 4096 + l * 128 + d), v); }
    }
    DEV void operator()(const f32x4 (&acc)[2][2][4][2], const mg::Unit& u, int wr, int wc, int fr, int fq) const {
        const int pn = u.pn; const bool is_rope = pn < 10 || pn == 12 || pn == 13 || pn == 16 || pn == 17;
#pragma unroll
        for (int ai = 0; ai < 2; ++ai) {
        f32x4 csv[4][2];
        if (is_rope) {
#pragma unroll
            for (int m = 0; m < 4; ++m) { const int t = (u.pm * 256 + ai * 128 + wr * 64 + m * 16 + fr) & (SEQ - 1); const float* rp = rope + (size_t)(t * 64 + 16 * wc + 4 * fq) * 2;
                csv[m][0] = *(const f32x4*)rp; csv[m][1] = *(const f32x4*)(rp + 4); } }
#pragma unroll
        for (int m = 0; m < 4; ++m) { const int rt = ai * 128 + wr * 64 + m * 16 + fr;
        const int row = u.pm * 256 + rt, t = row & (SEQ - 1), b = row >> 11;
#pragma unroll
            for (int bj = 0; bj < 2; ++bj) { const f32x4 v0 = acc[ai][bj][m][0], v1 = acc[ai][bj][m][1];
                if (is_rope) { const int d = 16 * wc + 4 * fq;
                    const f32x4 cs0 = csv[m][0], cs1 = csv[m][1];
                    const float c[4] = {cs0[0], cs0[2], cs1[0], cs1[2]}, sn[4] = {cs0[1], cs0[3], cs1[1], cs1[3]}; float o1[4], o2[4];
#pragma unroll
                    for (int j = 0; j < 4; ++j) { o1[j] = v0[j] * c[j] - v1[j] * sn[j]; o2[j] = v1[j] * c[j] + v0[j] * sn[j]; }
                    if (pn < 8) { bf16_t* dst = q + (size_t)row * 2048 + (2 * pn + bj) * 128 + d; st4(dst, o1); st4(dst + 64, o2); }
                    else if (pn < 10) { const int g = 2 * (pn - 8) + bj; im2col4(0, b, t, g, d, o1); im2col4(0, b, t, g, d + 64, o2); }
                    else { bf16_t* dst = (pn < 14 ? ks + (size_t)row * 512 + (2 * (pn - 12) + bj) * 128 : kw + (size_t)row * 512 + (2 * (pn - 16) + bj) * 128) + d; st4(dst, o1); st4(dst + 64, o2); }
                } else { const int c0 = 32 * wc + 8 * fq; const float o1[4] = {v0[0], v0[1], v0[2], v0[3]}, o2[4] = {v1[0], v1[1], v1[2], v1[3]};
                    if (pn < 12) { const int g = 2 * (pn - 10) + bj; im2col4(1, b, t, g, c0, o1); im2col4(1, b, t, g, c0 + 4, o2); }
                    else if (pn < 20) { bf16_t* dst = (pn < 16 ? vs + (size_t)row * 512 + (2 * (pn - 14) + bj) * 128 : vw + (size_t)row * 512 + (2 * (pn - 18) + bj) * 128) + c0; st4(dst, o1); st4(dst + 4, o2); }
                    else { const int col = bj * 128 + c0; if (col < 48) { float* gd = gate + (size_t)row * 48 + col;
#pragma unroll
                            for (int j = 0; j < 4; ++j) { gd[j] = 1.f / (1.f + __expf(-o1[j])); gd[4 + j] = 1.f / (1.f + __expf(-o2[j])); } } }
                } }
        } }
    }
};
struct EpiCmp1 {
    static constexpr bool PERM = true, ACC_INIT = false;
    bf16_t* h1;
    DEV void operator()(const f32x4 (&acc)[2][2][4][2], const mg::Unit& u, int wr, int wc, int fr, int fq) const {
        EPI_ROWS_BEGIN bf16_t* rowp = h1 + ((size_t)u.g * 2048 + u.pm * 256 + rt) * 256;
#pragma unroll
            for (int bj = 0; bj < 2; ++bj) { const int col = bj * 128 + wc * 32 + 8 * fq; float o[8];
#pragma unroll
                for (int j = 0; j < 4; ++j) { o[j] = acc[ai][bj][m][0][j]; o[4 + j] = acc[ai][bj][m][1][j]; }
#pragma unroll
                for (int j = 0; j < 8; ++j) { const float v = o[j], uu = 1.5957691216057308f * (v + 0.044715f * v * v * v); o[j] = v / (1.f + __expf(-uu)); }
                u32x4 w; w.x = mg::cvt_pk_bf16(o[0], o[1]); w.y = mg::cvt_pk_bf16(o[2], o[3]); w.z = mg::cvt_pk_bf16(o[4], o[5]); w.w = mg::cvt_pk_bf16(o[6], o[7]); *(u32x4*)(rowp + col) = w; }
        EPI_ROWS_END
    }
};
struct EpiCmp2 {
    static constexpr bool PERM = true, ACC_INIT = false;
    bf16_t* kvc;
    DEV void operator()(const f32x4 (&acc)[2][2][4][2], const mg::Unit& u, int wr, int wc, int fr, int fq) const {
        EPI_ROWS_BEGIN const int mrow = u.pm * 256 + rt; bf16_t* rowp = kvc + ((size_t)u.g * 2048 + mrow) * 128; const bool pad = (mrow & 127) == 127;
            { const int col = wc * 32 + 8 * fq; const f32x4 v0 = acc[ai][0][m][0], v1 = acc[ai][0][m][1];
              u32x4 w; w.x = mg::cvt_pk_bf16(v0[0], v0[1]); w.y = mg::cvt_pk_bf16(v0[2], v0[3]); w.z = mg::cvt_pk_bf16(v1[0], v1[1]); w.w = mg::cvt_pk_bf16(v1[2], v1[3]);
              if (pad) w = (u32x4){0u, 0u, 0u, 0u}; *(u32x4*)(rowp + col) = w; }
        EPI_ROWS_END
    }
};
DEV void cmp_gemm2_rows(const bf16_t* h1, const bf16_t* w2t  , bf16_t* kvc, int rowbase  ) {
    typedef float f32x16 __attribute__((ext_vector_type(16)));
    const int tid = tidx(), wid = tid >> 6, lane = tid & 63, r32 = lane & 31, hi = lane >> 5;
    const bf16_t* ap = h1 + (size_t)(rowbase + 32 * wid + r32) * 256 + hi * 8;
    const bf16_t* bp = w2t + (size_t)r32 * 256 + hi * 8;
    f32x16 acc[4] = {};
#pragma unroll 4
    for (int ks = 0; ks < 16; ++ks) { const bf16x8 a = *(const bf16x8*)(ap + ks * 16);
#pragma unroll
        for (int nbk = 0; nbk < 4; ++nbk) { const bf16x8 b = *(const bf16x8*)(bp + (size_t)nbk * 32 * 256 + ks * 16); acc[nbk] = __builtin_amdgcn_mfma_f32_32x32x16_bf16(a, b, acc[nbk], 0, 0, 0); } }
#pragma unroll
    for (int r = 0; r < 16; ++r) { const int row = rowbase + 32 * wid + (r & 3) + 8 * (r >> 2) + 4 * hi; const bool pad = (row & 127) == 127;
#pragma unroll
        for (int nbk = 0; nbk < 4; ++nbk) { const float v = pad ? 0.f : acc[nbk][r]; const float vn = swap_pair(v);
            if ((r32 & 1) == 0) *(unsigned*)(kvc + (size_t)row * 128 + nbk * 32 + r32) = mg::cvt_pk_bf16(v, vn); } }
}

struct AMoeGather { static constexpr bool GATHER = true; const bf16_t* A; const int* list; const int* cnt;
    DEV const char* ubase(const mg::Unit&) const { return (const char*)A; }
    DEV unsigned rowoff(const mg::Unit& u, int r) const { int idx = u.pm * 256 + r; const int c = cnt[u.g]; idx = idx < c ? idx : c - 1; return (unsigned)(list[u.g * T + idx] >> 1) * (unsigned)D_MODEL; } };
struct AMoeAct { static constexpr bool GATHER = false; const bf16_t* A; const int* tab;
    DEV const char* ubase(const mg::Unit& u) const { return (const char*)A + (size_t)(__builtin_amdgcn_readfirstlane(tab[64 + u.g]) + u.pm * 256) * MOE_FF; }
    DEV unsigned rowoff(const mg::Unit&, int r) const { return (unsigned)r * (unsigned)MOE_FF; } };
struct EpiMoeGU {
    static constexpr bool PERM = true, ACC_INIT = false;
    bf16_t* act; const int* cnt; const int* tab;
    DEV void operator()(const f32x4 (&acc)[2][2][4][2], const mg::Unit& u, int wr, int wc, int fr, int fq) const {
        const int c = cnt[u.g], rb = tab[64 + u.g];
        EPI_ROWS_BEGIN const int lr = u.pm * 256 + rt;
            if (lr < c) {
#pragma unroll
                for (int bj = 0; bj < 2; ++bj) { const int f = u.pn * 128 + bj * 64 + wc * 16 + 4 * fq; const f32x4 g = acc[ai][bj][m][0], up = acc[ai][bj][m][1]; float o[4];
#pragma unroll
                    for (int j = 0; j < 4; ++j) { const float gj = g[j] * (1.f / (F8_SX * F8_SW)); o[j] = gj / (1.f + __expf(-gj)) * (up[j] * (F8_SACT / (F8_SX * F8_SW))); }
                    *(unsigned*)((char*)act + (size_t)(rb + lr) * MOE_FF + f) = pk8(o[0], o[1], o[2], o[3]); } }
        EPI_ROWS_END
    }
};
struct EpiMoeDown {
    static constexpr bool PERM = true, ACC_INIT = false;
    bf16_t* ys; const int* list; const int* cnt; const float* ew;
    DEV void operator()(const f32x4 (&acc)[2][2][4][2], const mg::Unit& u, int wr, int wc, int fr, int fq) const {
        const int c = cnt[u.g];
#pragma unroll
        for (int ai = 0; ai < 2; ++ai) {
            int idxv[4]; float wv[4];
#pragma unroll
            for (int m = 0; m < 4; ++m) { const int lr = u.pm * 256 + ai * 128 + wr * 64 + m * 16 + fr; idxv[m] = lr < c ? list[u.g * T + lr] : -1; }
#pragma unroll
            for (int m = 0; m < 4; ++m) wv[m] = idxv[m] >= 0 ? ew[idxv[m]] * (1.f / (F8_SACT * F8_SW)) : 0.f;
#pragma unroll
            for (int m = 0; m < 4; ++m)
                if (idxv[m] >= 0) { const float w = wv[m]; bf16_t* rowp = ys + (size_t)idxv[m] * D_MODEL;
#pragma unroll
                    for (int bj = 0; bj < 2; ++bj) { const int col = u.pn * 256 + bj * 128 + wc * 32 + 8 * fq; const f32x4 v0 = acc[ai][bj][m][0] * w, v1 = acc[ai][bj][m][1] * w;
                        u32x4 pk; pk.x = mg::cvt_pk_bf16(v0[0], v0[1]); pk.y = mg::cvt_pk_bf16(v0[2], v0[3]); pk.z = mg::cvt_pk_bf16(v1[0], v1[1]); pk.w = mg::cvt_pk_bf16(v1[2], v1[3]);
                        *(u32x4*)(rowp + col) = pk; } }
        }
    }
};

template <bool F8 = false, class SF>
DEV void conv_wt(SF sf, int ngroups, int K, int Nphys, bf16_t* dst, float*  , int bid, int nb, int t0 = 0, int t1 = 0x7fffffff) {
    const int tid = tidx(), wid = tid >> 6, lane = tid & 63, kb = lane & 7, c4 = lane >> 3;
    const int ktn = K / 64, ntn = Nphys / 256, per = ktn * ntn, total = ngroups * per < t1 ? ngroups * per : t1;
    constexpr int NF = 4;
    (void)per; (void)total;
    const int ktq = ktn / 2, ntq = (ntn + 1) / 2, perq = ktq * ntq, totq = ngroups * perq;
    const int q0 = t0 / NF, q1 = (t1 == 0x7fffffff || t1 / NF > totq) ? totq : t1 / NF;
    for (int item = q0 + bid; item < q1; item += nb) {
        const int g = item / perq, rem = item - g * perq, kq = rem / ntq, nq = rem - kq * ntq;
        const int k0 = kq * 128 + kb * 16;
        f32x4 v[2][2][8];
#pragma unroll
        for (int un = 0; un < 2; ++un) { const int nt = nq * 2 + un; const int q = nt * 64 + wid * 8 + c4;
#pragma unroll
            for (int uk = 0; uk < 2; ++uk)
#pragma unroll
                for (int j = 0; j < 8; ++j) { const float* sp = nt < ntn ? sf(g, k0 + uk * 8 + j, q) : (const float*)nullptr; v[un][uk][j] = (f32x4){0.f, 0.f, 0.f, 0.f}; if (sp) v[un][uk][j] = __builtin_nontemporal_load((const f32x4*)sp); } }
#pragma unroll
        for (int un = 0; un < 2; ++un) { const int nt = nq * 2 + un; const int q = nt * 64 + wid * 8 + c4;
            if (nt < ntn) {
#pragma unroll
            for (int e = 0; e < 4; ++e) {
                if constexpr (F8) { u32x4 w;
                    w.x = pk8(v[un][0][0][e] * F8_SW, v[un][0][1][e] * F8_SW, v[un][0][2][e] * F8_SW, v[un][0][3][e] * F8_SW); w.y = pk8(v[un][0][4][e] * F8_SW, v[un][0][5][e] * F8_SW, v[un][0][6][e] * F8_SW, v[un][0][7][e] * F8_SW);
                    w.z = pk8(v[un][1][0][e] * F8_SW, v[un][1][1][e] * F8_SW, v[un][1][2][e] * F8_SW, v[un][1][3][e] * F8_SW); w.w = pk8(v[un][1][4][e] * F8_SW, v[un][1][5][e] * F8_SW, v[un][1][6][e] * F8_SW, v[un][1][7][e] * F8_SW);
                    __builtin_nontemporal_store(w, (u32x4*)((char*)dst + ((size_t)g * Nphys + 4 * q + e) * K + k0)); }
                else {
#pragma unroll
                    for (int uk = 0; uk < 2; ++uk) { u32x4 w; w.x = mg::cvt_pk_bf16(v[un][uk][0][e], v[un][uk][1][e]); w.y = mg::cvt_pk_bf16(v[un][uk][2][e], v[un][uk][3][e]); w.z = mg::cvt_pk_bf16(v[un][uk][4][e], v[un][uk][5][e]); w.w = mg::cvt_pk_bf16(v[un][uk][6][e], v[un][uk][7][e]);
                        __builtin_nontemporal_store(w, (u32x4*)(dst + ((size_t)g * Nphys + 4 * q + e) * K + k0 + uk * 8)); } } } } }
    }
}

template <bool F8 = false, bool X16 = false  >
DEV void rows_norm(const float* src, const bf16_t* add0, const bf16_t* add1, float* sumdst, const float* g, bf16_t* dst, int bid, int nb) {
    const int lane = tidx() & 63, wid = tidx() >> 6;
    for (int row = bid * 8 + wid; row < T; row += nb * 8) {
        float4 v[8]; float ss = 0.f;
#pragma unroll
        for (int i = 0; i < 8; ++i) {
            const size_t o = (size_t)row * D_MODEL + i * 256 + lane * 4;
            float4 a; if constexpr (X16) { const ushort4 s4 = *(const ushort4*)((const bf16_t*)src + o); a = make_float4(bf2f(s4.x), bf2f(s4.y), bf2f(s4.z), bf2f(s4.w)); } else a = *(const float4*)(src + o);
            if (add0) { const size_t o2 = (size_t)row * 2 * D_MODEL + i * 256 + lane * 4; const ushort4 b = *(const ushort4*)(add0 + o2), c = *(const ushort4*)(add1 + o2);
                a.x += bf2f(b.x) + bf2f(c.x); a.y += bf2f(b.y) + bf2f(c.y); a.z += bf2f(b.z) + bf2f(c.z); a.w += bf2f(b.w) + bf2f(c.w); }
            if (sumdst) { if constexpr (X16) { ushort4 q4; q4.x = f2bf(a.x); q4.y = f2bf(a.y); q4.z = f2bf(a.z); q4.w = f2bf(a.w); *(ushort4*)((bf16_t*)sumdst + o) = q4; } else *(float4*)(sumdst + o) = a; }
            v[i] = a; ss += a.x * a.x + a.y * a.y + a.z * a.z + a.w * a.w;
        }
        ss = wave_sum(ss);
        const float rinv = rsqrtf(ss * (1.f / D_MODEL) + NORM_EPS);
#pragma unroll
        for (int i = 0; i < 8; ++i) {
            const int c = i * 256 + lane * 4; const float4 gg = *(const float4*)(g + c);
            if constexpr (F8) { const float rs = rinv * F8_SX; *(unsigned*)((char*)dst + (size_t)row * D_MODEL + c) = pk8(v[i].x * rs * gg.x, v[i].y * rs * gg.y, v[i].z * rs * gg.z, v[i].w * rs * gg.w); }
            else { ushort4 o; o.x = f2bf(v[i].x * rinv * gg.x); o.y = f2bf(v[i].y * rinv * gg.y); o.z = f2bf(v[i].z * rinv * gg.z); o.w = f2bf(v[i].w * rinv * gg.w);
                *(ushort4*)(dst + (size_t)row * D_MODEL + c) = o; }
        }
    }
}

DEV void ph_rope_table(const P& p, int bid, int nb) {
    for (int i = bid * NTHREADS + tidx(); i < SEQ * 64; i += nb * NTHREADS) {
        const int pos = i >> 6, j = i & 63;
        const double inv = exp(-log(10000.0) * (double)j / 64.0);
        const float invf = (float)inv;
        const float ang = (float)pos * invf;
        p.rope[i * 2] = (float)cos((double)ang); p.rope[i * 2 + 1] = (float)sin((double)ang);
    }
}

DEV void ph_cmp_attn(const P& p, float* lds, int bid, int nb) {
    const int lane = tidx() & 63, wid = tidx() >> 6;
    float* qs = lds + wid * 640; float* ps = qs + 512;
    float* ocmp = (float*)(p.big + BIG_NSA_OCMP);
    const bf16_t* Q = (const bf16_t*)(p.big + BIG_NSA_Q);
    const float scale = 0.08838834764831845f;
    const bf16_t* kc = (const bf16_t*)(p.big + BIG_NSA_KVC); const bf16_t* vc = kc + (size_t)2048 * 128;
    for (int u = bid * 8 + wid; u < T * NKV; u += nb * 8) {
        const int g = u & 3, tok = u >> 2, b = tok / SEQ, t = tok % SEQ;
        const int ncv = t >= 31 ? (t - 31) / 16 + 1 : 0;
        const bf16_t* qrow = Q + (size_t)tok * 2048 + g * 4 * 128;
#pragma unroll
        for (int i = 0; i < 8; ++i) qs[lane + 64 * i] = bf2f(qrow[lane + 64 * i]);
        float psum0 = 0.f, psum1 = 0.f;
        for (int r = 0; r < 4; ++r) {
            float s0 = -INFINITY, s1 = -INFINITY;
            if (lane < ncv) { const bf16_t* kr = kc + ((size_t)((b * 4 + g) * 128 + lane)) * 128; float a = 0.f; for (int d = 0; d < 128; ++d) a = fmaf(qs[r * 128 + d], bf2f(kr[d]), a); s0 = a * scale; }
            if (lane + 64 < ncv) { const bf16_t* kr = kc + ((size_t)((b * 4 + g) * 128 + lane + 64)) * 128; float a = 0.f; for (int d = 0; d < 128; ++d) a = fmaf(qs[r * 128 + d], bf2f(kr[d]), a); s1 = a * scale; }
            float p0 = 0.f, p1 = 0.f;
            if (ncv > 0) {
                const float m = wave_max(fmaxf(s0, s1));
                const float e0 = lane < ncv ? expf(s0 - m) : 0.f, e1 = lane + 64 < ncv ? expf(s1 - m) : 0.f;
                const float sum = wave_sum(e0 + e1);
                p0 = e0 / sum; p1 = e1 / sum;
            }
            psum0 += p0; psum1 += p1;
            float o0 = 0.f, o1 = 0.f;
            for (int c = 0; c < ncv; ++c) {
                const float pc = c < 64 ? __shfl(p0, c) : __shfl(p1, c - 64);
                const bf16_t* vr = vc + ((size_t)((b * 4 + g) * 128 + c)) * 128;
                o0 = fmaf(pc, bf2f(vr[lane]), o0); o1 = fmaf(pc, bf2f(vr[lane + 64]), o1);
            }
            float* orow = ocmp + (size_t)tok * 2048 + (g * 4 + r) * 128;
            orow[lane] = o0; orow[lane + 64] = o1;
        }
        ps[lane] = psum0; ps[lane + 64] = psum1;
        float val = -INFINITY;
        const int j = lane;
        if (j < 32) {
            float imp = ps[4 * j] + ps[4 * j + 1] + ps[4 * j + 2] + 0.5f * ps[4 * j + 3] + (j > 0 ? 0.5f * ps[4 * j - 1] : 0.f);
            const int dist = (t >> 6) - j;
            const bool forced = (j == 0) || (dist >= 0 && dist < 2);
            val = forced ? 1e4f : imp;
            if (dist < 0) val = -INFINITY;
        }
        int rank = 0;
        for (int i = 0; i < 32; ++i) { const float vi = __shfl(val, i); rank += (vi > val || (vi == val && i < j)) ? 1 : 0; }
        const unsigned long long bal = __ballot(j < 32 && rank < 16);
        if (lane == 0) p.selmask[(size_t)(b * NKV + g) * SEQ + t] = (unsigned)bal;
    }
}

DEV void attend_wave(const bf16_t* Kb, const bf16_t* Vb, const float* qs, int b, int g, unsigned bmask, int lo, int hi, int lane, float& o0, float& o1) {
    const float scale = 0.08838834764831845f;
    float m = -INFINITY, l = 0.f; o0 = 0.f; o1 = 0.f;
    for (int j = lo >> 6; j <= (hi >> 6); ++j) {
        if (!((bmask >> j) & 1u)) continue;
        const int key = j * 64 + lane; const bool valid = key >= lo && key <= hi;
        float s = -INFINITY;
        if (valid) { const bf16_t* kr = Kb + (size_t)(b * SEQ + key) * 512 + g * 128; float a = 0.f;
            for (int d = 0; d < 128; d += 4) { const ushort4 kv = *(const ushort4*)(kr + d); a = fmaf(qs[d], bf2f(kv.x), a); a = fmaf(qs[d + 1], bf2f(kv.y), a); a = fmaf(qs[d + 2], bf2f(kv.z), a); a = fmaf(qs[d + 3], bf2f(kv.w), a); }
            s = a * scale; }
        const float bm = wave_max(s);
        if (bm == -INFINITY) continue;
        const float mn = fmaxf(m, bm), alpha = expf(m - mn);
        const float pr = valid ? expf(s - mn) : 0.f;
        l = l * alpha + wave_sum(pr); o0 *= alpha; o1 *= alpha; m = mn;
        for (int kk = 0; kk < 64; ++kk) {
            const float pk = __shfl(pr, kk);
            if (pk != 0.f) { const bf16_t* vr = Vb + (size_t)(b * SEQ + j * 64 + kk) * 512 + g * 128; o0 = fmaf(pk, bf2f(vr[lane]), o0); o1 = fmaf(pk, bf2f(vr[lane + 64]), o1); }
        }
    }
    const float inv = 1.f / l; o0 *= inv; o1 *= inv;
}

DEV void ph_attn_sw(const P& p, float* lds, int bid, int nb) {
    const int lane = tidx() & 63, wid = tidx() >> 6;
    float* qs = lds + wid * 128;
    const float* ocmp = (const float*)(p.big + BIG_NSA_OCMP); bf16_t* obuf = (bf16_t*)(p.big + BIG_NSA_OBUF);
    const bf16_t* Q = (const bf16_t*)(p.big + BIG_NSA_Q); const float* gate = (const float*)(p.big + BIG_NSA_GATE);
    const bf16_t* KS = (const bf16_t*)(p.big + BIG_NSA_KS); const bf16_t* VS = (const bf16_t*)(p.big + BIG_NSA_VS);
    const bf16_t* KW = (const bf16_t*)(p.big + BIG_NSA_KW); const bf16_t* VW = (const bf16_t*)(p.big + BIG_NSA_VW);
    for (int u = bid * 8 + wid; u < T * NH; u += nb * 8) {
        const int h = u & 15, tok = u >> 4, b = tok / SEQ, t = tok % SEQ, g = h >> 2;
        const bf16_t* qrow = Q + (size_t)tok * 2048 + h * 128;
        qs[lane] = bf2f(qrow[lane]); qs[lane + 64] = bf2f(qrow[lane + 64]);
        const unsigned sm = p.selmask[(size_t)(b * NKV + g) * SEQ + t];
        float s0, s1, w0, w1;
        attend_wave(KS, VS, qs, b, g, sm, 0, t, lane, s0, s1);
        attend_wave(KW, VW, qs, b, g, 0xffffffffu, t - (WINDOW - 1) > 0 ? t - (WINDOW - 1) : 0, t, lane, w0, w1);
        const float* gl = gate + (size_t)tok * 48 + h * 3;
        const float g0 = gl[0], g1 = gl[1], g2 = gl[2];
        const float* oc = ocmp + (size_t)tok * 2048 + h * 128;
        bf16_t* ob = obuf + (size_t)tok * 2048 + h * 128;
        ob[lane] = f2bf(g0 * oc[lane] + g1 * s0 + g2 * w0);
        ob[lane + 64] = f2bf(g0 * oc[lane + 64] + g1 * s1 + g2 * w1);
    }
}

namespace at {
typedef float f32x16 __attribute__((ext_vector_type(16)));
typedef short s16x4 __attribute__((ext_vector_type(4)));
constexpr int SHM = 16384;
constexpr float SCALE = 0.08838834764831845f, C2 = 1.4426950408889634f * SCALE, THR = 8.f;
#define AT_KSWZ(row, colB) ((row) * 256 + ((colB) ^ (((row) & 7) << 4)))
DEV int v_st(int k, int c) { const int kk = (k & ~0xC) | ((k & 4) << 1) | ((k & 8) >> 1); return ((kk >> 3) * 4 + (c >> 5)) * 512 + ((kk & 7) * 32 + (c & 31)) * 2; }
DEV int v_rd_base(int lane) { return ((lane & 3) << 3) | (((lane >> 2) & 3) << 6) | (((lane >> 4) & 1) << 5) | (((lane >> 5) & 1) << 8); }
DEV int crow(int r, int hi) { return (r & 3) + 8 * (r >> 2) + 4 * hi; }
DEV unsigned cvtpk(float lo, float hi) { unsigned r; asm volatile("v_cvt_pk_bf16_f32 %0, %1, %2" : "=v"(r) : "v"(lo), "v"(hi)); return r; }
DEV float swap_max(float x) { auto rr = __builtin_amdgcn_permlane32_swap(__float_as_uint(x), __float_as_uint(x), false, false); return fmaxf(__uint_as_float(rr[0]), __uint_as_float(rr[1])); }
DEV float swap_sum(float x) { auto rr = __builtin_amdgcn_permlane32_swap(__float_as_uint(x), __float_as_uint(x), false, false); return __uint_as_float(rr[0]) + __uint_as_float(rr[1]); }
#define AT_PK4(P, B_, OUT) do { unsigned a0 = cvtpk(P[B_+0], P[B_+1]), a1 = cvtpk(P[B_+2], P[B_+3]); unsigned b0 = cvtpk(P[B_+4], P[B_+5]), b1 = cvtpk(P[B_+6], P[B_+7]); \
        auto r0 = __builtin_amdgcn_permlane32_swap(a0, b0, false, false); auto r1 = __builtin_amdgcn_permlane32_swap(a1, b1, false, false); \
        u32x4 w = {r0[0], r1[0], r0[1], r1[1]}; OUT = *reinterpret_cast<bf16x8*>(&w); } while (0)
DEV void qkt(f32x16& p0, f32x16& p1, const char* Kl, int r32, int hi, const bf16x8* qr) {
    p0 = f32x16{}; p1 = f32x16{};
    const char* kb[4];
#pragma unroll
    for (int dd = 0; dd < 4; ++dd) kb[dd] = Kl + AT_KSWZ(r32, (dd * 16 + hi * 8) * 2);
#pragma unroll
    for (int d0 = 0; d0 < 8; ++d0) { const char* a = kb[d0 & 3] + (d0 >> 2) * 128;
        const bf16x8 b0 = *reinterpret_cast<const bf16x8*>(a), b1 = *reinterpret_cast<const bf16x8*>(a + 32 * 256);
        p0 = __builtin_amdgcn_mfma_f32_32x32x16_bf16(b0, qr[d0], p0, 0, 0, 0);
        p1 = __builtin_amdgcn_mfma_f32_32x32x16_bf16(b1, qr[d0], p1, 0, 0, 0); }
}
DEV void pv_tile(f32x16* o, int vb0, bf16x8 pa0, bf16x8 pa1, bf16x8 pa2, bf16x8 pa3) {
#define AT_TRRD(dst, off) asm volatile("ds_read_b64_tr_b16 %0, %1 offset:%2" : "=&v"(dst) : "v"(vb0), "i"(off) : "memory")
#define AT_RD8(S, d0) do { constexpr int b_ = (d0) * 512; AT_TRRD(S##l0, b_); AT_TRRD(S##h0, b_ + 2048); AT_TRRD(S##l1, b_ + 4096); AT_TRRD(S##h1, b_ + 6144); \
        AT_TRRD(S##l2, b_ + 8192); AT_TRRD(S##h2, b_ + 10240); AT_TRRD(S##l3, b_ + 12288); AT_TRRD(S##h3, b_ + 14336); } while (0)
#define AT_MM4(S, d0) do { \
        o[d0] = __builtin_amdgcn_mfma_f32_32x32x16_bf16(pa0, (bf16x8){S##l0[0], S##l0[1], S##l0[2], S##l0[3], S##h0[0], S##h0[1], S##h0[2], S##h0[3]}, o[d0], 0, 0, 0); \
        o[d0] = __builtin_amdgcn_mfma_f32_32x32x16_bf16(pa1, (bf16x8){S##l1[0], S##l1[1], S##l1[2], S##l1[3], S##h1[0], S##h1[1], S##h1[2], S##h1[3]}, o[d0], 0, 0, 0); \
        o[d0] = __builtin_amdgcn_mfma_f32_32x32x16_bf16(pa2, (bf16x8){S##l2[0], S##l2[1], S##l2[2], S##l2[3], S##h2[0], S##h2[1], S##h2[2], S##h2[3]}, o[d0], 0, 0, 0); \
        o[d0] = __builtin_amdgcn_mfma_f32_32x32x16_bf16(pa3, (bf16x8){S##l3[0], S##l3[1], S##l3[2], S##l3[3], S##h3[0], S##h3[1], S##h3[2], S##h3[3]}, o[d0], 0, 0, 0); } while (0)
#define AT_WAIT(n) do { asm volatile("s_waitcnt lgkmcnt(" #n ")" ::: "memory"); __builtin_amdgcn_sched_barrier(0); } while (0)
    s16x4 xl0, xl1, xl2, xl3, xh0, xh1, xh2, xh3, yl0, yl1, yl2, yl3, yh0, yh1, yh2, yh3;
    AT_RD8(x, 0); AT_RD8(y, 1);
    AT_WAIT(8); AT_MM4(x, 0);
    __builtin_amdgcn_sched_barrier(0); AT_RD8(x, 2);
    AT_WAIT(8); AT_MM4(y, 1);
    __builtin_amdgcn_sched_barrier(0); AT_RD8(y, 3);
    AT_WAIT(8); AT_MM4(x, 2);
    AT_WAIT(0); AT_MM4(y, 3);
#undef AT_WAIT
#undef AT_MM4
#undef AT_RD8
#undef AT_TRRD
}
DEV void mask_tile(f32x16& p0, f32x16& p1, int lo, int hi_, int hi) {
    const float NEG = -__builtin_inff(); const unsigned w = (unsigned)(hi_ - lo); const int base = 4 * hi - lo;
#pragma unroll
    for (int r = 0; r < 16; ++r) { const int cr = (r & 3) + 8 * (r >> 2);
        if ((unsigned)(cr + base) > w) p0[r] = NEG;
        if ((unsigned)(cr + 32 + base) > w) p1[r] = NEG; }
}
struct Ctx { char* L; int tid, wid, lane, r32, hi; unsigned ksrc[2], vsrc[2]; float* li_l; float* al_l; };
#define AT_STAGE(Kp, Vp, pitch, kb, vb) do { _Pragma("unroll") for (int _i = 0; _i < 2; ++_i) { unsigned ks_ = c.ksrc[_i], vs_ = c.vsrc[_i]; asm volatile("" : "+v"(ks_), "+v"(vs_));     \
        __builtin_amdgcn_global_load_lds((const unsigned*)((Kp) + (size_t)(ks_ >> 16) * (pitch) + (ks_ & 0xffffu)), (MG_LAS unsigned*)((MG_LAS char*)(c.L) + (kb) * SHM + c.wid * 1024 + _i * 8192), 16, 0, 0); \
        __builtin_amdgcn_global_load_lds((const unsigned*)((Vp) + (size_t)(vs_ >> 16) * (pitch) + (vs_ & 0xffffu)), (MG_LAS unsigned*)((MG_LAS char*)(c.L) + 2 * SHM + (vb) * SHM + c.wid * 1024 + _i * 8192), 16, 0, 0); } } while (0)
#define AT_RESC(a) do { if (__any((a) < 1.f)) { if (c.hi == 0) c.al_l[c.r32] = (a); asm volatile("s_waitcnt lgkmcnt(0)" ::: "memory"); \
        _Pragma("unroll") for (int d_ = 0; d_ < 4; ++d_) _Pragma("unroll") for (int r = 0; r < 16; ++r) o[d_][r] *= c.al_l[crow(r, c.hi)]; } } while (0)

template <int MODE>
DEV void branch(const Ctx& c, const bf16_t* Kb, const bf16_t* Vb  , unsigned tiles, int i, int tl, unsigned smask, const bf16x8* qr, f32x16* o, float& l_reg) {
    float m_reg = -1e30f; l_reg = 0.f;
#pragma unroll
    for (int d = 0; d < 4; ++d) o[d] = f32x16{};
    unsigned rem = tiles; int j = __builtin_ctz(rem); rem &= rem - 1; int buf = 0;
    AT_STAGE(Kb + (size_t)j * 64 * 512, Vb + (size_t)j * 64 * 512, 512, 0, 0);
    __syncthreads();
    for (;;) {
        const bool more = rem != 0u; int jn = j;
        if (more) { jn = __builtin_ctz(rem); rem &= rem - 1; AT_STAGE(Kb + (size_t)jn * 64 * 512, Vb + (size_t)jn * 64 * 512, 512, buf ^ 1, buf ^ 1); }
        int lo, hi_;
        if (MODE == 1) { const bool sel = (smask >> j) & 1u; lo = sel ? 0 : 100; hi_ = sel ? (j == i ? tl : 63) : 100; }
        else { const int a = tl + 64 * (i - j); hi_ = a < 63 ? a : 63; lo = a - 511 > 0 ? a - 511 : 0; if (lo > 63) { lo = 100; hi_ = 100; } }
        if (__any(lo <= 63)) {
        f32x16 p0, p1;
        qkt(p0, p1, c.L + buf * SHM, c.r32, c.hi, qr);
        if (!__all(lo <= 0 && hi_ >= 63)) {
            if (MODE == 1 && j != i) { const bool keep = lo == 0; const float NEG = -__builtin_inff();
#pragma unroll
                for (int r = 0; r < 16; ++r) { p0[r] = keep ? p0[r] : NEG; p1[r] = keep ? p1[r] : NEG; } }
            else mask_tile(p0, p1, lo, hi_, c.hi);
        }
        float pmax = p0[0];
#pragma unroll
        for (int r = 1; r < 16; ++r) pmax = fmaxf(pmax, p0[r]);
#pragma unroll
        for (int r = 0; r < 16; ++r) pmax = fmaxf(pmax, p1[r]);
        pmax = swap_max(pmax);
        float mn, alpha;
        if (__all((pmax - m_reg) * SCALE <= THR)) { mn = m_reg; alpha = 1.f; }
        else { mn = fmaxf(m_reg, pmax); alpha = __builtin_amdgcn_exp2f((m_reg - mn) * C2); m_reg = mn; }
        const float mnL = -mn * C2; float ps = 0.f;
#pragma unroll
        for (int r = 0; r < 16; ++r) { p0[r] = __builtin_amdgcn_exp2f(fmaf(p0[r], C2, mnL)); p1[r] = __builtin_amdgcn_exp2f(fmaf(p1[r], C2, mnL)); ps += p0[r] + p1[r]; }
        ps = swap_sum(ps);
        l_reg = l_reg * alpha + ps;
        bf16x8 pa0, pa1, pa2, pa3;
        AT_PK4(p0, 0, pa0); AT_PK4(p0, 8, pa1); AT_PK4(p1, 0, pa2); AT_PK4(p1, 8, pa3);
        AT_RESC(alpha);
        pv_tile(o, (int)(uintptr_t)(c.L + 2 * SHM + buf * SHM) + v_rd_base(c.lane), pa0, pa1, pa2, pa3);
        }
        __syncthreads();
        if (!more) break;
        j = jn; buf ^= 1;
    }
}
template <int MODE>
DEV void branch_acc(const Ctx& c, const f32x16* o, float rowscale, char* stash_w  , bf16_t* obuf, size_t orow0) {
    int hi = c.hi, r32 = c.r32, ln = c.lane; asm volatile("" : "+v"(hi), "+v"(r32), "+v"(ln));
    float* li = c.li_l; asm volatile("" : "+v"(li));
    if (hi == 0) li[r32] = rowscale;
    asm volatile("s_waitcnt lgkmcnt(0)" ::: "memory");
    float sc[16];
#pragma unroll
    for (int r = 0; r < 16; ++r) sc[r] = li[(r & 3) + 8 * (r >> 2) + 4 * hi];
    char* sp = stash_w + ln * 16;
#pragma unroll
    for (int jg = 0; jg < 8; ++jg) {
        u32x4 w = {0u, 0u, 0u, 0u};
        if (MODE != 0) w = *(const u32x4*)(sp + jg * 1024);
        const int d0 = jg >> 1;
        float v0[4], v1[4];
#pragma unroll
        for (int k = 0; k < 4; ++k) { const int r = 8 * (jg & 1) + 2 * k;
            float t0 = o[d0][r] * sc[r], t1 = o[d0][r + 1] * sc[r + 1];
            if (MODE != 0) { t0 += __uint_as_float(w[k] << 16); t1 += __uint_as_float(w[k] & 0xffff0000u); }
            if (MODE != 2) w[k] = cvtpk(t0, t1);
            v0[k] = t0; v1[k] = t1; }
        if (MODE == 2) {
            const int kq = r32 & 3; quad_transpose(v0, kq); quad_transpose(v1, kq);
            const int rl = 8 * (jg & 1) + 2 * kq; const size_t ob = orow0 + (size_t)(r32 & ~3) + (size_t)(4 * hi) * 2048 + d0 * 32;
            *(unsigned*)((char*)obuf + ob + (size_t)((rl & 3) + 8 * (rl >> 2)) * 2048) = pk8(v0[0] * F8_SO, v0[1] * F8_SO, v0[2] * F8_SO, v0[3] * F8_SO);
            *(unsigned*)((char*)obuf + ob + (size_t)(((rl + 1) & 3) + 8 * ((rl + 1) >> 2)) * 2048) = pk8(v1[0] * F8_SO, v1[1] * F8_SO, v1[2] * F8_SO, v1[3] * F8_SO); }
        if (MODE != 2) *(u32x4*)(sp + jg * 1024) = w;
    }
}
}

DEV void ph_attn_mfma(const P& p, char* L  , int bid, int nb) {
    using namespace at;
    Ctx c; c.L = L; c.tid = tidx(); c.wid = __builtin_amdgcn_readfirstlane(c.tid >> 6); c.lane = c.tid & 63; c.r32 = c.lane & 31; c.hi = c.lane >> 5;
#pragma unroll
    for (int i = 0; i < 2; ++i) { const int pos = c.tid * 16 + i * 8192;
        { const int row = pos >> 8, ch = ((pos >> 4) & 15) ^ (row & 7); c.ksrc[i] = (unsigned)(row << 16) | (unsigned)(ch * 8); }
        { const int sub = pos >> 9, w = (pos & 511) >> 1, kk = (sub >> 2) * 8 + (w >> 5), k = (kk & ~0xC) | ((kk & 4) << 1) | ((kk & 8) >> 1), col = (sub & 3) * 32 + (w & 31);
          c.vsrc[i] = (unsigned)(k << 16) | (unsigned)col; } }
    float* wsf = (float*)(L + 4 * SHM) + c.wid * 64; c.li_l = wsf; c.al_l = wsf + 32;
    unsigned* selm = (unsigned*)(L + 4 * SHM + 2048);
    unsigned* um = selm + 64;
    char* stash = L + 4 * SHM + 2560;
    float* impbuf = (float*)stash;
    float* impsum = impbuf + 4 * 64 * 33;
    const bf16_t* Q = (const bf16_t*)(p.big + BIG_NSA_Q); const float* gate = (const float*)(p.big + BIG_NSA_GATE);
    const bf16_t* KS = (const bf16_t*)(p.big + BIG_NSA_KS); const bf16_t* VS = (const bf16_t*)(p.big + BIG_NSA_VS);
    const bf16_t* KW = (const bf16_t*)(p.big + BIG_NSA_KW); const bf16_t* VW = (const bf16_t*)(p.big + BIG_NSA_VW);
    const bf16_t* KC = (const bf16_t*)(p.big + BIG_NSA_KVC); const bf16_t* VC = KC + (size_t)2048 * 128;
    bf16_t* obuf = (bf16_t*)(p.big + BIG_NSA_OBUF);
    const int rq = c.wid & 3, th = c.wid >> 2, tl = 32 * th + c.r32;
    for (int pr0 = bid; pr0 < 256; pr0 += nb) {
        const int pr = (nb == 256) ? ((pr0 & 7) * 32 + (pr0 >> 3)) : pr0;
        const int bg = pr >> 4, b = bg >> 2, g = bg & 3, ii = pr & 15;
#pragma unroll 1
        for (int pass = 0; pass < 2; ++pass) {
            const int i = pass == 0 ? 31 - ii : ii;
            const int hq = 4 * g + rq, tok0 = b * SEQ + 64 * i, tq = 64 * i + tl;
            bf16x8 qr[8];
            { int hiq = c.hi, tlq = tl; asm volatile("" : "+v"(hiq), "+v"(tlq));
              const bf16_t* qp = Q + (size_t)(tok0 + tlq) * 2048 + hq * 128 + hiq * 8;
#pragma unroll
              for (int d0 = 0; d0 < 8; ++d0) qr[d0] = *(const bf16x8*)(qp + d0 * 16); }
            f32x16 o[4]; float l_reg;
            const size_t orow0 = (size_t)(tok0 + 32 * th) * 2048 + hq * 128;
            {
                const bf16_t* kc = KC + (size_t)(bg * 128) * 128; const bf16_t* vc = VC + (size_t)(bg * 128) * 128;
                AT_STAGE(kc, vc, 128, 0, 0);
                AT_STAGE(kc + 64 * 128, vc + 64 * 128, 128, 1, 1);
                __syncthreads();
                f32x16 pA0, pA1, pB0, pB1;
                qkt(pA0, pA1, c.L, c.r32, c.hi, qr); qkt(pB0, pB1, c.L + SHM, c.r32, c.hi, qr);
                const int cmax = tq >= 31 ? (tq - 31) >> 4 : -1;
                { int lo = 0, hi_ = cmax < 63 ? cmax : 63; if (cmax < 0) { lo = 100; hi_ = 100; } mask_tile(pA0, pA1, lo, hi_, c.hi); }
                { int lo = 0, hi_ = cmax - 64 < 63 ? cmax - 64 : 63; if (cmax < 64) { lo = 100; hi_ = 100; } mask_tile(pB0, pB1, lo, hi_, c.hi); }
                float pmax = -1e30f;
#pragma unroll
                for (int r = 0; r < 16; ++r) pmax = fmaxf(fmaxf(pmax, fmaxf(pA0[r], pA1[r])), fmaxf(pB0[r], pB1[r]));
                pmax = swap_max(pmax);
                const float mnL = -pmax * C2; float ps = 0.f;
#pragma unroll
                for (int r = 0; r < 16; ++r) { pA0[r] = __builtin_amdgcn_exp2f(fmaf(pA0[r], C2, mnL)); pA1[r] = __builtin_amdgcn_exp2f(fmaf(pA1[r], C2, mnL));
                    pB0[r] = __builtin_amdgcn_exp2f(fmaf(pB0[r], C2, mnL)); pB1[r] = __builtin_amdgcn_exp2f(fmaf(pB1[r], C2, mnL)); ps += (pA0[r] + pA1[r]) + (pB0[r] + pB1[r]); }
                ps = swap_sum(ps); l_reg = ps;
                const float inv_l = l_reg > 0.f ? 1.f / l_reg : 0.f;
                { float prev = 0.f; float* ib = impbuf + (rq * 64 + tl) * 33;
#define AT_IMPG(P, G0) _Pragma("unroll") for (int rg = 0; rg < 4; ++rg) { const float car = 0.5f * P[4 * rg + 3] * inv_l, own = (P[4 * rg] + P[4 * rg + 1] + P[4 * rg + 2]) * inv_l + car; \
                        const float rc = __shfl_xor(car, 32); ib[2 * ((G0) + rg) + c.hi] = own + (c.hi ? rc : prev); prev = rc; }
                  AT_IMPG(pA0, 0) AT_IMPG(pA1, 4) AT_IMPG(pB0, 8) AT_IMPG(pB1, 12)
#undef AT_IMPG
                }
                bf16x8 pa0, pa1, pa2, pa3;
#pragma unroll
                for (int d = 0; d < 4; ++d) o[d] = f32x16{};
                AT_PK4(pA0, 0, pa0); AT_PK4(pA0, 8, pa1); AT_PK4(pA1, 0, pa2); AT_PK4(pA1, 8, pa3);
                pv_tile(o, (int)(uintptr_t)(c.L + 2 * SHM) + v_rd_base(c.lane), pa0, pa1, pa2, pa3);
                AT_PK4(pB0, 0, pa0); AT_PK4(pB0, 8, pa1); AT_PK4(pB1, 0, pa2); AT_PK4(pB1, 8, pa3);
                pv_tile(o, (int)(uintptr_t)(c.L + 3 * SHM) + v_rd_base(c.lane), pa0, pa1, pa2, pa3);
                __syncthreads();
                { const int tk = c.tid >> 3, q4 = c.tid & 7; float val[4];
#pragma unroll
                  for (int e = 0; e < 4; ++e) { const int j = 4 * q4 + e; float v = impbuf[(0 * 64 + tk) * 33 + j] + impbuf[(1 * 64 + tk) * 33 + j] + impbuf[(2 * 64 + tk) * 33 + j] + impbuf[(3 * 64 + tk) * 33 + j];
                      const int dist = i - j; const bool forced = (j == 0) || (dist >= 0 && dist < 2); v = forced ? 1e4f : v; if (dist < 0) v = -__builtin_inff(); val[e] = v; impsum[tk * 32 + j] = v; }
                  __syncthreads();
                  int rank[4] = {0, 0, 0, 0};
                  for (int i2 = 0; i2 < 32; ++i2) { const float x = impsum[tk * 32 + i2];
#pragma unroll
                      for (int e = 0; e < 4; ++e) rank[e] += (x > val[e] || (x == val[e] && i2 < 4 * q4 + e)) ? 1 : 0; }
                  unsigned bits = 0u;
#pragma unroll
                  for (int e = 0; e < 4; ++e) bits |= (rank[e] < 16 ? 1u : 0u) << (4 * q4 + e);
                  bits |= __shfl_xor(bits, 1); bits |= __shfl_xor(bits, 2); bits |= __shfl_xor(bits, 4);
                  if (q4 == 0) selm[tk] = bits;
                  unsigned u = bits; u |= __shfl_xor(u, 8); u |= __shfl_xor(u, 16); u |= __shfl_xor(u, 32);
                  if (c.lane == 0) um[c.wid] = u; }
                __syncthreads();
                branch_acc<0>(c, o, gate[(size_t)(tok0 + tl) * 48 + hq * 3 + 0] * inv_l, stash + c.wid * 8192, obuf, orow0);
            }
            const unsigned smask = selm[tl];
            unsigned umask = um[0] | um[1] | um[2] | um[3] | um[4] | um[5] | um[6] | um[7];
            umask = __builtin_amdgcn_readfirstlane(umask) & ((2u << i) - 1u);
            branch<1>(c, KS + (size_t)b * SEQ * 512 + g * 128, VS + (size_t)b * SEQ * 512 + g * 128, umask, i, tl, smask, qr, o, l_reg);
            branch_acc<1>(c, o, gate[(size_t)(tok0 + tl) * 48 + hq * 3 + 1] / l_reg, stash + c.wid * 8192, obuf, orow0);
            { const int jlo = i - 8 > 0 ? i - 8 : 0; const unsigned wt = ((2u << i) - 1u) & ~((1u << jlo) - 1u);
              branch<2>(c, KW + (size_t)b * SEQ * 512 + g * 128, VW + (size_t)b * SEQ * 512 + g * 128, wt, i, tl, 0u, qr, o, l_reg); }
            branch_acc<2>(c, o, gate[(size_t)(tok0 + tl) * 48 + hq * 3 + 2] / l_reg, stash + c.wid * 8192, obuf, orow0);
            __syncthreads();
        }
    }
}

DEV void ph_moe_route(const P& p, int layer, const bf16_t* xin  , float* lds, int bid, int nb) {
    typedef float f32x16 __attribute__((ext_vector_type(16)));
    const int tid = tidx(), wid = __builtin_amdgcn_readfirstlane(tid >> 6), lane = tid & 63, i = lane & 31, kk = lane >> 5;
    float* part = lds;
    float* gpart = lds + 8192;
    float* spart = gpart + 1024;
    float* logit = spart + 256;
    float* rinv_l = logit + 32 * 36;
    int* lcnt = (int*)(rinv_l + 32);
    int* lbase = lcnt + 32;
    const float* wr = p.wr + (size_t)layer * D_MODEL * MOE_E; const float* wgq = p.wgq + (size_t)layer * D_MODEL * MOE_G;
    const float* g = p.ln_ffn + layer * D_MODEL;
    const float* bgrp = p.moe_b_group + layer * MOE_G; const float* bexp = p.moe_b_expert + layer * MOE_E;
    int* cnt = p.cnt + layer * MOE_E;
    for (int tb = bid; tb < T / 32; tb += nb) {
        const int tok0 = tb * 32;
        const bf16_t* xr = xin + (size_t)(tok0 + i) * D_MODEL + 256 * wid + 4 * kk;
        const float* wrow = wr + (size_t)(256 * wid + 4 * kk) * MOE_E + i;
        const float* wgrow = wgq + (size_t)(256 * wid + 4 * kk) * MOE_G;
        f32x16 acc = f32x16{}; float ss = 0.f; f32x4 ga = {0.f, 0.f, 0.f, 0.f};
#pragma unroll 4
        for (int j = 0; j < 32; ++j) {
            const u32x2 xw = *(const u32x2*)(xr + 8 * j); const f32x4 xv = {__uint_as_float(xw.x << 16), __uint_as_float(xw.x & 0xffff0000u), __uint_as_float(xw.y << 16), __uint_as_float(xw.y & 0xffff0000u)};
            const float* wp = wrow + (size_t)(8 * j) * MOE_E;
            const float b0 = wp[0], b1 = wp[MOE_E], b2 = wp[2 * MOE_E], b3 = wp[3 * MOE_E];
            const f32x4* gp = (const f32x4*)(wgrow + (size_t)(8 * j) * MOE_G);
            const f32x4 g0 = gp[0], g1 = gp[1], g2 = gp[2], g3 = gp[3];
            acc = __builtin_amdgcn_mfma_f32_32x32x2f32(xv[0], b0, acc, 0, 0, 0); acc = __builtin_amdgcn_mfma_f32_32x32x2f32(xv[1], b1, acc, 0, 0, 0);
            acc = __builtin_amdgcn_mfma_f32_32x32x2f32(xv[2], b2, acc, 0, 0, 0); acc = __builtin_amdgcn_mfma_f32_32x32x2f32(xv[3], b3, acc, 0, 0, 0);
            ss += xv[0] * xv[0] + xv[1] * xv[1] + xv[2] * xv[2] + xv[3] * xv[3];
            ga += g0 * xv[0] + g1 * xv[1] + g2 * xv[2] + g3 * xv[3];
        }
        ss += __shfl_xor(ss, 32);
#pragma unroll
        for (int q = 0; q < 4; ++q) ga[q] += __shfl_xor(ga[q], 32);
#pragma unroll
        for (int r = 0; r < 16; ++r) part[(wid * 32 + (r & 3) + 8 * (r >> 2) + 4 * kk) * 32 + i] = acc[r];
        if (kk == 0) { *(f32x4*)(gpart + (wid * 32 + i) * 4) = ga; spart[wid * 32 + i] = ss; }
        __syncthreads();
#pragma unroll
        for (int e = 0; e < 2; ++e) { const int idx = tid + e * 512, tk = idx >> 5, o = idx & 31; float sm = 0.f;
#pragma unroll
            for (int w = 0; w < 8; ++w) sm += part[(w * 32 + tk) * 32 + o];
            logit[tk * 36 + o] = sm; }
        if (tid < 128) { const int tk = tid >> 2, q = tid & 3; float sm = 0.f;
#pragma unroll
            for (int w = 0; w < 8; ++w) sm += gpart[(w * 32 + tk) * 4 + q];
            logit[tk * 36 + 32 + q] = sm; }
        if (tid < 32) { float sm = 0.f;
#pragma unroll
            for (int w = 0; w < 8; ++w) sm += spart[w * 32 + tid];
            rinv_l[tid] = rsqrtf(sm * (1.f / D_MODEL) + NORM_EPS); lcnt[tid] = 0; }
        __syncthreads();
        if (tid < 32) { const int tok = tok0 + tid; const float rinv = rinv_l[tid]; const float* lg = logit + tid * 36;
            float gl[4]; for (int q = 0; q < 4; ++q) gl[q] = lg[32 + q] * rinv + bgrp[q];
            int gs = 0; float gm = gl[0]; for (int q = 1; q < 4; ++q) if (gl[q] > gm) { gm = gl[q]; gs = q; }
            float gsum = 0.f; for (int q = 0; q < 4; ++q) gsum += expf(gl[q] - gm);
            const float gw = 1.f / gsum;
            float ev[8]; for (int q = 0; q < 8; ++q) ev[q] = lg[gs * 8 + q] * rinv + bexp[gs * 8 + q];
            int i1 = 0; for (int q = 1; q < 8; ++q) if (ev[q] > ev[i1]) i1 = q;
            int i2 = i1 == 0 ? 1 : 0; for (int q = 0; q < 8; ++q) if (q != i1 && ev[q] > ev[i2]) i2 = q;
            const float e2 = expf(ev[i2] - ev[i1]); const float w1 = gw / (1.f + e2), w2 = gw * e2 / (1.f + e2);
            const int ea = gs * 8 + i1, eb = gs * 8 + i2;
            const int ra = atomicAdd(&lcnt[ea], 1), rb = atomicAdd(&lcnt[eb], 1);
            asm volatile("s_waitcnt lgkmcnt(0)" ::: "memory");
            const int mine = lcnt[tid]; int base = 0; if (mine) base = atomicAdd(&cnt[tid], mine);
            lbase[tid] = base;
            asm volatile("s_waitcnt lgkmcnt(0)" ::: "memory");
            p.list[ea * T + lbase[ea] + ra] = tok * 2; p.ew[tok * 2] = w1;
            p.list[eb * T + lbase[eb] + rb] = tok * 2 + 1; p.ew[tok * 2 + 1] = w2; }
#pragma unroll
        for (int tt = 0; tt < 4; ++tt) { const int tok = tok0 + 4 * wid + tt; const float rinv = rinv_l[4 * wid + tt];
#pragma unroll
            for (int ii = 0; ii < 8; ++ii) { const int c = ii * 256 + lane * 4; const u32x2 xw = *(const u32x2*)(xin + (size_t)tok * D_MODEL + c); const f32x4 xv = {__uint_as_float(xw.x << 16), __uint_as_float(xw.x & 0xffff0000u), __uint_as_float(xw.y << 16), __uint_as_float(xw.y & 0xffff0000u)}, gg = *(const f32x4*)(g + c);
                const float rs = rinv * F8_SX;
                *(unsigned*)((char*)p.hb16 + (size_t)tok * D_MODEL + c) = pk8(xv[0] * rs * gg[0], xv[1] * rs * gg[1], xv[2] * rs * gg[2], xv[3] * rs * gg[3]); } }
        __syncthreads();
    }
}

namespace ssd {
using namespace at;
constexpr int OFF_CK = 0, OFF_BK = 32768, OFF_BV = 65536, OFF_XV = 98304, OFF_XS = 114688, OFF_PV = 131072, OFF_TB = 147456;
DEV int v64_st(int k, int c) { const int kk = (k & ~0xC) | ((k & 4) << 1) | ((k & 8) >> 1); return ((kk >> 3) * 2 + (c >> 5)) * 512 + ((kk & 7) * 32 + (c & 31)) * 2; }
#define SD_TRRD(dst, base, off) asm volatile("ds_read_b64_tr_b16 %0, %1 offset:%2" : "=&v"(dst) : "v"(base), "i"(off) : "memory")
#define SD_MK(lo, hi) ((bf16x8){lo[0], lo[1], lo[2], lo[3], hi[0], hi[1], hi[2], hi[3]})
DEV float conv8(const bf16x8& r0, const bf16x8& r1, const bf16x8& r2, const bf16x8& r3, const float (&w)[4][8], const float (&bias)[8], int j) {
    float a = bias[j]; a = fmaf(bf2f((bf16_t)r0[j]), w[0][j], a); a = fmaf(bf2f((bf16_t)r1[j]), w[1][j], a); a = fmaf(bf2f((bf16_t)r2[j]), w[2][j], a); a = fmaf(bf2f((bf16_t)r3[j]), w[3][j], a);
    return a / (1.f + __expf(-a));
}
}

DEV void ph_ssd_conv_bc(const P& p, int bid, int nb) {
    using namespace ssd;
    const bf16_t* xp = (const bf16_t*)(p.big + BIG_SSD_XBCP); bf16_t* bc = (bf16_t*)(p.big + BIG_SSD_BC);
    const bf16x8 zero8 = {0, 0, 0, 0, 0, 0, 0, 0};
    for (int it = bid * NTHREADS + tidx(); it < (T / 16) * 256; it += nb * NTHREADS) {
        const int cg = it & 255, tb = it >> 8, ch = SSD_DI + cg * 8, t0 = (tb * 16) & (SEQ - 1); const size_t tok0 = (size_t)tb * 16;
        float w[4][8], bias[8];
#pragma unroll
        for (int k = 0; k < 4; ++k) { const f32x4 w0 = *(const f32x4*)(p.ssd_conv_w + k * SSD_CONVCH + ch), w1 = *(const f32x4*)(p.ssd_conv_w + k * SSD_CONVCH + ch + 4);
#pragma unroll
            for (int j = 0; j < 4; ++j) { w[k][j] = w0[j]; w[k][4 + j] = w1[j]; } }
        { const f32x4 b0 = *(const f32x4*)(p.ssd_conv_b + ch), b1 = *(const f32x4*)(p.ssd_conv_b + ch + 4);
#pragma unroll
          for (int j = 0; j < 4; ++j) { bias[j] = b0[j]; bias[4 + j] = b1[j]; } }
        bf16x8 r0 = t0 >= 3 ? *(const bf16x8*)(xp + (tok0 - 3) * SSD_CONVCH + ch) : zero8, r1 = t0 >= 2 ? *(const bf16x8*)(xp + (tok0 - 2) * SSD_CONVCH + ch) : zero8,
               r2 = t0 >= 1 ? *(const bf16x8*)(xp + (tok0 - 1) * SSD_CONVCH + ch) : zero8;
#pragma unroll 8
        for (int i = 0; i < 16; ++i) { const bf16x8 r3 = *(const bf16x8*)(xp + (tok0 + i) * SSD_CONVCH + ch); float o[8];
#pragma unroll
            for (int j = 0; j < 8; ++j) o[j] = conv8(r0, r1, r2, r3, w, bias, j);
            u32x4 pk; pk.x = cvtpk(o[0], o[1]); pk.y = cvtpk(o[2], o[3]); pk.z = cvtpk(o[4], o[5]); pk.w = cvtpk(o[6], o[7]);
            *(u32x4*)(bc + (tok0 + i) * 2048 + cg * 8) = pk; r0 = r1; r1 = r2; r2 = r3; }
    }
}

DEV void ph_ssd_mfma(const P& p, char* L, int bid, int nb) {
    using namespace ssd;
    const int tid = tidx(), wid = __builtin_amdgcn_readfirstlane(tid >> 6), lane = tid & 63;
    const int lb = wid & 3, pb = wid >> 2, nbk = wid & 3;
    const bf16_t* xp = (const bf16_t*)(p.big + BIG_SSD_XBCP); const bf16_t* bc = (const bf16_t*)(p.big + BIG_SSD_BC);
    bf16_t* yb = (bf16_t*)(p.big + BIG_SSD_YN);
    float* tabs = (float*)(L + OFF_TB);
    const bf16x8 zero8 = {0, 0, 0, 0, 0, 0, 0, 0};
    unsigned ksrc[2], vsrc[2];
#pragma unroll
    for (int i = 0; i < 2; ++i) { const int pos = tid * 16 + i * 8192;
        { const int row = pos >> 8, ch = ((pos >> 4) & 15) ^ (row & 7); ksrc[i] = (unsigned)(row * 2048 + ch * 8); }
        { const int sub = pos >> 9, w = (pos & 511) >> 1, kk = (sub >> 2) * 8 + (w >> 5), k = (kk & ~0xC) | ((kk & 4) << 1) | ((kk & 8) >> 1), col = (sub & 3) * 32 + (w & 31); vsrc[i] = (unsigned)(k * 2048 + col); } }
    for (int u0 = bid; u0 < BATCH * SSD_H; u0 += nb) {
        const int u = (nb == 256) ? ((u0 & 7) * 32 + (u0 >> 3)) : u0;
        const int b = u >> 6, h = u & 63, g = h >> 3;
        const float Ah = -expf(p.ssd_a_log[h]), Dh = p.ssd_d[h];
        f32x16 st = f32x16{};
        for (int i = tid; i < 16384 / 16; i += NTHREADS) *(bf16x8*)(L + OFF_PV + i * 16) = zero8;
        float* tabg = (float*)(p.big + BIG_SSD_TABG) + (size_t)u * 16 * 640;
#pragma unroll 1
        for (int cc = 0; cc < 2; ++cc) { const int chunk = 2 * wid + cc; float* tb_ = tabg + chunk * 640; const size_t t0_ = (size_t)b * SEQ + chunk * 128 + 2 * lane;
            const float d0 = p.dtb[t0_ * 64 + h], d1 = p.dtb[(t0_ + 1) * 64 + h]; const float a0 = d0 * Ah, a1 = d1 * Ah; float c = a0 + a1;
#pragma unroll
            for (int o_ = 1; o_ < 64; o_ <<= 1) { const float v = __shfl_up(c, o_); if (lane >= o_) c += v; }
            const float e1 = c, e0 = c - a1, tot = __shfl(c, 63);
            tb_[2 * lane] = e0 * 1.4426950408889634f; tb_[2 * lane + 1] = e1 * 1.4426950408889634f; tb_[128 + 2 * lane] = __expf(e0); tb_[128 + 2 * lane + 1] = __expf(e1);
            tb_[256 + 2 * lane] = __expf(tot - e0); tb_[256 + 2 * lane + 1] = __expf(tot - e1); tb_[384 + 2 * lane] = Dh / fmaxf(d0, 1e-30f); tb_[384 + 2 * lane + 1] = Dh / fmaxf(d1, 1e-30f); tb_[512 + 2 * lane] = d0; tb_[512 + 2 * lane + 1] = d1; }
        __syncthreads();
#pragma unroll 1
        for (int ck = 0; ck < SEQ / 128; ++ck) {
            const float* tb = tabs;
            const float* tg = tabg + ck * 640;
            const size_t tok0 = (size_t)b * SEQ + ck * 128;
            { const float v0 = tg[tid]; tabs[tid] = v0; if (tid < 128) tabs[512 + tid] = tg[512 + tid]; }
            { const bf16_t* bsrc = bc + tok0 * 2048 + g * 128; const bf16_t* csrc = bsrc + 1024;
#pragma unroll
              for (int tile = 0; tile < 2; ++tile)
#pragma unroll
                  for (int i = 0; i < 2; ++i) {
                      __builtin_amdgcn_global_load_lds((const unsigned*)(csrc + (size_t)tile * 64 * 2048 + ksrc[i]), (MG_LAS unsigned*)((MG_LAS char*)L + OFF_CK + tile * 16384 + wid * 1024 + i * 8192), 16, 0, 0);
                      __builtin_amdgcn_global_load_lds((const unsigned*)(bsrc + (size_t)tile * 64 * 2048 + ksrc[i]), (MG_LAS unsigned*)((MG_LAS char*)L + OFF_BK + tile * 16384 + wid * 1024 + i * 8192), 16, 0, 0);
                      __builtin_amdgcn_global_load_lds((const unsigned*)(bsrc + (size_t)tile * 64 * 2048 + vsrc[i]), (MG_LAS unsigned*)((MG_LAS char*)L + OFF_BV + tile * 16384 + wid * 1024 + i * 8192), 16, 0, 0); } }
            { int tl_ = tid; asm volatile("" : "+v"(tl_));
              const int cgx = tl_ & 7, rsx = tl_ >> 3, chx = h * 64 + cgx * 8;
              float w[4][8], bias[8];
#pragma unroll
              for (int k = 0; k < 4; ++k) { const f32x4 w0 = *(const f32x4*)(p.ssd_conv_w + k * SSD_CONVCH + chx), w1 = *(const f32x4*)(p.ssd_conv_w + k * SSD_CONVCH + chx + 4);
#pragma unroll
                  for (int j = 0; j < 4; ++j) { w[k][j] = w0[j]; w[k][4 + j] = w1[j]; } }
              { const f32x4 b0 = *(const f32x4*)(p.ssd_conv_b + chx), b1 = *(const f32x4*)(p.ssd_conv_b + chx + 4);
#pragma unroll
                for (int j = 0; j < 4; ++j) { bias[j] = b0[j]; bias[4 + j] = b1[j]; } }
              bf16x8 rw[5];
#pragma unroll
              for (int i = 0; i < 5; ++i) { const int l = 2 * rsx - 3 + i; rw[i] = (ck * 128 + l >= 0) ? *(const bf16x8*)(xp + (tok0 + l) * SSD_CONVCH + chx) : zero8; }
#pragma unroll
              for (int i = 0; i < 2; ++i) { const int l = 2 * rsx + i; const float dtl = tg[512 + l], sdl = tg[256 + l]; float o[8];
#pragma unroll
                  for (int j = 0; j < 8; ++j) o[j] = conv8(rw[i], rw[i + 1], rw[i + 2], rw[i + 3], w, bias, j) * dtl;
                  u32x4 pk; pk.x = cvtpk(o[0], o[1]); pk.y = cvtpk(o[2], o[3]); pk.z = cvtpk(o[4], o[5]); pk.w = cvtpk(o[6], o[7]);
                  *(u32x4*)(L + OFF_XV + v64_st(l, cgx * 8)) = pk;
                  pk.x = cvtpk(o[0] * sdl, o[1] * sdl); pk.y = cvtpk(o[2] * sdl, o[3] * sdl); pk.z = cvtpk(o[4] * sdl, o[5] * sdl); pk.w = cvtpk(o[6] * sdl, o[7] * sdl);
                  *(u32x4*)(L + OFF_XS + v64_st(l, cgx * 8)) = pk; } }
            __syncthreads();
            int ln_ = lane; asm volatile("" : "+v"(ln_)); const int r32 = ln_ & 31, hi = ln_ >> 5, lane2 = ln_;
            bf16x8 qr[8];
            { const char* cb_ = L + OFF_CK + (lb >> 1) * 16384;
#pragma unroll
              for (int d0 = 0; d0 < 8; ++d0) qr[d0] = *(const bf16x8*)(cb_ + AT_KSWZ((lb & 1) * 32 + r32, (d0 * 16 + hi * 8) * 2)); }
            f32x16 o = f32x16{}, oo = f32x16{};
            const int l = 32 * lb + r32; const float al = tb[l], dl = tb[384 + l];
            const int xvb = (int)(uintptr_t)(L + OFF_XV) + v_rd_base(lane2) + pb * 512;
            for (int kt = 0; kt <= (lb >> 1); ++kt) {
                f32x16 p0, p1;
                qkt(p0, p1, L + OFF_BK + kt * 16384, r32, hi, qr);
                if (kt < (lb >> 1)) {
#pragma unroll
                    for (int r = 0; r < 16; ++r) { const int s0 = 64 * kt + crow(r, hi), s1 = s0 + 32; p0[r] *= __builtin_amdgcn_exp2f(al - tb[s0]); p1[r] *= __builtin_amdgcn_exp2f(al - tb[s1]); }
                } else {
#pragma unroll
                for (int r = 0; r < 16; ++r) { const int s0 = 64 * kt + crow(r, hi), s1 = s0 + 32;
                    float v0 = p0[r] * __builtin_amdgcn_exp2f(al - tb[s0]), v1 = p1[r] * __builtin_amdgcn_exp2f(al - tb[s1]);
                    v0 = s0 <= l ? v0 : 0.f; v1 = s1 <= l ? v1 : 0.f; v0 += s0 == l ? dl : 0.f; v1 += s1 == l ? dl : 0.f; p0[r] = v0; p1[r] = v1; }
                }
                bf16x8 pa0, pa1, pa2, pa3;
                AT_PK4(p0, 0, pa0); AT_PK4(p0, 8, pa1); AT_PK4(p1, 0, pa2); AT_PK4(p1, 8, pa3);
                { const int vb = xvb + kt * 8192; s16x4 l0, l1, l2, l3, h0, h1, h2, h3;
                  SD_TRRD(l0, vb, 0); SD_TRRD(h0, vb, 1024); SD_TRRD(l1, vb, 2048); SD_TRRD(h1, vb, 3072); SD_TRRD(l2, vb, 4096); SD_TRRD(h2, vb, 5120); SD_TRRD(l3, vb, 6144); SD_TRRD(h3, vb, 7168);
                  asm volatile("s_waitcnt lgkmcnt(0)" ::: "memory"); __builtin_amdgcn_sched_barrier(0);
                  o = __builtin_amdgcn_mfma_f32_32x32x16_bf16(pa0, SD_MK(l0, h0), o, 0, 0, 0); o = __builtin_amdgcn_mfma_f32_32x32x16_bf16(pa1, SD_MK(l1, h1), o, 0, 0, 0);
                  o = __builtin_amdgcn_mfma_f32_32x32x16_bf16(pa2, SD_MK(l2, h2), o, 0, 0, 0); o = __builtin_amdgcn_mfma_f32_32x32x16_bf16(pa3, SD_MK(l3, h3), o, 0, 0, 0); }
            }
            { const int vb = (int)(uintptr_t)(L + OFF_PV) + v_rd_base(lane2) + pb * 512;
#define SD_YOFF(K0) do { s16x4 l0, l1, l2, l3, h0, h1, h2, h3; \
                  SD_TRRD(l0, vb, (K0) * 2048); SD_TRRD(h0, vb, (K0) * 2048 + 1024); SD_TRRD(l1, vb, (K0) * 2048 + 2048); SD_TRRD(h1, vb, (K0) * 2048 + 3072); \
                  SD_TRRD(l2, vb, (K0) * 2048 + 4096); SD_TRRD(h2, vb, (K0) * 2048 + 5120); SD_TRRD(l3, vb, (K0) * 2048 + 6144); SD_TRRD(h3, vb, (K0) * 2048 + 7168); \
                  asm volatile("s_waitcnt lgkmcnt(0)" ::: "memory"); __builtin_amdgcn_sched_barrier(0); \
                  oo = __builtin_amdgcn_mfma_f32_32x32x16_bf16(qr[(K0)], SD_MK(l0, h0), oo, 0, 0, 0); oo = __builtin_amdgcn_mfma_f32_32x32x16_bf16(qr[(K0) + 1], SD_MK(l1, h1), oo, 0, 0, 0); \
                  oo = __builtin_amdgcn_mfma_f32_32x32x16_bf16(qr[(K0) + 2], SD_MK(l2, h2), oo, 0, 0, 0); oo = __builtin_amdgcn_mfma_f32_32x32x16_bf16(qr[(K0) + 3], SD_MK(l3, h3), oo, 0, 0, 0); } while (0)
              SD_YOFF(0); SD_YOFF(4);
#undef SD_YOFF
            }
            { const float dec = tb[128 + 127];
#pragma unroll
              for (int r = 0; r < 16; ++r) st[r] *= dec;
              const int xsb = (int)(uintptr_t)(L + OFF_XS) + v_rd_base(lane2) + pb * 512;
              const int bvb = (int)(uintptr_t)(L + OFF_BV) + v_rd_base(lane2) + nbk * 512;
#define SD_STATE(K0, BOFF) do { s16x4 a0, a1, a2, a3, a4, a5, a6, a7, b0, b1, b2, b3, b4, b5, b6, b7; \
                  SD_TRRD(a0, xsb, (K0) * 2048); SD_TRRD(a1, xsb, (K0) * 2048 + 1024); SD_TRRD(a2, xsb, (K0) * 2048 + 2048); SD_TRRD(a3, xsb, (K0) * 2048 + 3072); \
                  SD_TRRD(a4, xsb, (K0) * 2048 + 4096); SD_TRRD(a5, xsb, (K0) * 2048 + 5120); SD_TRRD(a6, xsb, (K0) * 2048 + 6144); SD_TRRD(a7, xsb, (K0) * 2048 + 7168); \
                  SD_TRRD(b0, bvb, (BOFF)); SD_TRRD(b1, bvb, (BOFF) + 2048); SD_TRRD(b2, bvb, (BOFF) + 4096); SD_TRRD(b3, bvb, (BOFF) + 6144); \
                  SD_TRRD(b4, bvb, (BOFF) + 8192); SD_TRRD(b5, bvb, (BOFF) + 10240); SD_TRRD(b6, bvb, (BOFF) + 12288); SD_TRRD(b7, bvb, (BOFF) + 14336); \
                  asm volatile("s_waitcnt lgkmcnt(0)" ::: "memory"); __builtin_amdgcn_sched_barrier(0); \
                  st = __builtin_amdgcn_mfma_f32_32x32x16_bf16(SD_MK(a0, a1), SD_MK(b0, b1), st, 0, 0, 0); st = __builtin_amdgcn_mfma_f32_32x32x16_bf16(SD_MK(a2, a3), SD_MK(b2, b3), st, 0, 0, 0); \
                  st = __builtin_amdgcn_mfma_f32_32x32x16_bf16(SD_MK(a4, a5), SD_MK(b4, b5), st, 0, 0, 0); st = __builtin_amdgcn_mfma_f32_32x32x16_bf16(SD_MK(a6, a7), SD_MK(b6, b7), st, 0, 0, 0); } while (0)
              SD_STATE(0, 0); SD_STATE(4, 16384);
              asm volatile("s_nop 15\n\ts_nop 15" : "+v"(st));
#undef SD_STATE
            }
            { const int colg = h * 64 + 32 * pb + r32;
#pragma unroll
              for (int r = 0; r < 16; ++r) { const int lr = 32 * lb + crow(r, hi); const size_t tok = tok0 + lr;
                  const float y = o[r] + tb[128 + lr] * oo[r]; const float yn = swap_pair(y); if ((r32 & 1) == 0) *(unsigned*)(yb + tok * SSD_DI + colg) = cvtpk(y, yn); } }
            __syncthreads();
#pragma unroll
            for (int rg = 0; rg < 4; ++rg) { u32x2 w2; w2.x = cvtpk(st[4 * rg], st[4 * rg + 1]); w2.y = cvtpk(st[4 * rg + 2], st[4 * rg + 3]);
                *(u32x2*)(L + OFF_PV + v64_st(32 * nbk + r32, 32 * pb + 8 * rg + 4 * hi)) = w2; }
        }
        __syncthreads();
    }
}

DEV void ph_ssd_norm(const P& p, int bid, int nb) {
    const int lane = tidx() & 63, wid = tidx() >> 6;
    bf16_t* yb = (bf16_t*)(p.big + BIG_SSD_YN); const bf16_t* zb = (const bf16_t*)(p.big + BIG_SSD_Z);
    for (int tok = bid * 8 + wid; tok < T; tok += nb * 8) {
        const int lo = (lane >> 3) * 512 + (lane & 7) * 8;
        bf16_t* yr = yb + (size_t)tok * SSD_DI + lo; const bf16_t* zr = zb + (size_t)tok * SSD_DI + lo; const float* ng = p.ssd_norm + lo;
        float v[64]; float ss = 0.f;
#pragma unroll
        for (int i = 0; i < 8; ++i) { const bf16x8 yv = *(const bf16x8*)(yr + i * 64), zv = *(const bf16x8*)(zr + i * 64);
#pragma unroll
            for (int j = 0; j < 8; ++j) { const float z = bf2f((bf16_t)zv[j]); const float t = bf2f((bf16_t)yv[j]) * (z / (1.f + __expf(-z))); v[i * 8 + j] = t; ss += t * t; } }
        ss += __shfl_xor(ss, 1); ss += __shfl_xor(ss, 2); ss += __shfl_xor(ss, 4);
        const float rinv = rsqrtf(ss * (1.f / 512.f) + NORM_EPS);
#pragma unroll
        for (int i = 0; i < 8; ++i) { float o[8];
#pragma unroll
            for (int j = 0; j < 8; ++j) o[j] = v[i * 8 + j] * rinv * ng[i * 64 + j];
            u32x4 w; w.x = at::cvtpk(o[0], o[1]); w.y = at::cvtpk(o[2], o[3]); w.z = at::cvtpk(o[4], o[5]); w.w = at::cvtpk(o[6], o[7]); *(u32x4*)(yr + i * 64) = w; }
    }
}

#define XB_TMO      128
#define XB_XCNT(j)  (256  + 64 * (j))
#define XB_XSUB(j)  (1280 + 64 * (j))
#define XB_XGEN(j)  (2304 + 64 * (j))
#define XB_TOP      3328
#define XB_TOPGEN   3392
#define XCD_BAR_WORDS 3456
#define XB_SPIN_CAP (1u << 22)
#define LAS __attribute__((address_space(3)))

__device__ __forceinline__ unsigned xb_ld(unsigned* p)              { return __hip_atomic_load(p, __ATOMIC_RELAXED, __HIP_MEMORY_SCOPE_AGENT); }
__device__ __forceinline__ unsigned xb_add(unsigned* p, unsigned v) { return __hip_atomic_fetch_add(p, v, __ATOMIC_RELAXED, __HIP_MEMORY_SCOPE_AGENT); }
__device__ __forceinline__ unsigned xb_xcc_id() { return (unsigned)__builtin_amdgcn_s_getreg((3 << 11) | 20) & 0xFu; }
#define XB_SPIN(cond, bar) do { unsigned _sp = 0; while (cond) { __builtin_amdgcn_s_sleep(1); \
    if ((++_sp & 255u) == 0u) { if (xb_ld(&(bar)[XB_TMO])) break; if (_sp > XB_SPIN_CAP) { atomicAdd(&(bar)[XB_TMO], 1u); break; } } } } while (0)

struct XcdBarrier {
    unsigned* bar; unsigned x;
    volatile LAS unsigned* st;
};

__device__ __forceinline__ XcdBarrier xcd_barrier_post(unsigned* bar, volatile LAS unsigned* st) {
    XcdBarrier b; b.bar = bar; b.x = xb_xcc_id(); b.st = st;
    if (threadIdx.x == 0) (void)xb_add(&bar[XB_XCNT(b.x)], 1u);
    return b;
}
__device__ __forceinline__ void xcd_barrier_complete(unsigned* bar, unsigned x, unsigned& nloc, unsigned& nx) {
    const unsigned G = gridDim.x * gridDim.y * gridDim.z;
    unsigned sum, cnt, mine, sp = 0u;
    for (;;) {
        sum = 0u; cnt = 0u; mine = 0u;
#pragma unroll
        for (unsigned j = 0; j < 16; ++j) { const unsigned c = xb_ld(&bar[XB_XCNT(j)]); sum += c; cnt += (c > 0u) ? 1u : 0u; mine = (j == x) ? c : mine; }
        if (sum == G) break;
        __builtin_amdgcn_s_sleep(1);
        if ((++sp & 255u) == 0u) { if (xb_ld(&bar[XB_TMO])) break; if (sp > XB_SPIN_CAP) { atomicAdd(&bar[XB_TMO], 1u); break; } }
    }
    nloc = mine > 0u ? mine : 1u; nx = cnt > 0u ? cnt : 1u;
}

__device__ __forceinline__ void xcd_barrier(const XcdBarrier& b) {
    asm volatile("s_waitcnt vmcnt(0)" ::: "memory");
    __syncthreads();
    if (threadIdx.x == 0) {
        unsigned* bar = b.bar;
        __builtin_amdgcn_s_waitcnt(0);
        unsigned nloc = b.st[0], nx = b.st[1];
        if (nloc == 0u) { xcd_barrier_complete(bar, b.x, nloc, nx); b.st[0] = nloc; b.st[1] = nx; }
        const unsigned old = xb_add(&bar[XB_XSUB(b.x)], 1u);
        const unsigned gen = old / nloc;
        if (old + 1u == (gen + 1u) * nloc) {
            __builtin_amdgcn_fence(__ATOMIC_RELEASE, "agent");
            asm volatile("s_waitcnt vmcnt(0)" ::: "memory");
            const unsigned og = xb_add(&bar[XB_TOP], 1u);
            const unsigned tg = og / nx;
            if (og + 1u == (tg + 1u) * nx) xb_add(&bar[XB_TOPGEN], 1u);
            else XB_SPIN(xb_ld(&bar[XB_TOPGEN]) == tg, bar);
            __builtin_amdgcn_fence(__ATOMIC_ACQUIRE, "agent");
            xb_add(&bar[XB_XGEN(b.x)], 1u);
            asm volatile("s_waitcnt vmcnt(0)" ::: "memory");
        } else {
            XB_SPIN(xb_ld(&bar[XB_XGEN(b.x)]) == gen, bar);
            __builtin_amdgcn_fence(__ATOMIC_ACQUIRE, "agent");
            asm volatile("s_waitcnt vmcnt(0)" ::: "memory");
        }
    }
    __syncthreads();
}


constexpr int LDS_STAGE_OFF = 16, LDS_TAB_OFF = 16 + mg::STAGE_BYTES, LDS_BYTES = 16 + 147456 + 5120;
constexpr int NPHASE = 21;

DEV void moe_tables(const int* cnt, int* tab) {
    __syncthreads();
    if (tidx() == 0) { int s = 0, r = 0; for (int e = 0; e < MOE_E; ++e) { tab[e] = s; tab[64 + e] = r; const int c = cnt[e]; s += (c + 255) >> 8; r += c; } tab[MOE_E] = s; tab[64 + MOE_E] = r; }
    __syncthreads();
}
constexpr int MOE_CT_GU = 4096, MOE_CT_D = 2048, MOE_CT_L = MOE_CT_GU + MOE_CT_D;
DEV void conv_moe_tiles(const P& p, float* ldsf, int f0, int f1, int w, int nw) {
    if (w < 0 || f0 >= f1) return;
#pragma unroll 1
    for (int L = 0; L < 2; ++L) {
        const float* wg = p.moe_w_gate + (size_t)L * MOE_E * D_MODEL * MOE_FF; const float* wu = p.moe_w_up + (size_t)L * MOE_E * D_MODEL * MOE_FF;
        const float* wd = p.moe_w_down + (size_t)L * MOE_E * MOE_FF * D_MODEL;
        { const int a = f0 - L * MOE_CT_L, b = f1 - L * MOE_CT_L; const int lo = a > 0 ? a : 0, hi = b < MOE_CT_GU ? b : MOE_CT_GU;
          if (lo < hi) conv_wt<true>([=](int g, int k, int q) { const float* sp = (q & 1) ? wu : wg; return sp + ((size_t)g * D_MODEL + k) * MOE_FF + (q >> 1) * 4; }, MOE_E, D_MODEL, 2 * MOE_FF,
                               p.wt_gu + (size_t)L * MOE_E * MOE_FF * D_MODEL, ldsf, w, nw, lo, hi); }
        { const int a = f0 - L * MOE_CT_L - MOE_CT_GU, b = f1 - L * MOE_CT_L - MOE_CT_GU; const int lo = a > 0 ? a : 0, hi = b < MOE_CT_D ? b : MOE_CT_D;
          if (lo < hi) conv_wt<true>([=](int g, int k, int q) { return wd + ((size_t)g * MOE_FF + k) * D_MODEL + q * 4; }, MOE_E, MOE_FF, D_MODEL,
                               p.wt_d + (size_t)L * MOE_E * D_MODEL * MOE_FF / 2, ldsf, w, nw, lo, hi); }
    }
}
constexpr int CT_A = 1536, CT_B = MOE_CT_L, CT_C = MOE_CT_L + 1920, CT_D = MOE_CT_L + MOE_CT_GU, CT_E = 2 * MOE_CT_L;

template <int PH> DEV void run_phase(const P& p, float* ldsraw, int bid, int nb) {
    float* lds = ldsraw + 4;
    MG_LAS unsigned char* stage = (MG_LAS unsigned char*)ldsraw + LDS_STAGE_OFF;
    int* tab = (int*)((char*)ldsraw + LDS_TAB_OFF);
    if constexpr (PH == 0) {
        ph_rope_table(p, bid, nb);
        for (int i = bid * NTHREADS + tidx(); i < 2 * D_MODEL * MOE_E; i += nb * NTHREADS) p.wr[i] = p.moe_w_expert[i] * p.ln_ffn[i >> 5];
        for (int i = bid * NTHREADS + tidx(); i < 2 * D_MODEL * MOE_G; i += nb * NTHREADS) p.wgq[i] = p.moe_w_group[i] * p.ln_ffn[i >> 2];
        if (bid == 0 && tidx() < 64) p.cnt[tidx()] = 0;
        rows_norm<true>(p.x, nullptr, nullptr, nullptr, p.ln_mix, p.hb16, bid, nb);
        { const float* w = p.nsa_w_in; conv_wt<true>([=](int, int k, int q) { const int c = q * 4, pn = c >> 8; int lg = c;
              if (pn < 10 || pn == 12 || pn == 13 || pn == 16 || pn == 17) { const int c128 = c & 127; lg = (c & ~127) + 16 * (c128 >> 5) + 4 * ((c128 >> 3) & 3) + 64 * ((c128 >> 2) & 1); }
              return lg < NSA_PROJ ? w + (size_t)k * NSA_PROJ + lg : (const float*)nullptr; }, 1, D_MODEL, NSA_PROJ_P, p.wt_nsa_in, lds, bid, nb); }
        { const float* w = p.nsa_cmp_w1; conv_wt([=](int g, int k, int q) { return w + ((size_t)g * 4096 + k) * CMP_HIDDEN + q * 4; }, 2, 4096, CMP_HIDDEN, p.wt_cmp1, lds, bid, nb); }
        { const float* w = p.nsa_cmp_w2; conv_wt([=](int g, int k, int q) { return q < 32 ? w + ((size_t)g * CMP_HIDDEN + k) * 128 + q * 4 : (const float*)nullptr; }, 2, CMP_HIDDEN, 256, p.wt_cmp2, lds, bid, nb); }
    } else if constexpr (PH == 1) {
        mg::StaticOrder S; S.init(T, NSA_PROJ_P, nb, bid);
        mg::gemm_phase<true, 10>(stage, D_MODEL / 2, mg::APlain{p.hb16, D_MODEL / 2}, mg::BPlain{p.wt_nsa_in, D_MODEL / 2, 0}, S,
                       EpiNsaIn{(bf16_t*)(p.big + BIG_NSA_Q), (bf16_t*)(p.big + BIG_NSA_KS), (bf16_t*)(p.big + BIG_NSA_VS), (bf16_t*)(p.big + BIG_NSA_KW), (bf16_t*)(p.big + BIG_NSA_VW),
                                (bf16_t*)(p.big + BIG_NSA_ACMP), (float*)(p.big + BIG_NSA_GATE), p.rope, p.nsa_cmp_pe});
        { const int nu = (T / 256) * (NSA_PROJ_P / 256), rem = nu % nb; __syncthreads();
          if (rem) conv_moe_tiles(p, lds, 0, CT_A, bid - rem, nb - rem); else conv_moe_tiles(p, lds, 0, CT_A, bid, nb); }
    } else if constexpr (PH == 2) {
    } else if constexpr (PH == 3) {
        mg::FixedGroups S{2, 8, 1, nb, bid};
        mg::gemm_phase(stage, 4096, mg::AGrouped{(const bf16_t*)(p.big + BIG_NSA_ACMP), 4096, (size_t)2048 * 4096}, mg::BPlain{p.wt_cmp1, 4096, (size_t)CMP_HIDDEN * 4096}, S, EpiCmp1{(bf16_t*)(p.big + BIG_NSA_H1)});
        __syncthreads();
        for (int L = bid; L < 16; L += nb) { const int g = L >> 3, pm = L & 7;
            cmp_gemm2_rows((const bf16_t*)(p.big + BIG_NSA_H1) + (size_t)g * 2048 * 256, p.wt_cmp2 + (size_t)g * 256 * CMP_HIDDEN, (bf16_t*)(p.big + BIG_NSA_KVC) + (size_t)g * 2048 * 128, pm * 256); }
        if (nb > 16) conv_moe_tiles(p, lds, CT_A, CT_B, bid - 16, nb - 16); else conv_moe_tiles(p, lds, CT_A, CT_B, bid, nb);
        { const float* w = p.ssd_w_out; const int fb = nb > 16 ? bid - 16 : bid, fn = nb > 16 ? nb - 16 : nb;
          if (fb >= 0) conv_wt([=](int, int k, int q) { return w + (size_t)k * D_MODEL + q * 4; }, 1, SSD_DI, D_MODEL, p.wt_ssd_out, lds, fb, fn);
          if (fb >= 0) { const float* w1 = p.nsa_w_out; conv_wt<true>([=](int, int k, int q) { return w1 + (size_t)k * D_MODEL + q * 4; }, 1, 2048, D_MODEL, p.wt_nsa_out, lds, fb, fn); }
          if (fb >= 0) { const float* w2 = p.ssd_w_in; conv_wt([=](int, int k, int q) { const int c = q * 4; return c < SSD_PROJ ? w2 + (size_t)k * SSD_PROJ + c : (const float*)nullptr; }, 1, D_MODEL, SSD_PROJ_P, p.wt_ssd_in, lds, fb, fn); } }
    } else if constexpr (PH == 4) {
    } else if constexpr (PH == 5) {
        ph_attn_mfma(p, (char*)ldsraw + LDS_STAGE_OFF, bid, nb);
    } else if constexpr (PH == 6) {
    } else if constexpr (PH == 7) {
        mg::StaticOrder S; S.init(T, D_MODEL, nb, bid);
        mg::gemm_phase<true, 12>(stage, 2048 / 2, mg::APlain{(const bf16_t*)(p.big + BIG_NSA_OBUF), 2048 / 2}, mg::BPlain{p.wt_nsa_out, 2048 / 2, 0}, S, EpiResid<false, 12>{p.x, (bf16_t*)p.xB});
    } else if constexpr (PH == 8 || PH == 17) {
        ph_moe_route(p, PH == 8 ? 0 : 1, (const bf16_t*)p.xB, lds, bid, nb);
    } else if constexpr (PH == 9 || PH == 18) {
        constexpr int L = PH == 9 ? 0 : 1; const int* cnt = p.cnt + L * MOE_E;
        moe_tables(cnt, tab);
        mg::GroupedOrder S{tab, MOE_E, 4, nb, bid};
        mg::gemm_phase<true>(stage, D_MODEL / 2, AMoeGather{p.hb16, p.list, cnt}, mg::BPlain{p.wt_gu + (size_t)L * MOE_E * MOE_FF * D_MODEL, D_MODEL / 2, (size_t)MOE_FF * D_MODEL}, S, EpiMoeGU{(bf16_t*)(p.big + BIG_MOE_ACT), cnt, tab});
        { const int rem = (tab[MOE_E] * 4) % nb; __syncthreads(); constexpr int f0 = L == 0 ? CT_B : CT_D + 384, f1 = L == 0 ? CT_C : CT_E;
            if (rem) conv_moe_tiles(p, lds, f0, f1, bid - rem, nb - rem); else conv_moe_tiles(p, lds, f0, f1, bid, nb); }
    } else if constexpr (PH == 10 || PH == 19) {
        constexpr int L = PH == 10 ? 0 : 1; const int* cnt = p.cnt + L * MOE_E;
        moe_tables(cnt, tab);
        mg::GroupedOrder S{tab, MOE_E, 8, nb, bid};
        mg::gemm_phase<true>(stage, MOE_FF / 2, AMoeAct{(const bf16_t*)(p.big + BIG_MOE_ACT), tab}, mg::BPlain{p.wt_d + (size_t)L * MOE_E * D_MODEL * MOE_FF / 2, MOE_FF / 2, (size_t)D_MODEL * MOE_FF / 2}, S, EpiMoeDown{(bf16_t*)(p.big + BIG_MOE_YS), p.list, cnt, p.ew});
        if constexpr (L == 0) { const int rem = (tab[MOE_E] * 8) % nb; __syncthreads();
            if (rem) conv_moe_tiles(p, lds, CT_D, CT_D + 384, bid - rem, nb - rem); else conv_moe_tiles(p, lds, CT_D, CT_D + 384, bid, nb); }
    } else if constexpr (PH == 11) {
        const bf16_t* ys = (const bf16_t*)(p.big + BIG_MOE_YS);
        rows_norm<false, true>(p.xB, ys, ys + D_MODEL, p.xA, p.ln_mix + D_MODEL, p.hb16, bid, nb);
    } else if constexpr (PH == 12) {
        mg::StaticOrder S; S.init(T, SSD_PROJ_P, nb, bid);
        mg::gemm_phase(stage, D_MODEL, mg::APlain{p.hb16, D_MODEL}, mg::BPlain{p.wt_ssd_in, D_MODEL, 0}, S,
                       EpiSsdIn{(bf16_t*)(p.big + BIG_SSD_Z), (bf16_t*)(p.big + BIG_SSD_XBCP), p.dtb, p.ssd_dt_bias});
        { const int nu = (T / 256) * (SSD_PROJ_P / 256), rem = nu % nb; __syncthreads();
          if (rem) conv_moe_tiles(p, lds, CT_C, CT_D, bid - rem, nb - rem); else conv_moe_tiles(p, lds, CT_C, CT_D, bid, nb); }
    } else if constexpr (PH == 13) {
        ph_ssd_conv_bc(p, bid, nb);
    } else if constexpr (PH == 14) {
        ph_ssd_mfma(p, (char*)ldsraw + LDS_STAGE_OFF, bid, nb);
    } else if constexpr (PH == 15) {
        ph_ssd_norm(p, bid, nb);
    } else if constexpr (PH == 16) {
        mg::StaticOrder S; S.init(T, D_MODEL, nb, bid);
        mg::gemm_phase(stage, SSD_DI, mg::APlain{(const bf16_t*)(p.big + BIG_SSD_YN), SSD_DI}, mg::BPlain{p.wt_ssd_out, SSD_DI, 0}, S, EpiResid<true>{p.xA, (bf16_t*)p.xB});
    } else if constexpr (PH == 20) {
        const bf16_t* ys = (const bf16_t*)(p.big + BIG_MOE_YS);
        const int lane = tidx() & 63, wid = tidx() >> 6;
        for (int row = bid * 8 + wid; row < T; row += nb * 8) {
            float4 v[8]; float ss = 0.f;
#pragma unroll
            for (int i = 0; i < 8; ++i) { const int c = i * 256 + lane * 4; const ushort4 s4 = *(const ushort4*)((const bf16_t*)p.xB + (size_t)row * D_MODEL + c); float4 a = make_float4(bf2f(s4.x), bf2f(s4.y), bf2f(s4.z), bf2f(s4.w));
                const ushort4 y0 = *(const ushort4*)(ys + (size_t)(2 * row) * D_MODEL + c), y1 = *(const ushort4*)(ys + (size_t)(2 * row + 1) * D_MODEL + c);
                a.x += bf2f(y0.x) + bf2f(y1.x); a.y += bf2f(y0.y) + bf2f(y1.y); a.z += bf2f(y0.z) + bf2f(y1.z); a.w += bf2f(y0.w) + bf2f(y1.w);
                v[i] = a; ss += a.x * a.x + a.y * a.y + a.z * a.z + a.w * a.w; }
            ss = wave_sum(ss); const float rinv = rsqrtf(ss * (1.f / D_MODEL) + NORM_EPS);
#pragma unroll
            for (int i = 0; i < 8; ++i) { const int c = i * 256 + lane * 4; const float4 gg = *(const float4*)(p.ln_final + c);
                float4 o; o.x = v[i].x * rinv * gg.x; o.y = v[i].y * rinv * gg.y; o.z = v[i].z * rinv * gg.z; o.w = v[i].w * rinv * gg.w;
                __builtin_nontemporal_store((f32x4){o.x, o.y, o.z, o.w}, (f32x4*)(p.out + (size_t)row * D_MODEL + c)); }
        }
    }
}

template <int PH> __global__ __launch_bounds__(NTHREADS, 2) void k_phase(P p) {
    extern __shared__ __attribute__((aligned(16))) float lds[];
    run_phase<PH>(p, lds, blockIdx.x, gridDim.x);
}
template <int PH> static void launch_all(const P& p, hipStream_t stream) {
    if constexpr (PH < NPHASE) {
        static bool attr = false; if (!attr) { attr = true; (void)hipFuncSetAttribute((const void*)k_phase<PH>, hipFuncAttributeMaxDynamicSharedMemorySize, LDS_BYTES); }
        hipLaunchKernelGGL(k_phase<PH>, dim3(256), dim3(NTHREADS), LDS_BYTES, stream, p);
        launch_all<PH + 1>(p, stream);
    }
}
constexpr bool phase_empty(int ph) { return ph == 2 || ph == 4 || ph == 6; }
#ifndef PROBE_DUP_MASK
#define PROBE_DUP_MASK 0u
#endif
constexpr bool phase_dup(int ph) { return (PROBE_DUP_MASK >> ph) & 1u; }
template <int PH> DEV void mega_phases(const P& p, float* lds, const XcdBarrier& bar) {
    if constexpr (PH < NPHASE) {
        if constexpr (!phase_empty(PH)) {
            run_phase<PH>(p, lds, blockIdx.x, gridDim.x);
            if constexpr (phase_dup(PH)) { xcd_barrier(bar); run_phase<PH>(p, lds, blockIdx.x, gridDim.x); }
            if constexpr (PH + 1 < NPHASE) xcd_barrier(bar);
        }
        mega_phases<PH + 1>(p, lds, bar);
    }
}
__global__ __launch_bounds__(NTHREADS, 2) void k_mega(P p) {
    extern __shared__ __attribute__((aligned(16))) float lds[];
    if (threadIdx.x < 4) ((unsigned*)lds)[threadIdx.x] = 0u;
    __syncthreads();
    XcdBarrier bar = xcd_barrier_post(p.bar, (volatile LAS unsigned*)lds);
    mega_phases<0>(p, lds, bar);
}

extern "C" void kernel_launch(void* const* d_in, const int* in_sizes, int n_in, void* d_out, int out_size, void* d_ws, size_t ws_size, hipStream_t stream) {
    P p{};
    const float* const* in = (const float* const*)d_in;
    p.x = in[0]; p.ln_mix = in[1]; p.ln_ffn = in[2]; p.ln_final = in[3]; p.nsa_w_in = in[4]; p.nsa_cmp_pe = in[5]; p.nsa_cmp_w1 = in[6]; p.nsa_cmp_w2 = in[7]; p.nsa_w_out = in[8];
    p.ssd_w_in = in[9]; p.ssd_conv_w = in[10]; p.ssd_conv_b = in[11]; p.ssd_dt_bias = in[12]; p.ssd_a_log = in[13]; p.ssd_d = in[14]; p.ssd_norm = in[15]; p.ssd_w_out = in[16];
    p.moe_w_group = in[17]; p.moe_b_group = in[18]; p.moe_w_expert = in[19]; p.moe_b_expert = in[20]; p.moe_w_gate = in[21]; p.moe_w_up = in[22]; p.moe_w_down = in[23];
    p.out = (float*)d_out;
    char* w = (char*)d_ws; size_t off = 0;
    auto take = [&](size_t bytes) { char* r = w + off; off += (bytes + 255) & ~(size_t)255; return r; };
    p.bar = (unsigned*)take(XCD_BAR_WORDS * 4);
    p.wt_nsa_in = (bf16_t*)take((size_t)NSA_PROJ_P * D_MODEL * 2);
    p.wt_nsa_out = (bf16_t*)take((size_t)D_MODEL * 2048 * 2);
    p.wt_ssd_in = (bf16_t*)take((size_t)SSD_PROJ_P * D_MODEL * 2);
    p.wt_ssd_out = (bf16_t*)take((size_t)D_MODEL * SSD_DI * 2);
    p.wt_gu = (bf16_t*)take((size_t)2 * MOE_E * 2 * MOE_FF * D_MODEL * 2);
    p.wt_d = (bf16_t*)take((size_t)2 * MOE_E * D_MODEL * MOE_FF * 2);
    p.wt_cmp1 = (bf16_t*)take((size_t)2 * CMP_HIDDEN * 4096 * 2);
    p.wt_cmp2 = (bf16_t*)take((size_t)2 * 256 * CMP_HIDDEN * 2);
    p.xA = (float*)take((size_t)T * D_MODEL * 4);
    p.xB = (float*)take((size_t)T * D_MODEL * 4);
    p.hb16 = (bf16_t*)take((size_t)T * D_MODEL * 2);
    p.big = take(BIG_BYTES);
    p.rope = (float*)take((size_t)SEQ * 64 * 2 * 4);
    p.h1 = (float*)take((size_t)2 * 2032 * CMP_HIDDEN * 4);
    p.kvc = (float*)take((size_t)2 * 2032 * 128 * 4);
    p.selmask = (unsigned*)take((size_t)BATCH * NKV * SEQ * 4);
    p.cnt = (int*)take(64 * 4);
    p.list = (int*)take((size_t)MOE_E * T * 4);
    p.ew = (float*)take((size_t)T * 2 * 4);
    p.dtb = (float*)take((size_t)T * 64 * 4);
    p.wr = (float*)take((size_t)2 * D_MODEL * MOE_E * 4);
    p.wgq = (float*)take((size_t)2 * D_MODEL * MOE_G * 4);
    if (off > ws_size) { fprintf(stderr, "workspace too small: need %zu have %zu\n", off, ws_size); return; }
#if defined(MK_MULTI)
    launch_all<0>(p, stream);
#else
    static int grid = 0;
    if (!grid) {
        int dev = 0, cus = 0, per_cu = 0;
        (void)hipGetDevice(&dev);
        (void)hipDeviceGetAttribute(&cus, hipDeviceAttributeMultiprocessorCount, dev);
        (void)hipFuncSetAttribute((const void*)k_mega, hipFuncAttributeMaxDynamicSharedMemorySize, LDS_BYTES);
        (void)hipOccupancyMaxActiveBlocksPerMultiprocessor(&per_cu, k_mega, NTHREADS, LDS_BYTES);
        if (per_cu < 1) per_cu = 1;
        grid = cus * (per_cu < 1 ? per_cu : 1);
    }
    (void)hipMemsetAsync(p.bar, 0, XCD_BAR_WORDS * sizeof(unsigned), stream);
    hipLaunchKernelGGL(k_mega, dim3(grid), dim3(NTHREADS), LDS_BYTES, stream, p);
#endif
}
```

```cpp
#include <hip/hip_runtime.h>
#include <stdint.h>
#include <math.h>
#include <cstdio>

#define DEV __device__ __forceinline__

constexpr int D_MODEL = 2048, BATCH = 4, SEQ = 2048, T = BATCH * SEQ;
constexpr int NH = 16, NKV = 4, DH = 128;
constexpr int NCMP = 127, CMP_HIDDEN = 256;
constexpr int NSLC = 32;
constexpr int WINDOW = 512;
constexpr int NSA_PROJ = 5168, NSA_PROJ_P = 5376;
constexpr int OFF_Q = 0, OFF_KC = 2048, OFF_VC = 2560, OFF_KS = 3072, OFF_VS = 3584, OFF_KW = 4096, OFF_VW = 4608, OFF_G = 5120;
constexpr int SSD_DI = 4096, SSD_P = 64, SSD_H = 64, SSD_G = 8, SSD_N = 128, SSD_CONVCH = 6144, SSD_PROJ = 10304, SSD_PROJ_P = 10496;
constexpr int OFF_Z = 0, OFF_XBC = 4096, OFF_DT = 10240;
constexpr int MOE_G = 4, MOE_EPG = 8, MOE_E = 32, MOE_FF = 512;
constexpr float NORM_EPS = 1e-6f;
constexpr int NTHREADS = 512;
typedef unsigned short bf16_t;


struct P {
    const float *x, *ln_mix, *ln_ffn, *ln_final, *nsa_w_in, *nsa_cmp_pe, *nsa_cmp_w1, *nsa_cmp_w2, *nsa_w_out;
    const float *ssd_w_in, *ssd_conv_w, *ssd_conv_b, *ssd_dt_bias, *ssd_a_log, *ssd_d, *ssd_norm, *ssd_w_out;
    const float *moe_w_group, *moe_b_group, *moe_w_expert, *moe_b_expert, *moe_w_gate, *moe_w_up, *moe_w_down;
    float* out;
    bf16_t *wt_nsa_in, *wt_nsa_out, *wt_ssd_in, *wt_ssd_out, *wt_gu, *wt_d, *wt_cmp1, *wt_cmp2;
    float *xA, *xB; bf16_t* hb16;
    char* big;
    float* rope;
    float* h1;
    float* kvc;
    unsigned* selmask;
    int* cnt;
    int* list;
    float* ew;
    float* lw;
    float* dtb;
    float *wr, *wgq;
    unsigned* bar;
};
constexpr size_t BIG_NSA_Q = 0, BIG_NSA_KS = (size_t)T * 2048 * 2, BIG_NSA_VS = BIG_NSA_KS + (size_t)T * 512 * 2, BIG_NSA_KW = BIG_NSA_VS + (size_t)T * 512 * 2, BIG_NSA_VW = BIG_NSA_KW + (size_t)T * 512 * 2,
    BIG_NSA_ACMP = BIG_NSA_VW + (size_t)T * 512 * 2, BIG_NSA_H1 = BIG_NSA_ACMP + (size_t)2 * 2048 * 4096 * 2, BIG_NSA_KVC = BIG_NSA_H1 + (size_t)2 * 2048 * 256 * 2,
    BIG_NSA_GATE = BIG_NSA_KVC + (size_t)2 * 2048 * 128 * 2, BIG_NSA_OCMP = BIG_NSA_GATE + (size_t)T * 48 * 4, BIG_NSA_OBUF = BIG_NSA_OCMP + (size_t)T * 2048 * 4;
constexpr size_t BIG_MOE_ACT = 0, BIG_MOE_YS = (size_t)(2 * T + 256) * MOE_FF * 2;
constexpr size_t BIG_SSD_Z = 0, BIG_SSD_XBCP = (size_t)T * SSD_DI * 2, BIG_SSD_YN = BIG_SSD_XBCP + (size_t)T * SSD_CONVCH * 2, BIG_SSD_BC = BIG_SSD_YN + (size_t)T * SSD_DI * 2;
constexpr size_t BIG_SSD_TABG = BIG_SSD_BC + (size_t)T * 2048 * 2;
constexpr size_t BIG_BYTES = BIG_SSD_TABG + (size_t)256 * 16 * 640 * 4;
static_assert(BIG_NSA_OBUF + (size_t)T * 2048 * 2 <= BIG_BYTES && BIG_MOE_YS + (size_t)2 * T * D_MODEL * 4 <= BIG_BYTES, "big region");

DEV int tidx() { int t = threadIdx.x; asm volatile("" : "+v"(t)); return t; }
DEV float swap_pair(float v) { return __int_as_float(__builtin_amdgcn_mov_dpp(__float_as_int(v), 0xB1, 0xF, 0xF, true)); }
DEV float dpp_xor2(float v) { return __int_as_float(__builtin_amdgcn_mov_dpp(__float_as_int(v), 0x4E, 0xF, 0xF, true)); }
DEV void quad_transpose(float (&v)[4], int k) {
    { const bool up = (k & 2) != 0;
#pragma unroll
      for (int e = 0; e < 2; ++e) { const float snd = up ? v[e] : v[e + 2]; const float rcv = dpp_xor2(snd); if (up) v[e] = rcv; else v[e + 2] = rcv; } }
    { const bool od = (k & 1) != 0;
#pragma unroll
      for (int e = 0; e < 4; e += 2) { const float snd = od ? v[e] : v[e + 1]; const float rcv = swap_pair(snd); if (od) v[e] = rcv; else v[e + 1] = rcv; } }
}
DEV float wave_sum(float v) { for (int o = 32; o >= 1; o >>= 1) v += __shfl_xor(v, o); return v; }
DEV float wave_max(float v) { for (int o = 32; o >= 1; o >>= 1) v = fmaxf(v, __shfl_xor(v, o)); return v; }
DEV float siluf(float v) { return v / (1.f + expf(-v)); }
DEV float gelu_tanh(float v) { return 0.5f * v * (1.f + tanhf(0.7978845608028654f * (v + 0.044715f * v * v * v))); }
DEV float bf2f(bf16_t b) { return __uint_as_float(((unsigned)b) << 16); }
DEV bf16_t f2bf(float f) { unsigned u = __float_as_uint(f); u += 0x7FFFu + ((u >> 16) & 1u); return (bf16_t)(u >> 16); }

template <class CF, class AF, class BF, class EF>
DEV void ngemm(int ngroups, CF cntf, int N, int K, AF af, BF bf, EF ef, float* lds, int bid, int nb) {
    float* As = lds;
    float* Bs = lds + 16 * 132;
    int* pre = (int*)(lds + 16 * 132 + 16 * 68);
    const int tid = tidx(), tx = tid & 15, ty = tid >> 4;
    const int tilesN = (N + 63) / 64;
    __syncthreads();
    if (tid == 0) { int s = 0; for (int g = 0; g < ngroups; ++g) { pre[g] = s; s += ((cntf(g) + 127) / 128) * tilesN; } pre[ngroups] = s; }
    __syncthreads();
    const int total = pre[ngroups];
    for (int tile = bid; tile < total; tile += nb) {
        int g = 0; while (g + 1 < ngroups && pre[g + 1] <= tile) ++g;
        const int lt = tile - pre[g], tm = lt / tilesN, tn = lt % tilesN, M = cntf(g);
        float acc[4][4];
#pragma unroll
        for (int i = 0; i < 4; ++i)
#pragma unroll
            for (int j = 0; j < 4; ++j) acc[i][j] = 0.f;
        for (int k0 = 0; k0 < K; k0 += 16) {
#pragma unroll
            for (int it = 0; it < 4; ++it) { const int i = tid + it * 512, m = i >> 4, k = i & 15, gm = tm * 128 + m; As[k * 132 + m] = (gm < M) ? af(g, gm, k0 + k) : 0.f; }
#pragma unroll
            for (int it = 0; it < 2; ++it) { const int i = tid + it * 512, k = i >> 6, n = i & 63, gn = tn * 64 + n; Bs[k * 68 + n] = (gn < N) ? bf(g, k0 + k, gn) : 0.f; }
            __syncthreads();
#pragma unroll
            for (int k = 0; k < 16; ++k) {
                const float4 a = *(const float4*)(As + k * 132 + ty * 4), b = *(const float4*)(Bs + k * 68 + tx * 4);
                const float av[4] = {a.x, a.y, a.z, a.w}, bv[4] = {b.x, b.y, b.z, b.w};
#pragma unroll
                for (int i = 0; i < 4; ++i)
#pragma unroll
                    for (int j = 0; j < 4; ++j) acc[i][j] = fmaf(av[i], bv[j], acc[i][j]);
            }
            __syncthreads();
        }
#pragma unroll
        for (int i = 0; i < 4; ++i)
#pragma unroll
            for (int j = 0; j < 4; ++j) { const int gm = tm * 128 + ty * 4 + i, gn = tn * 64 + tx * 4 + j; if (gm < M && gn < N) ef(g, gm, gn, acc[i][j]); }
    }
}

#define MG_LAS __attribute__((address_space(3)))

typedef short bf16x8 __attribute__((ext_vector_type(8)));
typedef float f32x4 __attribute__((ext_vector_type(4)));
typedef unsigned u32x4 __attribute__((ext_vector_type(4)));
typedef unsigned u32x2 __attribute__((ext_vector_type(2)));
typedef int i32x8 __attribute__((ext_vector_type(8)));
typedef int i32x4 __attribute__((ext_vector_type(4)));
DEV unsigned pk8(float a, float b, float c, float d) {
    a = __builtin_amdgcn_fmed3f(a, -448.f, 448.f); b = __builtin_amdgcn_fmed3f(b, -448.f, 448.f); c = __builtin_amdgcn_fmed3f(c, -448.f, 448.f); d = __builtin_amdgcn_fmed3f(d, -448.f, 448.f);
    int w = __builtin_amdgcn_cvt_pk_fp8_f32(a, b, 0, false); w = __builtin_amdgcn_cvt_pk_fp8_f32(c, d, w, true); return (unsigned)w; }
constexpr float F8_SX = 4.f, F8_SW = 256.f, F8_SACT = 8.f, F8_SO = 16.f;
namespace mg {
constexpr int BM = 256, BK = 64, HALF = 128, HTB = HALF * BK * 2, STAGE_BYTES = 8 * HTB, NXCD = 8, WGM = 8;
DEV int lds_byte(int r, int c) { const int st = (r >> 4) * 2 + (c >> 5), rr = r & 15, cc = c & 31, ob = rr * 64 + cc * 2; return st * 1024 + (ob ^ (((ob >> 9) & 1) << 5)); }
DEV void stage_rc(int b, int& R, int& C) { const int st = b / 1024, sb = b % 1024, swz = sb ^ (((sb >> 9) & 1) << 5); R = (st >> 1) * 16 + swz / 64; C = (st & 1) * 32 + (swz % 64) / 2; }
DEV int perm32(int rho) { const int n = rho >> 4, i = rho & 15; return 8 * (i >> 2) + 4 * n + (i & 3); }
DEV unsigned cvt_pk_bf16(float lo, float hi) { unsigned r; asm volatile("v_cvt_pk_bf16_f32 %0, %1, %2" : "=v"(r) : "v"(lo), "v"(hi)); return r; }
struct Unit { int g, pm, pn; };

struct StaticOrder {
    int nM, nN, nwg, G, c;
    DEV void init(int M, int N, int G_, int c_) { nM = M / BM; nN = N / BM; nwg = nM * nN; G = G_; c = c_; }
    DEV bool next(int i, Unit& u) const {
        const long L = (long)i * G + c; if (L >= nwg) return false;
        int wgid = (int)L; { const int q = nwg / NXCD, r = nwg % NXCD, xcd = wgid % NXCD, off = wgid / NXCD; wgid = (xcd < r ? xcd * (q + 1) : r * (q + 1) + (xcd - r) * q) + off; }
        const int nig = WGM * nN, gid = wgid / nig, fm = gid * WGM, gsz = (nM - fm) < WGM ? (nM - fm) : WGM;
        u.g = 0; u.pm = fm + ((wgid % nig) % gsz); u.pn = (wgid % nig) / gsz; return true;
    }
};
struct GroupedOrder {
    const int* pre; int ng, nN, G, c;
    DEV bool next(int i, Unit& u) const {
        const int L = i * G + c; if (L >= pre[ng] * nN) return false;
        const int mt = L / nN; u.pn = L - mt * nN; int g = 0; while (g + 1 < ng && pre[g + 1] <= mt) ++g;
        u.g = __builtin_amdgcn_readfirstlane(g); u.pm = __builtin_amdgcn_readfirstlane(mt - pre[g]); u.pn = __builtin_amdgcn_readfirstlane(u.pn); return true;
    }
};
struct FixedGroups {
    int ng, mt, nN, G, c;
    DEV bool next(int i, Unit& u) const { const int L = i * G + c; if (L >= ng * mt * nN) return false; u.pn = L % nN; const int r = L / nN; u.pm = r % mt; u.g = r / mt; return true; }
};
struct AGrouped { static constexpr bool GATHER = false; const bf16_t* A; int lda; size_t gstride; DEV const char* ubase(const Unit& u) const { return (const char*)(A + (size_t)u.g * gstride + (size_t)u.pm * BM * lda); } DEV unsigned rowoff(const Unit&, int r) const { return (unsigned)(r * lda) * 2u; } };
struct APlain { static constexpr bool GATHER = false; const bf16_t* A; int lda; DEV const char* ubase(const Unit& u) const { return (const char*)(A + (size_t)u.pm * BM * lda); } DEV unsigned rowoff(const Unit&, int r) const { return (unsigned)(r * lda) * 2u; } };
struct BPlain { const bf16_t* Bt; int ldb; size_t gstride; DEV const char* base(const Unit& u) const { return (const char*)(Bt + (size_t)u.g * gstride + (size_t)u.pn * BM * ldb); } };

template <bool FP8 = false, int DS = 0  , class AOp, class BOp, class Epi, class Sched>
DEV void gemm_phase(MG_LAS unsigned char* lds, const int K, const AOp& aop, const BOp& bop, const Sched& S, const Epi& E) {
    int tid_ = tidx();
    const int tid = tid_, wid = __builtin_amdgcn_readfirstlane(tid >> 6), lane = tid & 63, wr = wid >> 2, wc = wid & 3, fr = lane & 15, fq = lane >> 4;
    int nt = K / BK; asm volatile("" : "+s"(nt));
    unsigned voffB[2];
#pragma unroll
    for (int i = 0; i < 2; ++i) { int R, C; stage_rc(tid * 16 + i * 8192, R, C); const int Rb = Epi::PERM ? ((R & ~31) + perm32(R & 31)) : R; voffB[i] = (unsigned)(Rb * bop.ldb + C) * 2u; }
#define MG_ROWOFFS(dst, unit) do { _Pragma("unroll") for (int _h = 0; _h < 2; ++_h) _Pragma("unroll") for (int _i = 0; _i < 2; ++_i) { int _R, _C; stage_rc(tid * 16 + _i * 8192, _R, _C); dst[_h][_i] = aop.rowoff(unit, _h * HALF + _R) + (unsigned)(_C * 2); } } while (0)
    const size_t kstep = (size_t)(BK * 2);
    const size_t hstepB = (size_t)HALF * bop.ldb * 2;
    const unsigned ldsw = (unsigned)wid * 1024u;
    const int aoff = lds_byte(wr * 64 + fr, fq * 8), boff = lds_byte(wc * 32 + fr, fq * 8);
#define MG_SA(b, h) (((b) * 2 + (h)) * HTB)
#define MG_SB(b, h) ((4 + (b) * 2 + (h)) * HTB)
#define MG_STAGE(bufoff, gbase, voff) do { _Pragma("unroll") for (int _i = 0; _i < 2; ++_i) \
        __builtin_amdgcn_global_load_lds((const unsigned*)((const char*)(gbase) + (voff)[_i]), (MG_LAS unsigned*)(lds + (bufoff) + ldsw + _i * 8192), 16, 0, 0); } while (0)
#define MG_LDA(dst, b, h) do { if constexpr (FP8) { _Pragma("unroll") for (int m = 0; m < 4; ++m) { dst##8[m].lo = *(const MG_LAS i32x4*)(lds + MG_SA(b, h) + aoff + m * 2048); dst##8[m].hi = *(const MG_LAS i32x4*)(lds + MG_SA(b, h) + aoff + m * 2048 + 1024); } } else { \
        _Pragma("unroll") for (int m = 0; m < 4; ++m) _Pragma("unroll") for (int k = 0; k < 2; ++k) dst[m][k] = *(const MG_LAS bf16x8*)(lds + MG_SA(b, h) + aoff + m * 2048 + k * 1024); } } while (0)
#define MG_LDB(dst, b, h) do { if constexpr (FP8) { _Pragma("unroll") for (int n = 0; n < 2; ++n) { dst##8[n].lo = *(const MG_LAS i32x4*)(lds + MG_SB(b, h) + boff + n * 2048); dst##8[n].hi = *(const MG_LAS i32x4*)(lds + MG_SB(b, h) + boff + n * 2048 + 1024); } } else { \
        _Pragma("unroll") for (int n = 0; n < 2; ++n) _Pragma("unroll") for (int k = 0; k < 2; ++k) dst[n][k] = *(const MG_LAS bf16x8*)(lds + MG_SB(b, h) + boff + n * 2048 + k * 1024); } } while (0)
#define MG_MMA(ai, bj, At, Bt) do { __builtin_amdgcn_s_setprio(1); if constexpr (FP8) { _Pragma("unroll") for (int m = 0; m < 4; ++m) _Pragma("unroll") for (int n = 0; n < 2; ++n) \
        asm volatile("v_mfma_f32_16x16x128_f8f6f4 %0, %1, %2, %0" : "+v"(acc[ai][bj][m][n]) : "v"(Bt##8[n]), "v"(At##8[m])); } else {     \
        _Pragma("unroll") for (int m = 0; m < 4; ++m) _Pragma("unroll") for (int n = 0; n < 2; ++n) _Pragma("unroll") for (int k = 0; k < 2; ++k) \
        acc[ai][bj][m][n] = __builtin_amdgcn_mfma_f32_16x16x32_bf16(Bt[n][k], At[m][k], acc[ai][bj][m][n], 0, 0, 0); } __builtin_amdgcn_s_setprio(0); } while (0)
#define MG_WAIT_V(n) asm volatile("s_waitcnt vmcnt(" #n ")" ::: "memory")
#define MG_WAIT_L(n) asm volatile("s_waitcnt lgkmcnt(" #n ")" ::: "memory")
#define MG_BAR __builtin_amdgcn_s_barrier()
#define MG_SCHED __builtin_amdgcn_sched_barrier(0)
    Unit cur, nxt; int ui = 0;
    if (!S.next(0, cur)) return;
    f32x4 acc[2][2][4][2];
#define MG_ACC_INIT(unit) do { if constexpr (Epi::ACC_INIT) E.init(acc, unit, wr, wc, fr, fq); else { \
        _Pragma("unroll") for (int a = 0; a < 2; ++a) _Pragma("unroll") for (int b = 0; b < 2; ++b) _Pragma("unroll") for (int m = 0; m < 4; ++m) _Pragma("unroll") for (int n = 0; n < 2; ++n) acc[a][b][m][n] = (f32x4){0.f, 0.f, 0.f, 0.f}; } } while (0)
    MG_ACC_INIT(cur);
    bf16x8 At[4][2], B0[2][2], B1[2][2];
    i32x8 At8[4], B08[2], B18[2];
    unsigned vAc[2][2], vAn[2][2];
    MG_ROWOFFS(vAc, cur);
    const char* cA = aop.ubase(cur); const char* cB = bop.base(cur);
    MG_STAGE(MG_SB(0, 0), cB, voffB); MG_STAGE(MG_SA(0, 0), cA, vAc[0]); MG_STAGE(MG_SB(0, 1), cB + hstepB, voffB); MG_STAGE(MG_SA(0, 1), cA, vAc[1]);
    if (wr == 1) MG_BAR;
    MG_WAIT_V(4); MG_BAR;
    MG_STAGE(MG_SB(1, 0), cB + kstep, voffB); MG_STAGE(MG_SA(1, 0), cA + kstep, vAc[0]); MG_STAGE(MG_SB(1, 1), cB + hstepB + kstep, voffB);
    MG_WAIT_V(6); MG_BAR;
    for (;;) {
        const bool has_next = S.next(ui + 1, nxt);
        const char* nB = has_next ? bop.base(nxt) : cB; const char* nA = has_next ? aop.ubase(nxt) : cA;
        if constexpr (AOp::GATHER) { if (has_next) MG_ROWOFFS(vAn, nxt); else {
#pragma unroll
            for (int h = 0; h < 2; ++h)
#pragma unroll
                for (int i = 0; i < 2; ++i) vAn[h][i] = vAc[h][i]; } }
        for (int t = 0; t < nt; t += 2) {
            const bool last = (t == nt - 2);
            const char* a1 = cA + (size_t)(t + 1) * kstep;
            const char* a2 = last ? nA : cA + (size_t)(t + 2) * kstep; const char* b2 = last ? nB : cB + (size_t)(t + 2) * kstep;
            const char* a3 = a2 + kstep; const char* b3 = b2 + kstep;
            MG_LDB(B0, 0, 0); MG_SCHED; MG_LDA(At, 0, 0); MG_STAGE(MG_SA(1, 1), a1, vAc[1]);
            if constexpr (AOp::GATHER) { if (last) {
#pragma unroll
                for (int h = 0; h < 2; ++h)
#pragma unroll
                    for (int i = 0; i < 2; ++i) vAc[h][i] = vAn[h][i]; } }
            MG_WAIT_L(8); MG_BAR; MG_WAIT_L(0); MG_MMA(0, 0, At, B0); MG_BAR; MG_SCHED;
            MG_LDB(B1, 0, 1); MG_STAGE(MG_SB(0, 0), b2, voffB);
            MG_BAR; MG_WAIT_L(0); MG_MMA(0, 1, At, B1); MG_BAR;
            MG_LDA(At, 0, 1); MG_STAGE(MG_SA(0, 0), a2, vAc[0]);
            MG_BAR; MG_WAIT_L(0); MG_MMA(1, 0, At, B0); MG_BAR; MG_SCHED;
            MG_STAGE(MG_SB(0, 1), b2 + hstepB, voffB);
            MG_WAIT_V(6); MG_BAR; MG_MMA(1, 1, At, B1); MG_BAR;
            MG_LDB(B0, 1, 0); MG_SCHED; MG_LDA(At, 1, 0); MG_STAGE(MG_SA(0, 1), a2, vAc[1]);
            MG_WAIT_L(8); MG_BAR; MG_WAIT_L(0); MG_MMA(0, 0, At, B0); MG_BAR; MG_SCHED;
            MG_LDB(B1, 1, 1); MG_STAGE(MG_SB(1, 0), b3, voffB);
            MG_BAR; MG_WAIT_L(0); MG_MMA(0, 1, At, B1); MG_BAR;
            MG_LDA(At, 1, 1); MG_STAGE(MG_SA(1, 0), a3, vAc[0]);
            MG_BAR; MG_WAIT_L(0); MG_MMA(1, 0, At, B0); MG_BAR; MG_SCHED;
            MG_STAGE(MG_SB(1, 1), b3 + hstepB, voffB);
            MG_WAIT_V(6); MG_BAR; MG_MMA(1, 1, At, B1); MG_BAR;
        }
        __builtin_amdgcn_sched_barrier(0); asm volatile("s_nop 15\n\ts_nop 15" ::: "memory"); __builtin_amdgcn_sched_barrier(0);
        if constexpr (DS != 0) {
#pragma unroll
            for (int a = 0; a < 2; ++a)
#pragma unroll
                for (int b = 0; b < 2; ++b)
#pragma unroll
                    for (int m = 0; m < 4; ++m)
#pragma unroll
                        for (int n = 0; n < 2; ++n) acc[a][b][m][n] *= (1.f / (float)(1 << DS)); }
        { int fr2 = fr, fq2 = fq; asm volatile("" : "+v"(fr2), "+v"(fq2));
          E(acc, cur, wr, wc, fr2, fq2); }
        if (!has_next) break;
        MG_ACC_INIT(nxt);
        cur = nxt; cB = nB; cA = nA; ++ui;
    }
    MG_WAIT_V(0);
    if (wr == 0) MG_BAR;
    MG_BAR;
#undef MG_ROWOFFS
#undef MG_ACC_INIT
#undef MG_SA
#undef MG_SB
#undef MG_STAGE
#undef MG_LDA
#undef MG_LDB
#undef MG_MMA
#undef MG_WAIT_V
#undef MG_WAIT_L
#undef MG_BAR
#undef MG_SCHED
}
}
#define EPI_ROWS_BEGIN _Pragma("unroll") for (int ai = 0; ai < 2; ++ai) _Pragma("unroll") for (int m = 0; m < 4; ++m) { const int rt = ai * 128 + wr * 64 + m * 16 + fr;
#define EPI_ROWS_END }
struct EpiF32 {
    static constexpr bool PERM = false, ACC_INIT = false;
    float* C; int ldc, nvalid;
    DEV void operator()(const f32x4 (&acc)[2][2][4][2], const mg::Unit& u, int wr, int wc, int fr, int fq) const {
        EPI_ROWS_BEGIN float* rowp = C + (size_t)(u.pm * 256 + rt) * ldc;
#pragma unroll
            for (int bj = 0; bj < 2; ++bj)
#pragma unroll
                for (int n = 0; n < 2; ++n) { const int col = u.pn * 256 + bj * 128 + wc * 32 + n * 16 + 4 * fq; if (col < nvalid) *(f32x4*)(rowp + col) = acc[ai][bj][m][n]; }
        EPI_ROWS_END
    }
};
template <bool RB16, int IS = 0  >
struct EpiResid {
    static constexpr bool PERM = true, ACC_INIT = true;
    const void* __restrict__ resid; bf16_t* __restrict__ out;
    DEV void init(f32x4 (&acc)[2][2][4][2], const mg::Unit& u, int wr, int wc, int fr, int fq) const {
#pragma unroll
        for (int ai = 0; ai < 2; ++ai)
#pragma unroll
            for (int m = 0; m < 4; ++m) { const size_t ro = (size_t)(u.pm * 256 + ai * 128 + wr * 64 + m * 16 + fr) * D_MODEL;
#pragma unroll
                for (int bj = 0; bj < 2; ++bj) { const size_t o = ro + u.pn * 256 + bj * 128 + wc * 32 + 8 * fq;
                    if constexpr (RB16) { const u32x4 w = __builtin_nontemporal_load((const u32x4*)((const bf16_t*)resid + o));
                        acc[ai][bj][m][0] = (f32x4){__uint_as_float(w.x << 16), __uint_as_float(w.x & 0xffff0000u), __uint_as_float(w.y << 16), __uint_as_float(w.y & 0xffff0000u)};
                        acc[ai][bj][m][1] = (f32x4){__uint_as_float(w.z << 16), __uint_as_float(w.z & 0xffff0000u), __uint_as_float(w.w << 16), __uint_as_float(w.w & 0xffff0000u)}; }
                    else { acc[ai][bj][m][0] = __builtin_nontemporal_load((const f32x4*)((const float*)resid + o)); acc[ai][bj][m][1] = __builtin_nontemporal_load((const f32x4*)((const float*)resid + o + 4)); }
                    if constexpr (IS != 0) { acc[ai][bj][m][0] *= (float)(1 << IS); acc[ai][bj][m][1] *= (float)(1 << IS); } } }
    }
    DEV void operator()(const f32x4 (&acc)[2][2][4][2], const mg::Unit& u, int wr, int wc, int fr, int fq) const {
#pragma unroll
        for (int ai = 0; ai < 2; ++ai)
#pragma unroll
            for (int m = 0; m < 4; ++m) { const size_t ro = (size_t)(u.pm * 256 + ai * 128 + wr * 64 + m * 16 + fr) * D_MODEL;
#pragma unroll
                for (int bj = 0; bj < 2; ++bj) { const f32x4 v0 = acc[ai][bj][m][0], v1 = acc[ai][bj][m][1];
                    u32x4 w; w.x = mg::cvt_pk_bf16(v0[0], v0[1]); w.y = mg::cvt_pk_bf16(v0[2], v0[3]); w.z = mg::cvt_pk_bf16(v1[0], v1[1]); w.w = mg::cvt_pk_bf16(v1[2], v1[3]);
                    *(u32x4*)(out + ro + u.pn * 256 + bj * 128 + wc * 32 + 8 * fq) = w; } }
    }
};
struct EpiSsdIn {
    static constexpr bool PERM = true, ACC_INIT = false;
    bf16_t* z; bf16_t* xbc; float* dtb; const float* dt_bias;
    DEV void operator()(const f32x4 (&acc)[2][2][4][2], const mg::Unit& u, int wr, int wc, int fr, int fq) const {
        if (u.pn < OFF_DT / 256) {
            EPI_ROWS_BEGIN const int row = u.pm * 256 + rt;
#pragma unroll
                for (int bj = 0; bj < 2; ++bj) { const int col = u.pn * 256 + bj * 128 + wc * 32 + 8 * fq; const f32x4 v0 = acc[ai][bj][m][0], v1 = acc[ai][bj][m][1];
                    u32x4 w; w.x = mg::cvt_pk_bf16(v0[0], v0[1]); w.y = mg::cvt_pk_bf16(v0[2], v0[3]); w.z = mg::cvt_pk_bf16(v1[0], v1[1]); w.w = mg::cvt_pk_bf16(v1[2], v1[3]);
                    bf16_t* dst = col < OFF_XBC ? z + (size_t)row * SSD_DI + col : xbc + (size_t)row * SSD_CONVCH + (col - OFF_XBC); *(u32x4*)dst = w; }
            EPI_ROWS_END
        } else if (wc < 2) {
            const int hcol = wc * 32 + 8 * fq; float bb[8];
#pragma unroll
            for (int j = 0; j < 8; ++j) bb[j] = dt_bias[hcol + j];
            EPI_ROWS_BEGIN const int row = u.pm * 256 + rt; float o[8];
#pragma unroll
                for (int j = 0; j < 4; ++j) { o[j] = acc[ai][0][m][0][j] + bb[j]; o[4 + j] = acc[ai][0][m][1][j] + bb[4 + j]; }
#pragma unroll
                for (int j = 0; j < 8; ++j) { const float x = o[j], uu = __expf(-fabsf(x)); const float lg = uu < 0.01f ? uu * (1.f - uu * (0.5f - uu * 0.33333333f)) : __logf(1.f + uu); o[j] = fmaxf(x, 0.f) + lg; }
                *(f32x4*)(dtb + (size_t)row * 64 + hcol) = (f32x4){o[0], o[1], o[2], o[3]}; *(f32x4*)(dtb + (size_t)row * 64 + hcol + 4) = (f32x4){o[4], o[5], o[6], o[7]};
            EPI_ROWS_END
        }
    }
};
struct EpiNsaIn {
    static constexpr bool PERM = true, ACC_INIT = false;
    bf16_t *q, *ks, *vs, *kw, *vw, *acmp; float* gate; const float* rope; const float* pe;
    DEV static void st4(bf16_t* dst, const float* o) { u32x2 w; w.x = mg::cvt_pk_bf16(o[0], o[1]); w.y = mg::cvt_pk_bf16(o[2], o[3]); *(u32x2*)dst = w; }
    DEV void im2col4(int kv, int b, int t, int g, int d, const float* o) const {
        const int c1 = t >> 4, l1 = t & 15; const float* pk = pe + kv * 4096;
        if (c1 <= 126) { const int l = l1; float v[4];
#pragma unroll
            for (int j = 0; j < 4; ++j) v[j] = o[j] + pk[l * 128 + d + j];
            st4(acmp + (((size_t)kv * 2048 + (b * 4 + g) * 128 + c1) * 4096 + l * 128 + d), v); }
        if (c1 >= 1) { const int l = l1 + 16; float v[4];
#pragma unroll
            for (int j = 0; j < 4; ++j) v[j] = o[j] + pk[l * 128 + d + j];
            st4(acmp + (((size_t)kv * 2048 + (b * 4 + g) * 128 + c1 - 1) * 4096 + l * 128 + d), v); }
    }
    DEV void operator()(const f32x4 (&acc)[2][2][4][2], const mg::Unit& u, int wr, int wc, int fr, int fq) const {
        const int pn = u.pn; const bool is_rope = pn < 10 || pn == 12 || pn == 13 || pn == 16 || pn == 17;
#pragma unroll
        for (int ai = 0; ai < 2; ++ai) {
        f32x4 csv[4][2];
        if (is_rope) {
#pragma unroll
            for (int m = 0; m < 4; ++m) { const int t = (u.pm * 256 + ai * 128 + wr * 64 + m * 16 + fr) & (SEQ - 1); const float* rp = rope + (size_t)(t * 64 + 16 * wc + 4 * fq) * 2;
                csv[m][0] = *(const f32x4*)rp; csv[m][1] = *(const f32x4*)(rp + 4); } }
#pragma unroll
        for (int m = 0; m < 4; ++m) { const int rt = ai * 128 + wr * 64 + m * 16 + fr;
        const int row = u.pm * 256 + rt, t = row & (SEQ - 1), b = row >> 11;
#pragma unroll
            for (int bj = 0; bj < 2; ++bj) { const f32x4 v0 = acc[ai][bj][m][0], v1 = acc[ai][bj][m][1];
                if (is_rope) { const int d = 16 * wc + 4 * fq;
                    const f32x4 cs0 = csv[m][0], cs1 = csv[m][1];
                    const float c[4] = {cs0[0], cs0[2], cs1[0], cs1[2]}, sn[4] = {cs0[1], cs0[3], cs1[1], cs1[3]}; float o1[4], o2[4];
#pragma unroll
                    for (int j = 0; j < 4; ++j) { o1[j] = v0[j] * c[j] - v1[j] * sn[j]; o2[j] = v1[j] * c[j] + v0[j] * sn[j]; }
                    if (pn < 8) { bf16_t* dst = q + (size_t)row * 2048 + (2 * pn + bj) * 128 + d; st4(dst, o1); st4(dst + 64, o2); }
                    else if (pn < 10) { const int g = 2 * (pn - 8) + bj; im2col4(0, b, t, g, d, o1); im2col4(0, b, t, g, d + 64, o2); }
                    else { bf16_t* dst = (pn < 14 ? ks + (size_t)row * 512 + (2 * (pn - 12) + bj) * 128 : kw + (size_t)row * 512 + (2 * (pn - 16) + bj) * 128) + d; st4(dst, o1); st4(dst + 64, o2); }
                } else { const int c0 = 32 * wc + 8 * fq; const float o1[4] = {v0[0], v0[1], v0[2], v0[3]}, o2[4] = {v1[0], v1[1], v1[2], v1[3]};
                    if (pn < 12) { const int g = 2 * (pn - 10) + bj; im2col4(1, b, t, g, c0, o1); im2col4(1, b, t, g, c0 + 4, o2); }
                    else if (pn < 20) { bf16_t* dst = (pn < 16 ? vs + (size_t)row * 512 + (2 * (pn - 14) + bj) * 128 : vw + (size_t)row * 512 + (2 * (pn - 18) + bj) * 128) + c0; st4(dst, o1); st4(dst + 4, o2); }
                    else { const int col = bj * 128 + c0; if (col < 48) { float* gd = gate + (size_t)row * 48 + col;
#pragma unroll
                            for (int j = 0; j < 4; ++j) { gd[j] = 1.f / (1.f + __expf(-o1[j])); gd[4 + j] = 1.f / (1.f + __expf(-o2[j])); } } }
                } }
        } }
    }
};
struct EpiCmp1 {
    static constexpr bool PERM = true, ACC_INIT = false;
    bf16_t* h1;
    DEV void operator()(const f32x4 (&acc)[2][2][4][2], const mg::Unit& u, int wr, int wc, int fr, int fq) const {
        EPI_ROWS_BEGIN bf16_t* rowp = h1 + ((size_t)u.g * 2048 + u.pm * 256 + rt) * 256;
#pragma unroll
            for (int bj = 0; bj < 2; ++bj) { const int col = bj * 128 + wc * 32 + 8 * fq; float o[8];
#pragma unroll
                for (int j = 0; j < 4; ++j) { o[j] = acc[ai][bj][m][0][j]; o[4 + j] = acc[ai][bj][m][1][j]; }
#pragma unroll
                for (int j = 0; j < 8; ++j) { const float v = o[j], uu = 1.5957691216057308f * (v + 0.044715f * v * v * v); o[j] = v / (1.f + __expf(-uu)); }
                u32x4 w; w.x = mg::cvt_pk_bf16(o[0], o[1]); w.y = mg::cvt_pk_bf16(o[2], o[3]); w.z = mg::cvt_pk_bf16(o[4], o[5]); w.w = mg::cvt_pk_bf16(o[6], o[7]); *(u32x4*)(rowp + col) = w; }
        EPI_ROWS_END
    }
};
struct EpiCmp2 {
    static constexpr bool PERM = true, ACC_INIT = false;
    bf16_t* kvc;
    DEV void operator()(const f32x4 (&acc)[2][2][4][2], const mg::Unit& u, int wr, int wc, int fr, int fq) const {
        EPI_ROWS_BEGIN const int mrow = u.pm * 256 + rt; bf16_t* rowp = kvc + ((size_t)u.g * 2048 + mrow) * 128; const bool pad = (mrow & 127) == 127;
            { const int col = wc * 32 + 8 * fq; const f32x4 v0 = acc[ai][0][m][0], v1 = acc[ai][0][m][1];
              u32x4 w; w.x = mg::cvt_pk_bf16(v0[0], v0[1]); w.y = mg::cvt_pk_bf16(v0[2], v0[3]); w.z = mg::cvt_pk_bf16(v1[0], v1[1]); w.w = mg::cvt_pk_bf16(v1[2], v1[3]);
              if (pad) w = (u32x4){0u, 0u, 0u, 0u}; *(u32x4*)(rowp + col) = w; }
        EPI_ROWS_END
    }
};
DEV void cmp_gemm2_rows(const bf16_t* h1, const bf16_t* w2t  , bf16_t* kvc, int rowbase  ) {
    typedef float f32x16 __attribute__((ext_vector_type(16)));
    const int tid = tidx(), wid = tid >> 6, lane = tid & 63, r32 = lane & 31, hi = lane >> 5;
    const bf16_t* ap = h1 + (size_t)(rowbase + 32 * wid + r32) * 256 + hi * 8;
    const bf16_t* bp = w2t + (size_t)r32 * 256 + hi * 8;
    f32x16 acc[4] = {};
#pragma unroll 4
    for (int ks = 0; ks < 16; ++ks) { const bf16x8 a = *(const bf16x8*)(ap + ks * 16);
#pragma unroll
        for (int nbk = 0; nbk < 4; ++nbk) { const bf16x8 b = *(const bf16x8*)(bp + (size_t)nbk * 32 * 256 + ks * 16); acc[nbk] = __builtin_amdgcn_mfma_f32_32x32x16_bf16(a, b, acc[nbk], 0, 0, 0); } }
#pragma unroll
    for (int r = 0; r < 16; ++r) { const int row = rowbase + 32 * wid + (r & 3) + 8 * (r >> 2) + 4 * hi; const bool pad = (row & 127) == 127;
#pragma unroll
        for (int nbk = 0; nbk < 4; ++nbk) { const float v = pad ? 0.f : acc[nbk][r]; const float vn = swap_pair(v);
            if ((r32 & 1) == 0) *(unsigned*)(kvc + (size_t)row * 128 + nbk * 32 + r32) = mg::cvt_pk_bf16(v, vn); } }
}

struct AMoeGather { static constexpr bool GATHER = true; const bf16_t* A; const int* list; const int* cnt;
    DEV const char* ubase(const mg::Unit&) const { return (const char*)A; }
    DEV unsigned rowoff(const mg::Unit& u, int r) const { int idx = u.pm * 256 + r; const int c = cnt[u.g]; idx = idx < c ? idx : c - 1; return (unsigned)(list[u.g * T + idx] >> 1) * (unsigned)D_MODEL; } };
struct AMoeAct { static constexpr bool GATHER = false; const bf16_t* A; const int* tab;
    DEV const char* ubase(const mg::Unit& u) const { return (const char*)A + (size_t)(__builtin_amdgcn_readfirstlane(tab[64 + u.g]) + u.pm * 256) * MOE_FF; }
    DEV unsigned rowoff(const mg::Unit&, int r) const { return (unsigned)r * (unsigned)MOE_FF; } };
struct EpiMoeGU {
    static constexpr bool PERM = true, ACC_INIT = false;
    bf16_t* act; const int* cnt; const int* tab;
    DEV void operator()(const f32x4 (&acc)[2][2][4][2], const mg::Unit& u, int wr, int wc, int fr, int fq) const {
        const int c = cnt[u.g], rb = tab[64 + u.g];
        EPI_ROWS_BEGIN const int lr = u.pm * 256 + rt;
            if (lr < c) {
#pragma unroll
                for (int bj = 0; bj < 2; ++bj) { const int f = u.pn * 128 + bj * 64 + wc * 16 + 4 * fq; const f32x4 g = acc[ai][bj][m][0], up = acc[ai][bj][m][1]; float o[4];
#pragma unroll
                    for (int j = 0; j < 4; ++j) { const float gj = g[j] * (1.f / (F8_SX * F8_SW)); o[j] = gj / (1.f + __expf(-gj)) * (up[j] * (F8_SACT / (F8_SX * F8_SW))); }
                    *(unsigned*)((char*)act + (size_t)(rb + lr) * MOE_FF + f) = pk8(o[0], o[1], o[2], o[3]); } }
        EPI_ROWS_END
    }
};
struct EpiMoeDown {
    static constexpr bool PERM = true, ACC_INIT = false;
    bf16_t* ys; const int* list; const int* cnt; const float* lw;
    DEV void operator()(const f32x4 (&acc)[2][2][4][2], const mg::Unit& u, int wr, int wc, int fr, int fq) const {
        const int c = cnt[u.g];
        int idxv[2][4]; float wv[2][4];
#pragma unroll
        for (int ai = 0; ai < 2; ++ai)
#pragma unroll
            for (int m = 0; m < 4; ++m) { const int lr = u.pm * 256 + ai * 128 + wr * 64 + m * 16 + fr; const bool ok = lr < c;
                idxv[ai][m] = ok ? list[u.g * T + lr] : -1; wv[ai][m] = ok ? lw[u.g * T + lr] * (1.f / (F8_SACT * F8_SW)) : 0.f; }
#pragma unroll
        for (int ai = 0; ai < 2; ++ai)
#pragma unroll
            for (int m = 0; m < 4; ++m)
                if (idxv[ai][m] >= 0) { const float w = wv[ai][m]; bf16_t* rowp = ys + (size_t)idxv[ai][m] * D_MODEL;
#pragma unroll
                    for (int bj = 0; bj < 2; ++bj) { const int col = u.pn * 256 + bj * 128 + wc * 32 + 8 * fq; const f32x4 v0 = acc[ai][bj][m][0] * w, v1 = acc[ai][bj][m][1] * w;
                        u32x4 pk; pk.x = mg::cvt_pk_bf16(v0[0], v0[1]); pk.y = mg::cvt_pk_bf16(v0[2], v0[3]); pk.z = mg::cvt_pk_bf16(v1[0], v1[1]); pk.w = mg::cvt_pk_bf16(v1[2], v1[3]);
                        *(u32x4*)(rowp + col) = pk; } }
    }
};

template <bool F8 = false, class SF>
DEV void conv_wt(SF sf, int ngroups, int K, int Nphys, bf16_t* dst, float*  , int bid, int nb, int t0 = 0, int t1 = 0x7fffffff) {
    const int tid = tidx(), wid = tid >> 6, lane = tid & 63, kb = lane & 7, c4 = lane >> 3;
    const int ktn = K / 64, ntn = Nphys / 256, per = ktn * ntn, total = ngroups * per < t1 ? ngroups * per : t1;
    constexpr int NF = 4;
    (void)per; (void)total;
    const int ktq = ktn / 2, ntq = (ntn + 1) / 2, perq = ktq * ntq, totq = ngroups * perq;
    const int q0 = t0 / NF, q1 = (t1 == 0x7fffffff || t1 / NF > totq) ? totq : t1 / NF;
    for (int item = q0 + bid; item < q1; item += nb) {
        const int g = item / perq, rem = item - g * perq, kq = rem / ntq, nq = rem - kq * ntq;
        const int k0 = kq * 128 + kb * 16;
        f32x4 v[2][2][8];
#pragma unroll
        for (int un = 0; un < 2; ++un) { const int nt = nq * 2 + un; const int q = nt * 64 + wid * 8 + c4;
#pragma unroll
            for (int uk = 0; uk < 2; ++uk)
#pragma unroll
                for (int j = 0; j < 8; ++j) { const float* sp = nt < ntn ? sf(g, k0 + uk * 8 + j, q) : (const float*)nullptr; v[un][uk][j] = (f32x4){0.f, 0.f, 0.f, 0.f}; if (sp) v[un][uk][j] = __builtin_nontemporal_load((const f32x4*)sp); } }
#pragma unroll
        for (int un = 0; un < 2; ++un) { const int nt = nq * 2 + un; const int q = nt * 64 + wid * 8 + c4;
            if (nt < ntn) {
#pragma unroll
            for (int e = 0; e < 4; ++e) {
                if constexpr (F8) { u32x4 w;
                    w.x = pk8(v[un][0][0][e] * F8_SW, v[un][0][1][e] * F8_SW, v[un][0][2][e] * F8_SW, v[un][0][3][e] * F8_SW); w.y = pk8(v[un][0][4][e] * F8_SW, v[un][0][5][e] * F8_SW, v[un][0][6][e] * F8_SW, v[un][0][7][e] * F8_SW);
                    w.z = pk8(v[un][1][0][e] * F8_SW, v[un][1][1][e] * F8_SW, v[un][1][2][e] * F8_SW, v[un][1][3][e] * F8_SW); w.w = pk8(v[un][1][4][e] * F8_SW, v[un][1][5][e] * F8_SW, v[un][1][6][e] * F8_SW, v[un][1][7][e] * F8_SW);
                    __builtin_nontemporal_store(w, (u32x4*)((char*)dst + ((size_t)g * Nphys + 4 * q + e) * K + k0)); }
                else {
#pragma unroll
                    for (int uk = 0; uk < 2; ++uk) { u32x4 w; w.x = mg::cvt_pk_bf16(v[un][uk][0][e], v[un][uk][1][e]); w.y = mg::cvt_pk_bf16(v[un][uk][2][e], v[un][uk][3][e]); w.z = mg::cvt_pk_bf16(v[un][uk][4][e], v[un][uk][5][e]); w.w = mg::cvt_pk_bf16(v[un][uk][6][e], v[un][uk][7][e]);
                        __builtin_nontemporal_store(w, (u32x4*)(dst + ((size_t)g * Nphys + 4 * q + e) * K + k0 + uk * 8)); } } } } }
    }
}

template <bool F8 = false, bool X16 = false  >
DEV void rows_norm(const float* src, const bf16_t* add0, const bf16_t* add1, float* sumdst, const float* g, bf16_t* dst, int bid, int nb) {
    const int lane = tidx() & 63, wid = tidx() >> 6;
    for (int row = bid * 8 + wid; row < T; row += nb * 8) {
        float4 v[8]; float ss = 0.f;
#pragma unroll
        for (int i = 0; i < 8; ++i) {
            const size_t o = (size_t)row * D_MODEL + i * 256 + lane * 4;
            float4 a; if constexpr (X16) { const ushort4 s4 = *(const ushort4*)((const bf16_t*)src + o); a = make_float4(bf2f(s4.x), bf2f(s4.y), bf2f(s4.z), bf2f(s4.w)); } else a = *(const float4*)(src + o);
            if (add0) { const size_t o2 = (size_t)row * 2 * D_MODEL + i * 256 + lane * 4; const ushort4 b = *(const ushort4*)(add0 + o2), c = *(const ushort4*)(add1 + o2);
                a.x += bf2f(b.x) + bf2f(c.x); a.y += bf2f(b.y) + bf2f(c.y); a.z += bf2f(b.z) + bf2f(c.z); a.w += bf2f(b.w) + bf2f(c.w); }
            if (sumdst) { if constexpr (X16) { ushort4 q4; q4.x = f2bf(a.x); q4.y = f2bf(a.y); q4.z = f2bf(a.z); q4.w = f2bf(a.w); *(ushort4*)((bf16_t*)sumdst + o) = q4; } else *(float4*)(sumdst + o) = a; }
            v[i] = a; ss += a.x * a.x + a.y * a.y + a.z * a.z + a.w * a.w;
        }
        ss = wave_sum(ss);
        const float rinv = rsqrtf(ss * (1.f / D_MODEL) + NORM_EPS);
#pragma unroll
        for (int i = 0; i < 8; ++i) {
            const int c = i * 256 + lane * 4; const float4 gg = *(const float4*)(g + c);
            if constexpr (F8) { const float rs = rinv * F8_SX; *(unsigned*)((char*)dst + (size_t)row * D_MODEL + c) = pk8(v[i].x * rs * gg.x, v[i].y * rs * gg.y, v[i].z * rs * gg.z, v[i].w * rs * gg.w); }
            else { ushort4 o; o.x = f2bf(v[i].x * rinv * gg.x); o.y = f2bf(v[i].y * rinv * gg.y); o.z = f2bf(v[i].z * rinv * gg.z); o.w = f2bf(v[i].w * rinv * gg.w);
                *(ushort4*)(dst + (size_t)row * D_MODEL + c) = o; }
        }
    }
}

DEV void ph_rope_table(const P& p, int bid, int nb) {
    for (int i = bid * NTHREADS + tidx(); i < SEQ * 64; i += nb * NTHREADS) {
        const int pos = i >> 6, j = i & 63;
        const double inv = exp(-log(10000.0) * (double)j / 64.0);
        const float invf = (float)inv;
        const float ang = (float)pos * invf;
        p.rope[i * 2] = (float)cos((double)ang); p.rope[i * 2 + 1] = (float)sin((double)ang);
    }
}

DEV void ph_cmp_attn(const P& p, float* lds, int bid, int nb) {
    const int lane = tidx() & 63, wid = tidx() >> 6;
    float* qs = lds + wid * 640; float* ps = qs + 512;
    float* ocmp = (float*)(p.big + BIG_NSA_OCMP);
    const bf16_t* Q = (const bf16_t*)(p.big + BIG_NSA_Q);
    const float scale = 0.08838834764831845f;
    const bf16_t* kc = (const bf16_t*)(p.big + BIG_NSA_KVC); const bf16_t* vc = kc + (size_t)2048 * 128;
    for (int u = bid * 8 + wid; u < T * NKV; u += nb * 8) {
        const int g = u & 3, tok = u >> 2, b = tok / SEQ, t = tok % SEQ;
        const int ncv = t >= 31 ? (t - 31) / 16 + 1 : 0;
        const bf16_t* qrow = Q + (size_t)tok * 2048 + g * 4 * 128;
#pragma unroll
        for (int i = 0; i < 8; ++i) qs[lane + 64 * i] = bf2f(qrow[lane + 64 * i]);
        float psum0 = 0.f, psum1 = 0.f;
        for (int r = 0; r < 4; ++r) {
            float s0 = -INFINITY, s1 = -INFINITY;
            if (lane < ncv) { const bf16_t* kr = kc + ((size_t)((b * 4 + g) * 128 + lane)) * 128; float a = 0.f; for (int d = 0; d < 128; ++d) a = fmaf(qs[r * 128 + d], bf2f(kr[d]), a); s0 = a * scale; }
            if (lane + 64 < ncv) { const bf16_t* kr = kc + ((size_t)((b * 4 + g) * 128 + lane + 64)) * 128; float a = 0.f; for (int d = 0; d < 128; ++d) a = fmaf(qs[r * 128 + d], bf2f(kr[d]), a); s1 = a * scale; }
            float p0 = 0.f, p1 = 0.f;
            if (ncv > 0) {
                const float m = wave_max(fmaxf(s0, s1));
                const float e0 = lane < ncv ? expf(s0 - m) : 0.f, e1 = lane + 64 < ncv ? expf(s1 - m) : 0.f;
                const float sum = wave_sum(e0 + e1);
                p0 = e0 / sum; p1 = e1 / sum;
            }
            psum0 += p0; psum1 += p1;
            float o0 = 0.f, o1 = 0.f;
            for (int c = 0; c < ncv; ++c) {
                const float pc = c < 64 ? __shfl(p0, c) : __shfl(p1, c - 64);
                const bf16_t* vr = vc + ((size_t)((b * 4 + g) * 128 + c)) * 128;
                o0 = fmaf(pc, bf2f(vr[lane]), o0); o1 = fmaf(pc, bf2f(vr[lane + 64]), o1);
            }
            float* orow = ocmp + (size_t)tok * 2048 + (g * 4 + r) * 128;
            orow[lane] = o0; orow[lane + 64] = o1;
        }
        ps[lane] = psum0; ps[lane + 64] = psum1;
        float val = -INFINITY;
        const int j = lane;
        if (j < 32) {
            float imp = ps[4 * j] + ps[4 * j + 1] + ps[4 * j + 2] + 0.5f * ps[4 * j + 3] + (j > 0 ? 0.5f * ps[4 * j - 1] : 0.f);
            const int dist = (t >> 6) - j;
            const bool forced = (j == 0) || (dist >= 0 && dist < 2);
            val = forced ? 1e4f : imp;
            if (dist < 0) val = -INFINITY;
        }
        int rank = 0;
        for (int i = 0; i < 32; ++i) { const float vi = __shfl(val, i); rank += (vi > val || (vi == val && i < j)) ? 1 : 0; }
        const unsigned long long bal = __ballot(j < 32 && rank < 16);
        if (lane == 0) p.selmask[(size_t)(b * NKV + g) * SEQ + t] = (unsigned)bal;
    }
}

DEV void attend_wave(const bf16_t* Kb, const bf16_t* Vb, const float* qs, int b, int g, unsigned bmask, int lo, int hi, int lane, float& o0, float& o1) {
    const float scale = 0.08838834764831845f;
    float m = -INFINITY, l = 0.f; o0 = 0.f; o1 = 0.f;
    for (int j = lo >> 6; j <= (hi >> 6); ++j) {
        if (!((bmask >> j) & 1u)) continue;
        const int key = j * 64 + lane; const bool valid = key >= lo && key <= hi;
        float s = -INFINITY;
        if (valid) { const bf16_t* kr = Kb + (size_t)(b * SEQ + key) * 512 + g * 128; float a = 0.f;
            for (int d = 0; d < 128; d += 4) { const ushort4 kv = *(const ushort4*)(kr + d); a = fmaf(qs[d], bf2f(kv.x), a); a = fmaf(qs[d + 1], bf2f(kv.y), a); a = fmaf(qs[d + 2], bf2f(kv.z), a); a = fmaf(qs[d + 3], bf2f(kv.w), a); }
            s = a * scale; }
        const float bm = wave_max(s);
        if (bm == -INFINITY) continue;
        const float mn = fmaxf(m, bm), alpha = expf(m - mn);
        const float pr = valid ? expf(s - mn) : 0.f;
        l = l * alpha + wave_sum(pr); o0 *= alpha; o1 *= alpha; m = mn;
        for (int kk = 0; kk < 64; ++kk) {
            const float pk = __shfl(pr, kk);
            if (pk != 0.f) { const bf16_t* vr = Vb + (size_t)(b * SEQ + j * 64 + kk) * 512 + g * 128; o0 = fmaf(pk, bf2f(vr[lane]), o0); o1 = fmaf(pk, bf2f(vr[lane + 64]), o1); }
        }
    }
    const float inv = 1.f / l; o0 *= inv; o1 *= inv;
}

DEV void ph_attn_sw(const P& p, float* lds, int bid, int nb) {
    const int lane = tidx() & 63, wid = tidx() >> 6;
    float* qs = lds + wid * 128;
    const float* ocmp = (const float*)(p.big + BIG_NSA_OCMP); bf16_t* obuf = (bf16_t*)(p.big + BIG_NSA_OBUF);
    const bf16_t* Q = (const bf16_t*)(p.big + BIG_NSA_Q); const float* gate = (const float*)(p.big + BIG_NSA_GATE);
    const bf16_t* KS = (const bf16_t*)(p.big + BIG_NSA_KS); const bf16_t* VS = (const bf16_t*)(p.big + BIG_NSA_VS);
    const bf16_t* KW = (const bf16_t*)(p.big + BIG_NSA_KW); const bf16_t* VW = (const bf16_t*)(p.big + BIG_NSA_VW);
    for (int u = bid * 8 + wid; u < T * NH; u += nb * 8) {
        const int h = u & 15, tok = u >> 4, b = tok / SEQ, t = tok % SEQ, g = h >> 2;
        const bf16_t* qrow = Q + (size_t)tok * 2048 + h * 128;
        qs[lane] = bf2f(qrow[lane]); qs[lane + 64] = bf2f(qrow[lane + 64]);
        const unsigned sm = p.selmask[(size_t)(b * NKV + g) * SEQ + t];
        float s0, s1, w0, w1;
        attend_wave(KS, VS, qs, b, g, sm, 0, t, lane, s0, s1);
        attend_wave(KW, VW, qs, b, g, 0xffffffffu, t - (WINDOW - 1) > 0 ? t - (WINDOW - 1) : 0, t, lane, w0, w1);
        const float* gl = gate + (size_t)tok * 48 + h * 3;
        const float g0 = gl[0], g1 = gl[1], g2 = gl[2];
        const float* oc = ocmp + (size_t)tok * 2048 + h * 128;
        bf16_t* ob = obuf + (size_t)tok * 2048 + h * 128;
        ob[lane] = f2bf(g0 * oc[lane] + g1 * s0 + g2 * w0);
        ob[lane + 64] = f2bf(g0 * oc[lane + 64] + g1 * s1 + g2 * w1);
    }
}

namespace at {
typedef float f32x16 __attribute__((ext_vector_type(16)));
typedef short s16x4 __attribute__((ext_vector_type(4)));
constexpr int SHM = 16384;
constexpr float SCALE = 0.08838834764831845f, C2 = 1.4426950408889634f * SCALE, THR = 8.f;
#define AT_KSWZ(row, colB) ((row) * 256 + ((colB) ^ (((row) & 7) << 4)))
DEV int v_st(int k, int c) { const int kk = (k & ~0xC) | ((k & 4) << 1) | ((k & 8) >> 1); return ((kk >> 3) * 4 + (c >> 5)) * 512 + ((kk & 7) * 32 + (c & 31)) * 2; }
DEV int v_rd_base(int lane) { return ((lane & 3) << 3) | (((lane >> 2) & 3) << 6) | (((lane >> 4) & 1) << 5) | (((lane >> 5) & 1) << 8); }
DEV int crow(int r, int hi) { return (r & 3) + 8 * (r >> 2) + 4 * hi; }
DEV unsigned cvtpk(float lo, float hi) { unsigned r; asm volatile("v_cvt_pk_bf16_f32 %0, %1, %2" : "=v"(r) : "v"(lo), "v"(hi)); return r; }
DEV float swap_max(float x) { auto rr = __builtin_amdgcn_permlane32_swap(__float_as_uint(x), __float_as_uint(x), false, false); return fmaxf(__uint_as_float(rr[0]), __uint_as_float(rr[1])); }
DEV float swap_sum(float x) { auto rr = __builtin_amdgcn_permlane32_swap(__float_as_uint(x), __float_as_uint(x), false, false); return __uint_as_float(rr[0]) + __uint_as_float(rr[1]); }
#define AT_PK4(P, B_, OUT) do { unsigned a0 = cvtpk(P[B_+0], P[B_+1]), a1 = cvtpk(P[B_+2], P[B_+3]); unsigned b0 = cvtpk(P[B_+4], P[B_+5]), b1 = cvtpk(P[B_+6], P[B_+7]); \
        auto r0 = __builtin_amdgcn_permlane32_swap(a0, b0, false, false); auto r1 = __builtin_amdgcn_permlane32_swap(a1, b1, false, false); \
        u32x4 w = {r0[0], r1[0], r0[1], r1[1]}; OUT = *reinterpret_cast<bf16x8*>(&w); } while (0)
DEV void qkt(f32x16& p0, f32x16& p1, const char* Kl, int r32, int hi, const bf16x8* qr) {
    p0 = f32x16{}; p1 = f32x16{};
    const char* kb[4];
#pragma unroll
    for (int dd = 0; dd < 4; ++dd) kb[dd] = Kl + AT_KSWZ(r32, (dd * 16 + hi * 8) * 2);
#pragma unroll
    for (int d0 = 0; d0 < 8; ++d0) { const char* a = kb[d0 & 3] + (d0 >> 2) * 128;
        const bf16x8 b0 = *reinterpret_cast<const bf16x8*>(a), b1 = *reinterpret_cast<const bf16x8*>(a + 32 * 256);
        p0 = __builtin_amdgcn_mfma_f32_32x32x16_bf16(b0, qr[d0], p0, 0, 0, 0);
        p1 = __builtin_amdgcn_mfma_f32_32x32x16_bf16(b1, qr[d0], p1, 0, 0, 0); }
}
DEV void pv_tile(f32x16* o, int vb0, bf16x8 pa0, bf16x8 pa1, bf16x8 pa2, bf16x8 pa3) {
#define AT_TRRD(dst, off) asm volatile("ds_read_b64_tr_b16 %0, %1 offset:%2" : "=&v"(dst) : "v"(vb0), "i"(off) : "memory")
#define AT_RD8(S, d0) do { constexpr int b_ = (d0) * 512; AT_TRRD(S##l0, b_); AT_TRRD(S##h0, b_ + 2048); AT_TRRD(S##l1, b_ + 4096); AT_TRRD(S##h1, b_ + 6144); \
        AT_TRRD(S##l2, b_ + 8192); AT_TRRD(S##h2, b_ + 10240); AT_TRRD(S##l3, b_ + 12288); AT_TRRD(S##h3, b_ + 14336); } while (0)
#define AT_MM4(S, d0) do { \
        o[d0] = __builtin_amdgcn_mfma_f32_32x32x16_bf16(pa0, (bf16x8){S##l0[0], S##l0[1], S##l0[2], S##l0[3], S##h0[0], S##h0[1], S##h0[2], S##h0[3]}, o[d0], 0, 0, 0); \
        o[d0] = __builtin_amdgcn_mfma_f32_32x32x16_bf16(pa1, (bf16x8){S##l1[0], S##l1[1], S##l1[2], S##l1[3], S##h1[0], S##h1[1], S##h1[2], S##h1[3]}, o[d0], 0, 0, 0); \
        o[d0] = __builtin_amdgcn_mfma_f32_32x32x16_bf16(pa2, (bf16x8){S##l2[0], S##l2[1], S##l2[2], S##l2[3], S##h2[0], S##h2[1], S##h2[2], S##h2[3]}, o[d0], 0, 0, 0); \
        o[d0] = __builtin_amdgcn_mfma_f32_32x32x16_bf16(pa3, (bf16x8){S##l3[0], S##l3[1], S##l3[2], S##l3[3], S##h3[0], S##h3[1], S##h3[2], S##h3[3]}, o[d0], 0, 0, 0); } while (0)
#define AT_WAIT(n) do { asm volatile("s_waitcnt lgkmcnt(" #n ")" ::: "memory"); __builtin_amdgcn_sched_barrier(0); } while (0)
    s16x4 xl0, xl1, xl2, xl3, xh0, xh1, xh2, xh3, yl0, yl1, yl2, yl3, yh0, yh1, yh2, yh3;
    AT_RD8(x, 0); AT_RD8(y, 1);
    AT_WAIT(8); AT_MM4(x, 0);
    __builtin_amdgcn_sched_barrier(0); AT_RD8(x, 2);
    AT_WAIT(8); AT_MM4(y, 1);
    __builtin_amdgcn_sched_barrier(0); AT_RD8(y, 3);
    AT_WAIT(8); AT_MM4(x, 2);
    AT_WAIT(0); AT_MM4(y, 3);
#undef AT_WAIT
#undef AT_MM4
#undef AT_RD8
#undef AT_TRRD
}
DEV void mask_tile(f32x16& p0, f32x16& p1, int lo, int hi_, int hi) {
    const float NEG = -__builtin_inff(); const unsigned w = (unsigned)(hi_ - lo); const int base = 4 * hi - lo;
#pragma unroll
    for (int r = 0; r < 16; ++r) { const int cr = (r & 3) + 8 * (r >> 2);
        if ((unsigned)(cr + base) > w) p0[r] = NEG;
        if ((unsigned)(cr + 32 + base) > w) p1[r] = NEG; }
}
struct Ctx { char* L; int tid, wid, lane, r32, hi; unsigned ksrc[2], vsrc[2]; float* li_l; float* al_l; };
#define AT_STAGE(Kp, Vp, pitch, kb, vb) do { _Pragma("unroll") for (int _i = 0; _i < 2; ++_i) { unsigned ks_ = c.ksrc[_i], vs_ = c.vsrc[_i]; asm volatile("" : "+v"(ks_), "+v"(vs_));     \
        __builtin_amdgcn_global_load_lds((const unsigned*)((Kp) + (size_t)(ks_ >> 16) * (pitch) + (ks_ & 0xffffu)), (MG_LAS unsigned*)((MG_LAS char*)(c.L) + (kb) * SHM + c.wid * 1024 + _i * 8192), 16, 0, 0); \
        __builtin_amdgcn_global_load_lds((const unsigned*)((Vp) + (size_t)(vs_ >> 16) * (pitch) + (vs_ & 0xffffu)), (MG_LAS unsigned*)((MG_LAS char*)(c.L) + 2 * SHM + (vb) * SHM + c.wid * 1024 + _i * 8192), 16, 0, 0); } } while (0)
#define AT_RESC(a) do { if (__any((a) < 1.f)) { if (c.hi == 0) c.al_l[c.r32] = (a); asm volatile("s_waitcnt lgkmcnt(0)" ::: "memory"); \
        _Pragma("unroll") for (int d_ = 0; d_ < 4; ++d_) _Pragma("unroll") for (int r = 0; r < 16; ++r) o[d_][r] *= c.al_l[crow(r, c.hi)]; } } while (0)

template <int MODE>
DEV void branch(const Ctx& c, const bf16_t* Kb, const bf16_t* Vb  , unsigned tiles, int i, int tl, unsigned smask, const bf16x8* qr, f32x16* o, float& l_reg) {
    float m_reg = -1e30f; l_reg = 0.f;
#pragma unroll
    for (int d = 0; d < 4; ++d) o[d] = f32x16{};
    unsigned rem = tiles; int j = __builtin_ctz(rem); rem &= rem - 1; int buf = 0;
    AT_STAGE(Kb + (size_t)j * 64 * 512, Vb + (size_t)j * 64 * 512, 512, 0, 0);
    __syncthreads();
    for (;;) {
        const bool more = rem != 0u; int jn = j;
        if (more) { jn = __builtin_ctz(rem); rem &= rem - 1; AT_STAGE(Kb + (size_t)jn * 64 * 512, Vb + (size_t)jn * 64 * 512, 512, buf ^ 1, buf ^ 1); }
        int lo, hi_;
        if (MODE == 1) { const bool sel = (smask >> j) & 1u; lo = sel ? 0 : 100; hi_ = sel ? (j == i ? tl : 63) : 100; }
        else { const int a = tl + 64 * (i - j); hi_ = a < 63 ? a : 63; lo = a - 511 > 0 ? a - 511 : 0; if (lo > 63) { lo = 100; hi_ = 100; } }
        if (__any(lo <= 63)) {
        f32x16 p0, p1;
        qkt(p0, p1, c.L + buf * SHM, c.r32, c.hi, qr);
        if (!__all(lo <= 0 && hi_ >= 63)) {
            if (MODE == 1 && j != i) { const bool keep = lo == 0; const float NEG = -__builtin_inff();
#pragma unroll
                for (int r = 0; r < 16; ++r) { p0[r] = keep ? p0[r] : NEG; p1[r] = keep ? p1[r] : NEG; } }
            else mask_tile(p0, p1, lo, hi_, c.hi);
        }
        float pmax = p0[0];
#pragma unroll
        for (int r = 1; r < 16; ++r) pmax = fmaxf(pmax, p0[r]);
#pragma unroll
        for (int r = 0; r < 16; ++r) pmax = fmaxf(pmax, p1[r]);
        pmax = swap_max(pmax);
        float mn, alpha;
        if (__all((pmax - m_reg) * SCALE <= THR)) { mn = m_reg; alpha = 1.f; }
        else { mn = fmaxf(m_reg, pmax); alpha = __builtin_amdgcn_exp2f((m_reg - mn) * C2); m_reg = mn; }
        const float mnL = -mn * C2; float ps = 0.f;
#pragma unroll
        for (int r = 0; r < 16; ++r) { p0[r] = __builtin_amdgcn_exp2f(fmaf(p0[r], C2, mnL)); p1[r] = __builtin_amdgcn_exp2f(fmaf(p1[r], C2, mnL)); ps += p0[r] + p1[r]; }
        ps = swap_sum(ps);
        l_reg = l_reg * alpha + ps;
        bf16x8 pa0, pa1, pa2, pa3;
        AT_PK4(p0, 0, pa0); AT_PK4(p0, 8, pa1); AT_PK4(p1, 0, pa2); AT_PK4(p1, 8, pa3);
        AT_RESC(alpha);
        pv_tile(o, (int)(uintptr_t)(c.L + 2 * SHM + buf * SHM) + v_rd_base(c.lane), pa0, pa1, pa2, pa3);
        }
        __syncthreads();
        if (!more) break;
        j = jn; buf ^= 1;
    }
}
template <int MODE>
DEV void branch_acc(const Ctx& c, const f32x16* o, float rowscale, char* stash_w  , bf16_t* obuf, size_t orow0) {
    int hi = c.hi, r32 = c.r32, ln = c.lane; asm volatile("" : "+v"(hi), "+v"(r32), "+v"(ln));
    float* li = c.li_l; asm volatile("" : "+v"(li));
    if (hi == 0) li[r32] = rowscale;
    asm volatile("s_waitcnt lgkmcnt(0)" ::: "memory");
    float sc[16];
#pragma unroll
    for (int r = 0; r < 16; ++r) sc[r] = li[(r & 3) + 8 * (r >> 2) + 4 * hi];
    char* sp = stash_w + ln * 16;
#pragma unroll
    for (int jg = 0; jg < 8; ++jg) {
        u32x4 w = {0u, 0u, 0u, 0u};
        if (MODE != 0) w = *(const u32x4*)(sp + jg * 1024);
        const int d0 = jg >> 1;
        float v0[4], v1[4];
#pragma unroll
        for (int k = 0; k < 4; ++k) { const int r = 8 * (jg & 1) + 2 * k;
            float t0 = o[d0][r] * sc[r], t1 = o[d0][r + 1] * sc[r + 1];
            if (MODE != 0) { t0 += __uint_as_float(w[k] << 16); t1 += __uint_as_float(w[k] & 0xffff0000u); }
            if (MODE != 2) w[k] = cvtpk(t0, t1);
            v0[k] = t0; v1[k] = t1; }
        if (MODE == 2) {
            const int kq = r32 & 3; quad_transpose(v0, kq); quad_transpose(v1, kq);
            const int rl = 8 * (jg & 1) + 2 * kq; const size_t ob = orow0 + (size_t)(r32 & ~3) + (size_t)(4 * hi) * 2048 + d0 * 32;
            *(unsigned*)((char*)obuf + ob + (size_t)((rl & 3) + 8 * (rl >> 2)) * 2048) = pk8(v0[0] * F8_SO, v0[1] * F8_SO, v0[2] * F8_SO, v0[3] * F8_SO);
            *(unsigned*)((char*)obuf + ob + (size_t)(((rl + 1) & 3) + 8 * ((rl + 1) >> 2)) * 2048) = pk8(v1[0] * F8_SO, v1[1] * F8_SO, v1[2] * F8_SO, v1[3] * F8_SO); }
        if (MODE != 2) *(u32x4*)(sp + jg * 1024) = w;
    }
}
}

DEV void ph_attn_mfma(const P& p, char* L  , int bid, int nb) {
    using namespace at;
    Ctx c; c.L = L; c.tid = tidx(); c.wid = __builtin_amdgcn_readfirstlane(c.tid >> 6); c.lane = c.tid & 63; c.r32 = c.lane & 31; c.hi = c.lane >> 5;
#pragma unroll
    for (int i = 0; i < 2; ++i) { const int pos = c.tid * 16 + i * 8192;
        { const int row = pos >> 8, ch = ((pos >> 4) & 15) ^ (row & 7); c.ksrc[i] = (unsigned)(row << 16) | (unsigned)(ch * 8); }
        { const int sub = pos >> 9, w = (pos & 511) >> 1, kk = (sub >> 2) * 8 + (w >> 5), k = (kk & ~0xC) | ((kk & 4) << 1) | ((kk & 8) >> 1), col = (sub & 3) * 32 + (w & 31);
          c.vsrc[i] = (unsigned)(k << 16) | (unsigned)col; } }
    float* wsf = (float*)(L + 4 * SHM) + c.wid * 64; c.li_l = wsf; c.al_l = wsf + 32;
    unsigned* selm = (unsigned*)(L + 4 * SHM + 2048);
    unsigned* um = selm + 64;
    char* stash = L + 4 * SHM + 2560;
    float* impbuf = (float*)stash;
    float* impsum = impbuf + 4 * 64 * 33;
    const bf16_t* Q = (const bf16_t*)(p.big + BIG_NSA_Q); const float* gate = (const float*)(p.big + BIG_NSA_GATE);
    const bf16_t* KS = (const bf16_t*)(p.big + BIG_NSA_KS); const bf16_t* VS = (const bf16_t*)(p.big + BIG_NSA_VS);
    const bf16_t* KW = (const bf16_t*)(p.big + BIG_NSA_KW); const bf16_t* VW = (const bf16_t*)(p.big + BIG_NSA_VW);
    const bf16_t* KC = (const bf16_t*)(p.big + BIG_NSA_KVC); const bf16_t* VC = KC + (size_t)2048 * 128;
    bf16_t* obuf = (bf16_t*)(p.big + BIG_NSA_OBUF);
    const int rq = c.wid & 3, th = c.wid >> 2, tl = 32 * th + c.r32;
    for (int pr0 = bid; pr0 < 256; pr0 += nb) {
        const int pr = (nb == 256) ? ((pr0 & 7) * 32 + (pr0 >> 3)) : pr0;
        const int bg = pr >> 4, b = bg >> 2, g = bg & 3, ii = pr & 15;
#pragma unroll 1
        for (int pass = 0; pass < 2; ++pass) {
            const int i = pass == 0 ? 31 - ii : ii;
            const int hq = 4 * g + rq, tok0 = b * SEQ + 64 * i, tq = 64 * i + tl;
            bf16x8 qr[8];
            { int hiq = c.hi, tlq = tl; asm volatile("" : "+v"(hiq), "+v"(tlq));
              const bf16_t* qp = Q + (size_t)(tok0 + tlq) * 2048 + hq * 128 + hiq * 8;
#pragma unroll
              for (int d0 = 0; d0 < 8; ++d0) qr[d0] = *(const bf16x8*)(qp + d0 * 16); }
            f32x16 o[4]; float l_reg;
            const size_t orow0 = (size_t)(tok0 + 32 * th) * 2048 + hq * 128;
            {
                const bf16_t* kc = KC + (size_t)(bg * 128) * 128; const bf16_t* vc = VC + (size_t)(bg * 128) * 128;
                AT_STAGE(kc, vc, 128, 0, 0);
                AT_STAGE(kc + 64 * 128, vc + 64 * 128, 128, 1, 1);
                __syncthreads();
                f32x16 pA0, pA1, pB0, pB1;
                qkt(pA0, pA1, c.L, c.r32, c.hi, qr); qkt(pB0, pB1, c.L + SHM, c.r32, c.hi, qr);
                const int cmax = tq >= 31 ? (tq - 31) >> 4 : -1;
                { int lo = 0, hi_ = cmax < 63 ? cmax : 63; if (cmax < 0) { lo = 100; hi_ = 100; } mask_tile(pA0, pA1, lo, hi_, c.hi); }
                { int lo = 0, hi_ = cmax - 64 < 63 ? cmax - 64 : 63; if (cmax < 64) { lo = 100; hi_ = 100; } mask_tile(pB0, pB1, lo, hi_, c.hi); }
                float pmax = -1e30f;
#pragma unroll
                for (int r = 0; r < 16; ++r) pmax = fmaxf(fmaxf(pmax, fmaxf(pA0[r], pA1[r])), fmaxf(pB0[r], pB1[r]));
                pmax = swap_max(pmax);
                const float mnL = -pmax * C2; float ps = 0.f;
#pragma unroll
                for (int r = 0; r < 16; ++r) { pA0[r] = __builtin_amdgcn_exp2f(fmaf(pA0[r], C2, mnL)); pA1[r] = __builtin_amdgcn_exp2f(fmaf(pA1[r], C2, mnL));
                    pB0[r] = __builtin_amdgcn_exp2f(fmaf(pB0[r], C2, mnL)); pB1[r] = __builtin_amdgcn_exp2f(fmaf(pB1[r], C2, mnL)); ps += (pA0[r] + pA1[r]) + (pB0[r] + pB1[r]); }
                ps = swap_sum(ps); l_reg = ps;
                const float inv_l = l_reg > 0.f ? 1.f / l_reg : 0.f;
                { float prev = 0.f; float* ib = impbuf + (rq * 64 + tl) * 33;
#define AT_IMPG(P, G0) _Pragma("unroll") for (int rg = 0; rg < 4; ++rg) { const float car = 0.5f * P[4 * rg + 3] * inv_l, own = (P[4 * rg] + P[4 * rg + 1] + P[4 * rg + 2]) * inv_l + car; \
                        const float rc = __shfl_xor(car, 32); ib[2 * ((G0) + rg) + c.hi] = own + (c.hi ? rc : prev); prev = rc; }
                  AT_IMPG(pA0, 0) AT_IMPG(pA1, 4) AT_IMPG(pB0, 8) AT_IMPG(pB1, 12)
#undef AT_IMPG
                }
                bf16x8 pa0, pa1, pa2, pa3;
#pragma unroll
                for (int d = 0; d < 4; ++d) o[d] = f32x16{};
                AT_PK4(pA0, 0, pa0); AT_PK4(pA0, 8, pa1); AT_PK4(pA1, 0, pa2); AT_PK4(pA1, 8, pa3);
                pv_tile(o, (int)(uintptr_t)(c.L + 2 * SHM) + v_rd_base(c.lane), pa0, pa1, pa2, pa3);
                AT_PK4(pB0, 0, pa0); AT_PK4(pB0, 8, pa1); AT_PK4(pB1, 0, pa2); AT_PK4(pB1, 8, pa3);
                pv_tile(o, (int)(uintptr_t)(c.L + 3 * SHM) + v_rd_base(c.lane), pa0, pa1, pa2, pa3);
                __syncthreads();
                { const int tk = c.tid >> 3, q4 = c.tid & 7; float val[4];
#pragma unroll
                  for (int e = 0; e < 4; ++e) { const int j = 4 * q4 + e; float v = impbuf[(0 * 64 + tk) * 33 + j] + impbuf[(1 * 64 + tk) * 33 + j] + impbuf[(2 * 64 + tk) * 33 + j] + impbuf[(3 * 64 + tk) * 33 + j];
                      const int dist = i - j; const bool forced = (j == 0) || (dist >= 0 && dist < 2); v = forced ? 1e4f : v; if (dist < 0) v = -__builtin_inff(); val[e] = v; impsum[tk * 32 + j] = v; }
                  __syncthreads();
                  int rank[4] = {0, 0, 0, 0};
                  for (int i2 = 0; i2 < 32; ++i2) { const float x = impsum[tk * 32 + i2];
#pragma unroll
                      for (int e = 0; e < 4; ++e) rank[e] += (x > val[e] || (x == val[e] && i2 < 4 * q4 + e)) ? 1 : 0; }
                  unsigned bits = 0u;
#pragma unroll
                  for (int e = 0; e < 4; ++e) bits |= (rank[e] < 16 ? 1u : 0u) << (4 * q4 + e);
                  bits |= __shfl_xor(bits, 1); bits |= __shfl_xor(bits, 2); bits |= __shfl_xor(bits, 4);
                  if (q4 == 0) selm[tk] = bits;
                  unsigned u = bits; u |= __shfl_xor(u, 8); u |= __shfl_xor(u, 16); u |= __shfl_xor(u, 32);
                  if (c.lane == 0) um[c.wid] = u; }
                __syncthreads();
                branch_acc<0>(c, o, gate[(size_t)(tok0 + tl) * 48 + hq * 3 + 0] * inv_l, stash + c.wid * 8192, obuf, orow0);
            }
            const unsigned smask = selm[tl];
            unsigned umask = um[0] | um[1] | um[2] | um[3] | um[4] | um[5] | um[6] | um[7];
            umask = __builtin_amdgcn_readfirstlane(umask) & ((2u << i) - 1u);
            branch<1>(c, KS + (size_t)b * SEQ * 512 + g * 128, VS + (size_t)b * SEQ * 512 + g * 128, umask, i, tl, smask, qr, o, l_reg);
            branch_acc<1>(c, o, gate[(size_t)(tok0 + tl) * 48 + hq * 3 + 1] / l_reg, stash + c.wid * 8192, obuf, orow0);
            { const int jlo = i - 8 > 0 ? i - 8 : 0; const unsigned wt = ((2u << i) - 1u) & ~((1u << jlo) - 1u);
              branch<2>(c, KW + (size_t)b * SEQ * 512 + g * 128, VW + (size_t)b * SEQ * 512 + g * 128, wt, i, tl, 0u, qr, o, l_reg); }
            branch_acc<2>(c, o, gate[(size_t)(tok0 + tl) * 48 + hq * 3 + 2] / l_reg, stash + c.wid * 8192, obuf, orow0);
            __syncthreads();
        }
    }
}

DEV void ph_moe_route(const P& p, int layer, const bf16_t* xin  , float* lds, int bid, int nb) {
    typedef float f32x16 __attribute__((ext_vector_type(16)));
    const int tid = tidx(), wid = __builtin_amdgcn_readfirstlane(tid >> 6), lane = tid & 63, i = lane & 31, kk = lane >> 5;
    float* part = lds;
    float* gpart = lds + 8192;
    float* spart = gpart + 1024;
    float* logit = spart + 256;
    float* rinv_l = logit + 32 * 36;
    int* lcnt = (int*)(rinv_l + 32);
    int* lbase = lcnt + 32;
    const float* wr = p.wr + (size_t)layer * D_MODEL * MOE_E; const float* wgq = p.wgq + (size_t)layer * D_MODEL * MOE_G;
    const float* g = p.ln_ffn + layer * D_MODEL;
    const float* bgrp = p.moe_b_group + layer * MOE_G; const float* bexp = p.moe_b_expert + layer * MOE_E;
    int* cnt = p.cnt + layer * MOE_E;
    for (int tb = bid; tb < T / 32; tb += nb) {
        const int tok0 = tb * 32;
        const bf16_t* xr = xin + (size_t)(tok0 + i) * D_MODEL + 256 * wid + 4 * kk;
        const float* wrow = wr + (size_t)(256 * wid + 4 * kk) * MOE_E + i;
        const float* wgrow = wgq + (size_t)(256 * wid + 4 * kk) * MOE_G;
        f32x16 acc = f32x16{}; float ss = 0.f; f32x4 ga = {0.f, 0.f, 0.f, 0.f};
#pragma unroll 4
        for (int j = 0; j < 32; ++j) {
            const u32x2 xw = *(const u32x2*)(xr + 8 * j); const f32x4 xv = {__uint_as_float(xw.x << 16), __uint_as_float(xw.x & 0xffff0000u), __uint_as_float(xw.y << 16), __uint_as_float(xw.y & 0xffff0000u)};
            const float* wp = wrow + (size_t)(8 * j) * MOE_E;
            const float b0 = wp[0], b1 = wp[MOE_E], b2 = wp[2 * MOE_E], b3 = wp[3 * MOE_E];
            const f32x4* gp = (const f32x4*)(wgrow + (size_t)(8 * j) * MOE_G);
            const f32x4 g0 = gp[0], g1 = gp[1], g2 = gp[2], g3 = gp[3];
            acc = __builtin_amdgcn_mfma_f32_32x32x2f32(xv[0], b0, acc, 0, 0, 0); acc = __builtin_amdgcn_mfma_f32_32x32x2f32(xv[1], b1, acc, 0, 0, 0);
            acc = __builtin_amdgcn_mfma_f32_32x32x2f32(xv[2], b2, acc, 0, 0, 0); acc = __builtin_amdgcn_mfma_f32_32x32x2f32(xv[3], b3, acc, 0, 0, 0);
            ss += xv[0] * xv[0] + xv[1] * xv[1] + xv[2] * xv[2] + xv[3] * xv[3];
            ga += g0 * xv[0] + g1 * xv[1] + g2 * xv[2] + g3 * xv[3];
        }
        ss += __shfl_xor(ss, 32);
#pragma unroll
        for (int q = 0; q < 4; ++q) ga[q] += __shfl_xor(ga[q], 32);
#pragma unroll
        for (int r = 0; r < 16; ++r) part[(wid * 32 + (r & 3) + 8 * (r >> 2) + 4 * kk) * 32 + i] = acc[r];
        if (kk == 0) { *(f32x4*)(gpart + (wid * 32 + i) * 4) = ga; spart[wid * 32 + i] = ss; }
        __syncthreads();
#pragma unroll
        for (int e = 0; e < 2; ++e) { const int idx = tid + e * 512, tk = idx >> 5, o = idx & 31; float sm = 0.f;
#pragma unroll
            for (int w = 0; w < 8; ++w) sm += part[(w * 32 + tk) * 32 + o];
            logit[tk * 36 + o] = sm; }
        if (tid < 128) { const int tk = tid >> 2, q = tid & 3; float sm = 0.f;
#pragma unroll
            for (int w = 0; w < 8; ++w) sm += gpart[(w * 32 + tk) * 4 + q];
            logit[tk * 36 + 32 + q] = sm; }
        if (tid < 32) { float sm = 0.f;
#pragma unroll
            for (int w = 0; w < 8; ++w) sm += spart[w * 32 + tid];
            rinv_l[tid] = rsqrtf(sm * (1.f / D_MODEL) + NORM_EPS); lcnt[tid] = 0; }
        __syncthreads();
        if (tid < 32) { const int tok = tok0 + tid; const float rinv = rinv_l[tid]; const float* lg = logit + tid * 36;
            float gl[4]; for (int q = 0; q < 4; ++q) gl[q] = lg[32 + q] * rinv + bgrp[q];
            int gs = 0; float gm = gl[0]; for (int q = 1; q < 4; ++q) if (gl[q] > gm) { gm = gl[q]; gs = q; }
            float gsum = 0.f; for (int q = 0; q < 4; ++q) gsum += expf(gl[q] - gm);
            const float gw = 1.f / gsum;
            float ev[8]; for (int q = 0; q < 8; ++q) ev[q] = lg[gs * 8 + q] * rinv + bexp[gs * 8 + q];
            int i1 = 0; for (int q = 1; q < 8; ++q) if (ev[q] > ev[i1]) i1 = q;
            int i2 = i1 == 0 ? 1 : 0; for (int q = 0; q < 8; ++q) if (q != i1 && ev[q] > ev[i2]) i2 = q;
            const float e2 = expf(ev[i2] - ev[i1]); const float w1 = gw / (1.f + e2), w2 = gw * e2 / (1.f + e2);
            const int ea = gs * 8 + i1, eb = gs * 8 + i2;
            const int ra = atomicAdd(&lcnt[ea], 1), rb = atomicAdd(&lcnt[eb], 1);
            asm volatile("s_waitcnt lgkmcnt(0)" ::: "memory");
            const int mine = lcnt[tid]; int base = 0; if (mine) base = atomicAdd(&cnt[tid], mine);
            lbase[tid] = base;
            asm volatile("s_waitcnt lgkmcnt(0)" ::: "memory");
            p.list[ea * T + lbase[ea] + ra] = tok * 2; p.lw[ea * T + lbase[ea] + ra] = w1;
            p.list[eb * T + lbase[eb] + rb] = tok * 2 + 1; p.lw[eb * T + lbase[eb] + rb] = w2; }
#pragma unroll
        for (int tt = 0; tt < 4; ++tt) { const int tok = tok0 + 4 * wid + tt; const float rinv = rinv_l[4 * wid + tt];
#pragma unroll
            for (int ii = 0; ii < 8; ++ii) { const int c = ii * 256 + lane * 4; const u32x2 xw = *(const u32x2*)(xin + (size_t)tok * D_MODEL + c); const f32x4 xv = {__uint_as_float(xw.x << 16), __uint_as_float(xw.x & 0xffff0000u), __uint_as_float(xw.y << 16), __uint_as_float(xw.y & 0xffff0000u)}, gg = *(const f32x4*)(g + c);
                const float rs = rinv * F8_SX;
                *(unsigned*)((char*)p.hb16 + (size_t)tok * D_MODEL + c) = pk8(xv[0] * rs * gg[0], xv[1] * rs * gg[1], xv[2] * rs * gg[2], xv[3] * rs * gg[3]); } }
        __syncthreads();
    }
}

namespace ssd {
using namespace at;
constexpr int OFF_CK = 0, OFF_BK = 32768, OFF_BV = 65536, OFF_XV = 98304, OFF_XS = 114688, OFF_PV = 131072, OFF_TB = 147456;
DEV int v64_st(int k, int c) { const int kk = (k & ~0xC) | ((k & 4) << 1) | ((k & 8) >> 1); return ((kk >> 3) * 2 + (c >> 5)) * 512 + ((kk & 7) * 32 + (c & 31)) * 2; }
#define SD_TRRD(dst, base, off) asm volatile("ds_read_b64_tr_b16 %0, %1 offset:%2" : "=&v"(dst) : "v"(base), "i"(off) : "memory")
#define SD_MK(lo, hi) ((bf16x8){lo[0], lo[1], lo[2], lo[3], hi[0], hi[1], hi[2], hi[3]})
DEV float conv8(const bf16x8& r0, const bf16x8& r1, const bf16x8& r2, const bf16x8& r3, const float (&w)[4][8], const float (&bias)[8], int j) {
    float a = bias[j]; a = fmaf(bf2f((bf16_t)r0[j]), w[0][j], a); a = fmaf(bf2f((bf16_t)r1[j]), w[1][j], a); a = fmaf(bf2f((bf16_t)r2[j]), w[2][j], a); a = fmaf(bf2f((bf16_t)r3[j]), w[3][j], a);
    return a / (1.f + __expf(-a));
}
}

DEV void ph_ssd_conv_bc(const P& p, int bid, int nb) {
    using namespace ssd;
    const bf16_t* xp = (const bf16_t*)(p.big + BIG_SSD_XBCP); bf16_t* bc = (bf16_t*)(p.big + BIG_SSD_BC);
    const bf16x8 zero8 = {0, 0, 0, 0, 0, 0, 0, 0};
    for (int it = bid * NTHREADS + tidx(); it < (T / 16) * 256; it += nb * NTHREADS) {
        const int cg = it & 255, tb = it >> 8, ch = SSD_DI + cg * 8, t0 = (tb * 16) & (SEQ - 1); const size_t tok0 = (size_t)tb * 16;
        float w[4][8], bias[8];
#pragma unroll
        for (int k = 0; k < 4; ++k) { const f32x4 w0 = *(const f32x4*)(p.ssd_conv_w + k * SSD_CONVCH + ch), w1 = *(const f32x4*)(p.ssd_conv_w + k * SSD_CONVCH + ch + 4);
#pragma unroll
            for (int j = 0; j < 4; ++j) { w[k][j] = w0[j]; w[k][4 + j] = w1[j]; } }
        { const f32x4 b0 = *(const f32x4*)(p.ssd_conv_b + ch), b1 = *(const f32x4*)(p.ssd_conv_b + ch + 4);
#pragma unroll
          for (int j = 0; j < 4; ++j) { bias[j] = b0[j]; bias[4 + j] = b1[j]; } }
        bf16x8 r0 = t0 >= 3 ? *(const bf16x8*)(xp + (tok0 - 3) * SSD_CONVCH + ch) : zero8, r1 = t0 >= 2 ? *(const bf16x8*)(xp + (tok0 - 2) * SSD_CONVCH + ch) : zero8,
               r2 = t0 >= 1 ? *(const bf16x8*)(xp + (tok0 - 1) * SSD_CONVCH + ch) : zero8;
#pragma unroll 8
        for (int i = 0; i < 16; ++i) { const bf16x8 r3 = *(const bf16x8*)(xp + (tok0 + i) * SSD_CONVCH + ch); float o[8];
#pragma unroll
            for (int j = 0; j < 8; ++j) o[j] = conv8(r0, r1, r2, r3, w, bias, j);
            u32x4 pk; pk.x = cvtpk(o[0], o[1]); pk.y = cvtpk(o[2], o[3]); pk.z = cvtpk(o[4], o[5]); pk.w = cvtpk(o[6], o[7]);
            *(u32x4*)(bc + (tok0 + i) * 2048 + cg * 8) = pk; r0 = r1; r1 = r2; r2 = r3; }
    }
}

DEV void ph_ssd_mfma(const P& p, char* L, int bid, int nb) {
    using namespace ssd;
    const int tid = tidx(), wid = __builtin_amdgcn_readfirstlane(tid >> 6), lane = tid & 63;
    const int lb = wid & 3, pb = wid >> 2, nbk = wid & 3;
    const bf16_t* xp = (const bf16_t*)(p.big + BIG_SSD_XBCP); const bf16_t* bc = (const bf16_t*)(p.big + BIG_SSD_BC);
    bf16_t* yb = (bf16_t*)(p.big + BIG_SSD_YN);
    float* tabs = (float*)(L + OFF_TB);
    const bf16x8 zero8 = {0, 0, 0, 0, 0, 0, 0, 0};
    unsigned ksrc[2], vsrc[2];
#pragma unroll
    for (int i = 0; i < 2; ++i) { const int pos = tid * 16 + i * 8192;
        { const int row = pos >> 8, ch = ((pos >> 4) & 15) ^ (row & 7); ksrc[i] = (unsigned)(row * 2048 + ch * 8); }
        { const int sub = pos >> 9, w = (pos & 511) >> 1, kk = (sub >> 2) * 8 + (w >> 5), k = (kk & ~0xC) | ((kk & 4) << 1) | ((kk & 8) >> 1), col = (sub & 3) * 32 + (w & 31); vsrc[i] = (unsigned)(k * 2048 + col); } }
    for (int u0 = bid; u0 < BATCH * SSD_H; u0 += nb) {
        const int u = (nb == 256) ? ((u0 & 7) * 32 + (u0 >> 3)) : u0;
        const int b = u >> 6, h = u & 63, g = h >> 3;
        const float Ah = -expf(p.ssd_a_log[h]), Dh = p.ssd_d[h];
        f32x16 st = f32x16{};
        for (int i = tid; i < 16384 / 16; i += NTHREADS) *(bf16x8*)(L + OFF_PV + i * 16) = zero8;
        float* tabg = (float*)(p.big + BIG_SSD_TABG) + (size_t)u * 16 * 640;
#pragma unroll 1
        for (int cc = 0; cc < 2; ++cc) { const int chunk = 2 * wid + cc; float* tb_ = tabg + chunk * 640; const size_t t0_ = (size_t)b * SEQ + chunk * 128 + 2 * lane;
            const float d0 = p.dtb[t0_ * 64 + h], d1 = p.dtb[(t0_ + 1) * 64 + h]; const float a0 = d0 * Ah, a1 = d1 * Ah; float c = a0 + a1;
#pragma unroll
            for (int o_ = 1; o_ < 64; o_ <<= 1) { const float v = __shfl_up(c, o_); if (lane >= o_) c += v; }
            const float e1 = c, e0 = c - a1, tot = __shfl(c, 63);
            tb_[2 * lane] = e0 * 1.4426950408889634f; tb_[2 * lane + 1] = e1 * 1.4426950408889634f; tb_[128 + 2 * lane] = __expf(e0); tb_[128 + 2 * lane + 1] = __expf(e1);
            tb_[256 + 2 * lane] = __expf(tot - e0); tb_[256 + 2 * lane + 1] = __expf(tot - e1); tb_[384 + 2 * lane] = Dh / fmaxf(d0, 1e-30f); tb_[384 + 2 * lane + 1] = Dh / fmaxf(d1, 1e-30f); tb_[512 + 2 * lane] = d0; tb_[512 + 2 * lane + 1] = d1; }
        __syncthreads();
#pragma unroll 1
        for (int ck = 0; ck < SEQ / 128; ++ck) {
            const float* tb = tabs;
            const float* tg = tabg + ck * 640;
            const size_t tok0 = (size_t)b * SEQ + ck * 128;
            { const float v0 = tg[tid]; tabs[tid] = v0; if (tid < 128) tabs[512 + tid] = tg[512 + tid]; }
            { const bf16_t* bsrc = bc + tok0 * 2048 + g * 128; const bf16_t* csrc = bsrc + 1024;
#pragma unroll
              for (int tile = 0; tile < 2; ++tile)
#pragma unroll
                  for (int i = 0; i < 2; ++i) {
                      __builtin_amdgcn_global_load_lds((const unsigned*)(csrc + (size_t)tile * 64 * 2048 + ksrc[i]), (MG_LAS unsigned*)((MG_LAS char*)L + OFF_CK + tile * 16384 + wid * 1024 + i * 8192), 16, 0, 0);
                      __builtin_amdgcn_global_load_lds((const unsigned*)(bsrc + (size_t)tile * 64 * 2048 + ksrc[i]), (MG_LAS unsigned*)((MG_LAS char*)L + OFF_BK + tile * 16384 + wid * 1024 + i * 8192), 16, 0, 0);
                      __builtin_amdgcn_global_load_lds((const unsigned*)(bsrc + (size_t)tile * 64 * 2048 + vsrc[i]), (MG_LAS unsigned*)((MG_LAS char*)L + OFF_BV + tile * 16384 + wid * 1024 + i * 8192), 16, 0, 0); } }
            { int tl_ = tid; asm volatile("" : "+v"(tl_));
              const int cgx = tl_ & 7, rsx = tl_ >> 3, chx = h * 64 + cgx * 8;
              float w[4][8], bias[8];
#pragma unroll
              for (int k = 0; k < 4; ++k) { const f32x4 w0 = *(const f32x4*)(p.ssd_conv_w + k * SSD_CONVCH + chx), w1 = *(const f32x4*)(p.ssd_conv_w + k * SSD_CONVCH + chx + 4);
#pragma unroll
                  for (int j = 0; j < 4; ++j) { w[k][j] = w0[j]; w[k][4 + j] = w1[j]; } }
              { const f32x4 b0 = *(const f32x4*)(p.ssd_conv_b + chx), b1 = *(const f32x4*)(p.ssd_conv_b + chx + 4);
#pragma unroll
                for (int j = 0; j < 4; ++j) { bias[j] = b0[j]; bias[4 + j] = b1[j]; } }
              bf16x8 rw[5];
#pragma unroll
              for (int i = 0; i < 5; ++i) { const int l = 2 * rsx - 3 + i; rw[i] = (ck * 128 + l >= 0) ? *(const bf16x8*)(xp + (tok0 + l) * SSD_CONVCH + chx) : zero8; }
#pragma unroll
              for (int i = 0; i < 2; ++i) { const int l = 2 * rsx + i; const float dtl = tg[512 + l], sdl = tg[256 + l]; float o[8];
#pragma unroll
                  for (int j = 0; j < 8; ++j) o[j] = conv8(rw[i], rw[i + 1], rw[i + 2], rw[i + 3], w, bias, j) * dtl;
                  u32x4 pk; pk.x = cvtpk(o[0], o[1]); pk.y = cvtpk(o[2], o[3]); pk.z = cvtpk(o[4], o[5]); pk.w = cvtpk(o[6], o[7]);
                  *(u32x4*)(L + OFF_XV + v64_st(l, cgx * 8)) = pk;
                  pk.x = cvtpk(o[0] * sdl, o[1] * sdl); pk.y = cvtpk(o[2] * sdl, o[3] * sdl); pk.z = cvtpk(o[4] * sdl, o[5] * sdl); pk.w = cvtpk(o[6] * sdl, o[7] * sdl);
                  *(u32x4*)(L + OFF_XS + v64_st(l, cgx * 8)) = pk; } }
            __syncthreads();
            int ln_ = lane; asm volatile("" : "+v"(ln_)); const int r32 = ln_ & 31, hi = ln_ >> 5, lane2 = ln_;
            bf16x8 qr[8];
            { const char* cb_ = L + OFF_CK + (lb >> 1) * 16384;
#pragma unroll
              for (int d0 = 0; d0 < 8; ++d0) qr[d0] = *(const bf16x8*)(cb_ + AT_KSWZ((lb & 1) * 32 + r32, (d0 * 16 + hi * 8) * 2)); }
            f32x16 o = f32x16{}, oo = f32x16{};
            const int l = 32 * lb + r32; const float al = tb[l], dl = tb[384 + l];
            const int xvb = (int)(uintptr_t)(L + OFF_XV) + v_rd_base(lane2) + pb * 512;
            for (int kt = 0; kt <= (lb >> 1); ++kt) {
                f32x16 p0, p1;
                qkt(p0, p1, L + OFF_BK + kt * 16384, r32, hi, qr);
                if (kt < (lb >> 1)) {
#pragma unroll
                    for (int r = 0; r < 16; ++r) { const int s0 = 64 * kt + crow(r, hi), s1 = s0 + 32; p0[r] *= __builtin_amdgcn_exp2f(al - tb[s0]); p1[r] *= __builtin_amdgcn_exp2f(al - tb[s1]); }
                } else {
#pragma unroll
                for (int r = 0; r < 16; ++r) { const int s0 = 64 * kt + crow(r, hi), s1 = s0 + 32;
                    float v0 = p0[r] * __builtin_amdgcn_exp2f(al - tb[s0]), v1 = p1[r] * __builtin_amdgcn_exp2f(al - tb[s1]);
                    v0 = s0 <= l ? v0 : 0.f; v1 = s1 <= l ? v1 : 0.f; v0 += s0 == l ? dl : 0.f; v1 += s1 == l ? dl : 0.f; p0[r] = v0; p1[r] = v1; }
                }
                bf16x8 pa0, pa1, pa2, pa3;
                AT_PK4(p0, 0, pa0); AT_PK4(p0, 8, pa1); AT_PK4(p1, 0, pa2); AT_PK4(p1, 8, pa3);
                { const int vb = xvb + kt * 8192; s16x4 l0, l1, l2, l3, h0, h1, h2, h3;
                  SD_TRRD(l0, vb, 0); SD_TRRD(h0, vb, 1024); SD_TRRD(l1, vb, 2048); SD_TRRD(h1, vb, 3072); SD_TRRD(l2, vb, 4096); SD_TRRD(h2, vb, 5120); SD_TRRD(l3, vb, 6144); SD_TRRD(h3, vb, 7168);
                  asm volatile("s_waitcnt lgkmcnt(0)" ::: "memory"); __builtin_amdgcn_sched_barrier(0);
                  o = __builtin_amdgcn_mfma_f32_32x32x16_bf16(pa0, SD_MK(l0, h0), o, 0, 0, 0); o = __builtin_amdgcn_mfma_f32_32x32x16_bf16(pa1, SD_MK(l1, h1), o, 0, 0, 0);
                  o = __builtin_amdgcn_mfma_f32_32x32x16_bf16(pa2, SD_MK(l2, h2), o, 0, 0, 0); o = __builtin_amdgcn_mfma_f32_32x32x16_bf16(pa3, SD_MK(l3, h3), o, 0, 0, 0); }
            }
            { const int vb = (int)(uintptr_t)(L + OFF_PV) + v_rd_base(lane2) + pb * 512;
#define SD_YOFF(K0) do { s16x4 l0, l1, l2, l3, h0, h1, h2, h3; \
                  SD_TRRD(l0, vb, (K0) * 2048); SD_TRRD(h0, vb, (K0) * 2048 + 1024); SD_TRRD(l1, vb, (K0) * 2048 + 2048); SD_TRRD(h1, vb, (K0) * 2048 + 3072); \
                  SD_TRRD(l2, vb, (K0) * 2048 + 4096); SD_TRRD(h2, vb, (K0) * 2048 + 5120); SD_TRRD(l3, vb, (K0) * 2048 + 6144); SD_TRRD(h3, vb, (K0) * 2048 + 7168); \
                  asm volatile("s_waitcnt lgkmcnt(0)" ::: "memory"); __builtin_amdgcn_sched_barrier(0); \
                  oo = __builtin_amdgcn_mfma_f32_32x32x16_bf16(qr[(K0)], SD_MK(l0, h0), oo, 0, 0, 0); oo = __builtin_amdgcn_mfma_f32_32x32x16_bf16(qr[(K0) + 1], SD_MK(l1, h1), oo, 0, 0, 0); \
                  oo = __builtin_amdgcn_mfma_f32_32x32x16_bf16(qr[(K0) + 2], SD_MK(l2, h2), oo, 0, 0, 0); oo = __builtin_amdgcn_mfma_f32_32x32x16_bf16(qr[(K0) + 3], SD_MK(l3, h3), oo, 0, 0, 0); } while (0)
              SD_YOFF(0); SD_YOFF(4);
#undef SD_YOFF
            }
            { const float dec = tb[128 + 127];
#pragma unroll
              for (int r = 0; r < 16; ++r) st[r] *= dec;
              const int xsb = (int)(uintptr_t)(L + OFF_XS) + v_rd_base(lane2) + pb * 512;
              const int bvb = (int)(uintptr_t)(L + OFF_BV) + v_rd_base(lane2) + nbk * 512;
#define SD_STATE(K0, BOFF) do { s16x4 a0, a1, a2, a3, a4, a5, a6, a7, b0, b1, b2, b3, b4, b5, b6, b7; \
                  SD_TRRD(a0, xsb, (K0) * 2048); SD_TRRD(a1, xsb, (K0) * 2048 + 1024); SD_TRRD(a2, xsb, (K0) * 2048 + 2048); SD_TRRD(a3, xsb, (K0) * 2048 + 3072); \
                  SD_TRRD(a4, xsb, (K0) * 2048 + 4096); SD_TRRD(a5, xsb, (K0) * 2048 + 5120); SD_TRRD(a6, xsb, (K0) * 2048 + 6144); SD_TRRD(a7, xsb, (K0) * 2048 + 7168); \
                  SD_TRRD(b0, bvb, (BOFF)); SD_TRRD(b1, bvb, (BOFF) + 2048); SD_TRRD(b2, bvb, (BOFF) + 4096); SD_TRRD(b3, bvb, (BOFF) + 6144); \
                  SD_TRRD(b4, bvb, (BOFF) + 8192); SD_TRRD(b5, bvb, (BOFF) + 10240); SD_TRRD(b6, bvb, (BOFF) + 12288); SD_TRRD(b7, bvb, (BOFF) + 14336); \
                  asm volatile("s_waitcnt lgkmcnt(0)" ::: "memory"); __builtin_amdgcn_sched_barrier(0); \
                  st = __builtin_amdgcn_mfma_f32_32x32x16_bf16(SD_MK(a0, a1), SD_MK(b0, b1), st, 0, 0, 0); st = __builtin_amdgcn_mfma_f32_32x32x16_bf16(SD_MK(a2, a3), SD_MK(b2, b3), st, 0, 0, 0); \
                  st = __builtin_amdgcn_mfma_f32_32x32x16_bf16(SD_MK(a4, a5), SD_MK(b4, b5), st, 0, 0, 0); st = __builtin_amdgcn_mfma_f32_32x32x16_bf16(SD_MK(a6, a7), SD_MK(b6, b7), st, 0, 0, 0); } while (0)
              SD_STATE(0, 0); SD_STATE(4, 16384);
              asm volatile("s_nop 15\n\ts_nop 15" : "+v"(st));
#undef SD_STATE
            }
            { const int colg = h * 64 + 32 * pb + r32;
#pragma unroll
              for (int r = 0; r < 16; ++r) { const int lr = 32 * lb + crow(r, hi); const size_t tok = tok0 + lr;
                  const float y = o[r] + tb[128 + lr] * oo[r]; const float yn = swap_pair(y); if ((r32 & 1) == 0) *(unsigned*)(yb + tok * SSD_DI + colg) = cvtpk(y, yn); } }
            __syncthreads();
#pragma unroll
            for (int rg = 0; rg < 4; ++rg) { u32x2 w2; w2.x = cvtpk(st[4 * rg], st[4 * rg + 1]); w2.y = cvtpk(st[4 * rg + 2], st[4 * rg + 3]);
                *(u32x2*)(L + OFF_PV + v64_st(32 * nbk + r32, 32 * pb + 8 * rg + 4 * hi)) = w2; }
        }
        __syncthreads();
    }
}

DEV void ph_ssd_norm(const P& p, int bid, int nb) {
    const int lane = tidx() & 63, wid = tidx() >> 6;
    bf16_t* yb = (bf16_t*)(p.big + BIG_SSD_YN); const bf16_t* zb = (const bf16_t*)(p.big + BIG_SSD_Z);
    for (int tok = bid * 8 + wid; tok < T; tok += nb * 8) {
        const int lo = (lane >> 3) * 512 + (lane & 7) * 8;
        bf16_t* yr = yb + (size_t)tok * SSD_DI + lo; const bf16_t* zr = zb + (size_t)tok * SSD_DI + lo; const float* ng = p.ssd_norm + lo;
        float v[64]; float ss = 0.f;
#pragma unroll
        for (int i = 0; i < 8; ++i) { const bf16x8 yv = *(const bf16x8*)(yr + i * 64), zv = *(const bf16x8*)(zr + i * 64);
#pragma unroll
            for (int j = 0; j < 8; ++j) { const float z = bf2f((bf16_t)zv[j]); const float t = bf2f((bf16_t)yv[j]) * (z / (1.f + __expf(-z))); v[i * 8 + j] = t; ss += t * t; } }
        ss += __shfl_xor(ss, 1); ss += __shfl_xor(ss, 2); ss += __shfl_xor(ss, 4);
        const float rinv = rsqrtf(ss * (1.f / 512.f) + NORM_EPS);
#pragma unroll
        for (int i = 0; i < 8; ++i) { float o[8];
#pragma unroll
            for (int j = 0; j < 8; ++j) o[j] = v[i * 8 + j] * rinv * ng[i * 64 + j];
            u32x4 w; w.x = at::cvtpk(o[0], o[1]); w.y = at::cvtpk(o[2], o[3]); w.z = at::cvtpk(o[4], o[5]); w.w = at::cvtpk(o[6], o[7]); *(u32x4*)(yr + i * 64) = w; }
    }
}

#define XB_TMO      128
#define XB_XCNT(j)  (256  + 64 * (j))
#define XB_XSUB(j)  (1280 + 64 * (j))
#define XB_XGEN(j)  (2304 + 64 * (j))
#define XB_TOP      3328
#define XB_TOPGEN   3392
#define XCD_BAR_WORDS 3456
#define XB_SPIN_CAP (1u << 22)
#define LAS __attribute__((address_space(3)))

__device__ __forceinline__ unsigned xb_ld(unsigned* p)              { return __hip_atomic_load(p, __ATOMIC_RELAXED, __HIP_MEMORY_SCOPE_AGENT); }
__device__ __forceinline__ unsigned xb_add(unsigned* p, unsigned v) { return __hip_atomic_fetch_add(p, v, __ATOMIC_RELAXED, __HIP_MEMORY_SCOPE_AGENT); }
__device__ __forceinline__ unsigned xb_xcc_id() { return (unsigned)__builtin_amdgcn_s_getreg((3 << 11) | 20) & 0xFu; }
#define XB_SPIN(cond, bar) do { unsigned _sp = 0; while (cond) { __builtin_amdgcn_s_sleep(1); \
    if ((++_sp & 255u) == 0u) { if (xb_ld(&(bar)[XB_TMO])) break; if (_sp > XB_SPIN_CAP) { atomicAdd(&(bar)[XB_TMO], 1u); break; } } } } while (0)

struct XcdBarrier {
    unsigned* bar; unsigned x;
    volatile LAS unsigned* st;
};

__device__ __forceinline__ XcdBarrier xcd_barrier_post(unsigned* bar, volatile LAS unsigned* st) {
    XcdBarrier b; b.bar = bar; b.x = xb_xcc_id(); b.st = st;
    if (threadIdx.x == 0) (void)xb_add(&bar[XB_XCNT(b.x)], 1u);
    return b;
}
__device__ __forceinline__ void xcd_barrier_complete(unsigned* bar, unsigned x, unsigned& nloc, unsigned& nx) {
    const unsigned G = gridDim.x * gridDim.y * gridDim.z;
    unsigned sum, cnt, mine, sp = 0u;
    for (;;) {
        sum = 0u; cnt = 0u; mine = 0u;
#pragma unroll
        for (unsigned j = 0; j < 16; ++j) { const unsigned c = xb_ld(&bar[XB_XCNT(j)]); sum += c; cnt += (c > 0u) ? 1u : 0u; mine = (j == x) ? c : mine; }
        if (sum == G) break;
        __builtin_amdgcn_s_sleep(1);
        if ((++sp & 255u) == 0u) { if (xb_ld(&bar[XB_TMO])) break; if (sp > XB_SPIN_CAP) { atomicAdd(&bar[XB_TMO], 1u); break; } }
    }
    nloc = mine > 0u ? mine : 1u; nx = cnt > 0u ? cnt : 1u;
}

__device__ __forceinline__ void xcd_barrier(const XcdBarrier& b) {
    asm volatile("s_waitcnt vmcnt(0)" ::: "memory");
    __syncthreads();
    if (threadIdx.x == 0) {
        unsigned* bar = b.bar;
        __builtin_amdgcn_s_waitcnt(0);
        unsigned nloc = b.st[0], nx = b.st[1];
        if (nloc == 0u) { xcd_barrier_complete(bar, b.x, nloc, nx); b.st[0] = nloc; b.st[1] = nx; }
        const unsigned old = xb_add(&bar[XB_XSUB(b.x)], 1u);
        const unsigned gen = old / nloc;
        if (old + 1u == (gen + 1u) * nloc) {
            __builtin_amdgcn_fence(__ATOMIC_RELEASE, "agent");
            asm volatile("s_waitcnt vmcnt(0)" ::: "memory");
            const unsigned og = xb_add(&bar[XB_TOP], 1u);
            const unsigned tg = og / nx;
            if (og + 1u == (tg + 1u) * nx) xb_add(&bar[XB_TOPGEN], 1u);
            else XB_SPIN(xb_ld(&bar[XB_TOPGEN]) == tg, bar);
            __builtin_amdgcn_fence(__ATOMIC_ACQUIRE, "agent");
            xb_add(&bar[XB_XGEN(b.x)], 1u);
            asm volatile("s_waitcnt vmcnt(0)" ::: "memory");
        } else {
            XB_SPIN(xb_ld(&bar[XB_XGEN(b.x)]) == gen, bar);
            __builtin_amdgcn_fence(__ATOMIC_ACQUIRE, "agent");
            asm volatile("s_waitcnt vmcnt(0)" ::: "memory");
        }
    }
    __syncthreads();
}


constexpr int LDS_STAGE_OFF = 16, LDS_TAB_OFF = 16 + mg::STAGE_BYTES, LDS_BYTES = 16 + 147456 + 5120;
constexpr int NPHASE = 21;

DEV void moe_tables(const int* cnt, int* tab) {
    __syncthreads();
    if (tidx() == 0) { int s = 0, r = 0; for (int e = 0; e < MOE_E; ++e) { tab[e] = s; tab[64 + e] = r; const int c = cnt[e]; s += (c + 255) >> 8; r += c; } tab[MOE_E] = s; tab[64 + MOE_E] = r; }
    __syncthreads();
}
constexpr int MOE_CT_GU = 4096, MOE_CT_D = 2048, MOE_CT_L = MOE_CT_GU + MOE_CT_D;
DEV void conv_moe_tiles(const P& p, float* ldsf, int f0, int f1, int w, int nw) {
    if (w < 0 || f0 >= f1) return;
#pragma unroll 1
    for (int L = 0; L < 2; ++L) {
        const float* wg = p.moe_w_gate + (size_t)L * MOE_E * D_MODEL * MOE_FF; const float* wu = p.moe_w_up + (size_t)L * MOE_E * D_MODEL * MOE_FF;
        const float* wd = p.moe_w_down + (size_t)L * MOE_E * MOE_FF * D_MODEL;
        { const int a = f0 - L * MOE_CT_L, b = f1 - L * MOE_CT_L; const int lo = a > 0 ? a : 0, hi = b < MOE_CT_GU ? b : MOE_CT_GU;
          if (lo < hi) conv_wt<true>([=](int g, int k, int q) { const float* sp = (q & 1) ? wu : wg; return sp + ((size_t)g * D_MODEL + k) * MOE_FF + (q >> 1) * 4; }, MOE_E, D_MODEL, 2 * MOE_FF,
                               p.wt_gu + (size_t)L * MOE_E * MOE_FF * D_MODEL, ldsf, w, nw, lo, hi); }
        { const int a = f0 - L * MOE_CT_L - MOE_CT_GU, b = f1 - L * MOE_CT_L - MOE_CT_GU; const int lo = a > 0 ? a : 0, hi = b < MOE_CT_D ? b : MOE_CT_D;
          if (lo < hi) conv_wt<true>([=](int g, int k, int q) { return wd + ((size_t)g * MOE_FF + k) * D_MODEL + q * 4; }, MOE_E, MOE_FF, D_MODEL,
                               p.wt_d + (size_t)L * MOE_E * D_MODEL * MOE_FF / 2, ldsf, w, nw, lo, hi); }
    }
}
constexpr int CT_A = 1536, CT_B = MOE_CT_L, CT_C = MOE_CT_L + 1920, CT_D = MOE_CT_L + MOE_CT_GU, CT_E = 2 * MOE_CT_L;

template <int PH> DEV void run_phase(const P& p, float* ldsraw, int bid, int nb) {
    float* lds = ldsraw + 4;
    MG_LAS unsigned char* stage = (MG_LAS unsigned char*)ldsraw + LDS_STAGE_OFF;
    int* tab = (int*)((char*)ldsraw + LDS_TAB_OFF);
    if constexpr (PH == 0) {
        ph_rope_table(p, bid, nb);
        for (int i = bid * NTHREADS + tidx(); i < 2 * D_MODEL * MOE_E; i += nb * NTHREADS) p.wr[i] = p.moe_w_expert[i] * p.ln_ffn[i >> 5];
        for (int i = bid * NTHREADS + tidx(); i < 2 * D_MODEL * MOE_G; i += nb * NTHREADS) p.wgq[i] = p.moe_w_group[i] * p.ln_ffn[i >> 2];
        if (bid == 0 && tidx() < 64) p.cnt[tidx()] = 0;
        rows_norm<true>(p.x, nullptr, nullptr, nullptr, p.ln_mix, p.hb16, bid, nb);
        { const float* w = p.nsa_w_in; conv_wt<true>([=](int, int k, int q) { const int c = q * 4, pn = c >> 8; int lg = c;
              if (pn < 10 || pn == 12 || pn == 13 || pn == 16 || pn == 17) { const int c128 = c & 127; lg = (c & ~127) + 16 * (c128 >> 5) + 4 * ((c128 >> 3) & 3) + 64 * ((c128 >> 2) & 1); }
              return lg < NSA_PROJ ? w + (size_t)k * NSA_PROJ + lg : (const float*)nullptr; }, 1, D_MODEL, NSA_PROJ_P, p.wt_nsa_in, lds, bid, nb); }
        { const float* w = p.nsa_cmp_w1; conv_wt([=](int g, int k, int q) { return w + ((size_t)g * 4096 + k) * CMP_HIDDEN + q * 4; }, 2, 4096, CMP_HIDDEN, p.wt_cmp1, lds, bid, nb); }
        { const float* w = p.nsa_cmp_w2; conv_wt([=](int g, int k, int q) { return q < 32 ? w + ((size_t)g * CMP_HIDDEN + k) * 128 + q * 4 : (const float*)nullptr; }, 2, CMP_HIDDEN, 256, p.wt_cmp2, lds, bid, nb); }
    } else if constexpr (PH == 1) {
        mg::StaticOrder S; S.init(T, NSA_PROJ_P, nb, bid);
        mg::gemm_phase<true, 10>(stage, D_MODEL / 2, mg::APlain{p.hb16, D_MODEL / 2}, mg::BPlain{p.wt_nsa_in, D_MODEL / 2, 0}, S,
                       EpiNsaIn{(bf16_t*)(p.big + BIG_NSA_Q), (bf16_t*)(p.big + BIG_NSA_KS), (bf16_t*)(p.big + BIG_NSA_VS), (bf16_t*)(p.big + BIG_NSA_KW), (bf16_t*)(p.big + BIG_NSA_VW),
                                (bf16_t*)(p.big + BIG_NSA_ACMP), (float*)(p.big + BIG_NSA_GATE), p.rope, p.nsa_cmp_pe});
        { const int nu = (T / 256) * (NSA_PROJ_P / 256), rem = nu % nb; __syncthreads();
          if (rem) conv_moe_tiles(p, lds, 0, CT_A, bid - rem, nb - rem); else conv_moe_tiles(p, lds, 0, CT_A, bid, nb); }
    } else if constexpr (PH == 2) {
    } else if constexpr (PH == 3) {
        mg::FixedGroups S{2, 8, 1, nb, bid};
        mg::gemm_phase(stage, 4096, mg::AGrouped{(const bf16_t*)(p.big + BIG_NSA_ACMP), 4096, (size_t)2048 * 4096}, mg::BPlain{p.wt_cmp1, 4096, (size_t)CMP_HIDDEN * 4096}, S, EpiCmp1{(bf16_t*)(p.big + BIG_NSA_H1)});
        __syncthreads();
        for (int L = bid; L < 16; L += nb) { const int g = L >> 3, pm = L & 7;
            cmp_gemm2_rows((const bf16_t*)(p.big + BIG_NSA_H1) + (size_t)g * 2048 * 256, p.wt_cmp2 + (size_t)g * 256 * CMP_HIDDEN, (bf16_t*)(p.big + BIG_NSA_KVC) + (size_t)g * 2048 * 128, pm * 256); }
        if (nb > 16) conv_moe_tiles(p, lds, CT_A, CT_B, bid - 16, nb - 16); else conv_moe_tiles(p, lds, CT_A, CT_B, bid, nb);
        { const float* w = p.ssd_w_out; const int fb = nb > 16 ? bid - 16 : bid, fn = nb > 16 ? nb - 16 : nb;
          if (fb >= 0) conv_wt([=](int, int k, int q) { return w + (size_t)k * D_MODEL + q * 4; }, 1, SSD_DI, D_MODEL, p.wt_ssd_out, lds, fb, fn);
          if (fb >= 0) { const float* w1 = p.nsa_w_out; conv_wt<true>([=](int, int k, int q) { return w1 + (size_t)k * D_MODEL + q * 4; }, 1, 2048, D_MODEL, p.wt_nsa_out, lds, fb, fn); }
          if (fb >= 0) { const float* w2 = p.ssd_w_in; conv_wt([=](int, int k, int q) { const int c = q * 4; return c < SSD_PROJ ? w2 + (size_t)k * SSD_PROJ + c : (const float*)nullptr; }, 1, D_MODEL, SSD_PROJ_P, p.wt_ssd_in, lds, fb, fn); } }
    } else if constexpr (PH == 4) {
    } else if constexpr (PH == 5) {
        ph_attn_mfma(p, (char*)ldsraw + LDS_STAGE_OFF, bid, nb);
    } else if constexpr (PH == 6) {
    } else if constexpr (PH == 7) {
        mg::StaticOrder S; S.init(T, D_MODEL, nb, bid);
        mg::gemm_phase<true, 12>(stage, 2048 / 2, mg::APlain{(const bf16_t*)(p.big + BIG_NSA_OBUF), 2048 / 2}, mg::BPlain{p.wt_nsa_out, 2048 / 2, 0}, S, EpiResid<false, 12>{p.x, (bf16_t*)p.xB});
    } else if constexpr (PH == 8 || PH == 17) {
        ph_moe_route(p, PH == 8 ? 0 : 1, (const bf16_t*)p.xB, lds, bid, nb);
    } else if constexpr (PH == 9 || PH == 18) {
        constexpr int L = PH == 9 ? 0 : 1; const int* cnt = p.cnt + L * MOE_E;
        moe_tables(cnt, tab);
        mg::GroupedOrder S{tab, MOE_E, 4, nb, bid};
        mg::gemm_phase<true>(stage, D_MODEL / 2, AMoeGather{p.hb16, p.list, cnt}, mg::BPlain{p.wt_gu + (size_t)L * MOE_E * MOE_FF * D_MODEL, D_MODEL / 2, (size_t)MOE_FF * D_MODEL}, S, EpiMoeGU{(bf16_t*)(p.big + BIG_MOE_ACT), cnt, tab});
        { const int rem = (tab[MOE_E] * 4) % nb; __syncthreads(); constexpr int f0 = L == 0 ? CT_B : CT_D + 384, f1 = L == 0 ? CT_C : CT_E;
            if (rem) conv_moe_tiles(p, lds, f0, f1, bid - rem, nb - rem); else conv_moe_tiles(p, lds, f0, f1, bid, nb); }
    } else if constexpr (PH == 10 || PH == 19) {
        constexpr int L = PH == 10 ? 0 : 1; const int* cnt = p.cnt + L * MOE_E;
        moe_tables(cnt, tab);
        mg::GroupedOrder S{tab, MOE_E, 8, nb, bid};
        mg::gemm_phase<true>(stage, MOE_FF / 2, AMoeAct{(const bf16_t*)(p.big + BIG_MOE_ACT), tab}, mg::BPlain{p.wt_d + (size_t)L * MOE_E * D_MODEL * MOE_FF / 2, MOE_FF / 2, (size_t)D_MODEL * MOE_FF / 2}, S, EpiMoeDown{(bf16_t*)(p.big + BIG_MOE_YS), p.list, cnt, p.lw});
        if constexpr (L == 0) { const int rem = (tab[MOE_E] * 8) % nb; __syncthreads();
            if (rem) conv_moe_tiles(p, lds, CT_D, CT_D + 384, bid - rem, nb - rem); else conv_moe_tiles(p, lds, CT_D, CT_D + 384, bid, nb); }
    } else if constexpr (PH == 11) {
        const bf16_t* ys = (const bf16_t*)(p.big + BIG_MOE_YS);
        rows_norm<false, true>(p.xB, ys, ys + D_MODEL, p.xA, p.ln_mix + D_MODEL, p.hb16, bid, nb);
    } else if constexpr (PH == 12) {
        mg::StaticOrder S; S.init(T, SSD_PROJ_P, nb, bid);
        mg::gemm_phase(stage, D_MODEL, mg::APlain{p.hb16, D_MODEL}, mg::BPlain{p.wt_ssd_in, D_MODEL, 0}, S,
                       EpiSsdIn{(bf16_t*)(p.big + BIG_SSD_Z), (bf16_t*)(p.big + BIG_SSD_XBCP), p.dtb, p.ssd_dt_bias});
        { const int nu = (T / 256) * (SSD_PROJ_P / 256), rem = nu % nb; __syncthreads();
          if (rem) conv_moe_tiles(p, lds, CT_C, CT_D, bid - rem, nb - rem); else conv_moe_tiles(p, lds, CT_C, CT_D, bid, nb); }
    } else if constexpr (PH == 13) {
        ph_ssd_conv_bc(p, bid, nb);
    } else if constexpr (PH == 14) {
        ph_ssd_mfma(p, (char*)ldsraw + LDS_STAGE_OFF, bid, nb);
    } else if constexpr (PH == 15) {
        ph_ssd_norm(p, bid, nb);
    } else if constexpr (PH == 16) {
        mg::StaticOrder S; S.init(T, D_MODEL, nb, bid);
        mg::gemm_phase(stage, SSD_DI, mg::APlain{(const bf16_t*)(p.big + BIG_SSD_YN), SSD_DI}, mg::BPlain{p.wt_ssd_out, SSD_DI, 0}, S, EpiResid<true>{p.xA, (bf16_t*)p.xB});
    } else if constexpr (PH == 20) {
        const bf16_t* ys = (const bf16_t*)(p.big + BIG_MOE_YS);
        const int lane = tidx() & 63, wid = tidx() >> 6;
        for (int row = bid * 8 + wid; row < T; row += nb * 8) {
            float4 v[8]; float ss = 0.f;
#pragma unroll
            for (int i = 0; i < 8; ++i) { const int c = i * 256 + lane * 4; const ushort4 s4 = *(const ushort4*)((const bf16_t*)p.xB + (size_t)row * D_MODEL + c); float4 a = make_float4(bf2f(s4.x), bf2f(s4.y), bf2f(s4.z), bf2f(s4.w));
                const ushort4 y0 = *(const ushort4*)(ys + (size_t)(2 * row) * D_MODEL + c), y1 = *(const ushort4*)(ys + (size_t)(2 * row + 1) * D_MODEL + c);
                a.x += bf2f(y0.x) + bf2f(y1.x); a.y += bf2f(y0.y) + bf2f(y1.y); a.z += bf2f(y0.z) + bf2f(y1.z); a.w += bf2f(y0.w) + bf2f(y1.w);
                v[i] = a; ss += a.x * a.x + a.y * a.y + a.z * a.z + a.w * a.w; }
            ss = wave_sum(ss); const float rinv = rsqrtf(ss * (1.f / D_MODEL) + NORM_EPS);
#pragma unroll
            for (int i = 0; i < 8; ++i) { const int c = i * 256 + lane * 4; const float4 gg = *(const float4*)(p.ln_final + c);
                float4 o; o.x = v[i].x * rinv * gg.x; o.y = v[i].y * rinv * gg.y; o.z = v[i].z * rinv * gg.z; o.w = v[i].w * rinv * gg.w;
                __builtin_nontemporal_store((f32x4){o.x, o.y, o.z, o.w}, (f32x4*)(p.out + (size_t)row * D_MODEL + c)); }
        }
    }
}

template <int PH> __global__ __launch_bounds__(NTHREADS, 2) void k_phase(P p) {
    extern __shared__ __attribute__((aligned(16))) float lds[];
    run_phase<PH>(p, lds, blockIdx.x, gridDim.x);
}
template <int PH> static void launch_all(const P& p, hipStream_t stream) {
    if constexpr (PH < NPHASE) {
        static bool attr = false; if (!attr) { attr = true; (void)hipFuncSetAttribute((const void*)k_phase<PH>, hipFuncAttributeMaxDynamicSharedMemorySize, LDS_BYTES); }
        hipLaunchKernelGGL(k_phase<PH>, dim3(256), dim3(NTHREADS), LDS_BYTES, stream, p);
        launch_all<PH + 1>(p, stream);
    }
}
constexpr bool phase_empty(int ph) { return ph == 2 || ph == 4 || ph == 6; }
#ifndef PROBE_DUP_MASK
#define PROBE_DUP_MASK 0u
#endif
constexpr bool phase_dup(int ph) { return (PROBE_DUP_MASK >> ph) & 1u; }
template <int PH> DEV void mega_phases(const P& p, float* lds, const XcdBarrier& bar) {
    if constexpr (PH < NPHASE) {
        if constexpr (!phase_empty(PH)) {
            run_phase<PH>(p, lds, blockIdx.x, gridDim.x);
            if constexpr (phase_dup(PH)) { xcd_barrier(bar); run_phase<PH>(p, lds, blockIdx.x, gridDim.x); }
            if constexpr (PH + 1 < NPHASE) xcd_barrier(bar);
        }
        mega_phases<PH + 1>(p, lds, bar);
    }
}
__global__ __launch_bounds__(NTHREADS, 2) void k_mega(P p) {
    extern __shared__ __attribute__((aligned(16))) float lds[];
    if (threadIdx.x < 4) ((unsigned*)lds)[threadIdx.x] = 0u;
    __syncthreads();
    XcdBarrier bar = xcd_barrier_post(p.bar, (volatile LAS unsigned*)lds);
    mega_phases<0>(p, lds, bar);
}

extern "C" void kernel_launch(void* const* d_in, const int* in_sizes, int n_in, void* d_out, int out_size, void* d_ws, size_t ws_size, hipStream_t stream) {
    P p{};
    const float* const* in = (const float* const*)d_in;
    p.x = in[0]; p.ln_mix = in[1]; p.ln_ffn = in[2]; p.ln_final = in[3]; p.nsa_w_in = in[4]; p.nsa_cmp_pe = in[5]; p.nsa_cmp_w1 = in[6]; p.nsa_cmp_w2 = in[7]; p.nsa_w_out = in[8];
    p.ssd_w_in = in[9]; p.ssd_conv_w = in[10]; p.ssd_conv_b = in[11]; p.ssd_dt_bias = in[12]; p.ssd_a_log = in[13]; p.ssd_d = in[14]; p.ssd_norm = in[15]; p.ssd_w_out = in[16];
    p.moe_w_group = in[17]; p.moe_b_group = in[18]; p.moe_w_expert = in[19]; p.moe_b_expert = in[20]; p.moe_w_gate = in[21]; p.moe_w_up = in[22]; p.moe_w_down = in[23];
    p.out = (float*)d_out;
    char* w = (char*)d_ws; size_t off = 0;
    auto take = [&](size_t bytes) { char* r = w + off; off += (bytes + 255) & ~(size_t)255; return r; };
    p.bar = (unsigned*)take(XCD_BAR_WORDS * 4);
    p.wt_nsa_in = (bf16_t*)take((size_t)NSA_PROJ_P * D_MODEL * 2);
    p.wt_nsa_out = (bf16_t*)take((size_t)D_MODEL * 2048 * 2);
    p.wt_ssd_in = (bf16_t*)take((size_t)SSD_PROJ_P * D_MODEL * 2);
    p.wt_ssd_out = (bf16_t*)take((size_t)D_MODEL * SSD_DI * 2);
    p.wt_gu = (bf16_t*)take((size_t)2 * MOE_E * 2 * MOE_FF * D_MODEL * 2);
    p.wt_d = (bf16_t*)take((size_t)2 * MOE_E * D_MODEL * MOE_FF * 2);
    p.wt_cmp1 = (bf16_t*)take((size_t)2 * CMP_HIDDEN * 4096 * 2);
    p.wt_cmp2 = (bf16_t*)take((size_t)2 * 256 * CMP_HIDDEN * 2);
    p.xA = (float*)take((size_t)T * D_MODEL * 4);
    p.xB = (float*)take((size_t)T * D_MODEL * 4);
    p.hb16 = (bf16_t*)take((size_t)T * D_MODEL * 2);
    p.big = take(BIG_BYTES);
    p.rope = (float*)take((size_t)SEQ * 64 * 2 * 4);
    p.h1 = (float*)take((size_t)2 * 2032 * CMP_HIDDEN * 4);
    p.kvc = (float*)take((size_t)2 * 2032 * 128 * 4);
    p.selmask = (unsigned*)take((size_t)BATCH * NKV * SEQ * 4);
    p.cnt = (int*)take(64 * 4);
    p.list = (int*)take((size_t)MOE_E * T * 4);
    p.ew = (float*)take((size_t)T * 2 * 4);
    p.lw = (float*)take((size_t)MOE_E * T * 4);
    p.dtb = (float*)take((size_t)T * 64 * 4);
    p.wr = (float*)take((size_t)2 * D_MODEL * MOE_E * 4);
    p.wgq = (float*)take((size_t)2 * D_MODEL * MOE_G * 4);
    if (off > ws_size) { fprintf(stderr, "workspace too small: need %zu have %zu\n", off, ws_size); return; }
#if defined(MK_MULTI)
    launch_all<0>(p, stream);
#else
    static int grid = 0;
    if (!grid) {
        int dev = 0, cus = 0, per_cu = 0;
        (void)hipGetDevice(&dev);
        (void)hipDeviceGetAttribute(&cus, hipDeviceAttributeMultiprocessorCount, dev);
        (void)hipFuncSetAttribute((const void*)k_mega, hipFuncAttributeMaxDynamicSharedMemorySize, LDS_BYTES);
        (void)hipOccupancyMaxActiveBlocksPerMultiprocessor(&per_cu, k_mega, NTHREADS, LDS_BYTES);
        if (per_cu < 1) per_cu = 1;
        grid = cus * (per_cu < 1 ? per_cu : 1);
    }
    (void)hipMemsetAsync(p.bar, 0, XCD_BAR_WORDS * sizeof(unsigned), stream);
    hipLaunchKernelGGL(k_mega, dim3(grid), dim3(NTHREADS), LDS_BYTES, stream, p);
#endif
}
```

```cpp
#include <hip/hip_runtime.h>
#include <stdint.h>
#include <math.h>
#include <cstdio>

#define DEV __device__ __forceinline__

constexpr int D_MODEL = 2048, BATCH = 4, SEQ = 2048, T = BATCH * SEQ;
constexpr int NH = 16, NKV = 4, DH = 128;
constexpr int NCMP = 127, CMP_HIDDEN = 256;
constexpr int NSLC = 32;
constexpr int WINDOW = 512;
constexpr int NSA_PROJ = 5168, NSA_PROJ_P = 5376;
constexpr int OFF_Q = 0, OFF_KC = 2048, OFF_VC = 2560, OFF_KS = 3072, OFF_VS = 3584, OFF_KW = 4096, OFF_VW = 4608, OFF_G = 5120;
constexpr int SSD_DI = 4096, SSD_P = 64, SSD_H = 64, SSD_G = 8, SSD_N = 128, SSD_CONVCH = 6144, SSD_PROJ = 10304, SSD_PROJ_P = 10496;
constexpr int OFF_Z = 0, OFF_XBC = 4096, OFF_DT = 10240;
constexpr int MOE_G = 4, MOE_EPG = 8, MOE_E = 32, MOE_FF = 512;
constexpr float NORM_EPS = 1e-6f;
constexpr int NTHREADS = 512;
typedef unsigned short bf16_t;


struct P {
    const float *x, *ln_mix, *ln_ffn, *ln_final, *nsa_w_in, *nsa_cmp_pe, *nsa_cmp_w1, *nsa_cmp_w2, *nsa_w_out;
    const float *ssd_w_in, *ssd_conv_w, *ssd_conv_b, *ssd_dt_bias, *ssd_a_log, *ssd_d, *ssd_norm, *ssd_w_out;
    const float *moe_w_group, *moe_b_group, *moe_w_expert, *moe_b_expert, *moe_w_gate, *moe_w_up, *moe_w_down;
    float* out;
    bf16_t *wt_nsa_in, *wt_nsa_out, *wt_ssd_in, *wt_ssd_out, *wt_gu, *wt_d, *wt_cmp1, *wt_cmp2;
    float *xA, *xB; bf16_t* hb16;
    char* big;
    float* rope;
    float* h1;
    float* kvc;
    unsigned* selmask;
    int* cnt;
    int* list;
    float* ew;
    float* lw;
    float* dtb;
    float *wr, *wgq;
    unsigned* bar;
};
constexpr size_t BIG_NSA_Q = 0, BIG_NSA_KS = (size_t)T * 2048 * 2, BIG_NSA_VS = BIG_NSA_KS + (size_t)T * 512 * 2, BIG_NSA_KW = BIG_NSA_VS + (size_t)T * 512 * 2, BIG_NSA_VW = BIG_NSA_KW + (size_t)T * 512 * 2,
    BIG_NSA_ACMP = BIG_NSA_VW + (size_t)T * 512 * 2, BIG_NSA_H1 = BIG_NSA_ACMP + (size_t)2 * 2048 * 4096 * 2, BIG_NSA_KVC = BIG_NSA_H1 + (size_t)2 * 2048 * 256 * 2,
    BIG_NSA_GATE = BIG_NSA_KVC + (size_t)2 * 2048 * 128 * 2, BIG_NSA_OCMP = BIG_NSA_GATE + (size_t)T * 48 * 4, BIG_NSA_OBUF = BIG_NSA_OCMP + (size_t)T * 2048 * 4;
constexpr size_t BIG_MOE_ACT = 0, BIG_MOE_YS = (size_t)(2 * T + 256) * MOE_FF * 2;
constexpr size_t BIG_SSD_Z = 0, BIG_SSD_XBCP = (size_t)T * SSD_DI * 2, BIG_SSD_YN = BIG_SSD_XBCP + (size_t)T * SSD_CONVCH * 2, BIG_SSD_BC = BIG_SSD_YN + (size_t)T * SSD_DI * 2;
constexpr size_t BIG_SSD_TABG = BIG_SSD_BC + (size_t)T * 2048 * 2;
constexpr size_t BIG_BYTES = BIG_SSD_TABG + (size_t)256 * 16 * 640 * 4;
static_assert(BIG_NSA_OBUF + (size_t)T * 2048 * 2 <= BIG_BYTES && BIG_MOE_YS + (size_t)2 * T * D_MODEL * 4 <= BIG_BYTES, "big region");

DEV int tidx() { int t = threadIdx.x; asm volatile("" : "+v"(t)); return t; }
DEV float swap_pair(float v) { return __int_as_float(__builtin_amdgcn_mov_dpp(__float_as_int(v), 0xB1, 0xF, 0xF, true)); }
DEV float dpp_xor2(float v) { return __int_as_float(__builtin_amdgcn_mov_dpp(__float_as_int(v), 0x4E, 0xF, 0xF, true)); }
DEV void quad_transpose(float (&v)[4], int k) {
    { const bool up = (k & 2) != 0;
#pragma unroll
      for (int e = 0; e < 2; ++e) { const float snd = up ? v[e] : v[e + 2]; const float rcv = dpp_xor2(snd); if (up) v[e] = rcv; else v[e + 2] = rcv; } }
    { const bool od = (k & 1) != 0;
#pragma unroll
      for (int e = 0; e < 4; e += 2) { const float snd = od ? v[e] : v[e + 1]; const float rcv = swap_pair(snd); if (od) v[e] = rcv; else v[e + 1] = rcv; } }
}
DEV float wave_sum(float v) { for (int o = 32; o >= 1; o >>= 1) v += __shfl_xor(v, o); return v; }
DEV float wave_max(float v) { for (int o = 32; o >= 1; o >>= 1) v = fmaxf(v, __shfl_xor(v, o)); return v; }
DEV float siluf(float v) { return v / (1.f + expf(-v)); }
DEV float gelu_tanh(float v) { return 0.5f * v * (1.f + tanhf(0.7978845608028654f * (v + 0.044715f * v * v * v))); }
DEV float bf2f(bf16_t b) { return __uint_as_float(((unsigned)b) << 16); }
DEV bf16_t f2bf(float f) { unsigned u = __float_as_uint(f); u += 0x7FFFu + ((u >> 16) & 1u); return (bf16_t)(u >> 16); }

template <class CF, class AF, class BF, class EF>
DEV void ngemm(int ngroups, CF cntf, int N, int K, AF af, BF bf, EF ef, float* lds, int bid, int nb) {
    float* As = lds;
    float* Bs = lds + 16 * 132;
    int* pre = (int*)(lds + 16 * 132 + 16 * 68);
    const int tid = tidx(), tx = tid & 15, ty = tid >> 4;
    const int tilesN = (N + 63) / 64;
    __syncthreads();
    if (tid == 0) { int s = 0; for (int g = 0; g < ngroups; ++g) { pre[g] = s; s += ((cntf(g) + 127) / 128) * tilesN; } pre[ngroups] = s; }
    __syncthreads();
    const int total = pre[ngroups];
    for (int tile = bid; tile < total; tile += nb) {
        int g = 0; while (g + 1 < ngroups && pre[g + 1] <= tile) ++g;
        const int lt = tile - pre[g], tm = lt / tilesN, tn = lt % tilesN, M = cntf(g);
        float acc[4][4];
#pragma unroll
        for (int i = 0; i < 4; ++i)
#pragma unroll
            for (int j = 0; j < 4; ++j) acc[i][j] = 0.f;
        for (int k0 = 0; k0 < K; k0 += 16) {
#pragma unroll
            for (int it = 0; it < 4; ++it) { const int i = tid + it * 512, m = i >> 4, k = i & 15, gm = tm * 128 + m; As[k * 132 + m] = (gm < M) ? af(g, gm, k0 + k) : 0.f; }
#pragma unroll
            for (int it = 0; it < 2; ++it) { const int i = tid + it * 512, k = i >> 6, n = i & 63, gn = tn * 64 + n; Bs[k * 68 + n] = (gn < N) ? bf(g, k0 + k, gn) : 0.f; }
            __syncthreads();
#pragma unroll
            for (int k = 0; k < 16; ++k) {
                const float4 a = *(const float4*)(As + k * 132 + ty * 4), b = *(const float4*)(Bs + k * 68 + tx * 4);
                const float av[4] = {a.x, a.y, a.z, a.w}, bv[4] = {b.x, b.y, b.z, b.w};
#pragma unroll
                for (int i = 0; i < 4; ++i)
#pragma unroll
                    for (int j = 0; j < 4; ++j) acc[i][j] = fmaf(av[i], bv[j], acc[i][j]);
            }
            __syncthreads();
        }
#pragma unroll
        for (int i = 0; i < 4; ++i)
#pragma unroll
            for (int j = 0; j < 4; ++j) { const int gm = tm * 128 + ty * 4 + i, gn = tn * 64 + tx * 4 + j; if (gm < M && gn < N) ef(g, gm, gn, acc[i][j]); }
    }
}

#define MG_LAS __attribute__((address_space(3)))

typedef short bf16x8 __attribute__((ext_vector_type(8)));
typedef float f32x4 __attribute__((ext_vector_type(4)));
typedef unsigned u32x4 __attribute__((ext_vector_type(4)));
typedef unsigned u32x2 __attribute__((ext_vector_type(2)));
typedef int i32x8 __attribute__((ext_vector_type(8)));
typedef int i32x4 __attribute__((ext_vector_type(4)));
DEV unsigned pk8(float a, float b, float c, float d) {
    a = __builtin_amdgcn_fmed3f(a, -448.f, 448.f); b = __builtin_amdgcn_fmed3f(b, -448.f, 448.f); c = __builtin_amdgcn_fmed3f(c, -448.f, 448.f); d = __builtin_amdgcn_fmed3f(d, -448.f, 448.f);
    int w = __builtin_amdgcn_cvt_pk_fp8_f32(a, b, 0, false); w = __builtin_amdgcn_cvt_pk_fp8_f32(c, d, w, true); return (unsigned)w; }
constexpr float F8_SX = 4.f, F8_SW = 256.f, F8_SACT = 8.f, F8_SO = 16.f;
namespace mg {
constexpr int BM = 256, BK = 64, HALF = 128, HTB = HALF * BK * 2, STAGE_BYTES = 8 * HTB, NXCD = 8, WGM = 8;
DEV int lds_byte(int r, int c) { const int st = (r >> 4) * 2 + (c >> 5), rr = r & 15, cc = c & 31, ob = rr * 64 + cc * 2; return st * 1024 + (ob ^ (((ob >> 9) & 1) << 5)); }
DEV void stage_rc(int b, int& R, int& C) { const int st = b / 1024, sb = b % 1024, swz = sb ^ (((sb >> 9) & 1) << 5); R = (st >> 1) * 16 + swz / 64; C = (st & 1) * 32 + (swz % 64) / 2; }
DEV int perm32(int rho) { const int n = rho >> 4, i = rho & 15; return 8 * (i >> 2) + 4 * n + (i & 3); }
DEV unsigned cvt_pk_bf16(float lo, float hi) { unsigned r; asm volatile("v_cvt_pk_bf16_f32 %0, %1, %2" : "=v"(r) : "v"(lo), "v"(hi)); return r; }
struct Unit { int g, pm, pn; };

struct StaticOrder {
    int nM, nN, nwg, G, c;
    DEV void init(int M, int N, int G_, int c_) { nM = M / BM; nN = N / BM; nwg = nM * nN; G = G_; c = c_; }
    DEV bool next(int i, Unit& u) const {
        const long L = (long)i * G + c; if (L >= nwg) return false;
        int wgid = (int)L; { const int q = nwg / NXCD, r = nwg % NXCD, xcd = wgid % NXCD, off = wgid / NXCD; wgid = (xcd < r ? xcd * (q + 1) : r * (q + 1) + (xcd - r) * q) + off; }
        const int nig = WGM * nN, gid = wgid / nig, fm = gid * WGM, gsz = (nM - fm) < WGM ? (nM - fm) : WGM;
        u.g = 0; u.pm = fm + ((wgid % nig) % gsz); u.pn = (wgid % nig) / gsz; return true;
    }
};
struct GroupedOrder {
    const int* pre; int ng, nN, G, c;
    DEV bool next(int i, Unit& u) const {
        const int L = i * G + c; if (L >= pre[ng] * nN) return false;
        const int mt = L / nN; u.pn = L - mt * nN; int g = 0; while (g + 1 < ng && pre[g + 1] <= mt) ++g;
        u.g = __builtin_amdgcn_readfirstlane(g); u.pm = __builtin_amdgcn_readfirstlane(mt - pre[g]); u.pn = __builtin_amdgcn_readfirstlane(u.pn); return true;
    }
};
struct FixedGroups {
    int ng, mt, nN, G, c;
    DEV bool next(int i, Unit& u) const { const int L = i * G + c; if (L >= ng * mt * nN) return false; u.pn = L % nN; const int r = L / nN; u.pm = r % mt; u.g = r / mt; return true; }
};
struct AGrouped { static constexpr bool GATHER = false; const bf16_t* A; int lda; size_t gstride; DEV const char* ubase(const Unit& u) const { return (const char*)(A + (size_t)u.g * gstride + (size_t)u.pm * BM * lda); } DEV unsigned rowoff(const Unit&, int r) const { return (unsigned)(r * lda) * 2u; } };
struct APlain { static constexpr bool GATHER = false; const bf16_t* A; int lda; DEV const char* ubase(const Unit& u) const { return (const char*)(A + (size_t)u.pm * BM * lda); } DEV unsigned rowoff(const Unit&, int r) const { return (unsigned)(r * lda) * 2u; } };
struct BPlain { const bf16_t* Bt; int ldb; size_t gstride; DEV const char* base(const Unit& u) const { return (const char*)(Bt + (size_t)u.g * gstride + (size_t)u.pn * BM * ldb); } };

template <bool FP8 = false, int DS = 0  , class AOp, class BOp, class Epi, class Sched>
DEV void gemm_phase(MG_LAS unsigned char* lds, const int K, const AOp& aop, const BOp& bop, const Sched& S, const Epi& E) {
    int tid_ = tidx();
    const int tid = tid_, wid = __builtin_amdgcn_readfirstlane(tid >> 6), lane = tid & 63, wr = wid >> 2, wc = wid & 3, fr = lane & 15, fq = lane >> 4;
    int nt = K / BK; asm volatile("" : "+s"(nt));
    unsigned voffB[2];
#pragma unroll
    for (int i = 0; i < 2; ++i) { int R, C; stage_rc(tid * 16 + i * 8192, R, C); const int Rb = Epi::PERM ? ((R & ~31) + perm32(R & 31)) : R; voffB[i] = (unsigned)(Rb * bop.ldb + C) * 2u; }
#define MG_ROWOFFS(dst, unit) do { _Pragma("unroll") for (int _h = 0; _h < 2; ++_h) _Pragma("unroll") for (int _i = 0; _i < 2; ++_i) { int _R, _C; stage_rc(tid * 16 + _i * 8192, _R, _C); dst[_h][_i] = aop.rowoff(unit, _h * HALF + _R) + (unsigned)(_C * 2); } } while (0)
    const size_t kstep = (size_t)(BK * 2);
    const size_t hstepB = (size_t)HALF * bop.ldb * 2;
    const unsigned ldsw = (unsigned)wid * 1024u;
    const int aoff = lds_byte(wr * 64 + fr, fq * 8), boff = lds_byte(wc * 32 + fr, fq * 8);
#define MG_SA(b, h) (((b) * 2 + (h)) * HTB)
#define MG_SB(b, h) ((4 + (b) * 2 + (h)) * HTB)
#define MG_STAGE(bufoff, gbase, voff) do { _Pragma("unroll") for (int _i = 0; _i < 2; ++_i) \
        __builtin_amdgcn_global_load_lds((const unsigned*)((const char*)(gbase) + (voff)[_i]), (MG_LAS unsigned*)(lds + (bufoff) + ldsw + _i * 8192), 16, 0, 0); } while (0)
#define MG_LDA(dst, b, h) do { if constexpr (FP8) { _Pragma("unroll") for (int m = 0; m < 4; ++m) { dst##8[m].lo = *(const MG_LAS i32x4*)(lds + MG_SA(b, h) + aoff + m * 2048); dst##8[m].hi = *(const MG_LAS i32x4*)(lds + MG_SA(b, h) + aoff + m * 2048 + 1024); } } else { \
        _Pragma("unroll") for (int m = 0; m < 4; ++m) _Pragma("unroll") for (int k = 0; k < 2; ++k) dst[m][k] = *(const MG_LAS bf16x8*)(lds + MG_SA(b, h) + aoff + m * 2048 + k * 1024); } } while (0)
#define MG_LDB(dst, b, h) do { if constexpr (FP8) { _Pragma("unroll") for (int n = 0; n < 2; ++n) { dst##8[n].lo = *(const MG_LAS i32x4*)(lds + MG_SB(b, h) + boff + n * 2048); dst##8[n].hi = *(const MG_LAS i32x4*)(lds + MG_SB(b, h) + boff + n * 2048 + 1024); } } else { \
        _Pragma("unroll") for (int n = 0; n < 2; ++n) _Pragma("unroll") for (int k = 0; k < 2; ++k) dst[n][k] = *(const MG_LAS bf16x8*)(lds + MG_SB(b, h) + boff + n * 2048 + k * 1024); } } while (0)
#define MG_MMA(ai, bj, At, Bt) do { __builtin_amdgcn_s_setprio(1); if constexpr (FP8) { _Pragma("unroll") for (int m = 0; m < 4; ++m) _Pragma("unroll") for (int n = 0; n < 2; ++n) \
        asm volatile("v_mfma_f32_16x16x128_f8f6f4 %0, %1, %2, %0" : "+v"(acc[ai][bj][m][n]) : "v"(Bt##8[n]), "v"(At##8[m])); } else {     \
        _Pragma("unroll") for (int m = 0; m < 4; ++m) _Pragma("unroll") for (int n = 0; n < 2; ++n) _Pragma("unroll") for (int k = 0; k < 2; ++k) \
        acc[ai][bj][m][n] = __builtin_amdgcn_mfma_f32_16x16x32_bf16(Bt[n][k], At[m][k], acc[ai][bj][m][n], 0, 0, 0); } __builtin_amdgcn_s_setprio(0); } while (0)
#define MG_WAIT_V(n) asm volatile("s_waitcnt vmcnt(" #n ")" ::: "memory")
#define MG_WAIT_L(n) asm volatile("s_waitcnt lgkmcnt(" #n ")" ::: "memory")
#define MG_BAR __builtin_amdgcn_s_barrier()
#define MG_SCHED __builtin_amdgcn_sched_barrier(0)
    Unit cur, nxt; int ui = 0;
    if (!S.next(0, cur)) return;
    f32x4 acc[2][2][4][2];
#define MG_ACC_INIT(unit) do { if constexpr (Epi::ACC_INIT) E.init(acc, unit, wr, wc, fr, fq); else { \
        _Pragma("unroll") for (int a = 0; a < 2; ++a) _Pragma("unroll") for (int b = 0; b < 2; ++b) _Pragma("unroll") for (int m = 0; m < 4; ++m) _Pragma("unroll") for (int n = 0; n < 2; ++n) acc[a][b][m][n] = (f32x4){0.f, 0.f, 0.f, 0.f}; } } while (0)
    MG_ACC_INIT(cur);
    bf16x8 At[4][2], B0[2][2], B1[2][2];
    i32x8 At8[4], B08[2], B18[2];
    unsigned vAc[2][2], vAn[2][2];
    MG_ROWOFFS(vAc, cur);
    const char* cA = aop.ubase(cur); const char* cB = bop.base(cur);
    MG_STAGE(MG_SB(0, 0), cB, voffB); MG_STAGE(MG_SA(0, 0), cA, vAc[0]); MG_STAGE(MG_SB(0, 1), cB + hstepB, voffB); MG_STAGE(MG_SA(0, 1), cA, vAc[1]);
    if (wr == 1) MG_BAR;
    MG_WAIT_V(4); MG_BAR;
    MG_STAGE(MG_SB(1, 0), cB + kstep, voffB); MG_STAGE(MG_SA(1, 0), cA + kstep, vAc[0]); MG_STAGE(MG_SB(1, 1), cB + hstepB + kstep, voffB);
    MG_WAIT_V(6); MG_BAR;
    for (;;) {
        const bool has_next = S.next(ui + 1, nxt);
        const char* nB = has_next ? bop.base(nxt) : cB; const char* nA = has_next ? aop.ubase(nxt) : cA;
        if constexpr (AOp::GATHER) { if (has_next) MG_ROWOFFS(vAn, nxt); else {
#pragma unroll
            for (int h = 0; h < 2; ++h)
#pragma unroll
                for (int i = 0; i < 2; ++i) vAn[h][i] = vAc[h][i]; } }
        for (int t = 0; t < nt; t += 2) {
            const bool last = (t == nt - 2);
            const char* a1 = cA + (size_t)(t + 1) * kstep;
            const char* a2 = last ? nA : cA + (size_t)(t + 2) * kstep; const char* b2 = last ? nB : cB + (size_t)(t + 2) * kstep;
            const char* a3 = a2 + kstep; const char* b3 = b2 + kstep;
            MG_LDB(B0, 0, 0); MG_SCHED; MG_LDA(At, 0, 0); MG_STAGE(MG_SA(1, 1), a1, vAc[1]);
            if constexpr (AOp::GATHER) { if (last) {
#pragma unroll
                for (int h = 0; h < 2; ++h)
#pragma unroll
                    for (int i = 0; i < 2; ++i) vAc[h][i] = vAn[h][i]; } }
            MG_WAIT_L(8); MG_BAR; MG_WAIT_L(0); MG_MMA(0, 0, At, B0); MG_BAR; MG_SCHED;
            MG_LDB(B1, 0, 1); MG_STAGE(MG_SB(0, 0), b2, voffB);
            MG_BAR; MG_WAIT_L(0); MG_MMA(0, 1, At, B1); MG_BAR;
            MG_LDA(At, 0, 1); MG_STAGE(MG_SA(0, 0), a2, vAc[0]);
            MG_BAR; MG_WAIT_L(0); MG_MMA(1, 0, At, B0); MG_BAR; MG_SCHED;
            MG_STAGE(MG_SB(0, 1), b2 + hstepB, voffB);
            MG_WAIT_V(6); MG_BAR; MG_MMA(1, 1, At, B1); MG_BAR;
            MG_LDB(B0, 1, 0); MG_SCHED; MG_LDA(At, 1, 0); MG_STAGE(MG_SA(0, 1), a2, vAc[1]);
            MG_WAIT_L(8); MG_BAR; MG_WAIT_L(0); MG_MMA(0, 0, At, B0); MG_BAR; MG_SCHED;
            MG_LDB(B1, 1, 1); MG_STAGE(MG_SB(1, 0), b3, voffB);
            MG_BAR; MG_WAIT_L(0); MG_MMA(0, 1, At, B1); MG_BAR;
            MG_LDA(At, 1, 1); MG_STAGE(MG_SA(1, 0), a3, vAc[0]);
            MG_BAR; MG_WAIT_L(0); MG_MMA(1, 0, At, B0); MG_BAR; MG_SCHED;
            MG_STAGE(MG_SB(1, 1), b3 + hstepB, voffB);
            MG_WAIT_V(6); MG_BAR; MG_MMA(1, 1, At, B1); MG_BAR;
        }
        __builtin_amdgcn_sched_barrier(0); asm volatile("s_nop 15\n\ts_nop 15" ::: "memory"); __builtin_amdgcn_sched_barrier(0);
        if constexpr (DS != 0) {
#pragma unroll
            for (int a = 0; a < 2; ++a)
#pragma unroll
                for (int b = 0; b < 2; ++b)
#pragma unroll
                    for (int m = 0; m < 4; ++m)
#pragma unroll
                        for (int n = 0; n < 2; ++n) acc[a][b][m][n] *= (1.f / (float)(1 << DS)); }
        { int fr2 = fr, fq2 = fq; asm volatile("" : "+v"(fr2), "+v"(fq2));
          E(acc, cur, wr, wc, fr2, fq2); }
        if (!has_next) break;
        MG_ACC_INIT(nxt);
        cur = nxt; cB = nB; cA = nA; ++ui;
    }
    MG_WAIT_V(0);
    if (wr == 0) MG_BAR;
    MG_BAR;
#undef MG_ROWOFFS
#undef MG_ACC_INIT
#undef MG_SA
#undef MG_SB
#undef MG_STAGE
#undef MG_LDA
#undef MG_LDB
#undef MG_MMA
#undef MG_WAIT_V
#undef MG_WAIT_L
#undef MG_BAR
#undef MG_SCHED
}
}
#define EPI_ROWS_BEGIN _Pragma("unroll") for (int ai = 0; ai < 2; ++ai) _Pragma("unroll") for (int m = 0; m < 4; ++m) { const int rt = ai * 128 + wr * 64 + m * 16 + fr;
#define EPI_ROWS_END }
struct EpiF32 {
    static constexpr bool PERM = false, ACC_INIT = false;
    float* C; int ldc, nvalid;
    DEV void operator()(const f32x4 (&acc)[2][2][4][2], const mg::Unit& u, int wr, int wc, int fr, int fq) const {
        EPI_ROWS_BEGIN float* rowp = C + (size_t)(u.pm * 256 + rt) * ldc;
#pragma unroll
            for (int bj = 0; bj < 2; ++bj)
#pragma unroll
                for (int n = 0; n < 2; ++n) { const int col = u.pn * 256 + bj * 128 + wc * 32 + n * 16 + 4 * fq; if (col < nvalid) *(f32x4*)(rowp + col) = acc[ai][bj][m][n]; }
        EPI_ROWS_END
    }
};
template <bool RB16, int IS = 0  >
struct EpiResid {
    static constexpr bool PERM = true, ACC_INIT = true;
    const void* __restrict__ resid; bf16_t* __restrict__ out;
    DEV void init(f32x4 (&acc)[2][2][4][2], const mg::Unit& u, int wr, int wc, int fr, int fq) const {
#pragma unroll
        for (int ai = 0; ai < 2; ++ai)
#pragma unroll
            for (int m = 0; m < 4; ++m) { const size_t ro = (size_t)(u.pm * 256 + ai * 128 + wr * 64 + m * 16 + fr) * D_MODEL;
#pragma unroll
                for (int bj = 0; bj < 2; ++bj) { const size_t o = ro + u.pn * 256 + bj * 128 + wc * 32 + 8 * fq;
                    if constexpr (RB16) { const u32x4 w = __builtin_nontemporal_load((const u32x4*)((const bf16_t*)resid + o));
                        acc[ai][bj][m][0] = (f32x4){__uint_as_float(w.x << 16), __uint_as_float(w.x & 0xffff0000u), __uint_as_float(w.y << 16), __uint_as_float(w.y & 0xffff0000u)};
                        acc[ai][bj][m][1] = (f32x4){__uint_as_float(w.z << 16), __uint_as_float(w.z & 0xffff0000u), __uint_as_float(w.w << 16), __uint_as_float(w.w & 0xffff0000u)}; }
                    else { acc[ai][bj][m][0] = __builtin_nontemporal_load((const f32x4*)((const float*)resid + o)); acc[ai][bj][m][1] = __builtin_nontemporal_load((const f32x4*)((const float*)resid + o + 4)); }
                    if constexpr (IS != 0) { acc[ai][bj][m][0] *= (float)(1 << IS); acc[ai][bj][m][1] *= (float)(1 << IS); } } }
    }
    DEV void operator()(const f32x4 (&acc)[2][2][4][2], const mg::Unit& u, int wr, int wc, int fr, int fq) const {
#pragma unroll
        for (int ai = 0; ai < 2; ++ai)
#pragma unroll
            for (int m = 0; m < 4; ++m) { const size_t ro = (size_t)(u.pm * 256 + ai * 128 + wr * 64 + m * 16 + fr) * D_MODEL;
#pragma unroll
                for (int bj = 0; bj < 2; ++bj) { const f32x4 v0 = acc[ai][bj][m][0], v1 = acc[ai][bj][m][1];
                    u32x4 w; w.x = mg::cvt_pk_bf16(v0[0], v0[1]); w.y = mg::cvt_pk_bf16(v0[2], v0[3]); w.z = mg::cvt_pk_bf16(v1[0], v1[1]); w.w = mg::cvt_pk_bf16(v1[2], v1[3]);
                    *(u32x4*)(out + ro + u.pn * 256 + bj * 128 + wc * 32 + 8 * fq) = w; } }
    }
};
struct EpiSsdIn {
    static constexpr bool PERM = true, ACC_INIT = false;
    bf16_t* z; bf16_t* xbc; float* dtb; const float* dt_bias;
    DEV void operator()(const f32x4 (&acc)[2][2][4][2], const mg::Unit& u, int wr, int wc, int fr, int fq) const {
        if (u.pn < OFF_DT / 256) {
            EPI_ROWS_BEGIN const int row = u.pm * 256 + rt;
#pragma unroll
                for (int bj = 0; bj < 2; ++bj) { const int col = u.pn * 256 + bj * 128 + wc * 32 + 8 * fq; const f32x4 v0 = acc[ai][bj][m][0], v1 = acc[ai][bj][m][1];
                    u32x4 w; w.x = mg::cvt_pk_bf16(v0[0], v0[1]); w.y = mg::cvt_pk_bf16(v0[2], v0[3]); w.z = mg::cvt_pk_bf16(v1[0], v1[1]); w.w = mg::cvt_pk_bf16(v1[2], v1[3]);
                    bf16_t* dst = col < OFF_XBC ? z + (size_t)row * SSD_DI + col : xbc + (size_t)row * SSD_CONVCH + (col - OFF_XBC); *(u32x4*)dst = w; }
            EPI_ROWS_END
        } else if (wc < 2) {
            const int hcol = wc * 32 + 8 * fq; float bb[8];
#pragma unroll
            for (int j = 0; j < 8; ++j) bb[j] = dt_bias[hcol + j];
            EPI_ROWS_BEGIN const int row = u.pm * 256 + rt; float o[8];
#pragma unroll
                for (int j = 0; j < 4; ++j) { o[j] = acc[ai][0][m][0][j] + bb[j]; o[4 + j] = acc[ai][0][m][1][j] + bb[4 + j]; }
#pragma unroll
                for (int j = 0; j < 8; ++j) { const float x = o[j], uu = __expf(-fabsf(x)); const float lg = uu < 0.01f ? uu * (1.f - uu * (0.5f - uu * 0.33333333f)) : __logf(1.f + uu); o[j] = fmaxf(x, 0.f) + lg; }
                *(f32x4*)(dtb + (size_t)row * 64 + hcol) = (f32x4){o[0], o[1], o[2], o[3]}; *(f32x4*)(dtb + (size_t)row * 64 + hcol + 4) = (f32x4){o[4], o[5], o[6], o[7]};
            EPI_ROWS_END
        }
    }
};
struct EpiNsaIn {
    static constexpr bool PERM = true, ACC_INIT = false;
    bf16_t *q, *ks, *vs, *kw, *vw, *acmp; float* gate; const float* rope; const float* pe;
    DEV static void st4(bf16_t* dst, const float* o) { u32x2 w; w.x = mg::cvt_pk_bf16(o[0], o[1]); w.y = mg::cvt_pk_bf16(o[2], o[3]); *(u32x2*)dst = w; }
    DEV bf16_t* cmp_row(int kv, int b, int t, int g) const { return acmp + ((size_t)(kv * 16 + b * 4 + g) * SEQ + t) * 128; }
    DEV void operator()(const f32x4 (&acc)[2][2][4][2], const mg::Unit& u, int wr, int wc, int fr, int fq) const {
        const int pn = u.pn; const bool is_rope = pn < 10 || pn == 12 || pn == 13 || pn == 16 || pn == 17;
#pragma unroll
        for (int ai = 0; ai < 2; ++ai) {
        f32x4 csv[4][2];
        if (is_rope) {
#pragma unroll
            for (int m = 0; m < 4; ++m) { const int t = (u.pm * 256 + ai * 128 + wr * 64 + m * 16 + fr) & (SEQ - 1); const float* rp = rope + (size_t)(t * 64 + 16 * wc + 4 * fq) * 2;
                csv[m][0] = *(const f32x4*)rp; csv[m][1] = *(const f32x4*)(rp + 4); } }
#pragma unroll
        for (int m = 0; m < 4; ++m) { const int rt = ai * 128 + wr * 64 + m * 16 + fr;
        const int row = u.pm * 256 + rt, t = row & (SEQ - 1), b = row >> 11;
#pragma unroll
            for (int bj = 0; bj < 2; ++bj) { const f32x4 v0 = acc[ai][bj][m][0], v1 = acc[ai][bj][m][1];
                if (is_rope) { const int d = 16 * wc + 4 * fq;
                    const f32x4 cs0 = csv[m][0], cs1 = csv[m][1];
                    const float c[4] = {cs0[0], cs0[2], cs1[0], cs1[2]}, sn[4] = {cs0[1], cs0[3], cs1[1], cs1[3]}; float o1[4], o2[4];
#pragma unroll
                    for (int j = 0; j < 4; ++j) { o1[j] = v0[j] * c[j] - v1[j] * sn[j]; o2[j] = v1[j] * c[j] + v0[j] * sn[j]; }
                    if (pn < 8) { bf16_t* dst = q + (size_t)row * 2048 + (2 * pn + bj) * 128 + d; st4(dst, o1); st4(dst + 64, o2); }
                    else if (pn < 10) { bf16_t* dst = cmp_row(0, b, t, 2 * (pn - 8) + bj) + d; st4(dst, o1); st4(dst + 64, o2); }
                    else { bf16_t* dst = (pn < 14 ? ks + (size_t)row * 512 + (2 * (pn - 12) + bj) * 128 : kw + (size_t)row * 512 + (2 * (pn - 16) + bj) * 128) + d; st4(dst, o1); st4(dst + 64, o2); }
                } else { const int c0 = 32 * wc + 8 * fq; const float o1[4] = {v0[0], v0[1], v0[2], v0[3]}, o2[4] = {v1[0], v1[1], v1[2], v1[3]};
                    if (pn < 12) { bf16_t* dst = cmp_row(1, b, t, 2 * (pn - 10) + bj) + c0; st4(dst, o1); st4(dst + 4, o2); }
                    else if (pn < 20) { bf16_t* dst = (pn < 16 ? vs + (size_t)row * 512 + (2 * (pn - 14) + bj) * 128 : vw + (size_t)row * 512 + (2 * (pn - 18) + bj) * 128) + c0; st4(dst, o1); st4(dst + 4, o2); }
                    else { const int col = bj * 128 + c0; if (col < 48) { float* gd = gate + (size_t)row * 48 + col;
#pragma unroll
                            for (int j = 0; j < 4; ++j) { gd[j] = 1.f / (1.f + __expf(-o1[j])); gd[4 + j] = 1.f / (1.f + __expf(-o2[j])); } } }
                } }
        } }
    }
};
struct EpiCmp1 {
    static constexpr bool PERM = true, ACC_INIT = false;
    bf16_t* h1; const float* cb;
    DEV void operator()(const f32x4 (&acc)[2][2][4][2], const mg::Unit& u, int wr, int wc, int fr, int fq) const {
        EPI_ROWS_BEGIN bf16_t* rowp = h1 + ((size_t)u.g * 2048 + u.pm * 256 + rt) * 256;
#pragma unroll
            for (int bj = 0; bj < 2; ++bj) { const int col = bj * 128 + wc * 32 + 8 * fq; float o[8];
#pragma unroll
                for (int j = 0; j < 4; ++j) { o[j] = acc[ai][bj][m][0][j] + cb[u.g * 256 + col + j]; o[4 + j] = acc[ai][bj][m][1][j] + cb[u.g * 256 + col + 4 + j]; }
#pragma unroll
                for (int j = 0; j < 8; ++j) { const float v = o[j], uu = 1.5957691216057308f * (v + 0.044715f * v * v * v); o[j] = v / (1.f + __expf(-uu)); }
                u32x4 w; w.x = mg::cvt_pk_bf16(o[0], o[1]); w.y = mg::cvt_pk_bf16(o[2], o[3]); w.z = mg::cvt_pk_bf16(o[4], o[5]); w.w = mg::cvt_pk_bf16(o[6], o[7]); *(u32x4*)(rowp + col) = w; }
        EPI_ROWS_END
    }
};
struct EpiCmp2 {
    static constexpr bool PERM = true, ACC_INIT = false;
    bf16_t* kvc;
    DEV void operator()(const f32x4 (&acc)[2][2][4][2], const mg::Unit& u, int wr, int wc, int fr, int fq) const {
        EPI_ROWS_BEGIN const int mrow = u.pm * 256 + rt; bf16_t* rowp = kvc + ((size_t)u.g * 2048 + mrow) * 128; const bool pad = (mrow & 127) == 127;
            { const int col = wc * 32 + 8 * fq; const f32x4 v0 = acc[ai][0][m][0], v1 = acc[ai][0][m][1];
              u32x4 w; w.x = mg::cvt_pk_bf16(v0[0], v0[1]); w.y = mg::cvt_pk_bf16(v0[2], v0[3]); w.z = mg::cvt_pk_bf16(v1[0], v1[1]); w.w = mg::cvt_pk_bf16(v1[2], v1[3]);
              if (pad) w = (u32x4){0u, 0u, 0u, 0u}; *(u32x4*)(rowp + col) = w; }
        EPI_ROWS_END
    }
};
DEV void cmp_gemm2_rows(const bf16_t* h1, const bf16_t* w2t  , bf16_t* kvc, int rowbase  ) {
    typedef float f32x16 __attribute__((ext_vector_type(16)));
    const int tid = tidx(), wid = tid >> 6, lane = tid & 63, r32 = lane & 31, hi = lane >> 5;
    const bf16_t* ap = h1 + (size_t)(rowbase + 32 * wid + r32) * 256 + hi * 8;
    const bf16_t* bp = w2t + (size_t)r32 * 256 + hi * 8;
    f32x16 acc[4] = {};
#pragma unroll 4
    for (int ks = 0; ks < 16; ++ks) { const bf16x8 a = *(const bf16x8*)(ap + ks * 16);
#pragma unroll
        for (int nbk = 0; nbk < 4; ++nbk) { const bf16x8 b = *(const bf16x8*)(bp + (size_t)nbk * 32 * 256 + ks * 16); acc[nbk] = __builtin_amdgcn_mfma_f32_32x32x16_bf16(a, b, acc[nbk], 0, 0, 0); } }
#pragma unroll
    for (int r = 0; r < 16; ++r) { const int row = rowbase + 32 * wid + (r & 3) + 8 * (r >> 2) + 4 * hi; const bool pad = (row & 127) == 127;
#pragma unroll
        for (int nbk = 0; nbk < 4; ++nbk) { const float v = pad ? 0.f : acc[nbk][r]; const float vn = swap_pair(v);
            if ((r32 & 1) == 0) *(unsigned*)(kvc + (size_t)row * 128 + nbk * 32 + r32) = mg::cvt_pk_bf16(v, vn); } }
}

struct AMoeGather { static constexpr bool GATHER = true; const bf16_t* A; const int* list; const int* cnt;
    DEV const char* ubase(const mg::Unit&) const { return (const char*)A; }
    DEV unsigned rowoff(const mg::Unit& u, int r) const { int idx = u.pm * 256 + r; const int c = cnt[u.g]; idx = idx < c ? idx : c - 1; return (unsigned)(list[u.g * T + idx] >> 1) * (unsigned)D_MODEL; } };
struct AMoeAct { static constexpr bool GATHER = false; const bf16_t* A; const int* tab;
    DEV const char* ubase(const mg::Unit& u) const { return (const char*)A + (size_t)(__builtin_amdgcn_readfirstlane(tab[64 + u.g]) + u.pm * 256) * MOE_FF; }
    DEV unsigned rowoff(const mg::Unit&, int r) const { return (unsigned)r * (unsigned)MOE_FF; } };
struct EpiMoeGU {
    static constexpr bool PERM = true, ACC_INIT = false;
    bf16_t* act; const int* cnt; const int* tab;
    DEV void operator()(const f32x4 (&acc)[2][2][4][2], const mg::Unit& u, int wr, int wc, int fr, int fq) const {
        const int c = cnt[u.g], rb = tab[64 + u.g];
        EPI_ROWS_BEGIN const int lr = u.pm * 256 + rt;
            if (lr < c) {
#pragma unroll
                for (int bj = 0; bj < 2; ++bj) { const int f = u.pn * 128 + bj * 64 + wc * 16 + 4 * fq; const f32x4 g = acc[ai][bj][m][0], up = acc[ai][bj][m][1]; float o[4];
#pragma unroll
                    for (int j = 0; j < 4; ++j) { const float gj = g[j] * (1.f / (F8_SX * F8_SW)); o[j] = gj / (1.f + __expf(-gj)) * (up[j] * (F8_SACT / (F8_SX * F8_SW))); }
                    *(unsigned*)((char*)act + (size_t)(rb + lr) * MOE_FF + f) = pk8(o[0], o[1], o[2], o[3]); } }
        EPI_ROWS_END
    }
};
struct EpiMoeDown {
    static constexpr bool PERM = true, ACC_INIT = false;
    bf16_t* ys; const int* list; const int* cnt; const float* lw;
    DEV void operator()(const f32x4 (&acc)[2][2][4][2], const mg::Unit& u, int wr, int wc, int fr, int fq) const {
        const int c = cnt[u.g];
        int idxv[2][4]; float wv[2][4];
#pragma unroll
        for (int ai = 0; ai < 2; ++ai)
#pragma unroll
            for (int m = 0; m < 4; ++m) { const int lr = u.pm * 256 + ai * 128 + wr * 64 + m * 16 + fr; const bool ok = lr < c;
                idxv[ai][m] = ok ? list[u.g * T + lr] : -1; wv[ai][m] = ok ? lw[u.g * T + lr] * (1.f / (F8_SACT * F8_SW)) : 0.f; }
#pragma unroll
        for (int ai = 0; ai < 2; ++ai)
#pragma unroll
            for (int m = 0; m < 4; ++m)
                if (idxv[ai][m] >= 0) { const float w = wv[ai][m]; bf16_t* rowp = ys + (size_t)idxv[ai][m] * D_MODEL;
#pragma unroll
                    for (int bj = 0; bj < 2; ++bj) { const int col = u.pn * 256 + bj * 128 + wc * 32 + 8 * fq; const f32x4 v0 = acc[ai][bj][m][0] * w, v1 = acc[ai][bj][m][1] * w;
                        u32x4 pk; pk.x = mg::cvt_pk_bf16(v0[0], v0[1]); pk.y = mg::cvt_pk_bf16(v0[2], v0[3]); pk.z = mg::cvt_pk_bf16(v1[0], v1[1]); pk.w = mg::cvt_pk_bf16(v1[2], v1[3]);
                        *(u32x4*)(rowp + col) = pk; } }
    }
};

template <bool F8 = false, class SF>
DEV void conv_wt(SF sf, int ngroups, int K, int Nphys, bf16_t* dst, float*  , int bid, int nb, int t0 = 0, int t1 = 0x7fffffff) {
    const int tid = tidx(), wid = tid >> 6, lane = tid & 63, kb = lane & 7, c4 = lane >> 3;
    const int ktn = K / 64, ntn = Nphys / 256, per = ktn * ntn, total = ngroups * per < t1 ? ngroups * per : t1;
    constexpr int NF = 4;
    (void)per; (void)total;
    const int ktq = ktn / 2, ntq = (ntn + 1) / 2, perq = ktq * ntq, totq = ngroups * perq;
    const int q0 = t0 / NF, q1 = (t1 == 0x7fffffff || t1 / NF > totq) ? totq : t1 / NF;
    for (int item = q0 + bid; item < q1; item += nb) {
        const int g = item / perq, rem = item - g * perq, kq = rem / ntq, nq = rem - kq * ntq;
        const int k0 = kq * 128 + kb * 16;
        f32x4 v[2][2][8];
#pragma unroll
        for (int un = 0; un < 2; ++un) { const int nt = nq * 2 + un; const int q = nt * 64 + wid * 8 + c4;
#pragma unroll
            for (int uk = 0; uk < 2; ++uk)
#pragma unroll
                for (int j = 0; j < 8; ++j) { const float* sp = nt < ntn ? sf(g, k0 + uk * 8 + j, q) : (const float*)nullptr; v[un][uk][j] = (f32x4){0.f, 0.f, 0.f, 0.f}; if (sp) v[un][uk][j] = __builtin_nontemporal_load((const f32x4*)sp); } }
#pragma unroll
        for (int un = 0; un < 2; ++un) { const int nt = nq * 2 + un; const int q = nt * 64 + wid * 8 + c4;
            if (nt < ntn) {
#pragma unroll
            for (int e = 0; e < 4; ++e) {
                if constexpr (F8) { u32x4 w;
                    w.x = pk8(v[un][0][0][e] * F8_SW, v[un][0][1][e] * F8_SW, v[un][0][2][e] * F8_SW, v[un][0][3][e] * F8_SW); w.y = pk8(v[un][0][4][e] * F8_SW, v[un][0][5][e] * F8_SW, v[un][0][6][e] * F8_SW, v[un][0][7][e] * F8_SW);
                    w.z = pk8(v[un][1][0][e] * F8_SW, v[un][1][1][e] * F8_SW, v[un][1][2][e] * F8_SW, v[un][1][3][e] * F8_SW); w.w = pk8(v[un][1][4][e] * F8_SW, v[un][1][5][e] * F8_SW, v[un][1][6][e] * F8_SW, v[un][1][7][e] * F8_SW);
                    __builtin_nontemporal_store(w, (u32x4*)((char*)dst + ((size_t)g * Nphys + 4 * q + e) * K + k0)); }
                else {
#pragma unroll
                    for (int uk = 0; uk < 2; ++uk) { u32x4 w; w.x = mg::cvt_pk_bf16(v[un][uk][0][e], v[un][uk][1][e]); w.y = mg::cvt_pk_bf16(v[un][uk][2][e], v[un][uk][3][e]); w.z = mg::cvt_pk_bf16(v[un][uk][4][e], v[un][uk][5][e]); w.w = mg::cvt_pk_bf16(v[un][uk][6][e], v[un][uk][7][e]);
                        __builtin_nontemporal_store(w, (u32x4*)(dst + ((size_t)g * Nphys + 4 * q + e) * K + k0 + uk * 8)); } } } } }
    }
}

template <bool F8 = false, bool X16 = false  >
DEV void rows_norm(const float* src, const bf16_t* add0, const bf16_t* add1, float* sumdst, const float* g, bf16_t* dst, int bid, int nb) {
    const int lane = tidx() & 63, wid = tidx() >> 6;
    for (int row = bid * 8 + wid; row < T; row += nb * 8) {
        float4 v[8]; float ss = 0.f;
#pragma unroll
        for (int i = 0; i < 8; ++i) {
            const size_t o = (size_t)row * D_MODEL + i * 256 + lane * 4;
            float4 a; if constexpr (X16) { const ushort4 s4 = *(const ushort4*)((const bf16_t*)src + o); a = make_float4(bf2f(s4.x), bf2f(s4.y), bf2f(s4.z), bf2f(s4.w)); } else a = *(const float4*)(src + o);
            if (add0) { const size_t o2 = (size_t)row * 2 * D_MODEL + i * 256 + lane * 4; const ushort4 b = *(const ushort4*)(add0 + o2), c = *(const ushort4*)(add1 + o2);
                a.x += bf2f(b.x) + bf2f(c.x); a.y += bf2f(b.y) + bf2f(c.y); a.z += bf2f(b.z) + bf2f(c.z); a.w += bf2f(b.w) + bf2f(c.w); }
            if (sumdst) { if constexpr (X16) { ushort4 q4; q4.x = f2bf(a.x); q4.y = f2bf(a.y); q4.z = f2bf(a.z); q4.w = f2bf(a.w); *(ushort4*)((bf16_t*)sumdst + o) = q4; } else *(float4*)(sumdst + o) = a; }
            v[i] = a; ss += a.x * a.x + a.y * a.y + a.z * a.z + a.w * a.w;
        }
        ss = wave_sum(ss);
        const float rinv = rsqrtf(ss * (1.f / D_MODEL) + NORM_EPS);
#pragma unroll
        for (int i = 0; i < 8; ++i) {
            const int c = i * 256 + lane * 4; const float4 gg = *(const float4*)(g + c);
            if constexpr (F8) { const float rs = rinv * F8_SX; *(unsigned*)((char*)dst + (size_t)row * D_MODEL + c) = pk8(v[i].x * rs * gg.x, v[i].y * rs * gg.y, v[i].z * rs * gg.z, v[i].w * rs * gg.w); }
            else { ushort4 o; o.x = f2bf(v[i].x * rinv * gg.x); o.y = f2bf(v[i].y * rinv * gg.y); o.z = f2bf(v[i].z * rinv * gg.z); o.w = f2bf(v[i].w * rinv * gg.w);
                *(ushort4*)(dst + (size_t)row * D_MODEL + c) = o; }
        }
    }
}

DEV void ph_rope_table(const P& p, int bid, int nb) {
    for (int i = bid * NTHREADS + tidx(); i < SEQ * 64; i += nb * NTHREADS) {
        const int pos = i >> 6, j = i & 63;
        const double inv = exp(-log(10000.0) * (double)j / 64.0);
        const float invf = (float)inv;
        const float ang = (float)pos * invf;
        p.rope[i * 2] = (float)cos((double)ang); p.rope[i * 2 + 1] = (float)sin((double)ang);
    }
}

DEV void ph_cmp_attn(const P& p, float* lds, int bid, int nb) {
    const int lane = tidx() & 63, wid = tidx() >> 6;
    float* qs = lds + wid * 640; float* ps = qs + 512;
    float* ocmp = (float*)(p.big + BIG_NSA_OCMP);
    const bf16_t* Q = (const bf16_t*)(p.big + BIG_NSA_Q);
    const float scale = 0.08838834764831845f;
    const bf16_t* kc = (const bf16_t*)(p.big + BIG_NSA_KVC); const bf16_t* vc = kc + (size_t)2048 * 128;
    for (int u = bid * 8 + wid; u < T * NKV; u += nb * 8) {
        const int g = u & 3, tok = u >> 2, b = tok / SEQ, t = tok % SEQ;
        const int ncv = t >= 31 ? (t - 31) / 16 + 1 : 0;
        const bf16_t* qrow = Q + (size_t)tok * 2048 + g * 4 * 128;
#pragma unroll
        for (int i = 0; i < 8; ++i) qs[lane + 64 * i] = bf2f(qrow[lane + 64 * i]);
        float psum0 = 0.f, psum1 = 0.f;
        for (int r = 0; r < 4; ++r) {
            float s0 = -INFINITY, s1 = -INFINITY;
            if (lane < ncv) { const bf16_t* kr = kc + ((size_t)((b * 4 + g) * 128 + lane)) * 128; float a = 0.f; for (int d = 0; d < 128; ++d) a = fmaf(qs[r * 128 + d], bf2f(kr[d]), a); s0 = a * scale; }
            if (lane + 64 < ncv) { const bf16_t* kr = kc + ((size_t)((b * 4 + g) * 128 + lane + 64)) * 128; float a = 0.f; for (int d = 0; d < 128; ++d) a = fmaf(qs[r * 128 + d], bf2f(kr[d]), a); s1 = a * scale; }
            float p0 = 0.f, p1 = 0.f;
            if (ncv > 0) {
                const float m = wave_max(fmaxf(s0, s1));
                const float e0 = lane < ncv ? expf(s0 - m) : 0.f, e1 = lane + 64 < ncv ? expf(s1 - m) : 0.f;
                const float sum = wave_sum(e0 + e1);
                p0 = e0 / sum; p1 = e1 / sum;
            }
            psum0 += p0; psum1 += p1;
            float o0 = 0.f, o1 = 0.f;
            for (int c = 0; c < ncv; ++c) {
                const float pc = c < 64 ? __shfl(p0, c) : __shfl(p1, c - 64);
                const bf16_t* vr = vc + ((size_t)((b * 4 + g) * 128 + c)) * 128;
                o0 = fmaf(pc, bf2f(vr[lane]), o0); o1 = fmaf(pc, bf2f(vr[lane + 64]), o1);
            }
            float* orow = ocmp + (size_t)tok * 2048 + (g * 4 + r) * 128;
            orow[lane] = o0; orow[lane + 64] = o1;
        }
        ps[lane] = psum0; ps[lane + 64] = psum1;
        float val = -INFINITY;
        const int j = lane;
        if (j < 32) {
            float imp = ps[4 * j] + ps[4 * j + 1] + ps[4 * j + 2] + 0.5f * ps[4 * j + 3] + (j > 0 ? 0.5f * ps[4 * j - 1] : 0.f);
            const int dist = (t >> 6) - j;
            const bool forced = (j == 0) || (dist >= 0 && dist < 2);
            val = forced ? 1e4f : imp;
            if (dist < 0) val = -INFINITY;
        }
        int rank = 0;
        for (int i = 0; i < 32; ++i) { const float vi = __shfl(val, i); rank += (vi > val || (vi == val && i < j)) ? 1 : 0; }
        const unsigned long long bal = __ballot(j < 32 && rank < 16);
        if (lane == 0) p.selmask[(size_t)(b * NKV + g) * SEQ + t] = (unsigned)bal;
    }
}

DEV void attend_wave(const bf16_t* Kb, const bf16_t* Vb, const float* qs, int b, int g, unsigned bmask, int lo, int hi, int lane, float& o0, float& o1) {
    const float scale = 0.08838834764831845f;
    float m = -INFINITY, l = 0.f; o0 = 0.f; o1 = 0.f;
    for (int j = lo >> 6; j <= (hi >> 6); ++j) {
        if (!((bmask >> j) & 1u)) continue;
        const int key = j * 64 + lane; const bool valid = key >= lo && key <= hi;
        float s = -INFINITY;
        if (valid) { const bf16_t* kr = Kb + (size_t)(b * SEQ + key) * 512 + g * 128; float a = 0.f;
            for (int d = 0; d < 128; d += 4) { const ushort4 kv = *(const ushort4*)(kr + d); a = fmaf(qs[d], bf2f(kv.x), a); a = fmaf(qs[d + 1], bf2f(kv.y), a); a = fmaf(qs[d + 2], bf2f(kv.z), a); a = fmaf(qs[d + 3], bf2f(kv.w), a); }
            s = a * scale; }
        const float bm = wave_max(s);
        if (bm == -INFINITY) continue;
        const float mn = fmaxf(m, bm), alpha = expf(m - mn);
        const float pr = valid ? expf(s - mn) : 0.f;
        l = l * alpha + wave_sum(pr); o0 *= alpha; o1 *= alpha; m = mn;
        for (int kk = 0; kk < 64; ++kk) {
            const float pk = __shfl(pr, kk);
            if (pk != 0.f) { const bf16_t* vr = Vb + (size_t)(b * SEQ + j * 64 + kk) * 512 + g * 128; o0 = fmaf(pk, bf2f(vr[lane]), o0); o1 = fmaf(pk, bf2f(vr[lane + 64]), o1); }
        }
    }
    const float inv = 1.f / l; o0 *= inv; o1 *= inv;
}

DEV void ph_attn_sw(const P& p, float* lds, int bid, int nb) {
    const int lane = tidx() & 63, wid = tidx() >> 6;
    float* qs = lds + wid * 128;
    const float* ocmp = (const float*)(p.big + BIG_NSA_OCMP); bf16_t* obuf = (bf16_t*)(p.big + BIG_NSA_OBUF);
    const bf16_t* Q = (const bf16_t*)(p.big + BIG_NSA_Q); const float* gate = (const float*)(p.big + BIG_NSA_GATE);
    const bf16_t* KS = (const bf16_t*)(p.big + BIG_NSA_KS); const bf16_t* VS = (const bf16_t*)(p.big + BIG_NSA_VS);
    const bf16_t* KW = (const bf16_t*)(p.big + BIG_NSA_KW); const bf16_t* VW = (const bf16_t*)(p.big + BIG_NSA_VW);
    for (int u = bid * 8 + wid; u < T * NH; u += nb * 8) {
        const int h = u & 15, tok = u >> 4, b = tok / SEQ, t = tok % SEQ, g = h >> 2;
        const bf16_t* qrow = Q + (size_t)tok * 2048 + h * 128;
        qs[lane] = bf2f(qrow[lane]); qs[lane + 64] = bf2f(qrow[lane + 64]);
        const unsigned sm = p.selmask[(size_t)(b * NKV + g) * SEQ + t];
        float s0, s1, w0, w1;
        attend_wave(KS, VS, qs, b, g, sm, 0, t, lane, s0, s1);
        attend_wave(KW, VW, qs, b, g, 0xffffffffu, t - (WINDOW - 1) > 0 ? t - (WINDOW - 1) : 0, t, lane, w0, w1);
        const float* gl = gate + (size_t)tok * 48 + h * 3;
        const float g0 = gl[0], g1 = gl[1], g2 = gl[2];
        const float* oc = ocmp + (size_t)tok * 2048 + h * 128;
        bf16_t* ob = obuf + (size_t)tok * 2048 + h * 128;
        ob[lane] = f2bf(g0 * oc[lane] + g1 * s0 + g2 * w0);
        ob[lane + 64] = f2bf(g0 * oc[lane + 64] + g1 * s1 + g2 * w1);
    }
}

namespace at {
typedef float f32x16 __attribute__((ext_vector_type(16)));
typedef short s16x4 __attribute__((ext_vector_type(4)));
constexpr int SHM = 16384;
constexpr float SCALE = 0.08838834764831845f, C2 = 1.4426950408889634f * SCALE, THR = 8.f;
#define AT_KSWZ(row, colB) ((row) * 256 + ((colB) ^ (((row) & 7) << 4)))
DEV int v_st(int k, int c) { const int kk = (k & ~0xC) | ((k & 4) << 1) | ((k & 8) >> 1); return ((kk >> 3) * 4 + (c >> 5)) * 512 + ((kk & 7) * 32 + (c & 31)) * 2; }
DEV int v_rd_base(int lane) { return ((lane & 3) << 3) | (((lane >> 2) & 3) << 6) | (((lane >> 4) & 1) << 5) | (((lane >> 5) & 1) << 8); }
DEV int crow(int r, int hi) { return (r & 3) + 8 * (r >> 2) + 4 * hi; }
DEV unsigned cvtpk(float lo, float hi) { unsigned r; asm volatile("v_cvt_pk_bf16_f32 %0, %1, %2" : "=v"(r) : "v"(lo), "v"(hi)); return r; }
DEV float swap_max(float x) { auto rr = __builtin_amdgcn_permlane32_swap(__float_as_uint(x), __float_as_uint(x), false, false); return fmaxf(__uint_as_float(rr[0]), __uint_as_float(rr[1])); }
DEV float swap_sum(float x) { auto rr = __builtin_amdgcn_permlane32_swap(__float_as_uint(x), __float_as_uint(x), false, false); return __uint_as_float(rr[0]) + __uint_as_float(rr[1]); }
#define AT_PK4(P, B_, OUT) do { unsigned a0 = cvtpk(P[B_+0], P[B_+1]), a1 = cvtpk(P[B_+2], P[B_+3]); unsigned b0 = cvtpk(P[B_+4], P[B_+5]), b1 = cvtpk(P[B_+6], P[B_+7]); \
        auto r0 = __builtin_amdgcn_permlane32_swap(a0, b0, false, false); auto r1 = __builtin_amdgcn_permlane32_swap(a1, b1, false, false); \
        u32x4 w = {r0[0], r1[0], r0[1], r1[1]}; OUT = *reinterpret_cast<bf16x8*>(&w); } while (0)
DEV void qkt(f32x16& p0, f32x16& p1, const char* Kl, int r32, int hi, const bf16x8* qr) {
    p0 = f32x16{}; p1 = f32x16{};
    const char* kb[4];
#pragma unroll
    for (int dd = 0; dd < 4; ++dd) kb[dd] = Kl + AT_KSWZ(r32, (dd * 16 + hi * 8) * 2);
#pragma unroll
    for (int d0 = 0; d0 < 8; ++d0) { const char* a = kb[d0 & 3] + (d0 >> 2) * 128;
        const bf16x8 b0 = *reinterpret_cast<const bf16x8*>(a), b1 = *reinterpret_cast<const bf16x8*>(a + 32 * 256);
        p0 = __builtin_amdgcn_mfma_f32_32x32x16_bf16(b0, qr[d0], p0, 0, 0, 0);
        p1 = __builtin_amdgcn_mfma_f32_32x32x16_bf16(b1, qr[d0], p1, 0, 0, 0); }
}
DEV void pv_tile(f32x16* o, int vb0, bf16x8 pa0, bf16x8 pa1, bf16x8 pa2, bf16x8 pa3) {
#define AT_TRRD(dst, off) asm volatile("ds_read_b64_tr_b16 %0, %1 offset:%2" : "=&v"(dst) : "v"(vb0), "i"(off) : "memory")
#define AT_RD8(S, d0) do { constexpr int b_ = (d0) * 512; AT_TRRD(S##l0, b_); AT_TRRD(S##h0, b_ + 2048); AT_TRRD(S##l1, b_ + 4096); AT_TRRD(S##h1, b_ + 6144); \
        AT_TRRD(S##l2, b_ + 8192); AT_TRRD(S##h2, b_ + 10240); AT_TRRD(S##l3, b_ + 12288); AT_TRRD(S##h3, b_ + 14336); } while (0)
#define AT_MM4(S, d0) do { \
        o[d0] = __builtin_amdgcn_mfma_f32_32x32x16_bf16(pa0, (bf16x8){S##l0[0], S##l0[1], S##l0[2], S##l0[3], S##h0[0], S##h0[1], S##h0[2], S##h0[3]}, o[d0], 0, 0, 0); \
        o[d0] = __builtin_amdgcn_mfma_f32_32x32x16_bf16(pa1, (bf16x8){S##l1[0], S##l1[1], S##l1[2], S##l1[3], S##h1[0], S##h1[1], S##h1[2], S##h1[3]}, o[d0], 0, 0, 0); \
        o[d0] = __builtin_amdgcn_mfma_f32_32x32x16_bf16(pa2, (bf16x8){S##l2[0], S##l2[1], S##l2[2], S##l2[3], S##h2[0], S##h2[1], S##h2[2], S##h2[3]}, o[d0], 0, 0, 0); \
        o[d0] = __builtin_amdgcn_mfma_f32_32x32x16_bf16(pa3, (bf16x8){S##l3[0], S##l3[1], S##l3[2], S##l3[3], S##h3[0], S##h3[1], S##h3[2], S##h3[3]}, o[d0], 0, 0, 0); } while (0)
#define AT_WAIT(n) do { asm volatile("s_waitcnt lgkmcnt(" #n ")" ::: "memory"); __builtin_amdgcn_sched_barrier(0); } while (0)
    s16x4 xl0, xl1, xl2, xl3, xh0, xh1, xh2, xh3, yl0, yl1, yl2, yl3, yh0, yh1, yh2, yh3;
    AT_RD8(x, 0); AT_RD8(y, 1);
    AT_WAIT(8); AT_MM4(x, 0);
    __builtin_amdgcn_sched_barrier(0); AT_RD8(x, 2);
    AT_WAIT(8); AT_MM4(y, 1);
    __builtin_amdgcn_sched_barrier(0); AT_RD8(y, 3);
    AT_WAIT(8); AT_MM4(x, 2);
    AT_WAIT(0); AT_MM4(y, 3);
#undef AT_WAIT
#undef AT_MM4
#undef AT_RD8
#undef AT_TRRD
}
DEV void mask_tile(f32x16& p0, f32x16& p1, int lo, int hi_, int hi) {
    const float NEG = -__builtin_inff(); const unsigned w = (unsigned)(hi_ - lo); const int base = 4 * hi - lo;
#pragma unroll
    for (int r = 0; r < 16; ++r) { const int cr = (r & 3) + 8 * (r >> 2);
        if ((unsigned)(cr + base) > w) p0[r] = NEG;
        if ((unsigned)(cr + 32 + base) > w) p1[r] = NEG; }
}
struct Ctx { char* L; int tid, wid, lane, r32, hi; unsigned ksrc[2], vsrc[2]; float* li_l; float* al_l; };
#define AT_STAGE(Kp, Vp, pitch, kb, vb) do { _Pragma("unroll") for (int _i = 0; _i < 2; ++_i) { unsigned ks_ = c.ksrc[_i], vs_ = c.vsrc[_i]; asm volatile("" : "+v"(ks_), "+v"(vs_));     \
        __builtin_amdgcn_global_load_lds((const unsigned*)((Kp) + (size_t)(ks_ >> 16) * (pitch) + (ks_ & 0xffffu)), (MG_LAS unsigned*)((MG_LAS char*)(c.L) + (kb) * SHM + c.wid * 1024 + _i * 8192), 16, 0, 0); \
        __builtin_amdgcn_global_load_lds((const unsigned*)((Vp) + (size_t)(vs_ >> 16) * (pitch) + (vs_ & 0xffffu)), (MG_LAS unsigned*)((MG_LAS char*)(c.L) + 2 * SHM + (vb) * SHM + c.wid * 1024 + _i * 8192), 16, 0, 0); } } while (0)
#define AT_RESC(a) do { if (__any((a) < 1.f)) { if (c.hi == 0) c.al_l[c.r32] = (a); asm volatile("s_waitcnt lgkmcnt(0)" ::: "memory"); \
        _Pragma("unroll") for (int d_ = 0; d_ < 4; ++d_) _Pragma("unroll") for (int r = 0; r < 16; ++r) o[d_][r] *= c.al_l[crow(r, c.hi)]; } } while (0)

template <int MODE>
DEV void branch(const Ctx& c, const bf16_t* Kb, const bf16_t* Vb  , unsigned tiles, int i, int tl, unsigned smask, const bf16x8* qr, f32x16* o, float& l_reg) {
    float m_reg = -1e30f; l_reg = 0.f;
#pragma unroll
    for (int d = 0; d < 4; ++d) o[d] = f32x16{};
    unsigned rem = tiles; int j = __builtin_ctz(rem); rem &= rem - 1; int buf = 0;
    AT_STAGE(Kb + (size_t)j * 64 * 512, Vb + (size_t)j * 64 * 512, 512, 0, 0);
    __syncthreads();
    for (;;) {
        const bool more = rem != 0u; int jn = j;
        if (more) { jn = __builtin_ctz(rem); rem &= rem - 1; AT_STAGE(Kb + (size_t)jn * 64 * 512, Vb + (size_t)jn * 64 * 512, 512, buf ^ 1, buf ^ 1); }
        int lo, hi_;
        if (MODE == 1) { const bool sel = (smask >> j) & 1u; lo = sel ? 0 : 100; hi_ = sel ? (j == i ? tl : 63) : 100; }
        else { const int a = tl + 64 * (i - j); hi_ = a < 63 ? a : 63; lo = a - 511 > 0 ? a - 511 : 0; if (lo > 63) { lo = 100; hi_ = 100; } }
        if (__any(lo <= 63)) {
        f32x16 p0, p1;
        qkt(p0, p1, c.L + buf * SHM, c.r32, c.hi, qr);
        if (!__all(lo <= 0 && hi_ >= 63)) {
            if (MODE == 1 && j != i) { const bool keep = lo == 0; const float NEG = -__builtin_inff();
#pragma unroll
                for (int r = 0; r < 16; ++r) { p0[r] = keep ? p0[r] : NEG; p1[r] = keep ? p1[r] : NEG; } }
            else mask_tile(p0, p1, lo, hi_, c.hi);
        }
        float pmax = p0[0];
#pragma unroll
        for (int r = 1; r < 16; ++r) pmax = fmaxf(pmax, p0[r]);
#pragma unroll
        for (int r = 0; r < 16; ++r) pmax = fmaxf(pmax, p1[r]);
        pmax = swap_max(pmax);
        float mn, alpha;
        if (__all((pmax - m_reg) * SCALE <= THR)) { mn = m_reg; alpha = 1.f; }
        else { mn = fmaxf(m_reg, pmax); alpha = __builtin_amdgcn_exp2f((m_reg - mn) * C2); m_reg = mn; }
        const float mnL = -mn * C2; float ps = 0.f;
#pragma unroll
        for (int r = 0; r < 16; ++r) { p0[r] = __builtin_amdgcn_exp2f(fmaf(p0[r], C2, mnL)); p1[r] = __builtin_amdgcn_exp2f(fmaf(p1[r], C2, mnL)); ps += p0[r] + p1[r]; }
        ps = swap_sum(ps);
        l_reg = l_reg * alpha + ps;
        bf16x8 pa0, pa1, pa2, pa3;
        AT_PK4(p0, 0, pa0); AT_PK4(p0, 8, pa1); AT_PK4(p1, 0, pa2); AT_PK4(p1, 8, pa3);
        AT_RESC(alpha);
        pv_tile(o, (int)(uintptr_t)(c.L + 2 * SHM + buf * SHM) + v_rd_base(c.lane), pa0, pa1, pa2, pa3);
        }
        __syncthreads();
        if (!more) break;
        j = jn; buf ^= 1;
    }
}
template <int MODE>
DEV void branch_acc(const Ctx& c, const f32x16* o, float rowscale, char* stash_w  , bf16_t* obuf, size_t orow0) {
    int hi = c.hi, r32 = c.r32, ln = c.lane; asm volatile("" : "+v"(hi), "+v"(r32), "+v"(ln));
    float* li = c.li_l; asm volatile("" : "+v"(li));
    if (hi == 0) li[r32] = rowscale;
    asm volatile("s_waitcnt lgkmcnt(0)" ::: "memory");
    float sc[16];
#pragma unroll
    for (int r = 0; r < 16; ++r) sc[r] = li[(r & 3) + 8 * (r >> 2) + 4 * hi];
    char* sp = stash_w + ln * 16;
#pragma unroll
    for (int jg = 0; jg < 8; ++jg) {
        u32x4 w = {0u, 0u, 0u, 0u};
        if (MODE != 0) w = *(const u32x4*)(sp + jg * 1024);
        const int d0 = jg >> 1;
        float v0[4], v1[4];
#pragma unroll
        for (int k = 0; k < 4; ++k) { const int r = 8 * (jg & 1) + 2 * k;
            float t0 = o[d0][r] * sc[r], t1 = o[d0][r + 1] * sc[r + 1];
            if (MODE != 0) { t0 += __uint_as_float(w[k] << 16); t1 += __uint_as_float(w[k] & 0xffff0000u); }
            if (MODE != 2) w[k] = cvtpk(t0, t1);
            v0[k] = t0; v1[k] = t1; }
        if (MODE == 2) {
            const int kq = r32 & 3; quad_transpose(v0, kq); quad_transpose(v1, kq);
            const int rl = 8 * (jg & 1) + 2 * kq; const size_t ob = orow0 + (size_t)(r32 & ~3) + (size_t)(4 * hi) * 2048 + d0 * 32;
            *(unsigned*)((char*)obuf + ob + (size_t)((rl & 3) + 8 * (rl >> 2)) * 2048) = pk8(v0[0] * F8_SO, v0[1] * F8_SO, v0[2] * F8_SO, v0[3] * F8_SO);
            *(unsigned*)((char*)obuf + ob + (size_t)(((rl + 1) & 3) + 8 * ((rl + 1) >> 2)) * 2048) = pk8(v1[0] * F8_SO, v1[1] * F8_SO, v1[2] * F8_SO, v1[3] * F8_SO); }
        if (MODE != 2) *(u32x4*)(sp + jg * 1024) = w;
    }
}
}

DEV void ph_attn_mfma(const P& p, char* L  , int bid, int nb) {
    using namespace at;
    Ctx c; c.L = L; c.tid = tidx(); c.wid = __builtin_amdgcn_readfirstlane(c.tid >> 6); c.lane = c.tid & 63; c.r32 = c.lane & 31; c.hi = c.lane >> 5;
#pragma unroll
    for (int i = 0; i < 2; ++i) { const int pos = c.tid * 16 + i * 8192;
        { const int row = pos >> 8, ch = ((pos >> 4) & 15) ^ (row & 7); c.ksrc[i] = (unsigned)(row << 16) | (unsigned)(ch * 8); }
        { const int sub = pos >> 9, w = (pos & 511) >> 1, kk = (sub >> 2) * 8 + (w >> 5), k = (kk & ~0xC) | ((kk & 4) << 1) | ((kk & 8) >> 1), col = (sub & 3) * 32 + (w & 31);
          c.vsrc[i] = (unsigned)(k << 16) | (unsigned)col; } }
    float* wsf = (float*)(L + 4 * SHM) + c.wid * 64; c.li_l = wsf; c.al_l = wsf + 32;
    unsigned* selm = (unsigned*)(L + 4 * SHM + 2048);
    unsigned* um = selm + 64;
    char* stash = L + 4 * SHM + 2560;
    float* impbuf = (float*)stash;
    float* impsum = impbuf + 4 * 64 * 33;
    const bf16_t* Q = (const bf16_t*)(p.big + BIG_NSA_Q); const float* gate = (const float*)(p.big + BIG_NSA_GATE);
    const bf16_t* KS = (const bf16_t*)(p.big + BIG_NSA_KS); const bf16_t* VS = (const bf16_t*)(p.big + BIG_NSA_VS);
    const bf16_t* KW = (const bf16_t*)(p.big + BIG_NSA_KW); const bf16_t* VW = (const bf16_t*)(p.big + BIG_NSA_VW);
    const bf16_t* KC = (const bf16_t*)(p.big + BIG_NSA_KVC); const bf16_t* VC = KC + (size_t)2048 * 128;
    bf16_t* obuf = (bf16_t*)(p.big + BIG_NSA_OBUF);
    const int rq = c.wid & 3, th = c.wid >> 2, tl = 32 * th + c.r32;
    for (int pr0 = bid; pr0 < 256; pr0 += nb) {
        const int pr = (nb == 256) ? ((pr0 & 7) * 32 + (pr0 >> 3)) : pr0;
        const int bg = pr >> 4, b = bg >> 2, g = bg & 3, ii = pr & 15;
#pragma unroll 1
        for (int pass = 0; pass < 2; ++pass) {
            const int i = pass == 0 ? 31 - ii : ii;
            const int hq = 4 * g + rq, tok0 = b * SEQ + 64 * i, tq = 64 * i + tl;
            bf16x8 qr[8];
            { int hiq = c.hi, tlq = tl; asm volatile("" : "+v"(hiq), "+v"(tlq));
              const bf16_t* qp = Q + (size_t)(tok0 + tlq) * 2048 + hq * 128 + hiq * 8;
#pragma unroll
              for (int d0 = 0; d0 < 8; ++d0) qr[d0] = *(const bf16x8*)(qp + d0 * 16); }
            f32x16 o[4]; float l_reg;
            const size_t orow0 = (size_t)(tok0 + 32 * th) * 2048 + hq * 128;
            {
                const bf16_t* kc = KC + (size_t)(bg * 128) * 128; const bf16_t* vc = VC + (size_t)(bg * 128) * 128;
                AT_STAGE(kc, vc, 128, 0, 0);
                AT_STAGE(kc + 64 * 128, vc + 64 * 128, 128, 1, 1);
                __syncthreads();
                f32x16 pA0, pA1, pB0, pB1;
                qkt(pA0, pA1, c.L, c.r32, c.hi, qr); qkt(pB0, pB1, c.L + SHM, c.r32, c.hi, qr);
                const int cmax = tq >= 31 ? (tq - 31) >> 4 : -1;
                { int lo = 0, hi_ = cmax < 63 ? cmax : 63; if (cmax < 0) { lo = 100; hi_ = 100; } mask_tile(pA0, pA1, lo, hi_, c.hi); }
                { int lo = 0, hi_ = cmax - 64 < 63 ? cmax - 64 : 63; if (cmax < 64) { lo = 100; hi_ = 100; } mask_tile(pB0, pB1, lo, hi_, c.hi); }
                float pmax = -1e30f;
#pragma unroll
                for (int r = 0; r < 16; ++r) pmax = fmaxf(fmaxf(pmax, fmaxf(pA0[r], pA1[r])), fmaxf(pB0[r], pB1[r]));
                pmax = swap_max(pmax);
                const float mnL = -pmax * C2; float ps = 0.f;
#pragma unroll
                for (int r = 0; r < 16; ++r) { pA0[r] = __builtin_amdgcn_exp2f(fmaf(pA0[r], C2, mnL)); pA1[r] = __builtin_amdgcn_exp2f(fmaf(pA1[r], C2, mnL));
                    pB0[r] = __builtin_amdgcn_exp2f(fmaf(pB0[r], C2, mnL)); pB1[r] = __builtin_amdgcn_exp2f(fmaf(pB1[r], C2, mnL)); ps += (pA0[r] + pA1[r]) + (pB0[r] + pB1[r]); }
                ps = swap_sum(ps); l_reg = ps;
                const float inv_l = l_reg > 0.f ? 1.f / l_reg : 0.f;
                { float prev = 0.f; float* ib = impbuf + (rq * 64 + tl) * 33;
#define AT_IMPG(P, G0) _Pragma("unroll") for (int rg = 0; rg < 4; ++rg) { const float car = 0.5f * P[4 * rg + 3] * inv_l, own = (P[4 * rg] + P[4 * rg + 1] + P[4 * rg + 2]) * inv_l + car; \
                        const float rc = __shfl_xor(car, 32); ib[2 * ((G0) + rg) + c.hi] = own + (c.hi ? rc : prev); prev = rc; }
                  AT_IMPG(pA0, 0) AT_IMPG(pA1, 4) AT_IMPG(pB0, 8) AT_IMPG(pB1, 12)
#undef AT_IMPG
                }
                bf16x8 pa0, pa1, pa2, pa3;
#pragma unroll
                for (int d = 0; d < 4; ++d) o[d] = f32x16{};
                AT_PK4(pA0, 0, pa0); AT_PK4(pA0, 8, pa1); AT_PK4(pA1, 0, pa2); AT_PK4(pA1, 8, pa3);
                pv_tile(o, (int)(uintptr_t)(c.L + 2 * SHM) + v_rd_base(c.lane), pa0, pa1, pa2, pa3);
                AT_PK4(pB0, 0, pa0); AT_PK4(pB0, 8, pa1); AT_PK4(pB1, 0, pa2); AT_PK4(pB1, 8, pa3);
                pv_tile(o, (int)(uintptr_t)(c.L + 3 * SHM) + v_rd_base(c.lane), pa0, pa1, pa2, pa3);
                __syncthreads();
                { const int tk = c.tid >> 3, q4 = c.tid & 7; float val[4];
#pragma unroll
                  for (int e = 0; e < 4; ++e) { const int j = 4 * q4 + e; float v = impbuf[(0 * 64 + tk) * 33 + j] + impbuf[(1 * 64 + tk) * 33 + j] + impbuf[(2 * 64 + tk) * 33 + j] + impbuf[(3 * 64 + tk) * 33 + j];
                      const int dist = i - j; const bool forced = (j == 0) || (dist >= 0 && dist < 2); v = forced ? 1e4f : v; if (dist < 0) v = -__builtin_inff(); val[e] = v; impsum[tk * 32 + j] = v; }
                  __syncthreads();
                  int rank[4] = {0, 0, 0, 0};
                  for (int i2 = 0; i2 < 32; ++i2) { const float x = impsum[tk * 32 + i2];
#pragma unroll
                      for (int e = 0; e < 4; ++e) rank[e] += (x > val[e] || (x == val[e] && i2 < 4 * q4 + e)) ? 1 : 0; }
                  unsigned bits = 0u;
#pragma unroll
                  for (int e = 0; e < 4; ++e) bits |= (rank[e] < 16 ? 1u : 0u) << (4 * q4 + e);
                  bits |= __shfl_xor(bits, 1); bits |= __shfl_xor(bits, 2); bits |= __shfl_xor(bits, 4);
                  if (q4 == 0) selm[tk] = bits;
                  unsigned u = bits; u |= __shfl_xor(u, 8); u |= __shfl_xor(u, 16); u |= __shfl_xor(u, 32);
                  if (c.lane == 0) um[c.wid] = u; }
                __syncthreads();
                branch_acc<0>(c, o, gate[(size_t)(tok0 + tl) * 48 + hq * 3 + 0] * inv_l, stash + c.wid * 8192, obuf, orow0);
            }
            const unsigned smask = selm[tl];
            unsigned umask = um[0] | um[1] | um[2] | um[3] | um[4] | um[5] | um[6] | um[7];
            umask = __builtin_amdgcn_readfirstlane(umask) & ((2u << i) - 1u);
            branch<1>(c, KS + (size_t)b * SEQ * 512 + g * 128, VS + (size_t)b * SEQ * 512 + g * 128, umask, i, tl, smask, qr, o, l_reg);
            branch_acc<1>(c, o, gate[(size_t)(tok0 + tl) * 48 + hq * 3 + 1] / l_reg, stash + c.wid * 8192, obuf, orow0);
            { const int jlo = i - 8 > 0 ? i - 8 : 0; const unsigned wt = ((2u << i) - 1u) & ~((1u << jlo) - 1u);
              branch<2>(c, KW + (size_t)b * SEQ * 512 + g * 128, VW + (size_t)b * SEQ * 512 + g * 128, wt, i, tl, 0u, qr, o, l_reg); }
            branch_acc<2>(c, o, gate[(size_t)(tok0 + tl) * 48 + hq * 3 + 2] / l_reg, stash + c.wid * 8192, obuf, orow0);
            __syncthreads();
        }
    }
}

DEV void ph_moe_route(const P& p, int layer, const bf16_t* xin  , float* lds, int bid, int nb) {
    typedef float f32x16 __attribute__((ext_vector_type(16)));
    const int tid = tidx(), wid = __builtin_amdgcn_readfirstlane(tid >> 6), lane = tid & 63, i = lane & 31, kk = lane >> 5;
    float* part = lds;
    float* gpart = lds + 8192;
    float* spart = gpart + 1024;
    float* logit = spart + 256;
    float* rinv_l = logit + 32 * 36;
    int* lcnt = (int*)(rinv_l + 32);
    int* lbase = lcnt + 32;
    const float* wr = p.wr + (size_t)layer * D_MODEL * MOE_E; const float* wgq = p.wgq + (size_t)layer * D_MODEL * MOE_G;
    const float* g = p.ln_ffn + layer * D_MODEL;
    const float* bgrp = p.moe_b_group + layer * MOE_G; const float* bexp = p.moe_b_expert + layer * MOE_E;
    int* cnt = p.cnt + layer * MOE_E;
    for (int tb = bid; tb < T / 32; tb += nb) {
        const int tok0 = tb * 32;
        const bf16_t* xr = xin + (size_t)(tok0 + i) * D_MODEL + 256 * wid + 4 * kk;
        const float* wrow = wr + (size_t)(256 * wid + 4 * kk) * MOE_E + i;
        const float* wgrow = wgq + (size_t)(256 * wid + 4 * kk) * MOE_G;
        f32x16 acc = f32x16{}; float ss = 0.f; f32x4 ga = {0.f, 0.f, 0.f, 0.f};
#pragma unroll 4
        for (int j = 0; j < 32; ++j) {
            const u32x2 xw = *(const u32x2*)(xr + 8 * j); const f32x4 xv = {__uint_as_float(xw.x << 16), __uint_as_float(xw.x & 0xffff0000u), __uint_as_float(xw.y << 16), __uint_as_float(xw.y & 0xffff0000u)};
            const float* wp = wrow + (size_t)(8 * j) * MOE_E;
            const float b0 = wp[0], b1 = wp[MOE_E], b2 = wp[2 * MOE_E], b3 = wp[3 * MOE_E];
            const f32x4* gp = (const f32x4*)(wgrow + (size_t)(8 * j) * MOE_G);
            const f32x4 g0 = gp[0], g1 = gp[1], g2 = gp[2], g3 = gp[3];
            acc = __builtin_amdgcn_mfma_f32_32x32x2f32(xv[0], b0, acc, 0, 0, 0); acc = __builtin_amdgcn_mfma_f32_32x32x2f32(xv[1], b1, acc, 0, 0, 0);
            acc = __builtin_amdgcn_mfma_f32_32x32x2f32(xv[2], b2, acc, 0, 0, 0); acc = __builtin_amdgcn_mfma_f32_32x32x2f32(xv[3], b3, acc, 0, 0, 0);
            ss += xv[0] * xv[0] + xv[1] * xv[1] + xv[2] * xv[2] + xv[3] * xv[3];
            ga += g0 * xv[0] + g1 * xv[1] + g2 * xv[2] + g3 * xv[3];
        }
        ss += __shfl_xor(ss, 32);
#pragma unroll
        for (int q = 0; q < 4; ++q) ga[q] += __shfl_xor(ga[q], 32);
#pragma unroll
        for (int r = 0; r < 16; ++r) part[(wid * 32 + (r & 3) + 8 * (r >> 2) + 4 * kk) * 32 + i] = acc[r];
        if (kk == 0) { *(f32x4*)(gpart + (wid * 32 + i) * 4) = ga; spart[wid * 32 + i] = ss; }
        __syncthreads();
#pragma unroll
        for (int e = 0; e < 2; ++e) { const int idx = tid + e * 512, tk = idx >> 5, o = idx & 31; float sm = 0.f;
#pragma unroll
            for (int w = 0; w < 8; ++w) sm += part[(w * 32 + tk) * 32 + o];
            logit[tk * 36 + o] = sm; }
        if (tid < 128) { const int tk = tid >> 2, q = tid & 3; float sm = 0.f;
#pragma unroll
            for (int w = 0; w < 8; ++w) sm += gpart[(w * 32 + tk) * 4 + q];
            logit[tk * 36 + 32 + q] = sm; }
        if (tid < 32) { float sm = 0.f;
#pragma unroll
            for (int w = 0; w < 8; ++w) sm += spart[w * 32 + tid];
            rinv_l[tid] = rsqrtf(sm * (1.f / D_MODEL) + NORM_EPS); lcnt[tid] = 0; }
        __syncthreads();
        if (tid < 32) { const int tok = tok0 + tid; const float rinv = rinv_l[tid]; const float* lg = logit + tid * 36;
            float gl[4]; for (int q = 0; q < 4; ++q) gl[q] = lg[32 + q] * rinv + bgrp[q];
            int gs = 0; float gm = gl[0]; for (int q = 1; q < 4; ++q) if (gl[q] > gm) { gm = gl[q]; gs = q; }
            float gsum = 0.f; for (int q = 0; q < 4; ++q) gsum += expf(gl[q] - gm);
            const float gw = 1.f / gsum;
            float ev[8]; for (int q = 0; q < 8; ++q) ev[q] = lg[gs * 8 + q] * rinv + bexp[gs * 8 + q];
            int i1 = 0; for (int q = 1; q < 8; ++q) if (ev[q] > ev[i1]) i1 = q;
            int i2 = i1 == 0 ? 1 : 0; for (int q = 0; q < 8; ++q) if (q != i1 && ev[q] > ev[i2]) i2 = q;
            const float e2 = expf(ev[i2] - ev[i1]); const float w1 = gw / (1.f + e2), w2 = gw * e2 / (1.f + e2);
            const int ea = gs * 8 + i1, eb = gs * 8 + i2;
            const int ra = atomicAdd(&lcnt[ea], 1), rb = atomicAdd(&lcnt[eb], 1);
            asm volatile("s_waitcnt lgkmcnt(0)" ::: "memory");
            const int mine = lcnt[tid]; int base = 0; if (mine) base = atomicAdd(&cnt[tid], mine);
            lbase[tid] = base;
            asm volatile("s_waitcnt lgkmcnt(0)" ::: "memory");
            p.list[ea * T + lbase[ea] + ra] = tok * 2; p.lw[ea * T + lbase[ea] + ra] = w1;
            p.list[eb * T + lbase[eb] + rb] = tok * 2 + 1; p.lw[eb * T + lbase[eb] + rb] = w2; }
#pragma unroll
        for (int tt = 0; tt < 4; ++tt) { const int tok = tok0 + 4 * wid + tt; const float rinv = rinv_l[4 * wid + tt];
#pragma unroll
            for (int ii = 0; ii < 8; ++ii) { const int c = ii * 256 + lane * 4; const u32x2 xw = *(const u32x2*)(xin + (size_t)tok * D_MODEL + c); const f32x4 xv = {__uint_as_float(xw.x << 16), __uint_as_float(xw.x & 0xffff0000u), __uint_as_float(xw.y << 16), __uint_as_float(xw.y & 0xffff0000u)}, gg = *(const f32x4*)(g + c);
                const float rs = rinv * F8_SX;
                *(unsigned*)((char*)p.hb16 + (size_t)tok * D_MODEL + c) = pk8(xv[0] * rs * gg[0], xv[1] * rs * gg[1], xv[2] * rs * gg[2], xv[3] * rs * gg[3]); } }
        __syncthreads();
    }
}

namespace ssd {
using namespace at;
constexpr int OFF_CK = 0, OFF_BK = 32768, OFF_BV = 65536, OFF_XV = 98304, OFF_XS = 114688, OFF_PV = 131072, OFF_TB = 147456;
DEV int v64_st(int k, int c) { const int kk = (k & ~0xC) | ((k & 4) << 1) | ((k & 8) >> 1); return ((kk >> 3) * 2 + (c >> 5)) * 512 + ((kk & 7) * 32 + (c & 31)) * 2; }
#define SD_TRRD(dst, base, off) asm volatile("ds_read_b64_tr_b16 %0, %1 offset:%2" : "=&v"(dst) : "v"(base), "i"(off) : "memory")
#define SD_MK(lo, hi) ((bf16x8){lo[0], lo[1], lo[2], lo[3], hi[0], hi[1], hi[2], hi[3]})
DEV float conv8(const bf16x8& r0, const bf16x8& r1, const bf16x8& r2, const bf16x8& r3, const float (&w)[4][8], const float (&bias)[8], int j) {
    float a = bias[j]; a = fmaf(bf2f((bf16_t)r0[j]), w[0][j], a); a = fmaf(bf2f((bf16_t)r1[j]), w[1][j], a); a = fmaf(bf2f((bf16_t)r2[j]), w[2][j], a); a = fmaf(bf2f((bf16_t)r3[j]), w[3][j], a);
    return a / (1.f + __expf(-a));
}
}

DEV void ph_ssd_conv_bc(const P& p, int bid, int nb) {
    using namespace ssd;
    const bf16_t* xp = (const bf16_t*)(p.big + BIG_SSD_XBCP); bf16_t* bc = (bf16_t*)(p.big + BIG_SSD_BC);
    const bf16x8 zero8 = {0, 0, 0, 0, 0, 0, 0, 0};
    for (int it = bid * NTHREADS + tidx(); it < (T / 16) * 256; it += nb * NTHREADS) {
        const int cg = it & 255, tb = it >> 8, ch = SSD_DI + cg * 8, t0 = (tb * 16) & (SEQ - 1); const size_t tok0 = (size_t)tb * 16;
        float w[4][8], bias[8];
#pragma unroll
        for (int k = 0; k < 4; ++k) { const f32x4 w0 = *(const f32x4*)(p.ssd_conv_w + k * SSD_CONVCH + ch), w1 = *(const f32x4*)(p.ssd_conv_w + k * SSD_CONVCH + ch + 4);
#pragma unroll
            for (int j = 0; j < 4; ++j) { w[k][j] = w0[j]; w[k][4 + j] = w1[j]; } }
        { const f32x4 b0 = *(const f32x4*)(p.ssd_conv_b + ch), b1 = *(const f32x4*)(p.ssd_conv_b + ch + 4);
#pragma unroll
          for (int j = 0; j < 4; ++j) { bias[j] = b0[j]; bias[4 + j] = b1[j]; } }
        bf16x8 r0 = t0 >= 3 ? *(const bf16x8*)(xp + (tok0 - 3) * SSD_CONVCH + ch) : zero8, r1 = t0 >= 2 ? *(const bf16x8*)(xp + (tok0 - 2) * SSD_CONVCH + ch) : zero8,
               r2 = t0 >= 1 ? *(const bf16x8*)(xp + (tok0 - 1) * SSD_CONVCH + ch) : zero8;
#pragma unroll 8
        for (int i = 0; i < 16; ++i) { const bf16x8 r3 = *(const bf16x8*)(xp + (tok0 + i) * SSD_CONVCH + ch); float o[8];
#pragma unroll
            for (int j = 0; j < 8; ++j) o[j] = conv8(r0, r1, r2, r3, w, bias, j);
            u32x4 pk; pk.x = cvtpk(o[0], o[1]); pk.y = cvtpk(o[2], o[3]); pk.z = cvtpk(o[4], o[5]); pk.w = cvtpk(o[6], o[7]);
            *(u32x4*)(bc + (tok0 + i) * 2048 + cg * 8) = pk; r0 = r1; r1 = r2; r2 = r3; }
    }
}

DEV void ph_ssd_mfma(const P& p, char* L, int bid, int nb) {
    using namespace ssd;
    const int tid = tidx(), wid = __builtin_amdgcn_readfirstlane(tid >> 6), lane = tid & 63;
    const int lb = wid & 3, pb = wid >> 2, nbk = wid & 3;
    const bf16_t* xp = (const bf16_t*)(p.big + BIG_SSD_XBCP); const bf16_t* bc = (const bf16_t*)(p.big + BIG_SSD_BC);
    bf16_t* yb = (bf16_t*)(p.big + BIG_SSD_YN);
    float* tabs = (float*)(L + OFF_TB);
    const bf16x8 zero8 = {0, 0, 0, 0, 0, 0, 0, 0};
    unsigned ksrc[2], vsrc[2];
#pragma unroll
    for (int i = 0; i < 2; ++i) { const int pos = tid * 16 + i * 8192;
        { const int row = pos >> 8, ch = ((pos >> 4) & 15) ^ (row & 7); ksrc[i] = (unsigned)(row * 2048 + ch * 8); }
        { const int sub = pos >> 9, w = (pos & 511) >> 1, kk = (sub >> 2) * 8 + (w >> 5), k = (kk & ~0xC) | ((kk & 4) << 1) | ((kk & 8) >> 1), col = (sub & 3) * 32 + (w & 31); vsrc[i] = (unsigned)(k * 2048 + col); } }
    for (int u0 = bid; u0 < BATCH * SSD_H; u0 += nb) {
        const int u = (nb == 256) ? ((u0 & 7) * 32 + (u0 >> 3)) : u0;
        const int b = u >> 6, h = u & 63, g = h >> 3;
        const float Ah = -expf(p.ssd_a_log[h]), Dh = p.ssd_d[h];
        f32x16 st = f32x16{};
        for (int i = tid; i < 16384 / 16; i += NTHREADS) *(bf16x8*)(L + OFF_PV + i * 16) = zero8;
        float* tabg = (float*)(p.big + BIG_SSD_TABG) + (size_t)u * 16 * 640;
#pragma unroll 1
        for (int cc = 0; cc < 2; ++cc) { const int chunk = 2 * wid + cc; float* tb_ = tabg + chunk * 640; const size_t t0_ = (size_t)b * SEQ + chunk * 128 + 2 * lane;
            const float d0 = p.dtb[t0_ * 64 + h], d1 = p.dtb[(t0_ + 1) * 64 + h]; const float a0 = d0 * Ah, a1 = d1 * Ah; float c = a0 + a1;
#pragma unroll
            for (int o_ = 1; o_ < 64; o_ <<= 1) { const float v = __shfl_up(c, o_); if (lane >= o_) c += v; }
            const float e1 = c, e0 = c - a1, tot = __shfl(c, 63);
            tb_[2 * lane] = e0 * 1.4426950408889634f; tb_[2 * lane + 1] = e1 * 1.4426950408889634f; tb_[128 + 2 * lane] = __expf(e0); tb_[128 + 2 * lane + 1] = __expf(e1);
            tb_[256 + 2 * lane] = __expf(tot - e0); tb_[256 + 2 * lane + 1] = __expf(tot - e1); tb_[384 + 2 * lane] = Dh / fmaxf(d0, 1e-30f); tb_[384 + 2 * lane + 1] = Dh / fmaxf(d1, 1e-30f); tb_[512 + 2 * lane] = d0; tb_[512 + 2 * lane + 1] = d1; }
        __syncthreads();
#pragma unroll 1
        for (int ck = 0; ck < SEQ / 128; ++ck) {
            const float* tb = tabs;
            const float* tg = tabg + ck * 640;
            const size_t tok0 = (size_t)b * SEQ + ck * 128;
            { const float v0 = tg[tid]; tabs[tid] = v0; if (tid < 128) tabs[512 + tid] = tg[512 + tid]; }
            { const bf16_t* bsrc = bc + tok0 * 2048 + g * 128; const bf16_t* csrc = bsrc + 1024;
#pragma unroll
              for (int tile = 0; tile < 2; ++tile)
#pragma unroll
                  for (int i = 0; i < 2; ++i) {
                      __builtin_amdgcn_global_load_lds((const unsigned*)(csrc + (size_t)tile * 64 * 2048 + ksrc[i]), (MG_LAS unsigned*)((MG_LAS char*)L + OFF_CK + tile * 16384 + wid * 1024 + i * 8192), 16, 0, 0);
                      __builtin_amdgcn_global_load_lds((const unsigned*)(bsrc + (size_t)tile * 64 * 2048 + ksrc[i]), (MG_LAS unsigned*)((MG_LAS char*)L + OFF_BK + tile * 16384 + wid * 1024 + i * 8192), 16, 0, 0);
                      __builtin_amdgcn_global_load_lds((const unsigned*)(bsrc + (size_t)tile * 64 * 2048 + vsrc[i]), (MG_LAS unsigned*)((MG_LAS char*)L + OFF_BV + tile * 16384 + wid * 1024 + i * 8192), 16, 0, 0); } }
            { int tl_ = tid; asm volatile("" : "+v"(tl_));
              const int cgx = tl_ & 7, rsx = tl_ >> 3, chx = h * 64 + cgx * 8;
              float w[4][8], bias[8];
#pragma unroll
              for (int k = 0; k < 4; ++k) { const f32x4 w0 = *(const f32x4*)(p.ssd_conv_w + k * SSD_CONVCH + chx), w1 = *(const f32x4*)(p.ssd_conv_w + k * SSD_CONVCH + chx + 4);
#pragma unroll
                  for (int j = 0; j < 4; ++j) { w[k][j] = w0[j]; w[k][4 + j] = w1[j]; } }
              { const f32x4 b0 = *(const f32x4*)(p.ssd_conv_b + chx), b1 = *(const f32x4*)(p.ssd_conv_b + chx + 4);
#pragma unroll
                for (int j = 0; j < 4; ++j) { bias[j] = b0[j]; bias[4 + j] = b1[j]; } }
              bf16x8 rw[5];
#pragma unroll
              for (int i = 0; i < 5; ++i) { const int l = 2 * rsx - 3 + i; rw[i] = (ck * 128 + l >= 0) ? *(const bf16x8*)(xp + (tok0 + l) * SSD_CONVCH + chx) : zero8; }
#pragma unroll
              for (int i = 0; i < 2; ++i) { const int l = 2 * rsx + i; const float dtl = tg[512 + l], sdl = tg[256 + l]; float o[8];
#pragma unroll
                  for (int j = 0; j < 8; ++j) o[j] = conv8(rw[i], rw[i + 1], rw[i + 2], rw[i + 3], w, bias, j) * dtl;
                  u32x4 pk; pk.x = cvtpk(o[0], o[1]); pk.y = cvtpk(o[2], o[3]); pk.z = cvtpk(o[4], o[5]); pk.w = cvtpk(o[6], o[7]);
                  *(u32x4*)(L + OFF_XV + v64_st(l, cgx * 8)) = pk;
                  pk.x = cvtpk(o[0] * sdl, o[1] * sdl); pk.y = cvtpk(o[2] * sdl, o[3] * sdl); pk.z = cvtpk(o[4] * sdl, o[5] * sdl); pk.w = cvtpk(o[6] * sdl, o[7] * sdl);
                  *(u32x4*)(L + OFF_XS + v64_st(l, cgx * 8)) = pk; } }
            __syncthreads();
            int ln_ = lane; asm volatile("" : "+v"(ln_)); const int r32 = ln_ & 31, hi = ln_ >> 5, lane2 = ln_;
            bf16x8 qr[8];
            { const char* cb_ = L + OFF_CK + (lb >> 1) * 16384;
#pragma unroll
              for (int d0 = 0; d0 < 8; ++d0) qr[d0] = *(const bf16x8*)(cb_ + AT_KSWZ((lb & 1) * 32 + r32, (d0 * 16 + hi * 8) * 2)); }
            f32x16 o = f32x16{}, oo = f32x16{};
            const int l = 32 * lb + r32; const float al = tb[l], dl = tb[384 + l];
            const int xvb = (int)(uintptr_t)(L + OFF_XV) + v_rd_base(lane2) + pb * 512;
            for (int kt = 0; kt <= (lb >> 1); ++kt) {
                f32x16 p0, p1;
                qkt(p0, p1, L + OFF_BK + kt * 16384, r32, hi, qr);
                if (kt < (lb >> 1)) {
#pragma unroll
                    for (int r = 0; r < 16; ++r) { const int s0 = 64 * kt + crow(r, hi), s1 = s0 + 32; p0[r] *= __builtin_amdgcn_exp2f(al - tb[s0]); p1[r] *= __builtin_amdgcn_exp2f(al - tb[s1]); }
                } else {
#pragma unroll
                for (int r = 0; r < 16; ++r) { const int s0 = 64 * kt + crow(r, hi), s1 = s0 + 32;
                    float v0 = p0[r] * __builtin_amdgcn_exp2f(al - tb[s0]), v1 = p1[r] * __builtin_amdgcn_exp2f(al - tb[s1]);
                    v0 = s0 <= l ? v0 : 0.f; v1 = s1 <= l ? v1 : 0.f; v0 += s0 == l ? dl : 0.f; v1 += s1 == l ? dl : 0.f; p0[r] = v0; p1[r] = v1; }
                }
                bf16x8 pa0, pa1, pa2, pa3;
                AT_PK4(p0, 0, pa0); AT_PK4(p0, 8, pa1); AT_PK4(p1, 0, pa2); AT_PK4(p1, 8, pa3);
                { const int vb = xvb + kt * 8192; s16x4 l0, l1, l2, l3, h0, h1, h2, h3;
                  SD_TRRD(l0, vb, 0); SD_TRRD(h0, vb, 1024); SD_TRRD(l1, vb, 2048); SD_TRRD(h1, vb, 3072); SD_TRRD(l2, vb, 4096); SD_TRRD(h2, vb, 5120); SD_TRRD(l3, vb, 6144); SD_TRRD(h3, vb, 7168);
                  asm volatile("s_waitcnt lgkmcnt(0)" ::: "memory"); __builtin_amdgcn_sched_barrier(0);
                  o = __builtin_amdgcn_mfma_f32_32x32x16_bf16(pa0, SD_MK(l0, h0), o, 0, 0, 0); o = __builtin_amdgcn_mfma_f32_32x32x16_bf16(pa1, SD_MK(l1, h1), o, 0, 0, 0);
                  o = __builtin_amdgcn_mfma_f32_32x32x16_bf16(pa2, SD_MK(l2, h2), o, 0, 0, 0); o = __builtin_amdgcn_mfma_f32_32x32x16_bf16(pa3, SD_MK(l3, h3), o, 0, 0, 0); }
            }
            { const int vb = (int)(uintptr_t)(L + OFF_PV) + v_rd_base(lane2) + pb * 512;
#define SD_YOFF(K0) do { s16x4 l0, l1, l2, l3, h0, h1, h2, h3; \
                  SD_TRRD(l0, vb, (K0) * 2048); SD_TRRD(h0, vb, (K0) * 2048 + 1024); SD_TRRD(l1, vb, (K0) * 2048 + 2048); SD_TRRD(h1, vb, (K0) * 2048 + 3072); \
                  SD_TRRD(l2, vb, (K0) * 2048 + 4096); SD_TRRD(h2, vb, (K0) * 2048 + 5120); SD_TRRD(l3, vb, (K0) * 2048 + 6144); SD_TRRD(h3, vb, (K0) * 2048 + 7168); \
                  asm volatile("s_waitcnt lgkmcnt(0)" ::: "memory"); __builtin_amdgcn_sched_barrier(0); \
                  oo = __builtin_amdgcn_mfma_f32_32x32x16_bf16(qr[(K0)], SD_MK(l0, h0), oo, 0, 0, 0); oo = __builtin_amdgcn_mfma_f32_32x32x16_bf16(qr[(K0) + 1], SD_MK(l1, h1), oo, 0, 0, 0); \
                  oo = __builtin_amdgcn_mfma_f32_32x32x16_bf16(qr[(K0) + 2], SD_MK(l2, h2), oo, 0, 0, 0); oo = __builtin_amdgcn_mfma_f32_32x32x16_bf16(qr[(K0) + 3], SD_MK(l3, h3), oo, 0, 0, 0); } while (0)
              SD_YOFF(0); SD_YOFF(4);
#undef SD_YOFF
            }
            { const float dec = tb[128 + 127];
#pragma unroll
              for (int r = 0; r < 16; ++r) st[r] *= dec;
              const int xsb = (int)(uintptr_t)(L + OFF_XS) + v_rd_base(lane2) + pb * 512;
              const int bvb = (int)(uintptr_t)(L + OFF_BV) + v_rd_base(lane2) + nbk * 512;
#define SD_STATE(K0, BOFF) do { s16x4 a0, a1, a2, a3, a4, a5, a6, a7, b0, b1, b2, b3, b4, b5, b6, b7; \
                  SD_TRRD(a0, xsb, (K0) * 2048); SD_TRRD(a1, xsb, (K0) * 2048 + 1024); SD_TRRD(a2, xsb, (K0) * 2048 + 2048); SD_TRRD(a3, xsb, (K0) * 2048 + 3072); \
                  SD_TRRD(a4, xsb, (K0) * 2048 + 4096); SD_TRRD(a5, xsb, (K0) * 2048 + 5120); SD_TRRD(a6, xsb, (K0) * 2048 + 6144); SD_TRRD(a7, xsb, (K0) * 2048 + 7168); \
                  SD_TRRD(b0, bvb, (BOFF)); SD_TRRD(b1, bvb, (BOFF) + 2048); SD_TRRD(b2, bvb, (BOFF) + 4096); SD_TRRD(b3, bvb, (BOFF) + 6144); \
                  SD_TRRD(b4, bvb, (BOFF) + 8192); SD_TRRD(b5, bvb, (BOFF) + 10240); SD_TRRD(b6, bvb, (BOFF) + 12288); SD_TRRD(b7, bvb, (BOFF) + 14336); \
                  asm volatile("s_waitcnt lgkmcnt(0)" ::: "memory"); __builtin_amdgcn_sched_barrier(0); \
                  st = __builtin_amdgcn_mfma_f32_32x32x16_bf16(SD_MK(a0, a1), SD_MK(b0, b1), st, 0, 0, 0); st = __builtin_amdgcn_mfma_f32_32x32x16_bf16(SD_MK(a2, a3), SD_MK(b2, b3), st, 0, 0, 0); \
                  st = __builtin_amdgcn_mfma_f32_32x32x16_bf16(SD_MK(a4, a5), SD_MK(b4, b5), st, 0, 0, 0); st = __builtin_amdgcn_mfma_f32_32x32x16_bf16(SD_MK(a6, a7), SD_MK(b6, b7), st, 0, 0, 0); } while (0)
              SD_STATE(0, 0); SD_STATE(4, 16384);
              asm volatile("s_nop 15\n\ts_nop 15" : "+v"(st));
#undef SD_STATE
            }
            { const int colg = h * 64 + 32 * pb + r32;
#pragma unroll
              for (int r = 0; r < 16; ++r) { const int lr = 32 * lb + crow(r, hi); const size_t tok = tok0 + lr;
                  const float y = o[r] + tb[128 + lr] * oo[r]; const float yn = swap_pair(y); if ((r32 & 1) == 0) *(unsigned*)(yb + tok * SSD_DI + colg) = cvtpk(y, yn); } }
            __syncthreads();
#pragma unroll
            for (int rg = 0; rg < 4; ++rg) { u32x2 w2; w2.x = cvtpk(st[4 * rg], st[4 * rg + 1]); w2.y = cvtpk(st[4 * rg + 2], st[4 * rg + 3]);
                *(u32x2*)(L + OFF_PV + v64_st(32 * nbk + r32, 32 * pb + 8 * rg + 4 * hi)) = w2; }
        }
        __syncthreads();
    }
}

DEV void ph_ssd_norm(const P& p, int bid, int nb) {
    const int lane = tidx() & 63, wid = tidx() >> 6;
    bf16_t* yb = (bf16_t*)(p.big + BIG_SSD_YN); const bf16_t* zb = (const bf16_t*)(p.big + BIG_SSD_Z);
    for (int tok = bid * 8 + wid; tok < T; tok += nb * 8) {
        const int lo = (lane >> 3) * 512 + (lane & 7) * 8;
        bf16_t* yr = yb + (size_t)tok * SSD_DI + lo; const bf16_t* zr = zb + (size_t)tok * SSD_DI + lo; const float* ng = p.ssd_norm + lo;
        float v[64]; float ss = 0.f;
#pragma unroll
        for (int i = 0; i < 8; ++i) { const bf16x8 yv = *(const bf16x8*)(yr + i * 64), zv = *(const bf16x8*)(zr + i * 64);
#pragma unroll
            for (int j = 0; j < 8; ++j) { const float z = bf2f((bf16_t)zv[j]); const float t = bf2f((bf16_t)yv[j]) * (z / (1.f + __expf(-z))); v[i * 8 + j] = t; ss += t * t; } }
        ss += __shfl_xor(ss, 1); ss += __shfl_xor(ss, 2); ss += __shfl_xor(ss, 4);
        const float rinv = rsqrtf(ss * (1.f / 512.f) + NORM_EPS);
#pragma unroll
        for (int i = 0; i < 8; ++i) { float o[8];
#pragma unroll
            for (int j = 0; j < 8; ++j) o[j] = v[i * 8 + j] * rinv * ng[i * 64 + j];
            u32x4 w; w.x = at::cvtpk(o[0], o[1]); w.y = at::cvtpk(o[2], o[3]); w.z = at::cvtpk(o[4], o[5]); w.w = at::cvtpk(o[6], o[7]); *(u32x4*)(yr + i * 64) = w; }
    }
}

#define XB_TMO      128
#define XB_XCNT(j)  (256  + 64 * (j))
#define XB_XSUB(j)  (1280 + 64 * (j))
#define XB_XGEN(j)  (2304 + 64 * (j))
#define XB_TOP      3328
#define XB_TOPGEN   3392
#define XCD_BAR_WORDS 3456
#define XB_SPIN_CAP (1u << 22)
#define LAS __attribute__((address_space(3)))

__device__ __forceinline__ unsigned xb_ld(unsigned* p)              { return __hip_atomic_load(p, __ATOMIC_RELAXED, __HIP_MEMORY_SCOPE_AGENT); }
__device__ __forceinline__ unsigned xb_add(unsigned* p, unsigned v) { return __hip_atomic_fetch_add(p, v, __ATOMIC_RELAXED, __HIP_MEMORY_SCOPE_AGENT); }
__device__ __forceinline__ unsigned xb_xcc_id() { return (unsigned)__builtin_amdgcn_s_getreg((3 << 11) | 20) & 0xFu; }
#define XB_SPIN(cond, bar) do { unsigned _sp = 0; while (cond) { __builtin_amdgcn_s_sleep(1); \
    if ((++_sp & 255u) == 0u) { if (xb_ld(&(bar)[XB_TMO])) break; if (_sp > XB_SPIN_CAP) { atomicAdd(&(bar)[XB_TMO], 1u); break; } } } } while (0)

struct XcdBarrier {
    unsigned* bar; unsigned x;
    volatile LAS unsigned* st;
};

__device__ __forceinline__ XcdBarrier xcd_barrier_post(unsigned* bar, volatile LAS unsigned* st) {
    XcdBarrier b; b.bar = bar; b.x = xb_xcc_id(); b.st = st;
    if (threadIdx.x == 0) (void)xb_add(&bar[XB_XCNT(b.x)], 1u);
    return b;
}
__device__ __forceinline__ void xcd_barrier_complete(unsigned* bar, unsigned x, unsigned& nloc, unsigned& nx) {
    const unsigned G = gridDim.x * gridDim.y * gridDim.z;
    unsigned sum, cnt, mine, sp = 0u;
    for (;;) {
        sum = 0u; cnt = 0u; mine = 0u;
#pragma unroll
        for (unsigned j = 0; j < 16; ++j) { const unsigned c = xb_ld(&bar[XB_XCNT(j)]); sum += c; cnt += (c > 0u) ? 1u : 0u; mine = (j == x) ? c : mine; }
        if (sum == G) break;
        __builtin_amdgcn_s_sleep(1);
        if ((++sp & 255u) == 0u) { if (xb_ld(&bar[XB_TMO])) break; if (sp > XB_SPIN_CAP) { atomicAdd(&bar[XB_TMO], 1u); break; } }
    }
    nloc = mine > 0u ? mine : 1u; nx = cnt > 0u ? cnt : 1u;
}

__device__ __forceinline__ void xcd_barrier(const XcdBarrier& b) {
    asm volatile("s_waitcnt vmcnt(0)" ::: "memory");
    __syncthreads();
    if (threadIdx.x == 0) {
        unsigned* bar = b.bar;
        __builtin_amdgcn_s_waitcnt(0);
        unsigned nloc = b.st[0], nx = b.st[1];
        if (nloc == 0u) { xcd_barrier_complete(bar, b.x, nloc, nx); b.st[0] = nloc; b.st[1] = nx; }
        const unsigned old = xb_add(&bar[XB_XSUB(b.x)], 1u);
        const unsigned gen = old / nloc;
        if (old + 1u == (gen + 1u) * nloc) {
            __builtin_amdgcn_fence(__ATOMIC_RELEASE, "agent");
            asm volatile("s_waitcnt vmcnt(0)" ::: "memory");
            const unsigned og = xb_add(&bar[XB_TOP], 1u);
            const unsigned tg = og / nx;
            if (og + 1u == (tg + 1u) * nx) xb_add(&bar[XB_TOPGEN], 1u);
            else XB_SPIN(xb_ld(&bar[XB_TOPGEN]) == tg, bar);
            __builtin_amdgcn_fence(__ATOMIC_ACQUIRE, "agent");
            xb_add(&bar[XB_XGEN(b.x)], 1u);
            asm volatile("s_waitcnt vmcnt(0)" ::: "memory");
        } else {
            XB_SPIN(xb_ld(&bar[XB_XGEN(b.x)]) == gen, bar);
            __builtin_amdgcn_fence(__ATOMIC_ACQUIRE, "agent");
            asm volatile("s_waitcnt vmcnt(0)" ::: "memory");
        }
    }
    __syncthreads();
}


constexpr int LDS_STAGE_OFF = 16, LDS_TAB_OFF = 16 + mg::STAGE_BYTES, LDS_BYTES = 16 + 147456 + 5120;
constexpr int NPHASE = 21;

DEV void moe_tables(const int* cnt, int* tab) {
    __syncthreads();
    if (tidx() == 0) { int s = 0, r = 0; for (int e = 0; e < MOE_E; ++e) { tab[e] = s; tab[64 + e] = r; const int c = cnt[e]; s += (c + 255) >> 8; r += c; } tab[MOE_E] = s; tab[64 + MOE_E] = r; }
    __syncthreads();
}
constexpr int MOE_CT_GU = 4096, MOE_CT_D = 2048, MOE_CT_L = MOE_CT_GU + MOE_CT_D;
DEV void conv_moe_tiles(const P& p, float* ldsf, int f0, int f1, int w, int nw) {
    if (w < 0 || f0 >= f1) return;
#pragma unroll 1
    for (int L = 0; L < 2; ++L) {
        const float* wg = p.moe_w_gate + (size_t)L * MOE_E * D_MODEL * MOE_FF; const float* wu = p.moe_w_up + (size_t)L * MOE_E * D_MODEL * MOE_FF;
        const float* wd = p.moe_w_down + (size_t)L * MOE_E * MOE_FF * D_MODEL;
        { const int a = f0 - L * MOE_CT_L, b = f1 - L * MOE_CT_L; const int lo = a > 0 ? a : 0, hi = b < MOE_CT_GU ? b : MOE_CT_GU;
          if (lo < hi) conv_wt<true>([=](int g, int k, int q) { const float* sp = (q & 1) ? wu : wg; return sp + ((size_t)g * D_MODEL + k) * MOE_FF + (q >> 1) * 4; }, MOE_E, D_MODEL, 2 * MOE_FF,
                               p.wt_gu + (size_t)L * MOE_E * MOE_FF * D_MODEL, ldsf, w, nw, lo, hi); }
        { const int a = f0 - L * MOE_CT_L - MOE_CT_GU, b = f1 - L * MOE_CT_L - MOE_CT_GU; const int lo = a > 0 ? a : 0, hi = b < MOE_CT_D ? b : MOE_CT_D;
          if (lo < hi) conv_wt<true>([=](int g, int k, int q) { return wd + ((size_t)g * MOE_FF + k) * D_MODEL + q * 4; }, MOE_E, MOE_FF, D_MODEL,
                               p.wt_d + (size_t)L * MOE_E * D_MODEL * MOE_FF / 2, ldsf, w, nw, lo, hi); }
    }
}
constexpr int CT_A = 1536, CT_B = MOE_CT_L, CT_C = MOE_CT_L + 1920, CT_D = MOE_CT_L + MOE_CT_GU, CT_E = 2 * MOE_CT_L;

template <int PH> DEV void run_phase(const P& p, float* ldsraw, int bid, int nb) {
    float* lds = ldsraw + 4;
    MG_LAS unsigned char* stage = (MG_LAS unsigned char*)ldsraw + LDS_STAGE_OFF;
    int* tab = (int*)((char*)ldsraw + LDS_TAB_OFF);
    if constexpr (PH == 0) {
        ph_rope_table(p, bid, nb);
        for (int i = bid * NTHREADS + tidx(); i < 2 * D_MODEL * MOE_E; i += nb * NTHREADS) p.wr[i] = p.moe_w_expert[i] * p.ln_ffn[i >> 5];
        for (int i = bid * NTHREADS + tidx(); i < 2 * D_MODEL * MOE_G; i += nb * NTHREADS) p.wgq[i] = p.moe_w_group[i] * p.ln_ffn[i >> 2];
        if (bid == 0 && tidx() < 64) p.cnt[tidx()] = 0;
        if (bid >= 64 && bid < 128) { const int kv = (bid - 64) >> 5, part = (bid - 64) & 31, j = tidx() & 255, hh = tidx() >> 8;
            const float* pe = p.nsa_cmp_pe + kv * 4096 + part * 128 + hh * 64; const float* w1 = p.nsa_cmp_w1 + ((size_t)kv * 4096 + part * 128 + hh * 64) * CMP_HIDDEN + j; float sm = 0.f;
#pragma unroll 8
            for (int i = 0; i < 64; ++i) sm += pe[i] * w1[(size_t)i * CMP_HIDDEN];
            p.h1[(kv * 64 + part * 2 + hh) * 256 + j] = sm; }
        rows_norm<true>(p.x, nullptr, nullptr, nullptr, p.ln_mix, p.hb16, bid, nb);
        { const float* w = p.nsa_w_in; conv_wt<true>([=](int, int k, int q) { const int c = q * 4, pn = c >> 8; int lg = c;
              if (pn < 10 || pn == 12 || pn == 13 || pn == 16 || pn == 17) { const int c128 = c & 127; lg = (c & ~127) + 16 * (c128 >> 5) + 4 * ((c128 >> 3) & 3) + 64 * ((c128 >> 2) & 1); }
              return lg < NSA_PROJ ? w + (size_t)k * NSA_PROJ + lg : (const float*)nullptr; }, 1, D_MODEL, NSA_PROJ_P, p.wt_nsa_in, lds, bid, nb); }
        { const float* w = p.nsa_cmp_w1; conv_wt([=](int g, int k, int q) { return w + ((size_t)g * 4096 + k) * CMP_HIDDEN + q * 4; }, 2, 4096, CMP_HIDDEN, p.wt_cmp1, lds, bid, nb); }
        { const float* w = p.nsa_cmp_w2; conv_wt([=](int g, int k, int q) { return q < 32 ? w + ((size_t)g * CMP_HIDDEN + k) * 128 + q * 4 : (const float*)nullptr; }, 2, CMP_HIDDEN, 256, p.wt_cmp2, lds, bid, nb); }
    } else if constexpr (PH == 1) {
        mg::StaticOrder S; S.init(T, NSA_PROJ_P, nb, bid);
        mg::gemm_phase<true, 10>(stage, D_MODEL / 2, mg::APlain{p.hb16, D_MODEL / 2}, mg::BPlain{p.wt_nsa_in, D_MODEL / 2, 0}, S,
                       EpiNsaIn{(bf16_t*)(p.big + BIG_NSA_Q), (bf16_t*)(p.big + BIG_NSA_KS), (bf16_t*)(p.big + BIG_NSA_VS), (bf16_t*)(p.big + BIG_NSA_KW), (bf16_t*)(p.big + BIG_NSA_VW),
                                (bf16_t*)(p.big + BIG_NSA_ACMP), (float*)(p.big + BIG_NSA_GATE), p.rope, p.nsa_cmp_pe});
        { const int nu = (T / 256) * (NSA_PROJ_P / 256), rem = nu % nb; __syncthreads();
          if (bid == nb - 1) { const int kv = tidx() >> 8, j = tidx() & 255; float sm = 0.f;
#pragma unroll 8
              for (int s_ = 0; s_ < 64; ++s_) sm += p.h1[(kv * 64 + s_) * 256 + j];
              p.kvc[kv * 256 + j] = sm; }
          if (rem) conv_moe_tiles(p, lds, 0, CT_A, bid - rem, nb - rem); else conv_moe_tiles(p, lds, 0, CT_A, bid, nb); }
    } else if constexpr (PH == 2) {
    } else if constexpr (PH == 3) {
        mg::FixedGroups S{2, 8, 1, nb, bid};
        mg::gemm_phase(stage, 4096, mg::AGrouped{(const bf16_t*)(p.big + BIG_NSA_ACMP), 2048, (size_t)2048 * 2048}, mg::BPlain{p.wt_cmp1, 4096, (size_t)CMP_HIDDEN * 4096}, S, EpiCmp1{(bf16_t*)(p.big + BIG_NSA_H1), (const float*)p.kvc});
        __syncthreads();
        for (int L = bid; L < 16; L += nb) { const int g = L >> 3, pm = L & 7;
            cmp_gemm2_rows((const bf16_t*)(p.big + BIG_NSA_H1) + (size_t)g * 2048 * 256, p.wt_cmp2 + (size_t)g * 256 * CMP_HIDDEN, (bf16_t*)(p.big + BIG_NSA_KVC) + (size_t)g * 2048 * 128, pm * 256); }
        if (nb > 16) conv_moe_tiles(p, lds, CT_A, CT_B, bid - 16, nb - 16); else conv_moe_tiles(p, lds, CT_A, CT_B, bid, nb);
        { const float* w = p.ssd_w_out; const int fb = nb > 16 ? bid - 16 : bid, fn = nb > 16 ? nb - 16 : nb;
          if (fb >= 0) conv_wt([=](int, int k, int q) { return w + (size_t)k * D_MODEL + q * 4; }, 1, SSD_DI, D_MODEL, p.wt_ssd_out, lds, fb, fn);
          if (fb >= 0) { const float* w1 = p.nsa_w_out; conv_wt<true>([=](int, int k, int q) { return w1 + (size_t)k * D_MODEL + q * 4; }, 1, 2048, D_MODEL, p.wt_nsa_out, lds, fb, fn); }
          if (fb >= 0) { const float* w2 = p.ssd_w_in; conv_wt([=](int, int k, int q) { const int c = q * 4; return c < SSD_PROJ ? w2 + (size_t)k * SSD_PROJ + c : (const float*)nullptr; }, 1, D_MODEL, SSD_PROJ_P, p.wt_ssd_in, lds, fb, fn); } }
    } else if constexpr (PH == 4) {
    } else if constexpr (PH == 5) {
        ph_attn_mfma(p, (char*)ldsraw + LDS_STAGE_OFF, bid, nb);
    } else if constexpr (PH == 6) {
    } else if constexpr (PH == 7) {
        mg::StaticOrder S; S.init(T, D_MODEL, nb, bid);
        mg::gemm_phase<true, 12>(stage, 2048 / 2, mg::APlain{(const bf16_t*)(p.big + BIG_NSA_OBUF), 2048 / 2}, mg::BPlain{p.wt_nsa_out, 2048 / 2, 0}, S, EpiResid<false, 12>{p.x, (bf16_t*)p.xB});
    } else if constexpr (PH == 8 || PH == 17) {
        ph_moe_route(p, PH == 8 ? 0 : 1, (const bf16_t*)p.xB, lds, bid, nb);
    } else if constexpr (PH == 9 || PH == 18) {
        constexpr int L = PH == 9 ? 0 : 1; const int* cnt = p.cnt + L * MOE_E;
        moe_tables(cnt, tab);
        mg::GroupedOrder S{tab, MOE_E, 4, nb, bid};
        mg::gemm_phase<true>(stage, D_MODEL / 2, AMoeGather{p.hb16, p.list, cnt}, mg::BPlain{p.wt_gu + (size_t)L * MOE_E * MOE_FF * D_MODEL, D_MODEL / 2, (size_t)MOE_FF * D_MODEL}, S, EpiMoeGU{(bf16_t*)(p.big + BIG_MOE_ACT), cnt, tab});
        { const int rem = (tab[MOE_E] * 4) % nb; __syncthreads(); constexpr int f0 = L == 0 ? CT_B : CT_D + 384, f1 = L == 0 ? CT_C : CT_E;
            if (rem) conv_moe_tiles(p, lds, f0, f1, bid - rem, nb - rem); else conv_moe_tiles(p, lds, f0, f1, bid, nb); }
    } else if constexpr (PH == 10 || PH == 19) {
        constexpr int L = PH == 10 ? 0 : 1; const int* cnt = p.cnt + L * MOE_E;
        moe_tables(cnt, tab);
        mg::GroupedOrder S{tab, MOE_E, 8, nb, bid};
        mg::gemm_phase<true>(stage, MOE_FF / 2, AMoeAct{(const bf16_t*)(p.big + BIG_MOE_ACT), tab}, mg::BPlain{p.wt_d + (size_t)L * MOE_E * D_MODEL * MOE_FF / 2, MOE_FF / 2, (size_t)D_MODEL * MOE_FF / 2}, S, EpiMoeDown{(bf16_t*)(p.big + BIG_MOE_YS), p.list, cnt, p.lw});
        if constexpr (L == 0) { const int rem = (tab[MOE_E] * 8) % nb; __syncthreads();
            if (rem) conv_moe_tiles(p, lds, CT_D, CT_D + 384, bid - rem, nb - rem); else conv_moe_tiles(p, lds, CT_D, CT_D + 384, bid, nb); }
    } else if constexpr (PH == 11) {
        const bf16_t* ys = (const bf16_t*)(p.big + BIG_MOE_YS);
        rows_norm<false, true>(p.xB, ys, ys + D_MODEL, p.xA, p.ln_mix + D_MODEL, p.hb16, bid, nb);
    } else if constexpr (PH == 12) {
        mg::StaticOrder S; S.init(T, SSD_PROJ_P, nb, bid);
        mg::gemm_phase(stage, D_MODEL, mg::APlain{p.hb16, D_MODEL}, mg::BPlain{p.wt_ssd_in, D_MODEL, 0}, S,
                       EpiSsdIn{(bf16_t*)(p.big + BIG_SSD_Z), (bf16_t*)(p.big + BIG_SSD_XBCP), p.dtb, p.ssd_dt_bias});
        { const int nu = (T / 256) * (SSD_PROJ_P / 256), rem = nu % nb; __syncthreads();
          if (rem) conv_moe_tiles(p, lds, CT_C, CT_D, bid - rem, nb - rem); else conv_moe_tiles(p, lds, CT_C, CT_D, bid, nb); }
    } else if constexpr (PH == 13) {
        ph_ssd_conv_bc(p, bid, nb);
    } else if constexpr (PH == 14) {
        ph_ssd_mfma(p, (char*)ldsraw + LDS_STAGE_OFF, bid, nb);
    } else if constexpr (PH == 15) {
        ph_ssd_norm(p, bid, nb);
    } else if constexpr (PH == 16) {
        mg::StaticOrder S; S.init(T, D_MODEL, nb, bid);
        mg::gemm_phase(stage, SSD_DI, mg::APlain{(const bf16_t*)(p.big + BIG_SSD_YN), SSD_DI}, mg::BPlain{p.wt_ssd_out, SSD_DI, 0}, S, EpiResid<true>{p.xA, (bf16_t*)p.xB});
    } else if constexpr (PH == 20) {
        const bf16_t* ys = (const bf16_t*)(p.big + BIG_MOE_YS);
        const int lane = tidx() & 63, wid = tidx() >> 6;
        for (int row = bid * 8 + wid; row < T; row += nb * 8) {
            float4 v[8]; float ss = 0.f;
#pragma unroll
            for (int i = 0; i < 8; ++i) { const int c = i * 256 + lane * 4; const ushort4 s4 = *(const ushort4*)((const bf16_t*)p.xB + (size_t)row * D_MODEL + c); float4 a = make_float4(bf2f(s4.x), bf2f(s4.y), bf2f(s4.z), bf2f(s4.w));
                const ushort4 y0 = *(const ushort4*)(ys + (size_t)(2 * row) * D_MODEL + c), y1 = *(const ushort4*)(ys + (size_t)(2 * row + 1) * D_MODEL + c);
                a.x += bf2f(y0.x) + bf2f(y1.x); a.y += bf2f(y0.y) + bf2f(y1.y); a.z += bf2f(y0.z) + bf2f(y1.z); a.w += bf2f(y0.w) + bf2f(y1.w);
                v[i] = a; ss += a.x * a.x + a.y * a.y + a.z * a.z + a.w * a.w; }
            ss = wave_sum(ss); const float rinv = rsqrtf(ss * (1.f / D_MODEL) + NORM_EPS);
#pragma unroll
            for (int i = 0; i < 8; ++i) { const int c = i * 256 + lane * 4; const float4 gg = *(const float4*)(p.ln_final + c);
                float4 o; o.x = v[i].x * rinv * gg.x; o.y = v[i].y * rinv * gg.y; o.z = v[i].z * rinv * gg.z; o.w = v[i].w * rinv * gg.w;
                __builtin_nontemporal_store((f32x4){o.x, o.y, o.z, o.w}, (f32x4*)(p.out + (size_t)row * D_MODEL + c)); }
        }
    }
}

template <int PH> __global__ __launch_bounds__(NTHREADS, 2) void k_phase(P p) {
    extern __shared__ __attribute__((aligned(16))) float lds[];
    run_phase<PH>(p, lds, blockIdx.x, gridDim.x);
}
template <int PH> static void launch_all(const P& p, hipStream_t stream) {
    if constexpr (PH < NPHASE) {
        static bool attr = false; if (!attr) { attr = true; (void)hipFuncSetAttribute((const void*)k_phase<PH>, hipFuncAttributeMaxDynamicSharedMemorySize, LDS_BYTES); }
        hipLaunchKernelGGL(k_phase<PH>, dim3(256), dim3(NTHREADS), LDS_BYTES, stream, p);
        launch_all<PH + 1>(p, stream);
    }
}
constexpr bool phase_empty(int ph) { return ph == 2 || ph == 4 || ph == 6; }
#ifndef PROBE_DUP_MASK
#define PROBE_DUP_MASK 0u
#endif
constexpr bool phase_dup(int ph) { return (PROBE_DUP_MASK >> ph) & 1u; }
template <int PH> DEV void mega_phases(const P& p, float* lds, const XcdBarrier& bar) {
    if constexpr (PH < NPHASE) {
        if constexpr (!phase_empty(PH)) {
            run_phase<PH>(p, lds, blockIdx.x, gridDim.x);
            if constexpr (phase_dup(PH)) { xcd_barrier(bar); run_phase<PH>(p, lds, blockIdx.x, gridDim.x); }
            if constexpr (PH + 1 < NPHASE) xcd_barrier(bar);
        }
        mega_phases<PH + 1>(p, lds, bar);
    }
}
__global__ __launch_bounds__(NTHREADS, 2) void k_mega(P p) {
    extern __shared__ __attribute__((aligned(16))) float lds[];
    if (threadIdx.x < 4) ((unsigned*)lds)[threadIdx.x] = 0u;
    __syncthreads();
    XcdBarrier bar = xcd_barrier_post(p.bar, (volatile LAS unsigned*)lds);
    mega_phases<0>(p, lds, bar);
}

extern "C" void kernel_launch(void* const* d_in, const int* in_sizes, int n_in, void* d_out, int out_size, void* d_ws, size_t ws_size, hipStream_t stream) {
    P p{};
    const float* const* in = (const float* const*)d_in;
    p.x = in[0]; p.ln_mix = in[1]; p.ln_ffn = in[2]; p.ln_final = in[3]; p.nsa_w_in = in[4]; p.nsa_cmp_pe = in[5]; p.nsa_cmp_w1 = in[6]; p.nsa_cmp_w2 = in[7]; p.nsa_w_out = in[8];
    p.ssd_w_in = in[9]; p.ssd_conv_w = in[10]; p.ssd_conv_b = in[11]; p.ssd_dt_bias = in[12]; p.ssd_a_log = in[13]; p.ssd_d = in[14]; p.ssd_norm = in[15]; p.ssd_w_out = in[16];
    p.moe_w_group = in[17]; p.moe_b_group = in[18]; p.moe_w_expert = in[19]; p.moe_b_expert = in[20]; p.moe_w_gate = in[21]; p.moe_w_up = in[22]; p.moe_w_down = in[23];
    p.out = (float*)d_out;
    char* w = (char*)d_ws; size_t off = 0;
    auto take = [&](size_t bytes) { char* r = w + off; off += (bytes + 255) & ~(size_t)255; return r; };
    p.bar = (unsigned*)take(XCD_BAR_WORDS * 4);
    p.wt_nsa_in = (bf16_t*)take((size_t)NSA_PROJ_P * D_MODEL * 2);
    p.wt_nsa_out = (bf16_t*)take((size_t)D_MODEL * 2048 * 2);
    p.wt_ssd_in = (bf16_t*)take((size_t)SSD_PROJ_P * D_MODEL * 2);
    p.wt_ssd_out = (bf16_t*)take((size_t)D_MODEL * SSD_DI * 2);
    p.wt_gu = (bf16_t*)take((size_t)2 * MOE_E * 2 * MOE_FF * D_MODEL * 2);
    p.wt_d = (bf16_t*)take((size_t)2 * MOE_E * D_MODEL * MOE_FF * 2);
    p.wt_cmp1 = (bf16_t*)take((size_t)2 * CMP_HIDDEN * 4096 * 2);
    p.wt_cmp2 = (bf16_t*)take((size_t)2 * 256 * CMP_HIDDEN * 2);
    p.xA = (float*)take((size_t)T * D_MODEL * 4);
    p.xB = (float*)take((size_t)T * D_MODEL * 4);
    p.hb16 = (bf16_t*)take((size_t)T * D_MODEL * 2);
    p.big = take(BIG_BYTES);
    p.rope = (float*)take((size_t)SEQ * 64 * 2 * 4);
    p.h1 = (float*)take((size_t)2 * 2032 * CMP_HIDDEN * 4);
    p.kvc = (float*)take((size_t)2 * 2032 * 128 * 4);
    p.selmask = (unsigned*)take((size_t)BATCH * NKV * SEQ * 4);
    p.cnt = (int*)take(64 * 4);
    p.list = (int*)take((size_t)MOE_E * T * 4);
    p.ew = (float*)take((size_t)T * 2 * 4);
    p.lw = (float*)take((size_t)MOE_E * T * 4);
    p.dtb = (float*)take((size_t)T * 64 * 4);
    p.wr = (float*)take((size_t)2 * D_MODEL * MOE_E * 4);
    p.wgq = (float*)take((size_t)2 * D_MODEL * MOE_G * 4);
    if (off > ws_size) { fprintf(stderr, "workspace too small: need %zu have %zu\n", off, ws_size); return; }
#if defined(MK_MULTI)
    launch_all<0>(p, stream);
#else
    static int grid = 0;
    if (!grid) {
        int dev = 0, cus = 0, per_cu = 0;
        (void)hipGetDevice(&dev);
        (void)hipDeviceGetAttribute(&cus, hipDeviceAttributeMultiprocessorCount, dev);
        (void)hipFuncSetAttribute((const void*)k_mega, hipFuncAttributeMaxDynamicSharedMemorySize, LDS_BYTES);
        (void)hipOccupancyMaxActiveBlocksPerMultiprocessor(&per_cu, k_mega, NTHREADS, LDS_BYTES);
        if (per_cu < 1) per_cu = 1;
        grid = cus * (per_cu < 1 ? per_cu : 1);
    }
    (void)hipMemsetAsync(p.bar, 0, XCD_BAR_WORDS * sizeof(unsigned), stream);
    hipLaunchKernelGGL(k_mega, dim3(grid), dim3(NTHREADS), LDS_BYTES, stream, p);
#endif
}
```

```cpp
#include <hip/hip_runtime.h>
#include <stdint.h>
#include <math.h>
#include <cstdio>

#define DEV __device__ __forceinline__

constexpr int D_MODEL = 2048, BATCH = 4, SEQ = 2048, T = BATCH * SEQ;
constexpr int NH = 16, NKV = 4, DH = 128;
constexpr int NCMP = 127, CMP_HIDDEN = 256;
constexpr int NSLC = 32;
constexpr int WINDOW = 512;
constexpr int NSA_PROJ = 5168, NSA_PROJ_P = 5376;
constexpr int OFF_Q = 0, OFF_KC = 2048, OFF_VC = 2560, OFF_KS = 3072, OFF_VS = 3584, OFF_KW = 4096, OFF_VW = 4608, OFF_G = 5120;
constexpr int SSD_DI = 4096, SSD_P = 64, SSD_H = 64, SSD_G = 8, SSD_N = 128, SSD_CONVCH = 6144, SSD_PROJ = 10304, SSD_PROJ_P = 10496;
constexpr int OFF_Z = 0, OFF_XBC = 4096, OFF_DT = 10240;
constexpr int MOE_G = 4, MOE_EPG = 8, MOE_E = 32, MOE_FF = 512;
constexpr float NORM_EPS = 1e-6f;
constexpr int NTHREADS = 512;
typedef unsigned short bf16_t;


struct P {
    const float *x, *ln_mix, *ln_ffn, *ln_final, *nsa_w_in, *nsa_cmp_pe, *nsa_cmp_w1, *nsa_cmp_w2, *nsa_w_out;
    const float *ssd_w_in, *ssd_conv_w, *ssd_conv_b, *ssd_dt_bias, *ssd_a_log, *ssd_d, *ssd_norm, *ssd_w_out;
    const float *moe_w_group, *moe_b_group, *moe_w_expert, *moe_b_expert, *moe_w_gate, *moe_w_up, *moe_w_down;
    float* out;
    bf16_t *wt_nsa_in, *wt_nsa_out, *wt_ssd_in, *wt_ssd_out, *wt_gu, *wt_d, *wt_cmp1, *wt_cmp2;
    float *xA, *xB; bf16_t* hb16;
    char* big;
    float* rope;
    float* h1;
    float* kvc;
    unsigned* selmask;
    int* cnt;
    int* list;
    float* ew;
    float* lw;
    float* dtb;
    float *wr, *wgq;
    unsigned* bar;
};
constexpr size_t BIG_NSA_Q = 0, BIG_NSA_KS = (size_t)T * 2048 * 2, BIG_NSA_VS = BIG_NSA_KS + (size_t)T * 512 * 2, BIG_NSA_KW = BIG_NSA_VS + (size_t)T * 512 * 2, BIG_NSA_VW = BIG_NSA_KW + (size_t)T * 512 * 2,
    BIG_NSA_ACMP = BIG_NSA_VW + (size_t)T * 512 * 2, BIG_NSA_H1 = BIG_NSA_ACMP + (size_t)2 * 2048 * 4096 * 2, BIG_NSA_KVC = BIG_NSA_H1 + (size_t)2 * 2048 * 256 * 2,
    BIG_NSA_GATE = BIG_NSA_KVC + (size_t)2 * 2048 * 128 * 2, BIG_NSA_OCMP = BIG_NSA_GATE + (size_t)T * 48 * 4, BIG_NSA_OBUF = BIG_NSA_OCMP + (size_t)T * 2048 * 4;
constexpr size_t BIG_MOE_ACT = 0, BIG_MOE_YS = (size_t)(2 * T + 256) * MOE_FF * 2;
constexpr size_t BIG_SSD_Z = 0, BIG_SSD_XBCP = (size_t)T * SSD_DI * 2, BIG_SSD_YN = BIG_SSD_XBCP + (size_t)T * SSD_CONVCH * 2, BIG_SSD_BC = BIG_SSD_YN + (size_t)T * SSD_DI * 2;
constexpr size_t BIG_SSD_TABG = BIG_SSD_BC + (size_t)T * 2048 * 2;
constexpr size_t BIG_BYTES = BIG_SSD_TABG + (size_t)256 * 16 * 640 * 4;
static_assert(BIG_NSA_OBUF + (size_t)T * 2048 * 2 <= BIG_BYTES && BIG_MOE_YS + (size_t)2 * T * D_MODEL * 4 <= BIG_BYTES, "big region");

DEV int tidx() { int t = threadIdx.x; asm volatile("" : "+v"(t)); return t; }
DEV float swap_pair(float v) { return __int_as_float(__builtin_amdgcn_mov_dpp(__float_as_int(v), 0xB1, 0xF, 0xF, true)); }
DEV float dpp_xor2(float v) { return __int_as_float(__builtin_amdgcn_mov_dpp(__float_as_int(v), 0x4E, 0xF, 0xF, true)); }
DEV void quad_transpose(float (&v)[4], int k) {
    { const bool up = (k & 2) != 0;
#pragma unroll
      for (int e = 0; e < 2; ++e) { const float snd = up ? v[e] : v[e + 2]; const float rcv = dpp_xor2(snd); if (up) v[e] = rcv; else v[e + 2] = rcv; } }
    { const bool od = (k & 1) != 0;
#pragma unroll
      for (int e = 0; e < 4; e += 2) { const float snd = od ? v[e] : v[e + 1]; const float rcv = swap_pair(snd); if (od) v[e] = rcv; else v[e + 1] = rcv; } }
}
DEV float wave_sum(float v) { for (int o = 32; o >= 1; o >>= 1) v += __shfl_xor(v, o); return v; }
DEV float wave_max(float v) { for (int o = 32; o >= 1; o >>= 1) v = fmaxf(v, __shfl_xor(v, o)); return v; }
DEV float siluf(float v) { return v / (1.f + expf(-v)); }
DEV float gelu_tanh(float v) { return 0.5f * v * (1.f + tanhf(0.7978845608028654f * (v + 0.044715f * v * v * v))); }
DEV float bf2f(bf16_t b) { return __uint_as_float(((unsigned)b) << 16); }
DEV bf16_t f2bf(float f) { unsigned u = __float_as_uint(f); u += 0x7FFFu + ((u >> 16) & 1u); return (bf16_t)(u >> 16); }

template <class CF, class AF, class BF, class EF>
DEV void ngemm(int ngroups, CF cntf, int N, int K, AF af, BF bf, EF ef, float* lds, int bid, int nb) {
    float* As = lds;
    float* Bs = lds + 16 * 132;
    int* pre = (int*)(lds + 16 * 132 + 16 * 68);
    const int tid = tidx(), tx = tid & 15, ty = tid >> 4;
    const int tilesN = (N + 63) / 64;
    __syncthreads();
    if (tid == 0) { int s = 0; for (int g = 0; g < ngroups; ++g) { pre[g] = s; s += ((cntf(g) + 127) / 128) * tilesN; } pre[ngroups] = s; }
    __syncthreads();
    const int total = pre[ngroups];
    for (int tile = bid; tile < total; tile += nb) {
        int g = 0; while (g + 1 < ngroups && pre[g + 1] <= tile) ++g;
        const int lt = tile - pre[g], tm = lt / tilesN, tn = lt % tilesN, M = cntf(g);
        float acc[4][4];
#pragma unroll
        for (int i = 0; i < 4; ++i)
#pragma unroll
            for (int j = 0; j < 4; ++j) acc[i][j] = 0.f;
        for (int k0 = 0; k0 < K; k0 += 16) {
#pragma unroll
            for (int it = 0; it < 4; ++it) { const int i = tid + it * 512, m = i >> 4, k = i & 15, gm = tm * 128 + m; As[k * 132 + m] = (gm < M) ? af(g, gm, k0 + k) : 0.f; }
#pragma unroll
            for (int it = 0; it < 2; ++it) { const int i = tid + it * 512, k = i >> 6, n = i & 63, gn = tn * 64 + n; Bs[k * 68 + n] = (gn < N) ? bf(g, k0 + k, gn) : 0.f; }
            __syncthreads();
#pragma unroll
            for (int k = 0; k < 16; ++k) {
                const float4 a = *(const float4*)(As + k * 132 + ty * 4), b = *(const float4*)(Bs + k * 68 + tx * 4);
                const float av[4] = {a.x, a.y, a.z, a.w}, bv[4] = {b.x, b.y, b.z, b.w};
#pragma unroll
                for (int i = 0; i < 4; ++i)
#pragma unroll
                    for (int j = 0; j < 4; ++j) acc[i][j] = fmaf(av[i], bv[j], acc[i][j]);
            }
            __syncthreads();
        }
#pragma unroll
        for (int i = 0; i < 4; ++i)
#pragma unroll
            for (int j = 0; j < 4; ++j) { const int gm = tm * 128 + ty * 4 + i, gn = tn * 64 + tx * 4 + j; if (gm < M && gn < N) ef(g, gm, gn, acc[i][j]); }
    }
}

#define MG_LAS __attribute__((address_space(3)))

typedef short bf16x8 __attribute__((ext_vector_type(8)));
typedef float f32x4 __attribute__((ext_vector_type(4)));
typedef unsigned u32x4 __attribute__((ext_vector_type(4)));
typedef unsigned u32x2 __attribute__((ext_vector_type(2)));
typedef int i32x8 __attribute__((ext_vector_type(8)));
typedef int i32x4 __attribute__((ext_vector_type(4)));
DEV unsigned pk8(float a, float b, float c, float d) {
    a = __builtin_amdgcn_fmed3f(a, -448.f, 448.f); b = __builtin_amdgcn_fmed3f(b, -448.f, 448.f); c = __builtin_amdgcn_fmed3f(c, -448.f, 448.f); d = __builtin_amdgcn_fmed3f(d, -448.f, 448.f);
    int w = __builtin_amdgcn_cvt_pk_fp8_f32(a, b, 0, false); w = __builtin_amdgcn_cvt_pk_fp8_f32(c, d, w, true); return (unsigned)w; }
constexpr float F8_SX = 4.f, F8_SW = 256.f, F8_SACT = 8.f, F8_SO = 16.f;
namespace mg {
constexpr int BM = 256, BK = 64, HALF = 128, HTB = HALF * BK * 2, STAGE_BYTES = 8 * HTB, NXCD = 8, WGM = 8;
DEV int lds_byte(int r, int c) { const int st = (r >> 4) * 2 + (c >> 5), rr = r & 15, cc = c & 31, ob = rr * 64 + cc * 2; return st * 1024 + (ob ^ (((ob >> 9) & 1) << 5)); }
DEV void stage_rc(int b, int& R, int& C) { const int st = b / 1024, sb = b % 1024, swz = sb ^ (((sb >> 9) & 1) << 5); R = (st >> 1) * 16 + swz / 64; C = (st & 1) * 32 + (swz % 64) / 2; }
DEV int perm32(int rho) { const int n = rho >> 4, i = rho & 15; return 8 * (i >> 2) + 4 * n + (i & 3); }
DEV unsigned cvt_pk_bf16(float lo, float hi) { unsigned r; asm volatile("v_cvt_pk_bf16_f32 %0, %1, %2" : "=v"(r) : "v"(lo), "v"(hi)); return r; }
struct Unit { int g, pm, pn; };

struct StaticOrder {
    int nM, nN, nwg, G, c;
    DEV void init(int M, int N, int G_, int c_) { nM = M / BM; nN = N / BM; nwg = nM * nN; G = G_; c = c_; }
    DEV bool next(int i, Unit& u) const {
        const long L = (long)i * G + c; if (L >= nwg) return false;
        int wgid = (int)L; { const int q = nwg / NXCD, r = nwg % NXCD, xcd = wgid % NXCD, off = wgid / NXCD; wgid = (xcd < r ? xcd * (q + 1) : r * (q + 1) + (xcd - r) * q) + off; }
        const int nig = WGM * nN, gid = wgid / nig, fm = gid * WGM, gsz = (nM - fm) < WGM ? (nM - fm) : WGM;
        u.g = 0; u.pm = fm + ((wgid % nig) % gsz); u.pn = (wgid % nig) / gsz; return true;
    }
};
struct GroupedOrder {
    const int* pre; int ng, nN, G, c;
    DEV bool next(int i, Unit& u) const {
        const int L = i * G + c; if (L >= pre[ng] * nN) return false;
        const int mt = L / nN; u.pn = L - mt * nN; int g = 0; while (g + 1 < ng && pre[g + 1] <= mt) ++g;
        u.g = __builtin_amdgcn_readfirstlane(g); u.pm = __builtin_amdgcn_readfirstlane(mt - pre[g]); u.pn = __builtin_amdgcn_readfirstlane(u.pn); return true;
    }
};
struct FixedGroups {
    int ng, mt, nN, G, c;
    DEV bool next(int i, Unit& u) const { const int L = i * G + c; if (L >= ng * mt * nN) return false; u.pn = L % nN; const int r = L / nN; u.pm = r % mt; u.g = r / mt; return true; }
};
struct AGrouped { static constexpr bool GATHER = false; const bf16_t* A; int lda; size_t gstride; DEV const char* ubase(const Unit& u) const { return (const char*)(A + (size_t)u.g * gstride + (size_t)u.pm * BM * lda); } DEV unsigned rowoff(const Unit&, int r) const { return (unsigned)(r * lda) * 2u; } };
struct APlain { static constexpr bool GATHER = false; const bf16_t* A; int lda; DEV const char* ubase(const Unit& u) const { return (const char*)(A + (size_t)u.pm * BM * lda); } DEV unsigned rowoff(const Unit&, int r) const { return (unsigned)(r * lda) * 2u; } };
struct BPlain { const bf16_t* Bt; int ldb; size_t gstride; DEV const char* base(const Unit& u) const { return (const char*)(Bt + (size_t)u.g * gstride + (size_t)u.pn * BM * ldb); } };

template <bool FP8 = false, int DS = 0  , class AOp, class BOp, class Epi, class Sched>
DEV void gemm_phase(MG_LAS unsigned char* lds, const int K, const AOp& aop, const BOp& bop, const Sched& S, const Epi& E) {
    int tid_ = tidx();
    const int tid = tid_, wid = __builtin_amdgcn_readfirstlane(tid >> 6), lane = tid & 63, wr = wid >> 2, wc = wid & 3, fr = lane & 15, fq = lane >> 4;
    int nt = K / BK; asm volatile("" : "+s"(nt));
    unsigned voffB[2];
#pragma unroll
    for (int i = 0; i < 2; ++i) { int R, C; stage_rc(tid * 16 + i * 8192, R, C); const int Rb = Epi::PERM ? ((R & ~31) + perm32(R & 31)) : R; voffB[i] = (unsigned)(Rb * bop.ldb + C) * 2u; }
#define MG_ROWOFFS(dst, unit) do { _Pragma("unroll") for (int _h = 0; _h < 2; ++_h) _Pragma("unroll") for (int _i = 0; _i < 2; ++_i) { int _R, _C; stage_rc(tid * 16 + _i * 8192, _R, _C); dst[_h][_i] = aop.rowoff(unit, _h * HALF + _R) + (unsigned)(_C * 2); } } while (0)
    const size_t kstep = (size_t)(BK * 2);
    const size_t hstepB = (size_t)HALF * bop.ldb * 2;
    const unsigned ldsw = (unsigned)wid * 1024u;
    const int aoff = lds_byte(wr * 64 + fr, fq * 8), boff = lds_byte(wc * 32 + fr, fq * 8);
#define MG_SA(b, h) (((b) * 2 + (h)) * HTB)
#define MG_SB(b, h) ((4 + (b) * 2 + (h)) * HTB)
#define MG_STAGE(bufoff, gbase, voff) do { _Pragma("unroll") for (int _i = 0; _i < 2; ++_i) \
        __builtin_amdgcn_global_load_lds((const unsigned*)((const char*)(gbase) + (voff)[_i]), (MG_LAS unsigned*)(lds + (bufoff) + ldsw + _i * 8192), 16, 0, 0); } while (0)
#define MG_LDA(dst, b, h) do { if constexpr (FP8) { _Pragma("unroll") for (int m = 0; m < 4; ++m) { dst##8[m].lo = *(const MG_LAS i32x4*)(lds + MG_SA(b, h) + aoff + m * 2048); dst##8[m].hi = *(const MG_LAS i32x4*)(lds + MG_SA(b, h) + aoff + m * 2048 + 1024); } } else { \
        _Pragma("unroll") for (int m = 0; m < 4; ++m) _Pragma("unroll") for (int k = 0; k < 2; ++k) dst[m][k] = *(const MG_LAS bf16x8*)(lds + MG_SA(b, h) + aoff + m * 2048 + k * 1024); } } while (0)
#define MG_LDB(dst, b, h) do { if constexpr (FP8) { _Pragma("unroll") for (int n = 0; n < 2; ++n) { dst##8[n].lo = *(const MG_LAS i32x4*)(lds + MG_SB(b, h) + boff + n * 2048); dst##8[n].hi = *(const MG_LAS i32x4*)(lds + MG_SB(b, h) + boff + n * 2048 + 1024); } } else { \
        _Pragma("unroll") for (int n = 0; n < 2; ++n) _Pragma("unroll") for (int k = 0; k < 2; ++k) dst[n][k] = *(const MG_LAS bf16x8*)(lds + MG_SB(b, h) + boff + n * 2048 + k * 1024); } } while (0)
#define MG_MMA(ai, bj, At, Bt) do { __builtin_amdgcn_s_setprio(1); if constexpr (FP8) { _Pragma("unroll") for (int m = 0; m < 4; ++m) _Pragma("unroll") for (int n = 0; n < 2; ++n) \
        asm volatile("v_mfma_f32_16x16x128_f8f6f4 %0, %1, %2, %0" : "+v"(acc[ai][bj][m][n]) : "v"(Bt##8[n]), "v"(At##8[m])); } else {     \
        _Pragma("unroll") for (int m = 0; m < 4; ++m) _Pragma("unroll") for (int n = 0; n < 2; ++n) _Pragma("unroll") for (int k = 0; k < 2; ++k) \
        acc[ai][bj][m][n] = __builtin_amdgcn_mfma_f32_16x16x32_bf16(Bt[n][k], At[m][k], acc[ai][bj][m][n], 0, 0, 0); } __builtin_amdgcn_s_setprio(0); } while (0)
#define MG_WAIT_V(n) asm volatile("s_waitcnt vmcnt(" #n ")" ::: "memory")
#define MG_WAIT_L(n) asm volatile("s_waitcnt lgkmcnt(" #n ")" ::: "memory")
#define MG_BAR __builtin_amdgcn_s_barrier()
#define MG_SCHED __builtin_amdgcn_sched_barrier(0)
    Unit cur, nxt; int ui = 0;
    if (!S.next(0, cur)) return;
    f32x4 acc[2][2][4][2];
#define MG_ACC_INIT(unit) do { if constexpr (Epi::ACC_INIT) E.init(acc, unit, wr, wc, fr, fq); else { \
        _Pragma("unroll") for (int a = 0; a < 2; ++a) _Pragma("unroll") for (int b = 0; b < 2; ++b) _Pragma("unroll") for (int m = 0; m < 4; ++m) _Pragma("unroll") for (int n = 0; n < 2; ++n) acc[a][b][m][n] = (f32x4){0.f, 0.f, 0.f, 0.f}; } } while (0)
    MG_ACC_INIT(cur);
    bf16x8 At[4][2], B0[2][2], B1[2][2];
    i32x8 At8[4], B08[2], B18[2];
    unsigned vAc[2][2], vAn[2][2];
    MG_ROWOFFS(vAc, cur);
    const char* cA = aop.ubase(cur); const char* cB = bop.base(cur);
    MG_STAGE(MG_SB(0, 0), cB, voffB); MG_STAGE(MG_SA(0, 0), cA, vAc[0]); MG_STAGE(MG_SB(0, 1), cB + hstepB, voffB); MG_STAGE(MG_SA(0, 1), cA, vAc[1]);
    if (wr == 1) MG_BAR;
    MG_WAIT_V(4); MG_BAR;
    MG_STAGE(MG_SB(1, 0), cB + kstep, voffB); MG_STAGE(MG_SA(1, 0), cA + kstep, vAc[0]); MG_STAGE(MG_SB(1, 1), cB + hstepB + kstep, voffB);
    MG_WAIT_V(6); MG_BAR;
    for (;;) {
        const bool has_next = S.next(ui + 1, nxt);
        const char* nB = has_next ? bop.base(nxt) : cB; const char* nA = has_next ? aop.ubase(nxt) : cA;
        if constexpr (AOp::GATHER) { if (has_next) MG_ROWOFFS(vAn, nxt); else {
#pragma unroll
            for (int h = 0; h < 2; ++h)
#pragma unroll
                for (int i = 0; i < 2; ++i) vAn[h][i] = vAc[h][i]; } }
        for (int t = 0; t < nt; t += 2) {
            const bool last = (t == nt - 2);
            const char* a1 = cA + (size_t)(t + 1) * kstep;
            const char* a2 = last ? nA : cA + (size_t)(t + 2) * kstep; const char* b2 = last ? nB : cB + (size_t)(t + 2) * kstep;
            const char* a3 = a2 + kstep; const char* b3 = b2 + kstep;
            MG_LDB(B0, 0, 0); MG_SCHED; MG_LDA(At, 0, 0); MG_STAGE(MG_SA(1, 1), a1, vAc[1]);
            if constexpr (AOp::GATHER) { if (last) {
#pragma unroll
                for (int h = 0; h < 2; ++h)
#pragma unroll
                    for (int i = 0; i < 2; ++i) vAc[h][i] = vAn[h][i]; } }
            MG_WAIT_L(8); MG_BAR; MG_WAIT_L(0); MG_MMA(0, 0, At, B0); MG_BAR; MG_SCHED;
            MG_LDB(B1, 0, 1); MG_STAGE(MG_SB(0, 0), b2, voffB);
            MG_BAR; MG_WAIT_L(0); MG_MMA(0, 1, At, B1); MG_BAR;
            MG_LDA(At, 0, 1); MG_STAGE(MG_SA(0, 0), a2, vAc[0]);
            MG_BAR; MG_WAIT_L(0); MG_MMA(1, 0, At, B0); MG_BAR; MG_SCHED;
            MG_STAGE(MG_SB(0, 1), b2 + hstepB, voffB);
            MG_WAIT_V(6); MG_BAR; MG_MMA(1, 1, At, B1); MG_BAR;
            MG_LDB(B0, 1, 0); MG_SCHED; MG_LDA(At, 1, 0); MG_STAGE(MG_SA(0, 1), a2, vAc[1]);
            MG_WAIT_L(8); MG_BAR; MG_WAIT_L(0); MG_MMA(0, 0, At, B0); MG_BAR; MG_SCHED;
            MG_LDB(B1, 1, 1); MG_STAGE(MG_SB(1, 0), b3, voffB);
            MG_BAR; MG_WAIT_L(0); MG_MMA(0, 1, At, B1); MG_BAR;
            MG_LDA(At, 1, 1); MG_STAGE(MG_SA(1, 0), a3, vAc[0]);
            MG_BAR; MG_WAIT_L(0); MG_MMA(1, 0, At, B0); MG_BAR; MG_SCHED;
            MG_STAGE(MG_SB(1, 1), b3 + hstepB, voffB);
            MG_WAIT_V(6); MG_BAR; MG_MMA(1, 1, At, B1); MG_BAR;
        }
        __builtin_amdgcn_sched_barrier(0); asm volatile("s_nop 15\n\ts_nop 15" ::: "memory"); __builtin_amdgcn_sched_barrier(0);
        if constexpr (DS != 0) {
#pragma unroll
            for (int a = 0; a < 2; ++a)
#pragma unroll
                for (int b = 0; b < 2; ++b)
#pragma unroll
                    for (int m = 0; m < 4; ++m)
#pragma unroll
                        for (int n = 0; n < 2; ++n) acc[a][b][m][n] *= (1.f / (float)(1 << DS)); }
        { int fr2 = fr, fq2 = fq; asm volatile("" : "+v"(fr2), "+v"(fq2));
          E(acc, cur, wr, wc, fr2, fq2); }
        if (!has_next) break;
        MG_ACC_INIT(nxt);
        cur = nxt; cB = nB; cA = nA; ++ui;
    }
    MG_WAIT_V(0);
    if (wr == 0) MG_BAR;
    MG_BAR;
#undef MG_ROWOFFS
#undef MG_ACC_INIT
#undef MG_SA
#undef MG_SB
#undef MG_STAGE
#undef MG_LDA
#undef MG_LDB
#undef MG_MMA
#undef MG_WAIT_V
#undef MG_WAIT_L
#undef MG_BAR
#undef MG_SCHED
}
}
#define EPI_ROWS_BEGIN _Pragma("unroll") for (int ai = 0; ai < 2; ++ai) _Pragma("unroll") for (int m = 0; m < 4; ++m) { const int rt = ai * 128 + wr * 64 + m * 16 + fr;
#define EPI_ROWS_END }
struct EpiF32 {
    static constexpr bool PERM = false, ACC_INIT = false;
    float* C; int ldc, nvalid;
    DEV void operator()(const f32x4 (&acc)[2][2][4][2], const mg::Unit& u, int wr, int wc, int fr, int fq) const {
        EPI_ROWS_BEGIN float* rowp = C + (size_t)(u.pm * 256 + rt) * ldc;
#pragma unroll
            for (int bj = 0; bj < 2; ++bj)
#pragma unroll
                for (int n = 0; n < 2; ++n) { const int col = u.pn * 256 + bj * 128 + wc * 32 + n * 16 + 4 * fq; if (col < nvalid) *(f32x4*)(rowp + col) = acc[ai][bj][m][n]; }
        EPI_ROWS_END
    }
};
template <bool RB16, int IS = 0  >
struct EpiResid {
    static constexpr bool PERM = true, ACC_INIT = true;
    const void* __restrict__ resid; bf16_t* __restrict__ out;
    DEV void init(f32x4 (&acc)[2][2][4][2], const mg::Unit& u, int wr, int wc, int fr, int fq) const {
#pragma unroll
        for (int ai = 0; ai < 2; ++ai)
#pragma unroll
            for (int m = 0; m < 4; ++m) { const size_t ro = (size_t)(u.pm * 256 + ai * 128 + wr * 64 + m * 16 + fr) * D_MODEL;
#pragma unroll
                for (int bj = 0; bj < 2; ++bj) { const size_t o = ro + u.pn * 256 + bj * 128 + wc * 32 + 8 * fq;
                    if constexpr (RB16) { const u32x4 w = __builtin_nontemporal_load((const u32x4*)((const bf16_t*)resid + o));
                        acc[ai][bj][m][0] = (f32x4){__uint_as_float(w.x << 16), __uint_as_float(w.x & 0xffff0000u), __uint_as_float(w.y << 16), __uint_as_float(w.y & 0xffff0000u)};
                        acc[ai][bj][m][1] = (f32x4){__uint_as_float(w.z << 16), __uint_as_float(w.z & 0xffff0000u), __uint_as_float(w.w << 16), __uint_as_float(w.w & 0xffff0000u)}; }
                    else { acc[ai][bj][m][0] = __builtin_nontemporal_load((const f32x4*)((const float*)resid + o)); acc[ai][bj][m][1] = __builtin_nontemporal_load((const f32x4*)((const float*)resid + o + 4)); }
                    if constexpr (IS != 0) { acc[ai][bj][m][0] *= (float)(1 << IS); acc[ai][bj][m][1] *= (float)(1 << IS); } } }
    }
    DEV void operator()(const f32x4 (&acc)[2][2][4][2], const mg::Unit& u, int wr, int wc, int fr, int fq) const {
#pragma unroll
        for (int ai = 0; ai < 2; ++ai)
#pragma unroll
            for (int m = 0; m < 4; ++m) { const size_t ro = (size_t)(u.pm * 256 + ai * 128 + wr * 64 + m * 16 + fr) * D_MODEL;
#pragma unroll
                for (int bj = 0; bj < 2; ++bj) { const f32x4 v0 = acc[ai][bj][m][0], v1 = acc[ai][bj][m][1];
                    u32x4 w; w.x = mg::cvt_pk_bf16(v0[0], v0[1]); w.y = mg::cvt_pk_bf16(v0[2], v0[3]); w.z = mg::cvt_pk_bf16(v1[0], v1[1]); w.w = mg::cvt_pk_bf16(v1[2], v1[3]);
                    *(u32x4*)(out + ro + u.pn * 256 + bj * 128 + wc * 32 + 8 * fq) = w; } }
    }
};
struct EpiSsdIn {
    static constexpr bool PERM = true, ACC_INIT = false;
    bf16_t* z; bf16_t* xbc; float* dtb; const float* dt_bias;
    DEV void operator()(const f32x4 (&acc)[2][2][4][2], const mg::Unit& u, int wr, int wc, int fr, int fq) const {
        if (u.pn < OFF_DT / 256) {
            EPI_ROWS_BEGIN const int row = u.pm * 256 + rt;
#pragma unroll
                for (int bj = 0; bj < 2; ++bj) { const int col = u.pn * 256 + bj * 128 + wc * 32 + 8 * fq; const f32x4 v0 = acc[ai][bj][m][0], v1 = acc[ai][bj][m][1];
                    u32x4 w; w.x = mg::cvt_pk_bf16(v0[0], v0[1]); w.y = mg::cvt_pk_bf16(v0[2], v0[3]); w.z = mg::cvt_pk_bf16(v1[0], v1[1]); w.w = mg::cvt_pk_bf16(v1[2], v1[3]);
                    bf16_t* dst = col < OFF_XBC ? z + (size_t)row * SSD_DI + col : xbc + (size_t)row * SSD_CONVCH + (col - OFF_XBC); *(u32x4*)dst = w; }
            EPI_ROWS_END
        } else if (wc < 2) {
            const int hcol = wc * 32 + 8 * fq; float bb[8];
#pragma unroll
            for (int j = 0; j < 8; ++j) bb[j] = dt_bias[hcol + j];
            EPI_ROWS_BEGIN const int row = u.pm * 256 + rt; float o[8];
#pragma unroll
                for (int j = 0; j < 4; ++j) { o[j] = acc[ai][0][m][0][j] + bb[j]; o[4 + j] = acc[ai][0][m][1][j] + bb[4 + j]; }
#pragma unroll
                for (int j = 0; j < 8; ++j) { const float x = o[j], uu = __expf(-fabsf(x)); const float lg = uu < 0.01f ? uu * (1.f - uu * (0.5f - uu * 0.33333333f)) : __logf(1.f + uu); o[j] = fmaxf(x, 0.f) + lg; }
                *(f32x4*)(dtb + (size_t)row * 64 + hcol) = (f32x4){o[0], o[1], o[2], o[3]}; *(f32x4*)(dtb + (size_t)row * 64 + hcol + 4) = (f32x4){o[4], o[5], o[6], o[7]};
            EPI_ROWS_END
        }
    }
};
struct EpiNsaIn {
    static constexpr bool PERM = true, ACC_INIT = false;
    bf16_t *q, *ks, *vs, *kw, *vw, *acmp; float* gate; const float* rope; const float* pe;
    DEV static void st4(bf16_t* dst, const float* o) { u32x2 w; w.x = mg::cvt_pk_bf16(o[0], o[1]); w.y = mg::cvt_pk_bf16(o[2], o[3]); *(u32x2*)dst = w; }
    DEV bf16_t* cmp_row(int kv, int b, int t, int g) const { return acmp + ((size_t)(kv * 16 + b * 4 + g) * SEQ + t) * 128; }
    DEV void operator()(const f32x4 (&acc)[2][2][4][2], const mg::Unit& u, int wr, int wc, int fr, int fq) const {
        const int pn = u.pn; const bool is_rope = pn < 10 || pn == 12 || pn == 13 || pn == 16 || pn == 17;
#pragma unroll
        for (int ai = 0; ai < 2; ++ai) {
        f32x4 csv[4][2];
        if (is_rope) {
#pragma unroll
            for (int m = 0; m < 4; ++m) { const int t = (u.pm * 256 + ai * 128 + wr * 64 + m * 16 + fr) & (SEQ - 1); const float* rp = rope + (size_t)(t * 64 + 16 * wc + 4 * fq) * 2;
                csv[m][0] = *(const f32x4*)rp; csv[m][1] = *(const f32x4*)(rp + 4); } }
#pragma unroll
        for (int m = 0; m < 4; ++m) { const int rt = ai * 128 + wr * 64 + m * 16 + fr;
        const int row = u.pm * 256 + rt, t = row & (SEQ - 1), b = row >> 11;
#pragma unroll
            for (int bj = 0; bj < 2; ++bj) { const f32x4 v0 = acc[ai][bj][m][0], v1 = acc[ai][bj][m][1];
                if (is_rope) { const int d = 16 * wc + 4 * fq;
                    const f32x4 cs0 = csv[m][0], cs1 = csv[m][1];
                    const float c[4] = {cs0[0], cs0[2], cs1[0], cs1[2]}, sn[4] = {cs0[1], cs0[3], cs1[1], cs1[3]}; float o1[4], o2[4];
#pragma unroll
                    for (int j = 0; j < 4; ++j) { o1[j] = v0[j] * c[j] - v1[j] * sn[j]; o2[j] = v1[j] * c[j] + v0[j] * sn[j]; }
                    if (pn < 8) { bf16_t* dst = q + (size_t)row * 2048 + (2 * pn + bj) * 128 + d; st4(dst, o1); st4(dst + 64, o2); }
                    else if (pn < 10) { bf16_t* dst = cmp_row(0, b, t, 2 * (pn - 8) + bj) + d; st4(dst, o1); st4(dst + 64, o2); }
                    else { bf16_t* dst = (pn < 14 ? ks + (size_t)row * 512 + (2 * (pn - 12) + bj) * 128 : kw + (size_t)row * 512 + (2 * (pn - 16) + bj) * 128) + d; st4(dst, o1); st4(dst + 64, o2); }
                } else { const int c0 = 32 * wc + 8 * fq; const float o1[4] = {v0[0], v0[1], v0[2], v0[3]}, o2[4] = {v1[0], v1[1], v1[2], v1[3]};
                    if (pn < 12) { bf16_t* dst = cmp_row(1, b, t, 2 * (pn - 10) + bj) + c0; st4(dst, o1); st4(dst + 4, o2); }
                    else if (pn < 20) { bf16_t* dst = (pn < 16 ? vs + (size_t)row * 512 + (2 * (pn - 14) + bj) * 128 : vw + (size_t)row * 512 + (2 * (pn - 18) + bj) * 128) + c0; st4(dst, o1); st4(dst + 4, o2); }
                    else { const int col = bj * 128 + c0; if (col < 48) { float* gd = gate + (size_t)row * 48 + col;
#pragma unroll
                            for (int j = 0; j < 4; ++j) { gd[j] = 1.f / (1.f + __expf(-o1[j])); gd[4 + j] = 1.f / (1.f + __expf(-o2[j])); } } }
                } }
        } }
    }
};
struct EpiCmp1 {
    static constexpr bool PERM = true, ACC_INIT = false;
    bf16_t* h1; const float* cb;
    DEV void operator()(const f32x4 (&acc)[2][2][4][2], const mg::Unit& u, int wr, int wc, int fr, int fq) const {
        EPI_ROWS_BEGIN bf16_t* rowp = h1 + ((size_t)u.g * 2048 + u.pm * 256 + rt) * 256;
#pragma unroll
            for (int bj = 0; bj < 2; ++bj) { const int col = bj * 128 + wc * 32 + 8 * fq; float o[8];
#pragma unroll
                for (int j = 0; j < 4; ++j) { o[j] = acc[ai][bj][m][0][j] + cb[u.g * 256 + col + j]; o[4 + j] = acc[ai][bj][m][1][j] + cb[u.g * 256 + col + 4 + j]; }
#pragma unroll
                for (int j = 0; j < 8; ++j) { const float v = o[j], uu = 1.5957691216057308f * (v + 0.044715f * v * v * v); o[j] = v / (1.f + __expf(-uu)); }
                u32x4 w; w.x = mg::cvt_pk_bf16(o[0], o[1]); w.y = mg::cvt_pk_bf16(o[2], o[3]); w.z = mg::cvt_pk_bf16(o[4], o[5]); w.w = mg::cvt_pk_bf16(o[6], o[7]); *(u32x4*)(rowp + col) = w; }
        EPI_ROWS_END
    }
};
struct EpiCmp2 {
    static constexpr bool PERM = true, ACC_INIT = false;
    bf16_t* kvc;
    DEV void operator()(const f32x4 (&acc)[2][2][4][2], const mg::Unit& u, int wr, int wc, int fr, int fq) const {
        EPI_ROWS_BEGIN const int mrow = u.pm * 256 + rt; bf16_t* rowp = kvc + ((size_t)u.g * 2048 + mrow) * 128; const bool pad = (mrow & 127) == 127;
            { const int col = wc * 32 + 8 * fq; const f32x4 v0 = acc[ai][0][m][0], v1 = acc[ai][0][m][1];
              u32x4 w; w.x = mg::cvt_pk_bf16(v0[0], v0[1]); w.y = mg::cvt_pk_bf16(v0[2], v0[3]); w.z = mg::cvt_pk_bf16(v1[0], v1[1]); w.w = mg::cvt_pk_bf16(v1[2], v1[3]);
              if (pad) w = (u32x4){0u, 0u, 0u, 0u}; *(u32x4*)(rowp + col) = w; }
        EPI_ROWS_END
    }
};
DEV void cmp_gemm2_rows(const bf16_t* h1, const bf16_t* w2t  , bf16_t* kvc, int rowbase  ) {
    typedef float f32x16 __attribute__((ext_vector_type(16)));
    const int tid = tidx(), wid = tid >> 6, lane = tid & 63, r32 = lane & 31, hi = lane >> 5;
    const bf16_t* ap = h1 + (size_t)(rowbase + 32 * wid + r32) * 256 + hi * 8;
    const bf16_t* bp = w2t + (size_t)r32 * 256 + hi * 8;
    f32x16 acc[4] = {};
#pragma unroll 4
    for (int ks = 0; ks < 16; ++ks) { const bf16x8 a = *(const bf16x8*)(ap + ks * 16);
#pragma unroll
        for (int nbk = 0; nbk < 4; ++nbk) { const bf16x8 b = *(const bf16x8*)(bp + (size_t)nbk * 32 * 256 + ks * 16); acc[nbk] = __builtin_amdgcn_mfma_f32_32x32x16_bf16(a, b, acc[nbk], 0, 0, 0); } }
#pragma unroll
    for (int r = 0; r < 16; ++r) { const int row = rowbase + 32 * wid + (r & 3) + 8 * (r >> 2) + 4 * hi; const bool pad = (row & 127) == 127;
#pragma unroll
        for (int nbk = 0; nbk < 4; ++nbk) { const float v = pad ? 0.f : acc[nbk][r]; const float vn = swap_pair(v);
            if ((r32 & 1) == 0) *(unsigned*)(kvc + (size_t)row * 128 + nbk * 32 + r32) = mg::cvt_pk_bf16(v, vn); } }
}

struct AMoeGather { static constexpr bool GATHER = true; const bf16_t* A; const int* list; const int* cnt;
    DEV const char* ubase(const mg::Unit&) const { return (const char*)A; }
    DEV unsigned rowoff(const mg::Unit& u, int r) const { int idx = u.pm * 256 + r; const int c = cnt[u.g]; idx = idx < c ? idx : c - 1; return (unsigned)(list[u.g * T + idx] >> 1) * (unsigned)D_MODEL; } };
struct AMoeAct { static constexpr bool GATHER = false; const bf16_t* A; const int* tab;
    DEV const char* ubase(const mg::Unit& u) const { return (const char*)A + (size_t)(__builtin_amdgcn_readfirstlane(tab[64 + u.g]) + u.pm * 256) * MOE_FF; }
    DEV unsigned rowoff(const mg::Unit&, int r) const { return (unsigned)r * (unsigned)MOE_FF; } };
struct EpiMoeGU {
    static constexpr bool PERM = true, ACC_INIT = false;
    bf16_t* act; const int* cnt; const int* tab;
    DEV void operator()(const f32x4 (&acc)[2][2][4][2], const mg::Unit& u, int wr, int wc, int fr, int fq) const {
        const int c = cnt[u.g], rb = tab[64 + u.g];
        EPI_ROWS_BEGIN const int lr = u.pm * 256 + rt;
            if (lr < c) {
#pragma unroll
                for (int bj = 0; bj < 2; ++bj) { const int f = u.pn * 128 + bj * 64 + wc * 16 + 4 * fq; const f32x4 g = acc[ai][bj][m][0], up = acc[ai][bj][m][1]; float o[4];
#pragma unroll
                    for (int j = 0; j < 4; ++j) { const float gj = g[j] * (1.f / (F8_SX * F8_SW)); o[j] = gj / (1.f + __expf(-gj)) * (up[j] * (F8_SACT / (F8_SX * F8_SW))); }
                    *(unsigned*)((char*)act + (size_t)(rb + lr) * MOE_FF + f) = pk8(o[0], o[1], o[2], o[3]); } }
        EPI_ROWS_END
    }
};
struct EpiMoeDown {
    static constexpr bool PERM = true, ACC_INIT = false;
    bf16_t* ys; const int* list; const int* cnt; const float* lw;
    DEV void operator()(const f32x4 (&acc)[2][2][4][2], const mg::Unit& u, int wr, int wc, int fr, int fq) const {
        const int c = cnt[u.g];
        int idxv[2][4]; float wv[2][4];
#pragma unroll
        for (int ai = 0; ai < 2; ++ai)
#pragma unroll
            for (int m = 0; m < 4; ++m) { const int lr = u.pm * 256 + ai * 128 + wr * 64 + m * 16 + fr; const bool ok = lr < c;
                idxv[ai][m] = ok ? list[u.g * T + lr] : -1; wv[ai][m] = ok ? lw[u.g * T + lr] * (1.f / (F8_SACT * F8_SW)) : 0.f; }
#pragma unroll
        for (int ai = 0; ai < 2; ++ai)
#pragma unroll
            for (int m = 0; m < 4; ++m)
                if (idxv[ai][m] >= 0) { const float w = wv[ai][m]; bf16_t* rowp = ys + (size_t)idxv[ai][m] * D_MODEL;
#pragma unroll
                    for (int bj = 0; bj < 2; ++bj) { const int col = u.pn * 256 + bj * 128 + wc * 32 + 8 * fq; const f32x4 v0 = acc[ai][bj][m][0] * w, v1 = acc[ai][bj][m][1] * w;
                        u32x4 pk; pk.x = mg::cvt_pk_bf16(v0[0], v0[1]); pk.y = mg::cvt_pk_bf16(v0[2], v0[3]); pk.z = mg::cvt_pk_bf16(v1[0], v1[1]); pk.w = mg::cvt_pk_bf16(v1[2], v1[3]);
                        *(u32x4*)(rowp + col) = pk; } }
    }
};

template <bool F8 = false, class SF>
DEV void conv_wt(SF sf, int ngroups, int K, int Nphys, bf16_t* dst, float*  , int bid, int nb, int t0 = 0, int t1 = 0x7fffffff) {
    const int tid = tidx(), wid = tid >> 6, lane = tid & 63, kb = lane & 7, c4 = lane >> 3;
    const int ktn = K / 64, ntn = Nphys / 256, per = ktn * ntn, total = ngroups * per < t1 ? ngroups * per : t1;
    constexpr int NF = 4;
    (void)per; (void)total;
    const int ktq = ktn / 2, ntq = (ntn + 1) / 2, perq = ktq * ntq, totq = ngroups * perq;
    const int q0 = t0 / NF, q1 = (t1 == 0x7fffffff || t1 / NF > totq) ? totq : t1 / NF;
    for (int item = q0 + bid; item < q1; item += nb) {
        const int g = item / perq, rem = item - g * perq, kq = rem / ntq, nq = rem - kq * ntq;
        const int k0 = kq * 128 + kb * 16;
        f32x4 v[2][2][8];
#pragma unroll
        for (int un = 0; un < 2; ++un) { const int nt = nq * 2 + un; const int q = nt * 64 + wid * 8 + c4;
#pragma unroll
            for (int uk = 0; uk < 2; ++uk)
#pragma unroll
                for (int j = 0; j < 8; ++j) { const float* sp = nt < ntn ? sf(g, k0 + uk * 8 + j, q) : (const float*)nullptr; v[un][uk][j] = (f32x4){0.f, 0.f, 0.f, 0.f}; if (sp) v[un][uk][j] = __builtin_nontemporal_load((const f32x4*)sp); } }
#pragma unroll
        for (int un = 0; un < 2; ++un) { const int nt = nq * 2 + un; const int q = nt * 64 + wid * 8 + c4;
            if (nt < ntn) {
#pragma unroll
            for (int e = 0; e < 4; ++e) {
                if constexpr (F8) { u32x4 w;
                    w.x = pk8(v[un][0][0][e] * F8_SW, v[un][0][1][e] * F8_SW, v[un][0][2][e] * F8_SW, v[un][0][3][e] * F8_SW); w.y = pk8(v[un][0][4][e] * F8_SW, v[un][0][5][e] * F8_SW, v[un][0][6][e] * F8_SW, v[un][0][7][e] * F8_SW);
                    w.z = pk8(v[un][1][0][e] * F8_SW, v[un][1][1][e] * F8_SW, v[un][1][2][e] * F8_SW, v[un][1][3][e] * F8_SW); w.w = pk8(v[un][1][4][e] * F8_SW, v[un][1][5][e] * F8_SW, v[un][1][6][e] * F8_SW, v[un][1][7][e] * F8_SW);
                    __builtin_nontemporal_store(w, (u32x4*)((char*)dst + ((size_t)g * Nphys + 4 * q + e) * K + k0)); }
                else {
#pragma unroll
                    for (int uk = 0; uk < 2; ++uk) { u32x4 w; w.x = mg::cvt_pk_bf16(v[un][uk][0][e], v[un][uk][1][e]); w.y = mg::cvt_pk_bf16(v[un][uk][2][e], v[un][uk][3][e]); w.z = mg::cvt_pk_bf16(v[un][uk][4][e], v[un][uk][5][e]); w.w = mg::cvt_pk_bf16(v[un][uk][6][e], v[un][uk][7][e]);
                        __builtin_nontemporal_store(w, (u32x4*)(dst + ((size_t)g * Nphys + 4 * q + e) * K + k0 + uk * 8)); } } } } }
    }
}

template <bool F8 = false, bool X16 = false  >
DEV void rows_norm(const float* src, const bf16_t* add0, const bf16_t* add1, float* sumdst, const float* g, bf16_t* dst, int bid, int nb) {
    const int lane = tidx() & 63, wid = tidx() >> 6;
    for (int row = bid * 8 + wid; row < T; row += nb * 8) {
        float4 v[8]; float ss = 0.f;
#pragma unroll
        for (int i = 0; i < 8; ++i) {
            const size_t o = (size_t)row * D_MODEL + i * 256 + lane * 4;
            float4 a; if constexpr (X16) { const ushort4 s4 = *(const ushort4*)((const bf16_t*)src + o); a = make_float4(bf2f(s4.x), bf2f(s4.y), bf2f(s4.z), bf2f(s4.w)); } else a = *(const float4*)(src + o);
            if (add0) { const size_t o2 = (size_t)row * 2 * D_MODEL + i * 256 + lane * 4; const ushort4 b = *(const ushort4*)(add0 + o2), c = *(const ushort4*)(add1 + o2);
                a.x += bf2f(b.x) + bf2f(c.x); a.y += bf2f(b.y) + bf2f(c.y); a.z += bf2f(b.z) + bf2f(c.z); a.w += bf2f(b.w) + bf2f(c.w); }
            if (sumdst) { if constexpr (X16) { ushort4 q4; q4.x = f2bf(a.x); q4.y = f2bf(a.y); q4.z = f2bf(a.z); q4.w = f2bf(a.w); *(ushort4*)((bf16_t*)sumdst + o) = q4; } else *(float4*)(sumdst + o) = a; }
            v[i] = a; ss += a.x * a.x + a.y * a.y + a.z * a.z + a.w * a.w;
        }
        ss = wave_sum(ss);
        const float rinv = rsqrtf(ss * (1.f / D_MODEL) + NORM_EPS);
#pragma unroll
        for (int i = 0; i < 8; ++i) {
            const int c = i * 256 + lane * 4; const float4 gg = *(const float4*)(g + c);
            if constexpr (F8) { const float rs = rinv * F8_SX; *(unsigned*)((char*)dst + (size_t)row * D_MODEL + c) = pk8(v[i].x * rs * gg.x, v[i].y * rs * gg.y, v[i].z * rs * gg.z, v[i].w * rs * gg.w); }
            else { ushort4 o; o.x = f2bf(v[i].x * rinv * gg.x); o.y = f2bf(v[i].y * rinv * gg.y); o.z = f2bf(v[i].z * rinv * gg.z); o.w = f2bf(v[i].w * rinv * gg.w);
                *(ushort4*)(dst + (size_t)row * D_MODEL + c) = o; }
        }
    }
}

DEV void ph_rope_table(const P& p, int bid, int nb) {
    for (int i = bid * NTHREADS + tidx(); i < SEQ * 64; i += nb * NTHREADS) {
        const int pos = i >> 6, j = i & 63;
        const double inv = exp(-log(10000.0) * (double)j / 64.0);
        const float invf = (float)inv;
        const float ang = (float)pos * invf;
        p.rope[i * 2] = (float)cos((double)ang); p.rope[i * 2 + 1] = (float)sin((double)ang);
    }
}

DEV void ph_cmp_attn(const P& p, float* lds, int bid, int nb) {
    const int lane = tidx() & 63, wid = tidx() >> 6;
    float* qs = lds + wid * 640; float* ps = qs + 512;
    float* ocmp = (float*)(p.big + BIG_NSA_OCMP);
    const bf16_t* Q = (const bf16_t*)(p.big + BIG_NSA_Q);
    const float scale = 0.08838834764831845f;
    const bf16_t* kc = (const bf16_t*)(p.big + BIG_NSA_KVC); const bf16_t* vc = kc + (size_t)2048 * 128;
    for (int u = bid * 8 + wid; u < T * NKV; u += nb * 8) {
        const int g = u & 3, tok = u >> 2, b = tok / SEQ, t = tok % SEQ;
        const int ncv = t >= 31 ? (t - 31) / 16 + 1 : 0;
        const bf16_t* qrow = Q + (size_t)tok * 2048 + g * 4 * 128;
#pragma unroll
        for (int i = 0; i < 8; ++i) qs[lane + 64 * i] = bf2f(qrow[lane + 64 * i]);
        float psum0 = 0.f, psum1 = 0.f;
        for (int r = 0; r < 4; ++r) {
            float s0 = -INFINITY, s1 = -INFINITY;
            if (lane < ncv) { const bf16_t* kr = kc + ((size_t)((b * 4 + g) * 128 + lane)) * 128; float a = 0.f; for (int d = 0; d < 128; ++d) a = fmaf(qs[r * 128 + d], bf2f(kr[d]), a); s0 = a * scale; }
            if (lane + 64 < ncv) { const bf16_t* kr = kc + ((size_t)((b * 4 + g) * 128 + lane + 64)) * 128; float a = 0.f; for (int d = 0; d < 128; ++d) a = fmaf(qs[r * 128 + d], bf2f(kr[d]), a); s1 = a * scale; }
            float p0 = 0.f, p1 = 0.f;
            if (ncv > 0) {
                const float m = wave_max(fmaxf(s0, s1));
                const float e0 = lane < ncv ? expf(s0 - m) : 0.f, e1 = lane + 64 < ncv ? expf(s1 - m) : 0.f;
                const float sum = wave_sum(e0 + e1);
                p0 = e0 / sum; p1 = e1 / sum;
            }
            psum0 += p0; psum1 += p1;
            float o0 = 0.f, o1 = 0.f;
            for (int c = 0; c < ncv; ++c) {
                const float pc = c < 64 ? __shfl(p0, c) : __shfl(p1, c - 64);
                const bf16_t* vr = vc + ((size_t)((b * 4 + g) * 128 + c)) * 128;
                o0 = fmaf(pc, bf2f(vr[lane]), o0); o1 = fmaf(pc, bf2f(vr[lane + 64]), o1);
            }
            float* orow = ocmp + (size_t)tok * 2048 + (g * 4 + r) * 128;
            orow[lane] = o0; orow[lane + 64] = o1;
        }
        ps[lane] = psum0; ps[lane + 64] = psum1;
        float val = -INFINITY;
        const int j = lane;
        if (j < 32) {
            float imp = ps[4 * j] + ps[4 * j + 1] + ps[4 * j + 2] + 0.5f * ps[4 * j + 3] + (j > 0 ? 0.5f * ps[4 * j - 1] : 0.f);
            const int dist = (t >> 6) - j;
            const bool forced = (j == 0) || (dist >= 0 && dist < 2);
            val = forced ? 1e4f : imp;
            if (dist < 0) val = -INFINITY;
        }
        int rank = 0;
        for (int i = 0; i < 32; ++i) { const float vi = __shfl(val, i); rank += (vi > val || (vi == val && i < j)) ? 1 : 0; }
        const unsigned long long bal = __ballot(j < 32 && rank < 16);
        if (lane == 0) p.selmask[(size_t)(b * NKV + g) * SEQ + t] = (unsigned)bal;
    }
}

DEV void attend_wave(const bf16_t* Kb, const bf16_t* Vb, const float* qs, int b, int g, unsigned bmask, int lo, int hi, int lane, float& o0, float& o1) {
    const float scale = 0.08838834764831845f;
    float m = -INFINITY, l = 0.f; o0 = 0.f; o1 = 0.f;
    for (int j = lo >> 6; j <= (hi >> 6); ++j) {
        if (!((bmask >> j) & 1u)) continue;
        const int key = j * 64 + lane; const bool valid = key >= lo && key <= hi;
        float s = -INFINITY;
        if (valid) { const bf16_t* kr = Kb + (size_t)(b * SEQ + key) * 512 + g * 128; float a = 0.f;
            for (int d = 0; d < 128; d += 4) { const ushort4 kv = *(const ushort4*)(kr + d); a = fmaf(qs[d], bf2f(kv.x), a); a = fmaf(qs[d + 1], bf2f(kv.y), a); a = fmaf(qs[d + 2], bf2f(kv.z), a); a = fmaf(qs[d + 3], bf2f(kv.w), a); }
            s = a * scale; }
        const float bm = wave_max(s);
        if (bm == -INFINITY) continue;
        const float mn = fmaxf(m, bm), alpha = expf(m - mn);
        const float pr = valid ? expf(s - mn) : 0.f;
        l = l * alpha + wave_sum(pr); o0 *= alpha; o1 *= alpha; m = mn;
        for (int kk = 0; kk < 64; ++kk) {
            const float pk = __shfl(pr, kk);
            if (pk != 0.f) { const bf16_t* vr = Vb + (size_t)(b * SEQ + j * 64 + kk) * 512 + g * 128; o0 = fmaf(pk, bf2f(vr[lane]), o0); o1 = fmaf(pk, bf2f(vr[lane + 64]), o1); }
        }
    }
    const float inv = 1.f / l; o0 *= inv; o1 *= inv;
}

DEV void ph_attn_sw(const P& p, float* lds, int bid, int nb) {
    const int lane = tidx() & 63, wid = tidx() >> 6;
    float* qs = lds + wid * 128;
    const float* ocmp = (const float*)(p.big + BIG_NSA_OCMP); bf16_t* obuf = (bf16_t*)(p.big + BIG_NSA_OBUF);
    const bf16_t* Q = (const bf16_t*)(p.big + BIG_NSA_Q); const float* gate = (const float*)(p.big + BIG_NSA_GATE);
    const bf16_t* KS = (const bf16_t*)(p.big + BIG_NSA_KS); const bf16_t* VS = (const bf16_t*)(p.big + BIG_NSA_VS);
    const bf16_t* KW = (const bf16_t*)(p.big + BIG_NSA_KW); const bf16_t* VW = (const bf16_t*)(p.big + BIG_NSA_VW);
    for (int u = bid * 8 + wid; u < T * NH; u += nb * 8) {
        const int h = u & 15, tok = u >> 4, b = tok / SEQ, t = tok % SEQ, g = h >> 2;
        const bf16_t* qrow = Q + (size_t)tok * 2048 + h * 128;
        qs[lane] = bf2f(qrow[lane]); qs[lane + 64] = bf2f(qrow[lane + 64]);
        const unsigned sm = p.selmask[(size_t)(b * NKV + g) * SEQ + t];
        float s0, s1, w0, w1;
        attend_wave(KS, VS, qs, b, g, sm, 0, t, lane, s0, s1);
        attend_wave(KW, VW, qs, b, g, 0xffffffffu, t - (WINDOW - 1) > 0 ? t - (WINDOW - 1) : 0, t, lane, w0, w1);
        const float* gl = gate + (size_t)tok * 48 + h * 3;
        const float g0 = gl[0], g1 = gl[1], g2 = gl[2];
        const float* oc = ocmp + (size_t)tok * 2048 + h * 128;
        bf16_t* ob = obuf + (size_t)tok * 2048 + h * 128;
        ob[lane] = f2bf(g0 * oc[lane] + g1 * s0 + g2 * w0);
        ob[lane + 64] = f2bf(g0 * oc[lane + 64] + g1 * s1 + g2 * w1);
    }
}

namespace at {
typedef float f32x16 __attribute__((ext_vector_type(16)));
typedef short s16x4 __attribute__((ext_vector_type(4)));
constexpr int SHM = 16384;
constexpr float SCALE = 0.08838834764831845f, C2 = 1.4426950408889634f * SCALE, THR = 8.f;
#define AT_KSWZ(row, colB) ((row) * 256 + ((colB) ^ (((row) & 7) << 4)))
DEV int v_st(int k, int c) { const int kk = (k & ~0xC) | ((k & 4) << 1) | ((k & 8) >> 1); return ((kk >> 3) * 4 + (c >> 5)) * 512 + ((kk & 7) * 32 + (c & 31)) * 2; }
DEV int v_rd_base(int lane) { return ((lane & 3) << 3) | (((lane >> 2) & 3) << 6) | (((lane >> 4) & 1) << 5) | (((lane >> 5) & 1) << 8); }
DEV int crow(int r, int hi) { return (r & 3) + 8 * (r >> 2) + 4 * hi; }
DEV unsigned cvtpk(float lo, float hi) { unsigned r; asm volatile("v_cvt_pk_bf16_f32 %0, %1, %2" : "=v"(r) : "v"(lo), "v"(hi)); return r; }
DEV float swap_max(float x) { auto rr = __builtin_amdgcn_permlane32_swap(__float_as_uint(x), __float_as_uint(x), false, false); return fmaxf(__uint_as_float(rr[0]), __uint_as_float(rr[1])); }
DEV float swap_sum(float x) { auto rr = __builtin_amdgcn_permlane32_swap(__float_as_uint(x), __float_as_uint(x), false, false); return __uint_as_float(rr[0]) + __uint_as_float(rr[1]); }
#define AT_PK4(P, B_, OUT) do { unsigned a0 = cvtpk(P[B_+0], P[B_+1]), a1 = cvtpk(P[B_+2], P[B_+3]); unsigned b0 = cvtpk(P[B_+4], P[B_+5]), b1 = cvtpk(P[B_+6], P[B_+7]); \
        auto r0 = __builtin_amdgcn_permlane32_swap(a0, b0, false, false); auto r1 = __builtin_amdgcn_permlane32_swap(a1, b1, false, false); \
        u32x4 w = {r0[0], r1[0], r0[1], r1[1]}; OUT = *reinterpret_cast<bf16x8*>(&w); } while (0)
DEV void qkt(f32x16& p0, f32x16& p1, const char* Kl, int r32, int hi, const bf16x8* qr) {
    p0 = f32x16{}; p1 = f32x16{};
    const char* kb[4];
#pragma unroll
    for (int dd = 0; dd < 4; ++dd) kb[dd] = Kl + AT_KSWZ(r32, (dd * 16 + hi * 8) * 2);
#pragma unroll
    for (int d0 = 0; d0 < 8; ++d0) { const char* a = kb[d0 & 3] + (d0 >> 2) * 128;
        const bf16x8 b0 = *reinterpret_cast<const bf16x8*>(a), b1 = *reinterpret_cast<const bf16x8*>(a + 32 * 256);
        p0 = __builtin_amdgcn_mfma_f32_32x32x16_bf16(b0, qr[d0], p0, 0, 0, 0);
        p1 = __builtin_amdgcn_mfma_f32_32x32x16_bf16(b1, qr[d0], p1, 0, 0, 0); }
}
DEV void pv_tile(f32x16* o, int vb0, bf16x8 pa0, bf16x8 pa1, bf16x8 pa2, bf16x8 pa3) {
#define AT_TRRD(dst, off) asm volatile("ds_read_b64_tr_b16 %0, %1 offset:%2" : "=&v"(dst) : "v"(vb0), "i"(off) : "memory")
#define AT_RD8(S, d0) do { constexpr int b_ = (d0) * 512; AT_TRRD(S##l0, b_); AT_TRRD(S##h0, b_ + 2048); AT_TRRD(S##l1, b_ + 4096); AT_TRRD(S##h1, b_ + 6144); \
        AT_TRRD(S##l2, b_ + 8192); AT_TRRD(S##h2, b_ + 10240); AT_TRRD(S##l3, b_ + 12288); AT_TRRD(S##h3, b_ + 14336); } while (0)
#define AT_MM4(S, d0) do { \
        o[d0] = __builtin_amdgcn_mfma_f32_32x32x16_bf16(pa0, (bf16x8){S##l0[0], S##l0[1], S##l0[2], S##l0[3], S##h0[0], S##h0[1], S##h0[2], S##h0[3]}, o[d0], 0, 0, 0); \
        o[d0] = __builtin_amdgcn_mfma_f32_32x32x16_bf16(pa1, (bf16x8){S##l1[0], S##l1[1], S##l1[2], S##l1[3], S##h1[0], S##h1[1], S##h1[2], S##h1[3]}, o[d0], 0, 0, 0); \
        o[d0] = __builtin_amdgcn_mfma_f32_32x32x16_bf16(pa2, (bf16x8){S##l2[0], S##l2[1], S##l2[2], S##l2[3], S##h2[0], S##h2[1], S##h2[2], S##h2[3]}, o[d0], 0, 0, 0); \
        o[d0] = __builtin_amdgcn_mfma_f32_32x32x16_bf16(pa3, (bf16x8){S##l3[0], S##l3[1], S##l3[2], S##l3[3], S##h3[0], S##h3[1], S##h3[2], S##h3[3]}, o[d0], 0, 0, 0); } while (0)
#define AT_WAIT(n) do { asm volatile("s_waitcnt lgkmcnt(" #n ")" ::: "memory"); __builtin_amdgcn_sched_barrier(0); } while (0)
    s16x4 xl0, xl1, xl2, xl3, xh0, xh1, xh2, xh3, yl0, yl1, yl2, yl3, yh0, yh1, yh2, yh3;
    AT_RD8(x, 0); AT_RD8(y, 1);
    AT_WAIT(8); AT_MM4(x, 0);
    __builtin_amdgcn_sched_barrier(0); AT_RD8(x, 2);
    AT_WAIT(8); AT_MM4(y, 1);
    __builtin_amdgcn_sched_barrier(0); AT_RD8(y, 3);
    AT_WAIT(8); AT_MM4(x, 2);
    AT_WAIT(0); AT_MM4(y, 3);
#undef AT_WAIT
#undef AT_MM4
#undef AT_RD8
#undef AT_TRRD
}
DEV void mask_tile(f32x16& p0, f32x16& p1, int lo, int hi_, int hi) {
    const float NEG = -__builtin_inff(); const unsigned w = (unsigned)(hi_ - lo); const int base = 4 * hi - lo;
#pragma unroll
    for (int r = 0; r < 16; ++r) { const int cr = (r & 3) + 8 * (r >> 2);
        if ((unsigned)(cr + base) > w) p0[r] = NEG;
        if ((unsigned)(cr + 32 + base) > w) p1[r] = NEG; }
}
struct Ctx { char* L; int tid, wid, lane, r32, hi; unsigned ksrc[2], vsrc[2]; float* li_l; float* al_l; };
#define AT_STAGE(Kp, Vp, pitch, kb, vb) do { _Pragma("unroll") for (int _i = 0; _i < 2; ++_i) { unsigned ks_ = c.ksrc[_i], vs_ = c.vsrc[_i]; asm volatile("" : "+v"(ks_), "+v"(vs_));     \
        __builtin_amdgcn_global_load_lds((const unsigned*)((Kp) + (size_t)(ks_ >> 16) * (pitch) + (ks_ & 0xffffu)), (MG_LAS unsigned*)((MG_LAS char*)(c.L) + (kb) * SHM + c.wid * 1024 + _i * 8192), 16, 0, 0); \
        __builtin_amdgcn_global_load_lds((const unsigned*)((Vp) + (size_t)(vs_ >> 16) * (pitch) + (vs_ & 0xffffu)), (MG_LAS unsigned*)((MG_LAS char*)(c.L) + 2 * SHM + (vb) * SHM + c.wid * 1024 + _i * 8192), 16, 0, 0); } } while (0)
#define AT_RESC(a) do { if (__any((a) < 1.f)) { if (c.hi == 0) c.al_l[c.r32] = (a); asm volatile("s_waitcnt lgkmcnt(0)" ::: "memory"); \
        _Pragma("unroll") for (int d_ = 0; d_ < 4; ++d_) _Pragma("unroll") for (int r = 0; r < 16; ++r) o[d_][r] *= c.al_l[crow(r, c.hi)]; } } while (0)

template <int MODE>
DEV void branch(const Ctx& c, const bf16_t* Kb, const bf16_t* Vb  , unsigned tiles, int i, int tl, unsigned smask, const bf16x8* qr, f32x16* o, float& l_reg) {
    float m_reg = -1e30f; l_reg = 0.f;
#pragma unroll
    for (int d = 0; d < 4; ++d) o[d] = f32x16{};
    unsigned rem = tiles; int j = __builtin_ctz(rem); rem &= rem - 1; int buf = 0;
    AT_STAGE(Kb + (size_t)j * 64 * 512, Vb + (size_t)j * 64 * 512, 512, 0, 0);
    __syncthreads();
    for (;;) {
        const bool more = rem != 0u; int jn = j;
        if (more) { jn = __builtin_ctz(rem); rem &= rem - 1; AT_STAGE(Kb + (size_t)jn * 64 * 512, Vb + (size_t)jn * 64 * 512, 512, buf ^ 1, buf ^ 1); }
        int lo, hi_;
        if (MODE == 1) { const bool sel = (smask >> j) & 1u; lo = sel ? 0 : 100; hi_ = sel ? (j == i ? tl : 63) : 100; }
        else { const int a = tl + 64 * (i - j); hi_ = a < 63 ? a : 63; lo = a - 511 > 0 ? a - 511 : 0; if (lo > 63) { lo = 100; hi_ = 100; } }
        if (__any(lo <= 63)) {
        f32x16 p0, p1;
        qkt(p0, p1, c.L + buf * SHM, c.r32, c.hi, qr);
        if (!__all(lo <= 0 && hi_ >= 63)) {
            if (MODE == 1 && j != i) { const bool keep = lo == 0; const float NEG = -__builtin_inff();
#pragma unroll
                for (int r = 0; r < 16; ++r) { p0[r] = keep ? p0[r] : NEG; p1[r] = keep ? p1[r] : NEG; } }
            else mask_tile(p0, p1, lo, hi_, c.hi);
        }
        float pmax = p0[0];
#pragma unroll
        for (int r = 1; r < 16; ++r) pmax = fmaxf(pmax, p0[r]);
#pragma unroll
        for (int r = 0; r < 16; ++r) pmax = fmaxf(pmax, p1[r]);
        pmax = swap_max(pmax);
        float mn, alpha;
        if (__all((pmax - m_reg) * SCALE <= THR)) { mn = m_reg; alpha = 1.f; }
        else { mn = fmaxf(m_reg, pmax); alpha = __builtin_amdgcn_exp2f((m_reg - mn) * C2); m_reg = mn; }
        const float mnL = -mn * C2; float ps = 0.f;
#pragma unroll
        for (int r = 0; r < 16; ++r) { p0[r] = __builtin_amdgcn_exp2f(fmaf(p0[r], C2, mnL)); p1[r] = __builtin_amdgcn_exp2f(fmaf(p1[r], C2, mnL)); ps += p0[r] + p1[r]; }
        ps = swap_sum(ps);
        l_reg = l_reg * alpha + ps;
        bf16x8 pa0, pa1, pa2, pa3;
        AT_PK4(p0, 0, pa0); AT_PK4(p0, 8, pa1); AT_PK4(p1, 0, pa2); AT_PK4(p1, 8, pa3);
        AT_RESC(alpha);
        pv_tile(o, (int)(uintptr_t)(c.L + 2 * SHM + buf * SHM) + v_rd_base(c.lane), pa0, pa1, pa2, pa3);
        }
        __syncthreads();
        if (!more) break;
        j = jn; buf ^= 1;
    }
}
template <int MODE>
DEV void branch_acc(const Ctx& c, const f32x16* o, float rowscale, char* stash_w  , bf16_t* obuf, size_t orow0) {
    int hi = c.hi, r32 = c.r32, ln = c.lane; asm volatile("" : "+v"(hi), "+v"(r32), "+v"(ln));
    float* li = c.li_l; asm volatile("" : "+v"(li));
    if (hi == 0) li[r32] = rowscale;
    asm volatile("s_waitcnt lgkmcnt(0)" ::: "memory");
    float sc[16];
#pragma unroll
    for (int r = 0; r < 16; ++r) sc[r] = li[(r & 3) + 8 * (r >> 2) + 4 * hi];
    char* sp = stash_w + ln * 16;
#pragma unroll
    for (int jg = 0; jg < 8; ++jg) {
        u32x4 w = {0u, 0u, 0u, 0u};
        if (MODE != 0) w = *(const u32x4*)(sp + jg * 1024);
        const int d0 = jg >> 1;
        float v0[4], v1[4];
#pragma unroll
        for (int k = 0; k < 4; ++k) { const int r = 8 * (jg & 1) + 2 * k;
            float t0 = o[d0][r] * sc[r], t1 = o[d0][r + 1] * sc[r + 1];
            if (MODE != 0) { t0 += __uint_as_float(w[k] << 16); t1 += __uint_as_float(w[k] & 0xffff0000u); }
            if (MODE != 2) w[k] = cvtpk(t0, t1);
            v0[k] = t0; v1[k] = t1; }
        if (MODE == 2) {
            const int kq = r32 & 3; quad_transpose(v0, kq); quad_transpose(v1, kq);
            const int rl = 8 * (jg & 1) + 2 * kq; const size_t ob = orow0 + (size_t)(r32 & ~3) + (size_t)(4 * hi) * 2048 + d0 * 32;
            *(unsigned*)((char*)obuf + ob + (size_t)((rl & 3) + 8 * (rl >> 2)) * 2048) = pk8(v0[0] * F8_SO, v0[1] * F8_SO, v0[2] * F8_SO, v0[3] * F8_SO);
            *(unsigned*)((char*)obuf + ob + (size_t)(((rl + 1) & 3) + 8 * ((rl + 1) >> 2)) * 2048) = pk8(v1[0] * F8_SO, v1[1] * F8_SO, v1[2] * F8_SO, v1[3] * F8_SO); }
        if (MODE != 2) *(u32x4*)(sp + jg * 1024) = w;
    }
}
}

DEV void ph_attn_mfma(const P& p, char* L  , int bid, int nb) {
    using namespace at;
    Ctx c; c.L = L; c.tid = tidx(); c.wid = __builtin_amdgcn_readfirstlane(c.tid >> 6); c.lane = c.tid & 63; c.r32 = c.lane & 31; c.hi = c.lane >> 5;
#pragma unroll
    for (int i = 0; i < 2; ++i) { const int pos = c.tid * 16 + i * 8192;
        { const int row = pos >> 8, ch = ((pos >> 4) & 15) ^ (row & 7); c.ksrc[i] = (unsigned)(row << 16) | (unsigned)(ch * 8); }
        { const int sub = pos >> 9, w = (pos & 511) >> 1, kk = (sub >> 2) * 8 + (w >> 5), k = (kk & ~0xC) | ((kk & 4) << 1) | ((kk & 8) >> 1), col = (sub & 3) * 32 + (w & 31);
          c.vsrc[i] = (unsigned)(k << 16) | (unsigned)col; } }
    float* wsf = (float*)(L + 4 * SHM) + c.wid * 64; c.li_l = wsf; c.al_l = wsf + 32;
    unsigned* selm = (unsigned*)(L + 4 * SHM + 2048);
    unsigned* um = selm + 64;
    char* stash = L + 4 * SHM + 2560;
    float* impbuf = (float*)stash;
    float* impsum = impbuf + 4 * 64 * 33;
    const bf16_t* Q = (const bf16_t*)(p.big + BIG_NSA_Q); const float* gate = (const float*)(p.big + BIG_NSA_GATE);
    const bf16_t* KS = (const bf16_t*)(p.big + BIG_NSA_KS); const bf16_t* VS = (const bf16_t*)(p.big + BIG_NSA_VS);
    const bf16_t* KW = (const bf16_t*)(p.big + BIG_NSA_KW); const bf16_t* VW = (const bf16_t*)(p.big + BIG_NSA_VW);
    const bf16_t* KC = (const bf16_t*)(p.big + BIG_NSA_KVC); const bf16_t* VC = KC + (size_t)2048 * 128;
    bf16_t* obuf = (bf16_t*)(p.big + BIG_NSA_OBUF);
    const int rq = c.wid & 3, th = c.wid >> 2, tl = 32 * th + c.r32;
    for (int pr0 = bid; pr0 < 256; pr0 += nb) {
        const int pr = (nb == 256) ? ((pr0 & 7) * 32 + (pr0 >> 3)) : pr0;
        const int bg = pr >> 4, b = bg >> 2, g = bg & 3, ii = pr & 15;
#pragma unroll 1
        for (int pass = 0; pass < 2; ++pass) {
            const int i = pass == 0 ? 31 - ii : ii;
            const int hq = 4 * g + rq, tok0 = b * SEQ + 64 * i, tq = 64 * i + tl;
            bf16x8 qr[8];
            { int hiq = c.hi, tlq = tl; asm volatile("" : "+v"(hiq), "+v"(tlq));
              const bf16_t* qp = Q + (size_t)(tok0 + tlq) * 2048 + hq * 128 + hiq * 8;
#pragma unroll
              for (int d0 = 0; d0 < 8; ++d0) qr[d0] = *(const bf16x8*)(qp + d0 * 16); }
            f32x16 o[4]; float l_reg;
            const size_t orow0 = (size_t)(tok0 + 32 * th) * 2048 + hq * 128;
            {
                const bf16_t* kc = KC + (size_t)(bg * 128) * 128; const bf16_t* vc = VC + (size_t)(bg * 128) * 128;
                AT_STAGE(kc, vc, 128, 0, 0);
                AT_STAGE(kc + 64 * 128, vc + 64 * 128, 128, 1, 1);
                __syncthreads();
                f32x16 pA0, pA1, pB0, pB1;
                qkt(pA0, pA1, c.L, c.r32, c.hi, qr); qkt(pB0, pB1, c.L + SHM, c.r32, c.hi, qr);
                const int cmax = tq >= 31 ? (tq - 31) >> 4 : -1;
                { int lo = 0, hi_ = cmax < 63 ? cmax : 63; if (cmax < 0) { lo = 100; hi_ = 100; } mask_tile(pA0, pA1, lo, hi_, c.hi); }
                { int lo = 0, hi_ = cmax - 64 < 63 ? cmax - 64 : 63; if (cmax < 64) { lo = 100; hi_ = 100; } mask_tile(pB0, pB1, lo, hi_, c.hi); }
                float pmax = -1e30f;
#pragma unroll
                for (int r = 0; r < 16; ++r) pmax = fmaxf(fmaxf(pmax, fmaxf(pA0[r], pA1[r])), fmaxf(pB0[r], pB1[r]));
                pmax = swap_max(pmax);
                const float mnL = -pmax * C2; float ps = 0.f;
#pragma unroll
                for (int r = 0; r < 16; ++r) { pA0[r] = __builtin_amdgcn_exp2f(fmaf(pA0[r], C2, mnL)); pA1[r] = __builtin_amdgcn_exp2f(fmaf(pA1[r], C2, mnL));
                    pB0[r] = __builtin_amdgcn_exp2f(fmaf(pB0[r], C2, mnL)); pB1[r] = __builtin_amdgcn_exp2f(fmaf(pB1[r], C2, mnL)); ps += (pA0[r] + pA1[r]) + (pB0[r] + pB1[r]); }
                ps = swap_sum(ps); l_reg = ps;
                const float inv_l = l_reg > 0.f ? 1.f / l_reg : 0.f;
                { float prev = 0.f; float* ib = impbuf + (rq * 64 + tl) * 33;
#define AT_IMPG(P, G0) _Pragma("unroll") for (int rg = 0; rg < 4; ++rg) { const float car = 0.5f * P[4 * rg + 3] * inv_l, own = (P[4 * rg] + P[4 * rg + 1] + P[4 * rg + 2]) * inv_l + car; \
                        const float rc = __shfl_xor(car, 32); ib[2 * ((G0) + rg) + c.hi] = own + (c.hi ? rc : prev); prev = rc; }
                  AT_IMPG(pA0, 0) AT_IMPG(pA1, 4) AT_IMPG(pB0, 8) AT_IMPG(pB1, 12)
#undef AT_IMPG
                }
                bf16x8 pa0, pa1, pa2, pa3;
#pragma unroll
                for (int d = 0; d < 4; ++d) o[d] = f32x16{};
                AT_PK4(pA0, 0, pa0); AT_PK4(pA0, 8, pa1); AT_PK4(pA1, 0, pa2); AT_PK4(pA1, 8, pa3);
                pv_tile(o, (int)(uintptr_t)(c.L + 2 * SHM) + v_rd_base(c.lane), pa0, pa1, pa2, pa3);
                AT_PK4(pB0, 0, pa0); AT_PK4(pB0, 8, pa1); AT_PK4(pB1, 0, pa2); AT_PK4(pB1, 8, pa3);
                pv_tile(o, (int)(uintptr_t)(c.L + 3 * SHM) + v_rd_base(c.lane), pa0, pa1, pa2, pa3);
                __syncthreads();
                { const int tk = c.tid >> 3, q4 = c.tid & 7; float val[4];
#pragma unroll
                  for (int e = 0; e < 4; ++e) { const int j = 4 * q4 + e; float v = impbuf[(0 * 64 + tk) * 33 + j] + impbuf[(1 * 64 + tk) * 33 + j] + impbuf[(2 * 64 + tk) * 33 + j] + impbuf[(3 * 64 + tk) * 33 + j];
                      const int dist = i - j; const bool forced = (j == 0) || (dist >= 0 && dist < 2); v = forced ? 1e4f : v; if (dist < 0) v = -__builtin_inff(); val[e] = v; impsum[tk * 32 + j] = v; }
                  __syncthreads();
                  int rank[4] = {0, 0, 0, 0};
                  for (int i2 = 0; i2 < 32; ++i2) { const float x = impsum[tk * 32 + i2];
#pragma unroll
                      for (int e = 0; e < 4; ++e) rank[e] += (x > val[e] || (x == val[e] && i2 < 4 * q4 + e)) ? 1 : 0; }
                  unsigned bits = 0u;
#pragma unroll
                  for (int e = 0; e < 4; ++e) bits |= (rank[e] < 16 ? 1u : 0u) << (4 * q4 + e);
                  bits |= __shfl_xor(bits, 1); bits |= __shfl_xor(bits, 2); bits |= __shfl_xor(bits, 4);
                  if (q4 == 0) selm[tk] = bits;
                  unsigned u = bits; u |= __shfl_xor(u, 8); u |= __shfl_xor(u, 16); u |= __shfl_xor(u, 32);
                  if (c.lane == 0) um[c.wid] = u; }
                __syncthreads();
                branch_acc<0>(c, o, gate[(size_t)(tok0 + tl) * 48 + hq * 3 + 0] * inv_l, stash + c.wid * 8192, obuf, orow0);
            }
            const unsigned smask = selm[tl];
            unsigned umask = um[0] | um[1] | um[2] | um[3] | um[4] | um[5] | um[6] | um[7];
            umask = __builtin_amdgcn_readfirstlane(umask) & ((2u << i) - 1u);
            branch<1>(c, KS + (size_t)b * SEQ * 512 + g * 128, VS + (size_t)b * SEQ * 512 + g * 128, umask, i, tl, smask, qr, o, l_reg);
            branch_acc<1>(c, o, gate[(size_t)(tok0 + tl) * 48 + hq * 3 + 1] / l_reg, stash + c.wid * 8192, obuf, orow0);
            { const int jlo = i - 8 > 0 ? i - 8 : 0; const unsigned wt = ((2u << i) - 1u) & ~((1u << jlo) - 1u);
              branch<2>(c, KW + (size_t)b * SEQ * 512 + g * 128, VW + (size_t)b * SEQ * 512 + g * 128, wt, i, tl, 0u, qr, o, l_reg); }
            branch_acc<2>(c, o, gate[(size_t)(tok0 + tl) * 48 + hq * 3 + 2] / l_reg, stash + c.wid * 8192, obuf, orow0);
            __syncthreads();
        }
    }
}

DEV void ph_moe_route(const P& p, int layer, const bf16_t* xin  , float* lds, int bid, int nb) {
    typedef float f32x16 __attribute__((ext_vector_type(16)));
    const int tid = tidx(), wid = __builtin_amdgcn_readfirstlane(tid >> 6), lane = tid & 63, i = lane & 31, kk = lane >> 5;
    float* part = lds;
    float* gpart = lds + 8192;
    float* spart = gpart + 1024;
    float* logit = spart + 256;
    float* rinv_l = logit + 32 * 36;
    int* lcnt = (int*)(rinv_l + 32);
    int* lbase = lcnt + 32;
    const float* wr = p.wr + (size_t)layer * D_MODEL * MOE_E; const float* wgq = p.wgq + (size_t)layer * D_MODEL * MOE_G;
    const float* g = p.ln_ffn + layer * D_MODEL;
    const float* bgrp = p.moe_b_group + layer * MOE_G; const float* bexp = p.moe_b_expert + layer * MOE_E;
    int* cnt = p.cnt + layer * MOE_E;
    for (int tb = bid; tb < T / 32; tb += nb) {
        const int tok0 = tb * 32;
        const bf16_t* xr = xin + (size_t)(tok0 + i) * D_MODEL + 256 * wid + 4 * kk;
        const float* wrow = wr + (size_t)(256 * wid + 4 * kk) * MOE_E + i;
        const float* wgrow = wgq + (size_t)(256 * wid + 4 * kk) * MOE_G;
        f32x16 acc = f32x16{}; float ss = 0.f; f32x4 ga = {0.f, 0.f, 0.f, 0.f};
#pragma unroll 4
        for (int j = 0; j < 32; ++j) {
            const u32x2 xw = *(const u32x2*)(xr + 8 * j); const f32x4 xv = {__uint_as_float(xw.x << 16), __uint_as_float(xw.x & 0xffff0000u), __uint_as_float(xw.y << 16), __uint_as_float(xw.y & 0xffff0000u)};
            const float* wp = wrow + (size_t)(8 * j) * MOE_E;
            const float b0 = wp[0], b1 = wp[MOE_E], b2 = wp[2 * MOE_E], b3 = wp[3 * MOE_E];
            const f32x4* gp = (const f32x4*)(wgrow + (size_t)(8 * j) * MOE_G);
            const f32x4 g0 = gp[0], g1 = gp[1], g2 = gp[2], g3 = gp[3];
            acc = __builtin_amdgcn_mfma_f32_32x32x2f32(xv[0], b0, acc, 0, 0, 0); acc = __builtin_amdgcn_mfma_f32_32x32x2f32(xv[1], b1, acc, 0, 0, 0);
            acc = __builtin_amdgcn_mfma_f32_32x32x2f32(xv[2], b2, acc, 0, 0, 0); acc = __builtin_amdgcn_mfma_f32_32x32x2f32(xv[3], b3, acc, 0, 0, 0);
            ss += xv[0] * xv[0] + xv[1] * xv[1] + xv[2] * xv[2] + xv[3] * xv[3];
            ga += g0 * xv[0] + g1 * xv[1] + g2 * xv[2] + g3 * xv[3];
        }
        ss += __shfl_xor(ss, 32);
#pragma unroll
        for (int q = 0; q < 4; ++q) ga[q] += __shfl_xor(ga[q], 32);
#pragma unroll
        for (int r = 0; r < 16; ++r) part[(wid * 32 + (r & 3) + 8 * (r >> 2) + 4 * kk) * 32 + i] = acc[r];
        if (kk == 0) { *(f32x4*)(gpart + (wid * 32 + i) * 4) = ga; spart[wid * 32 + i] = ss; }
        __syncthreads();
#pragma unroll
        for (int e = 0; e < 2; ++e) { const int idx = tid + e * 512, tk = idx >> 5, o = idx & 31; float sm = 0.f;
#pragma unroll
            for (int w = 0; w < 8; ++w) sm += part[(w * 32 + tk) * 32 + o];
            logit[tk * 36 + o] = sm; }
        if (tid < 128) { const int tk = tid >> 2, q = tid & 3; float sm = 0.f;
#pragma unroll
            for (int w = 0; w < 8; ++w) sm += gpart[(w * 32 + tk) * 4 + q];
            logit[tk * 36 + 32 + q] = sm; }
        if (tid < 32) { float sm = 0.f;
#pragma unroll
            for (int w = 0; w < 8; ++w) sm += spart[w * 32 + tid];
            rinv_l[tid] = rsqrtf(sm * (1.f / D_MODEL) + NORM_EPS); lcnt[tid] = 0; }
        __syncthreads();
        if (tid < 32) { const int tok = tok0 + tid; const float rinv = rinv_l[tid]; const float* lg = logit + tid * 36;
            float gl[4]; for (int q = 0; q < 4; ++q) gl[q] = lg[32 + q] * rinv + bgrp[q];
            int gs = 0; float gm = gl[0]; for (int q = 1; q < 4; ++q) if (gl[q] > gm) { gm = gl[q]; gs = q; }
            float gsum = 0.f; for (int q = 0; q < 4; ++q) gsum += expf(gl[q] - gm);
            const float gw = 1.f / gsum;
            float ev[8]; for (int q = 0; q < 8; ++q) ev[q] = lg[gs * 8 + q] * rinv + bexp[gs * 8 + q];
            int i1 = 0; for (int q = 1; q < 8; ++q) if (ev[q] > ev[i1]) i1 = q;
            int i2 = i1 == 0 ? 1 : 0; for (int q = 0; q < 8; ++q) if (q != i1 && ev[q] > ev[i2]) i2 = q;
            const float e2 = expf(ev[i2] - ev[i1]); const float w1 = gw / (1.f + e2), w2 = gw * e2 / (1.f + e2);
            const int ea = gs * 8 + i1, eb = gs * 8 + i2;
            const int ra = atomicAdd(&lcnt[ea], 1), rb = atomicAdd(&lcnt[eb], 1);
            asm volatile("s_waitcnt lgkmcnt(0)" ::: "memory");
            const int mine = lcnt[tid]; int base = 0; if (mine) base = atomicAdd(&cnt[tid], mine);
            lbase[tid] = base;
            asm volatile("s_waitcnt lgkmcnt(0)" ::: "memory");
            p.list[ea * T + lbase[ea] + ra] = tok * 2; p.lw[ea * T + lbase[ea] + ra] = w1;
            p.list[eb * T + lbase[eb] + rb] = tok * 2 + 1; p.lw[eb * T + lbase[eb] + rb] = w2; }
#pragma unroll
        for (int tt = 0; tt < 4; ++tt) { const int tok = tok0 + 4 * wid + tt; const float rinv = rinv_l[4 * wid + tt];
#pragma unroll
            for (int ii = 0; ii < 8; ++ii) { const int c = ii * 256 + lane * 4; const u32x2 xw = *(const u32x2*)(xin + (size_t)tok * D_MODEL + c); const f32x4 xv = {__uint_as_float(xw.x << 16), __uint_as_float(xw.x & 0xffff0000u), __uint_as_float(xw.y << 16), __uint_as_float(xw.y & 0xffff0000u)}, gg = *(const f32x4*)(g + c);
                const float rs = rinv * F8_SX;
                *(unsigned*)((char*)p.hb16 + (size_t)tok * D_MODEL + c) = pk8(xv[0] * rs * gg[0], xv[1] * rs * gg[1], xv[2] * rs * gg[2], xv[3] * rs * gg[3]); } }
        __syncthreads();
    }
}

namespace ssd {
using namespace at;
constexpr int OFF_CK = 0, OFF_BK = 32768, OFF_BV = 65536, OFF_XV = 98304, OFF_XS = 114688, OFF_PV = 131072, OFF_TB = 147456;
DEV int v64_st(int k, int c) { const int kk = (k & ~0xC) | ((k & 4) << 1) | ((k & 8) >> 1); return ((kk >> 3) * 2 + (c >> 5)) * 512 + ((kk & 7) * 32 + (c & 31)) * 2; }
#define SD_TRRD(dst, base, off) asm volatile("ds_read_b64_tr_b16 %0, %1 offset:%2" : "=&v"(dst) : "v"(base), "i"(off) : "memory")
#define SD_MK(lo, hi) ((bf16x8){lo[0], lo[1], lo[2], lo[3], hi[0], hi[1], hi[2], hi[3]})
DEV float conv8(const bf16x8& r0, const bf16x8& r1, const bf16x8& r2, const bf16x8& r3, const float (&w)[4][8], const float (&bias)[8], int j) {
    float a = bias[j]; a = fmaf(bf2f((bf16_t)r0[j]), w[0][j], a); a = fmaf(bf2f((bf16_t)r1[j]), w[1][j], a); a = fmaf(bf2f((bf16_t)r2[j]), w[2][j], a); a = fmaf(bf2f((bf16_t)r3[j]), w[3][j], a);
    return a / (1.f + __expf(-a));
}
}

DEV void ph_ssd_conv_bc(const P& p, int bid, int nb) {
    using namespace ssd;
    const bf16_t* xp = (const bf16_t*)(p.big + BIG_SSD_XBCP); bf16_t* bc = (bf16_t*)(p.big + BIG_SSD_BC);
    const bf16x8 zero8 = {0, 0, 0, 0, 0, 0, 0, 0};
    for (int it = bid * NTHREADS + tidx(); it < (T / 16) * 256; it += nb * NTHREADS) {
        const int cg = it & 255, tb = it >> 8, ch = SSD_DI + cg * 8, t0 = (tb * 16) & (SEQ - 1); const size_t tok0 = (size_t)tb * 16;
        float w[4][8], bias[8];
#pragma unroll
        for (int k = 0; k < 4; ++k) { const f32x4 w0 = *(const f32x4*)(p.ssd_conv_w + k * SSD_CONVCH + ch), w1 = *(const f32x4*)(p.ssd_conv_w + k * SSD_CONVCH + ch + 4);
#pragma unroll
            for (int j = 0; j < 4; ++j) { w[k][j] = w0[j]; w[k][4 + j] = w1[j]; } }
        { const f32x4 b0 = *(const f32x4*)(p.ssd_conv_b + ch), b1 = *(const f32x4*)(p.ssd_conv_b + ch + 4);
#pragma unroll
          for (int j = 0; j < 4; ++j) { bias[j] = b0[j]; bias[4 + j] = b1[j]; } }
        bf16x8 r0 = t0 >= 3 ? *(const bf16x8*)(xp + (tok0 - 3) * SSD_CONVCH + ch) : zero8, r1 = t0 >= 2 ? *(const bf16x8*)(xp + (tok0 - 2) * SSD_CONVCH + ch) : zero8,
               r2 = t0 >= 1 ? *(const bf16x8*)(xp + (tok0 - 1) * SSD_CONVCH + ch) : zero8;
#pragma unroll 8
        for (int i = 0; i < 16; ++i) { const bf16x8 r3 = *(const bf16x8*)(xp + (tok0 + i) * SSD_CONVCH + ch); float o[8];
#pragma unroll
            for (int j = 0; j < 8; ++j) o[j] = conv8(r0, r1, r2, r3, w, bias, j);
            u32x4 pk; pk.x = cvtpk(o[0], o[1]); pk.y = cvtpk(o[2], o[3]); pk.z = cvtpk(o[4], o[5]); pk.w = cvtpk(o[6], o[7]);
            *(u32x4*)(bc + (tok0 + i) * 2048 + cg * 8) = pk; r0 = r1; r1 = r2; r2 = r3; }
    }
}

DEV void ph_ssd_mfma(const P& p, char* L, int bid, int nb) {
    using namespace ssd;
    const int tid = tidx(), wid = __builtin_amdgcn_readfirstlane(tid >> 6), lane = tid & 63;
    const int lb = wid & 3, pb = wid >> 2, nbk = wid & 3;
    const bf16_t* xp = (const bf16_t*)(p.big + BIG_SSD_XBCP); const bf16_t* bc = (const bf16_t*)(p.big + BIG_SSD_BC);
    bf16_t* yb = (bf16_t*)(p.big + BIG_SSD_YN);
    float* tabs = (float*)(L + OFF_TB);
    const bf16x8 zero8 = {0, 0, 0, 0, 0, 0, 0, 0};
    unsigned ksrc[2], vsrc[2];
#pragma unroll
    for (int i = 0; i < 2; ++i) { const int pos = tid * 16 + i * 8192;
        { const int row = pos >> 8, ch = ((pos >> 4) & 15) ^ (row & 7); ksrc[i] = (unsigned)(row * 2048 + ch * 8); }
        { const int sub = pos >> 9, w = (pos & 511) >> 1, kk = (sub >> 2) * 8 + (w >> 5), k = (kk & ~0xC) | ((kk & 4) << 1) | ((kk & 8) >> 1), col = (sub & 3) * 32 + (w & 31); vsrc[i] = (unsigned)(k * 2048 + col); } }
    for (int u0 = bid; u0 < BATCH * SSD_H; u0 += nb) {
        const int u = (nb == 256) ? ((u0 & 7) * 32 + (u0 >> 3)) : u0;
        const int b = u >> 6, h = u & 63, g = h >> 3;
        const float Ah = -expf(p.ssd_a_log[h]), Dh = p.ssd_d[h];
        f32x16 st = f32x16{};
        for (int i = tid; i < 16384 / 16; i += NTHREADS) *(bf16x8*)(L + OFF_PV + i * 16) = zero8;
        float* tabg = (float*)(p.big + BIG_SSD_TABG) + (size_t)u * 16 * 640;
#pragma unroll 1
        for (int cc = 0; cc < 2; ++cc) { const int chunk = 2 * wid + cc; float* tb_ = tabg + chunk * 640; const size_t t0_ = (size_t)b * SEQ + chunk * 128 + 2 * lane;
            const float d0 = p.dtb[t0_ * 64 + h], d1 = p.dtb[(t0_ + 1) * 64 + h]; const float a0 = d0 * Ah, a1 = d1 * Ah; float c = a0 + a1;
#pragma unroll
            for (int o_ = 1; o_ < 64; o_ <<= 1) { const float v = __shfl_up(c, o_); if (lane >= o_) c += v; }
            const float e1 = c, e0 = c - a1, tot = __shfl(c, 63);
            tb_[2 * lane] = e0 * 1.4426950408889634f; tb_[2 * lane + 1] = e1 * 1.4426950408889634f; tb_[128 + 2 * lane] = __expf(e0); tb_[128 + 2 * lane + 1] = __expf(e1);
            tb_[256 + 2 * lane] = __expf(tot - e0); tb_[256 + 2 * lane + 1] = __expf(tot - e1); tb_[384 + 2 * lane] = Dh / fmaxf(d0, 1e-30f); tb_[384 + 2 * lane + 1] = Dh / fmaxf(d1, 1e-30f); tb_[512 + 2 * lane] = d0; tb_[512 + 2 * lane + 1] = d1; }
        __syncthreads();
#pragma unroll 1
        for (int ck = 0; ck < SEQ / 128; ++ck) {
            const float* tb = tabs;
            const float* tg = tabg + ck * 640;
            const size_t tok0 = (size_t)b * SEQ + ck * 128;
            { const float v0 = tg[tid]; tabs[tid] = v0; if (tid < 128) tabs[512 + tid] = tg[512 + tid]; }
            { const bf16_t* bsrc = bc + tok0 * 2048 + g * 128; const bf16_t* csrc = bsrc + 1024;
#pragma unroll
              for (int tile = 0; tile < 2; ++tile)
#pragma unroll
                  for (int i = 0; i < 2; ++i) {
                      __builtin_amdgcn_global_load_lds((const unsigned*)(csrc + (size_t)tile * 64 * 2048 + ksrc[i]), (MG_LAS unsigned*)((MG_LAS char*)L + OFF_CK + tile * 16384 + wid * 1024 + i * 8192), 16, 0, 0);
                      __builtin_amdgcn_global_load_lds((const unsigned*)(bsrc + (size_t)tile * 64 * 2048 + ksrc[i]), (MG_LAS unsigned*)((MG_LAS char*)L + OFF_BK + tile * 16384 + wid * 1024 + i * 8192), 16, 0, 0);
                      __builtin_amdgcn_global_load_lds((const unsigned*)(bsrc + (size_t)tile * 64 * 2048 + vsrc[i]), (MG_LAS unsigned*)((MG_LAS char*)L + OFF_BV + tile * 16384 + wid * 1024 + i * 8192), 16, 0, 0); } }
            { int tl_ = tid; asm volatile("" : "+v"(tl_));
              const int cgx = tl_ & 7, rsx = tl_ >> 3, chx = h * 64 + cgx * 8;
              float w[4][8], bias[8];
#pragma unroll
              for (int k = 0; k < 4; ++k) { const f32x4 w0 = *(const f32x4*)(p.ssd_conv_w + k * SSD_CONVCH + chx), w1 = *(const f32x4*)(p.ssd_conv_w + k * SSD_CONVCH + chx + 4);
#pragma unroll
                  for (int j = 0; j < 4; ++j) { w[k][j] = w0[j]; w[k][4 + j] = w1[j]; } }
              { const f32x4 b0 = *(const f32x4*)(p.ssd_conv_b + chx), b1 = *(const f32x4*)(p.ssd_conv_b + chx + 4);
#pragma unroll
                for (int j = 0; j < 4; ++j) { bias[j] = b0[j]; bias[4 + j] = b1[j]; } }
              bf16x8 rw[5];
#pragma unroll
              for (int i = 0; i < 5; ++i) { const int l = 2 * rsx - 3 + i; rw[i] = (ck * 128 + l >= 0) ? *(const bf16x8*)(xp + (tok0 + l) * SSD_CONVCH + chx) : zero8; }
#pragma unroll
              for (int i = 0; i < 2; ++i) { const int l = 2 * rsx + i; const float dtl = tg[512 + l], sdl = tg[256 + l]; float o[8];
#pragma unroll
                  for (int j = 0; j < 8; ++j) o[j] = conv8(rw[i], rw[i + 1], rw[i + 2], rw[i + 3], w, bias, j) * dtl;
                  u32x4 pk; pk.x = cvtpk(o[0], o[1]); pk.y = cvtpk(o[2], o[3]); pk.z = cvtpk(o[4], o[5]); pk.w = cvtpk(o[6], o[7]);
                  *(u32x4*)(L + OFF_XV + v64_st(l, cgx * 8)) = pk;
                  pk.x = cvtpk(o[0] * sdl, o[1] * sdl); pk.y = cvtpk(o[2] * sdl, o[3] * sdl); pk.z = cvtpk(o[4] * sdl, o[5] * sdl); pk.w = cvtpk(o[6] * sdl, o[7] * sdl);
                  *(u32x4*)(L + OFF_XS + v64_st(l, cgx * 8)) = pk; } }
            __syncthreads();
            int ln_ = lane; asm volatile("" : "+v"(ln_)); const int r32 = ln_ & 31, hi = ln_ >> 5, lane2 = ln_;
            bf16x8 qr[8];
            { const char* cb_ = L + OFF_CK + (lb >> 1) * 16384;
#pragma unroll
              for (int d0 = 0; d0 < 8; ++d0) qr[d0] = *(const bf16x8*)(cb_ + AT_KSWZ((lb & 1) * 32 + r32, (d0 * 16 + hi * 8) * 2)); }
            f32x16 o = f32x16{}, oo = f32x16{};
            const int l = 32 * lb + r32; const float al = tb[l], dl = tb[384 + l];
            const int xvb = (int)(uintptr_t)(L + OFF_XV) + v_rd_base(lane2) + pb * 512;
            for (int kt = 0; kt <= (lb >> 1); ++kt) {
                f32x16 p0, p1;
                qkt(p0, p1, L + OFF_BK + kt * 16384, r32, hi, qr);
                if (kt < (lb >> 1)) {
#pragma unroll
                    for (int r = 0; r < 16; ++r) { const int s0 = 64 * kt + crow(r, hi), s1 = s0 + 32; p0[r] *= __builtin_amdgcn_exp2f(al - tb[s0]); p1[r] *= __builtin_amdgcn_exp2f(al - tb[s1]); }
                } else {
#pragma unroll
                for (int r = 0; r < 16; ++r) { const int s0 = 64 * kt + crow(r, hi), s1 = s0 + 32;
                    float v0 = p0[r] * __builtin_amdgcn_exp2f(al - tb[s0]), v1 = p1[r] * __builtin_amdgcn_exp2f(al - tb[s1]);
                    v0 = s0 <= l ? v0 : 0.f; v1 = s1 <= l ? v1 : 0.f; v0 += s0 == l ? dl : 0.f; v1 += s1 == l ? dl : 0.f; p0[r] = v0; p1[r] = v1; }
                }
                bf16x8 pa0, pa1, pa2, pa3;
                AT_PK4(p0, 0, pa0); AT_PK4(p0, 8, pa1); AT_PK4(p1, 0, pa2); AT_PK4(p1, 8, pa3);
                { const int vb = xvb + kt * 8192; s16x4 l0, l1, l2, l3, h0, h1, h2, h3;
                  SD_TRRD(l0, vb, 0); SD_TRRD(h0, vb, 1024); SD_TRRD(l1, vb, 2048); SD_TRRD(h1, vb, 3072); SD_TRRD(l2, vb, 4096); SD_TRRD(h2, vb, 5120); SD_TRRD(l3, vb, 6144); SD_TRRD(h3, vb, 7168);
                  asm volatile("s_waitcnt lgkmcnt(0)" ::: "memory"); __builtin_amdgcn_sched_barrier(0);
                  o = __builtin_amdgcn_mfma_f32_32x32x16_bf16(pa0, SD_MK(l0, h0), o, 0, 0, 0); o = __builtin_amdgcn_mfma_f32_32x32x16_bf16(pa1, SD_MK(l1, h1), o, 0, 0, 0);
                  o = __builtin_amdgcn_mfma_f32_32x32x16_bf16(pa2, SD_MK(l2, h2), o, 0, 0, 0); o = __builtin_amdgcn_mfma_f32_32x32x16_bf16(pa3, SD_MK(l3, h3), o, 0, 0, 0); }
            }
            { const int vb = (int)(uintptr_t)(L + OFF_PV) + v_rd_base(lane2) + pb * 512;
#define SD_YOFF(K0) do { s16x4 l0, l1, l2, l3, h0, h1, h2, h3; \
                  SD_TRRD(l0, vb, (K0) * 2048); SD_TRRD(h0, vb, (K0) * 2048 + 1024); SD_TRRD(l1, vb, (K0) * 2048 + 2048); SD_TRRD(h1, vb, (K0) * 2048 + 3072); \
                  SD_TRRD(l2, vb, (K0) * 2048 + 4096); SD_TRRD(h2, vb, (K0) * 2048 + 5120); SD_TRRD(l3, vb, (K0) * 2048 + 6144); SD_TRRD(h3, vb, (K0) * 2048 + 7168); \
                  asm volatile("s_waitcnt lgkmcnt(0)" ::: "memory"); __builtin_amdgcn_sched_barrier(0); \
                  oo = __builtin_amdgcn_mfma_f32_32x32x16_bf16(qr[(K0)], SD_MK(l0, h0), oo, 0, 0, 0); oo = __builtin_amdgcn_mfma_f32_32x32x16_bf16(qr[(K0) + 1], SD_MK(l1, h1), oo, 0, 0, 0); \
                  oo = __builtin_amdgcn_mfma_f32_32x32x16_bf16(qr[(K0) + 2], SD_MK(l2, h2), oo, 0, 0, 0); oo = __builtin_amdgcn_mfma_f32_32x32x16_bf16(qr[(K0) + 3], SD_MK(l3, h3), oo, 0, 0, 0); } while (0)
              SD_YOFF(0); SD_YOFF(4);
#undef SD_YOFF
            }
            { const float dec = tb[128 + 127];
#pragma unroll
              for (int r = 0; r < 16; ++r) st[r] *= dec;
              const int xsb = (int)(uintptr_t)(L + OFF_XS) + v_rd_base(lane2) + pb * 512;
              const int bvb = (int)(uintptr_t)(L + OFF_BV) + v_rd_base(lane2) + nbk * 512;
#define SD_STATE(K0, BOFF) do { s16x4 a0, a1, a2, a3, a4, a5, a6, a7, b0, b1, b2, b3, b4, b5, b6, b7; \
                  SD_TRRD(a0, xsb, (K0) * 2048); SD_TRRD(a1, xsb, (K0) * 2048 + 1024); SD_TRRD(a2, xsb, (K0) * 2048 + 2048); SD_TRRD(a3, xsb, (K0) * 2048 + 3072); \
                  SD_TRRD(a4, xsb, (K0) * 2048 + 4096); SD_TRRD(a5, xsb, (K0) * 2048 + 5120); SD_TRRD(a6, xsb, (K0) * 2048 + 6144); SD_TRRD(a7, xsb, (K0) * 2048 + 7168); \
                  SD_TRRD(b0, bvb, (BOFF)); SD_TRRD(b1, bvb, (BOFF) + 2048); SD_TRRD(b2, bvb, (BOFF) + 4096); SD_TRRD(b3, bvb, (BOFF) + 6144); \
                  SD_TRRD(b4, bvb, (BOFF) + 8192); SD_TRRD(b5, bvb, (BOFF) + 10240); SD_TRRD(b6, bvb, (BOFF) + 12288); SD_TRRD(b7, bvb, (BOFF) + 14336); \
                  asm volatile("s_waitcnt lgkmcnt(0)" ::: "memory"); __builtin_amdgcn_sched_barrier(0); \
                  st = __builtin_amdgcn_mfma_f32_32x32x16_bf16(SD_MK(a0, a1), SD_MK(b0, b1), st, 0, 0, 0); st = __builtin_amdgcn_mfma_f32_32x32x16_bf16(SD_MK(a2, a3), SD_MK(b2, b3), st, 0, 0, 0); \
                  st = __builtin_amdgcn_mfma_f32_32x32x16_bf16(SD_MK(a4, a5), SD_MK(b4, b5), st, 0, 0, 0); st = __builtin_amdgcn_mfma_f32_32x32x16_bf16(SD_MK(a6, a7), SD_MK(b6, b7), st, 0, 0, 0); } while (0)
              SD_STATE(0, 0); SD_STATE(4, 16384);
              asm volatile("s_nop 15\n\ts_nop 15" : "+v"(st));
#undef SD_STATE
            }
            { const int colg = h * 64 + 32 * pb + r32;
#pragma unroll
              for (int r = 0; r < 16; ++r) { const int lr = 32 * lb + crow(r, hi); const size_t tok = tok0 + lr;
                  const float y = o[r] + tb[128 + lr] * oo[r]; const float yn = swap_pair(y); if ((r32 & 1) == 0) *(unsigned*)(yb + tok * SSD_DI + colg) = cvtpk(y, yn); } }
            __syncthreads();
#pragma unroll
            for (int rg = 0; rg < 4; ++rg) { u32x2 w2; w2.x = cvtpk(st[4 * rg], st[4 * rg + 1]); w2.y = cvtpk(st[4 * rg + 2], st[4 * rg + 3]);
                *(u32x2*)(L + OFF_PV + v64_st(32 * nbk + r32, 32 * pb + 8 * rg + 4 * hi)) = w2; }
        }
        __syncthreads();
    }
}

DEV void ph_ssd_norm(const P& p, int bid, int nb) {
    const int lane = tidx() & 63, wid = tidx() >> 6;
    bf16_t* yb = (bf16_t*)(p.big + BIG_SSD_YN); const bf16_t* zb = (const bf16_t*)(p.big + BIG_SSD_Z);
    for (int tok = bid * 8 + wid; tok < T; tok += nb * 8) {
        const int lo = (lane >> 3) * 512 + (lane & 7) * 8;
        bf16_t* yr = yb + (size_t)tok * SSD_DI + lo; const bf16_t* zr = zb + (size_t)tok * SSD_DI + lo; const float* ng = p.ssd_norm + lo;
        float v[64]; float ss = 0.f;
#pragma unroll
        for (int i = 0; i < 8; ++i) { const bf16x8 yv = *(const bf16x8*)(yr + i * 64), zv = *(const bf16x8*)(zr + i * 64);
#pragma unroll
            for (int j = 0; j < 8; ++j) { const float z = bf2f((bf16_t)zv[j]); const float t = bf2f((bf16_t)yv[j]) * (z / (1.f + __expf(-z))); v[i * 8 + j] = t; ss += t * t; } }
        ss += __shfl_xor(ss, 1); ss += __shfl_xor(ss, 2); ss += __shfl_xor(ss, 4);
        const float rinv = rsqrtf(ss * (1.f / 512.f) + NORM_EPS);
#pragma unroll
        for (int i = 0; i < 8; ++i) { float o[8];
#pragma unroll
            for (int j = 0; j < 8; ++j) o[j] = v[i * 8 + j] * rinv * ng[i * 64 + j];
            u32x4 w; w.x = at::cvtpk(o[0], o[1]); w.y = at::cvtpk(o[2], o[3]); w.z = at::cvtpk(o[4], o[5]); w.w = at::cvtpk(o[6], o[7]); *(u32x4*)(yr + i * 64) = w; }
    }
}

#define XB_TMO      128
#define XB_XCNT(j)  (256  + 64 * (j))
#define XB_XSUB(j)  (1280 + 64 * (j))
#define XB_XGEN(j)  (2304 + 64 * (j))
#define XB_TOP      3328
#define XB_TOPGEN   3392
#define XCD_BAR_WORDS 3456
#define XB_SPIN_CAP (1u << 22)
#define LAS __attribute__((address_space(3)))

__device__ __forceinline__ unsigned xb_ld(unsigned* p)              { return __hip_atomic_load(p, __ATOMIC_RELAXED, __HIP_MEMORY_SCOPE_AGENT); }
__device__ __forceinline__ unsigned xb_add(unsigned* p, unsigned v) { return __hip_atomic_fetch_add(p, v, __ATOMIC_RELAXED, __HIP_MEMORY_SCOPE_AGENT); }
__device__ __forceinline__ unsigned xb_xcc_id() { return (unsigned)__builtin_amdgcn_s_getreg((3 << 11) | 20) & 0xFu; }
#define XB_SPIN(cond, bar) do { unsigned _sp = 0; while (cond) { __builtin_amdgcn_s_sleep(1); \
    if ((++_sp & 255u) == 0u) { if (xb_ld(&(bar)[XB_TMO])) break; if (_sp > XB_SPIN_CAP) { atomicAdd(&(bar)[XB_TMO], 1u); break; } } } } while (0)

struct XcdBarrier {
    unsigned* bar; unsigned x;
    volatile LAS unsigned* st;
};

__device__ __forceinline__ XcdBarrier xcd_barrier_post(unsigned* bar, volatile LAS unsigned* st) {
    XcdBarrier b; b.bar = bar; b.x = xb_xcc_id(); b.st = st;
    if (threadIdx.x == 0) (void)xb_add(&bar[XB_XCNT(b.x)], 1u);
    return b;
}
__device__ __forceinline__ void xcd_barrier_complete(unsigned* bar, unsigned x, unsigned& nloc, unsigned& nx) {
    const unsigned G = gridDim.x * gridDim.y * gridDim.z;
    unsigned sum, cnt, mine, sp = 0u;
    for (;;) {
        sum = 0u; cnt = 0u; mine = 0u;
#pragma unroll
        for (unsigned j = 0; j < 16; ++j) { const unsigned c = xb_ld(&bar[XB_XCNT(j)]); sum += c; cnt += (c > 0u) ? 1u : 0u; mine = (j == x) ? c : mine; }
        if (sum == G) break;
        __builtin_amdgcn_s_sleep(1);
        if ((++sp & 255u) == 0u) { if (xb_ld(&bar[XB_TMO])) break; if (sp > XB_SPIN_CAP) { atomicAdd(&bar[XB_TMO], 1u); break; } }
    }
    nloc = mine > 0u ? mine : 1u; nx = cnt > 0u ? cnt : 1u;
}

__device__ __forceinline__ void xcd_barrier(const XcdBarrier& b) {
    asm volatile("s_waitcnt vmcnt(0)" ::: "memory");
    __syncthreads();
    if (threadIdx.x == 0) {
        unsigned* bar = b.bar;
        __builtin_amdgcn_s_waitcnt(0);
        unsigned nloc = b.st[0], nx = b.st[1];
        if (nloc == 0u) { xcd_barrier_complete(bar, b.x, nloc, nx); b.st[0] = nloc; b.st[1] = nx; }
        const unsigned old = xb_add(&bar[XB_XSUB(b.x)], 1u);
        const unsigned gen = old / nloc;
        if (old + 1u == (gen + 1u) * nloc) {
            __builtin_amdgcn_fence(__ATOMIC_RELEASE, "agent");
            asm volatile("s_waitcnt vmcnt(0)" ::: "memory");
            const unsigned og = xb_add(&bar[XB_TOP], 1u);
            const unsigned tg = og / nx;
            if (og + 1u == (tg + 1u) * nx) xb_add(&bar[XB_TOPGEN], 1u);
            else XB_SPIN(xb_ld(&bar[XB_TOPGEN]) == tg, bar);
            __builtin_amdgcn_fence(__ATOMIC_ACQUIRE, "agent");
            xb_add(&bar[XB_XGEN(b.x)], 1u);
            asm volatile("s_waitcnt vmcnt(0)" ::: "memory");
        } else {
            XB_SPIN(xb_ld(&bar[XB_XGEN(b.x)]) == gen, bar);
            __builtin_amdgcn_fence(__ATOMIC_ACQUIRE, "agent");
            asm volatile("s_waitcnt vmcnt(0)" ::: "memory");
        }
    }
    __syncthreads();
}


constexpr int LDS_STAGE_OFF = 16, LDS_TAB_OFF = 16 + mg::STAGE_BYTES, LDS_BYTES = 16 + 147456 + 5120;
constexpr int NPHASE = 21;

DEV void moe_tables(const int* cnt, int* tab) {
    __syncthreads();
    if (tidx() == 0) { int s = 0, r = 0; for (int e = 0; e < MOE_E; ++e) { tab[e] = s; tab[64 + e] = r; const int c = cnt[e]; s += (c + 255) >> 8; r += c; } tab[MOE_E] = s; tab[64 + MOE_E] = r; }
    __syncthreads();
}
constexpr int MOE_CT_GU = 4096, MOE_CT_D = 2048, MOE_CT_L = MOE_CT_GU + MOE_CT_D;
DEV void conv_moe_tiles(const P& p, float* ldsf, int f0, int f1, int w, int nw) {
    if (w < 0 || f0 >= f1) return;
#pragma unroll 1
    for (int L = 0; L < 2; ++L) {
        const float* wg = p.moe_w_gate + (size_t)L * MOE_E * D_MODEL * MOE_FF; const float* wu = p.moe_w_up + (size_t)L * MOE_E * D_MODEL * MOE_FF;
        const float* wd = p.moe_w_down + (size_t)L * MOE_E * MOE_FF * D_MODEL;
        { const int a = f0 - L * MOE_CT_L, b = f1 - L * MOE_CT_L; const int lo = a > 0 ? a : 0, hi = b < MOE_CT_GU ? b : MOE_CT_GU;
          if (lo < hi) conv_wt<true>([=](int g, int k, int q) { const float* sp = (q & 1) ? wu : wg; return sp + ((size_t)g * D_MODEL + k) * MOE_FF + (q >> 1) * 4; }, MOE_E, D_MODEL, 2 * MOE_FF,
                               p.wt_gu + (size_t)L * MOE_E * MOE_FF * D_MODEL, ldsf, w, nw, lo, hi); }
        { const int a = f0 - L * MOE_CT_L - MOE_CT_GU, b = f1 - L * MOE_CT_L - MOE_CT_GU; const int lo = a > 0 ? a : 0, hi = b < MOE_CT_D ? b : MOE_CT_D;
          if (lo < hi) conv_wt<true>([=](int g, int k, int q) { return wd + ((size_t)g * MOE_FF + k) * D_MODEL + q * 4; }, MOE_E, MOE_FF, D_MODEL,
                               p.wt_d + (size_t)L * MOE_E * D_MODEL * MOE_FF / 2, ldsf, w, nw, lo, hi); }
    }
}
constexpr int CT_A = 768, CT_B = MOE_CT_L, CT_C = MOE_CT_L + 1920, CT_D = MOE_CT_L + MOE_CT_GU, CT_E = 2 * MOE_CT_L;

template <int PH> DEV void run_phase(const P& p, float* ldsraw, int bid, int nb) {
    float* lds = ldsraw + 4;
    MG_LAS unsigned char* stage = (MG_LAS unsigned char*)ldsraw + LDS_STAGE_OFF;
    int* tab = (int*)((char*)ldsraw + LDS_TAB_OFF);
    if constexpr (PH == 0) {
        ph_rope_table(p, bid, nb);
        for (int i = bid * NTHREADS + tidx(); i < 2 * D_MODEL * MOE_E; i += nb * NTHREADS) p.wr[i] = p.moe_w_expert[i] * p.ln_ffn[i >> 5];
        for (int i = bid * NTHREADS + tidx(); i < 2 * D_MODEL * MOE_G; i += nb * NTHREADS) p.wgq[i] = p.moe_w_group[i] * p.ln_ffn[i >> 2];
        if (bid == 0 && tidx() < 64) p.cnt[tidx()] = 0;
        if (bid >= 64 && bid < 128) { const int kv = (bid - 64) >> 5, part = (bid - 64) & 31, j = tidx() & 255, hh = tidx() >> 8;
            const float* pe = p.nsa_cmp_pe + kv * 4096 + part * 128 + hh * 64; const float* w1 = p.nsa_cmp_w1 + ((size_t)kv * 4096 + part * 128 + hh * 64) * CMP_HIDDEN + j; float sm = 0.f;
#pragma unroll 8
            for (int i = 0; i < 64; ++i) sm += pe[i] * w1[(size_t)i * CMP_HIDDEN];
            p.h1[(kv * 64 + part * 2 + hh) * 256 + j] = sm; }
        rows_norm<true>(p.x, nullptr, nullptr, nullptr, p.ln_mix, p.hb16, bid, nb);
        { const float* w = p.nsa_w_in; conv_wt<true>([=](int, int k, int q) { const int c = q * 4, pn = c >> 8; int lg = c;
              if (pn < 10 || pn == 12 || pn == 13 || pn == 16 || pn == 17) { const int c128 = c & 127; lg = (c & ~127) + 16 * (c128 >> 5) + 4 * ((c128 >> 3) & 3) + 64 * ((c128 >> 2) & 1); }
              return lg < NSA_PROJ ? w + (size_t)k * NSA_PROJ + lg : (const float*)nullptr; }, 1, D_MODEL, NSA_PROJ_P, p.wt_nsa_in, lds, bid, nb); }
        { const float* w = p.nsa_cmp_w1; conv_wt([=](int g, int k, int q) { return w + ((size_t)g * 4096 + k) * CMP_HIDDEN + q * 4; }, 2, 4096, CMP_HIDDEN, p.wt_cmp1, lds, bid, nb); }
        { const float* w = p.nsa_cmp_w2; conv_wt([=](int g, int k, int q) { return q < 32 ? w + ((size_t)g * CMP_HIDDEN + k) * 128 + q * 4 : (const float*)nullptr; }, 2, CMP_HIDDEN, 256, p.wt_cmp2, lds, bid, nb); }
    } else if constexpr (PH == 1) {
        mg::StaticOrder S; S.init(T, NSA_PROJ_P, nb, bid);
        mg::gemm_phase<true, 10>(stage, D_MODEL / 2, mg::APlain{p.hb16, D_MODEL / 2}, mg::BPlain{p.wt_nsa_in, D_MODEL / 2, 0}, S,
                       EpiNsaIn{(bf16_t*)(p.big + BIG_NSA_Q), (bf16_t*)(p.big + BIG_NSA_KS), (bf16_t*)(p.big + BIG_NSA_VS), (bf16_t*)(p.big + BIG_NSA_KW), (bf16_t*)(p.big + BIG_NSA_VW),
                                (bf16_t*)(p.big + BIG_NSA_ACMP), (float*)(p.big + BIG_NSA_GATE), p.rope, p.nsa_cmp_pe});
        { const int nu = (T / 256) * (NSA_PROJ_P / 256), rem = nu % nb; __syncthreads();
          if (bid == nb - 1) { const int kv = tidx() >> 8, j = tidx() & 255; float sm = 0.f;
#pragma unroll 8
              for (int s_ = 0; s_ < 64; ++s_) sm += p.h1[(kv * 64 + s_) * 256 + j];
              p.kvc[kv * 256 + j] = sm; }
          if (rem) conv_moe_tiles(p, lds, 0, CT_A, bid - rem, nb - rem); else conv_moe_tiles(p, lds, 0, CT_A, bid, nb); }
    } else if constexpr (PH == 2) {
    } else if constexpr (PH == 3) {
        mg::FixedGroups S{2, 8, 1, nb, bid};
        mg::gemm_phase(stage, 4096, mg::AGrouped{(const bf16_t*)(p.big + BIG_NSA_ACMP), 2048, (size_t)2048 * 2048}, mg::BPlain{p.wt_cmp1, 4096, (size_t)CMP_HIDDEN * 4096}, S, EpiCmp1{(bf16_t*)(p.big + BIG_NSA_H1), (const float*)p.kvc});
        __syncthreads();
        for (int L = bid; L < 16; L += nb) { const int g = L >> 3, pm = L & 7;
            cmp_gemm2_rows((const bf16_t*)(p.big + BIG_NSA_H1) + (size_t)g * 2048 * 256, p.wt_cmp2 + (size_t)g * 256 * CMP_HIDDEN, (bf16_t*)(p.big + BIG_NSA_KVC) + (size_t)g * 2048 * 128, pm * 256); }
        if (nb > 16) conv_moe_tiles(p, lds, CT_A, CT_B, bid - 16, nb - 16); else conv_moe_tiles(p, lds, CT_A, CT_B, bid, nb);
        { const float* w = p.ssd_w_out; const int fb = nb > 16 ? bid - 16 : bid, fn = nb > 16 ? nb - 16 : nb;
          if (fb >= 0) conv_wt([=](int, int k, int q) { return w + (size_t)k * D_MODEL + q * 4; }, 1, SSD_DI, D_MODEL, p.wt_ssd_out, lds, fb, fn);
          if (fb >= 0) { const float* w1 = p.nsa_w_out; conv_wt<true>([=](int, int k, int q) { return w1 + (size_t)k * D_MODEL + q * 4; }, 1, 2048, D_MODEL, p.wt_nsa_out, lds, fb, fn); }
          if (fb >= 0) { const float* w2 = p.ssd_w_in; conv_wt([=](int, int k, int q) { const int c = q * 4; return c < SSD_PROJ ? w2 + (size_t)k * SSD_PROJ + c : (const float*)nullptr; }, 1, D_MODEL, SSD_PROJ_P, p.wt_ssd_in, lds, fb, fn); } }
    } else if constexpr (PH == 4) {
    } else if constexpr (PH == 5) {
        ph_attn_mfma(p, (char*)ldsraw + LDS_STAGE_OFF, bid, nb);
    } else if constexpr (PH == 6) {
    } else if constexpr (PH == 7) {
        mg::StaticOrder S; S.init(T, D_MODEL, nb, bid);
        mg::gemm_phase<true, 12>(stage, 2048 / 2, mg::APlain{(const bf16_t*)(p.big + BIG_NSA_OBUF), 2048 / 2}, mg::BPlain{p.wt_nsa_out, 2048 / 2, 0}, S, EpiResid<false, 12>{p.x, (bf16_t*)p.xB});
    } else if constexpr (PH == 8 || PH == 17) {
        ph_moe_route(p, PH == 8 ? 0 : 1, (const bf16_t*)p.xB, lds, bid, nb);
    } else if constexpr (PH == 9 || PH == 18) {
        constexpr int L = PH == 9 ? 0 : 1; const int* cnt = p.cnt + L * MOE_E;
        moe_tables(cnt, tab);
        mg::GroupedOrder S{tab, MOE_E, 4, nb, bid};
        mg::gemm_phase<true>(stage, D_MODEL / 2, AMoeGather{p.hb16, p.list, cnt}, mg::BPlain{p.wt_gu + (size_t)L * MOE_E * MOE_FF * D_MODEL, D_MODEL / 2, (size_t)MOE_FF * D_MODEL}, S, EpiMoeGU{(bf16_t*)(p.big + BIG_MOE_ACT), cnt, tab});
        { const int rem = (tab[MOE_E] * 4) % nb; __syncthreads(); constexpr int f0 = L == 0 ? CT_B : CT_D + 384, f1 = L == 0 ? CT_C : CT_E;
            if (rem) conv_moe_tiles(p, lds, f0, f1, bid - rem, nb - rem); else conv_moe_tiles(p, lds, f0, f1, bid, nb); }
    } else if constexpr (PH == 10 || PH == 19) {
        constexpr int L = PH == 10 ? 0 : 1; const int* cnt = p.cnt + L * MOE_E;
        moe_tables(cnt, tab);
        mg::GroupedOrder S{tab, MOE_E, 8, nb, bid};
        mg::gemm_phase<true>(stage, MOE_FF / 2, AMoeAct{(const bf16_t*)(p.big + BIG_MOE_ACT), tab}, mg::BPlain{p.wt_d + (size_t)L * MOE_E * D_MODEL * MOE_FF / 2, MOE_FF / 2, (size_t)D_MODEL * MOE_FF / 2}, S, EpiMoeDown{(bf16_t*)(p.big + BIG_MOE_YS), p.list, cnt, p.lw});
        if constexpr (L == 0) { const int rem = (tab[MOE_E] * 8) % nb; __syncthreads();
            if (rem) conv_moe_tiles(p, lds, CT_D, CT_D + 384, bid - rem, nb - rem); else conv_moe_tiles(p, lds, CT_D, CT_D + 384, bid, nb); }
    } else if constexpr (PH == 11) {
        const bf16_t* ys = (const bf16_t*)(p.big + BIG_MOE_YS);
        rows_norm<false, true>(p.xB, ys, ys + D_MODEL, p.xA, p.ln_mix + D_MODEL, p.hb16, bid, nb);
    } else if constexpr (PH == 12) {
        mg::StaticOrder S; S.init(T, SSD_PROJ_P, nb, bid);
        mg::gemm_phase(stage, D_MODEL, mg::APlain{p.hb16, D_MODEL}, mg::BPlain{p.wt_ssd_in, D_MODEL, 0}, S,
                       EpiSsdIn{(bf16_t*)(p.big + BIG_SSD_Z), (bf16_t*)(p.big + BIG_SSD_XBCP), p.dtb, p.ssd_dt_bias});
        { const int nu = (T / 256) * (SSD_PROJ_P / 256), rem = nu % nb; __syncthreads();
          if (rem) conv_moe_tiles(p, lds, CT_C, CT_D, bid - rem, nb - rem); else conv_moe_tiles(p, lds, CT_C, CT_D, bid, nb); }
    } else if constexpr (PH == 13) {
        ph_ssd_conv_bc(p, bid, nb);
    } else if constexpr (PH == 14) {
        ph_ssd_mfma(p, (char*)ldsraw + LDS_STAGE_OFF, bid, nb);
    } else if constexpr (PH == 15) {
        ph_ssd_norm(p, bid, nb);
    } else if constexpr (PH == 16) {
        mg::StaticOrder S; S.init(T, D_MODEL, nb, bid);
        mg::gemm_phase(stage, SSD_DI, mg::APlain{(const bf16_t*)(p.big + BIG_SSD_YN), SSD_DI}, mg::BPlain{p.wt_ssd_out, SSD_DI, 0}, S, EpiResid<true>{p.xA, (bf16_t*)p.xB});
    } else if constexpr (PH == 20) {
        const bf16_t* ys = (const bf16_t*)(p.big + BIG_MOE_YS);
        const int lane = tidx() & 63, wid = tidx() >> 6;
        for (int row = bid * 8 + wid; row < T; row += nb * 8) {
            float4 v[8]; float ss = 0.f;
#pragma unroll
            for (int i = 0; i < 8; ++i) { const int c = i * 256 + lane * 4; const ushort4 s4 = *(const ushort4*)((const bf16_t*)p.xB + (size_t)row * D_MODEL + c); float4 a = make_float4(bf2f(s4.x), bf2f(s4.y), bf2f(s4.z), bf2f(s4.w));
                const ushort4 y0 = *(const ushort4*)(ys + (size_t)(2 * row) * D_MODEL + c), y1 = *(const ushort4*)(ys + (size_t)(2 * row + 1) * D_MODEL + c);
                a.x += bf2f(y0.x) + bf2f(y1.x); a.y += bf2f(y0.y) + bf2f(y1.y); a.z += bf2f(y0.z) + bf2f(y1.z); a.w += bf2f(y0.w) + bf2f(y1.w);
                v[i] = a; ss += a.x * a.x + a.y * a.y + a.z * a.z + a.w * a.w; }
            ss = wave_sum(ss); const float rinv = rsqrtf(ss * (1.f / D_MODEL) + NORM_EPS);
#pragma unroll
            for (int i = 0; i < 8; ++i) { const int c = i * 256 + lane * 4; const float4 gg = *(const float4*)(p.ln_final + c);
                float4 o; o.x = v[i].x * rinv * gg.x; o.y = v[i].y * rinv * gg.y; o.z = v[i].z * rinv * gg.z; o.w = v[i].w * rinv * gg.w;
                __builtin_nontemporal_store((f32x4){o.x, o.y, o.z, o.w}, (f32x4*)(p.out + (size_t)row * D_MODEL + c)); }
        }
    }
}

template <int PH> __global__ __launch_bounds__(NTHREADS, 2) void k_phase(P p) {
    extern __shared__ __attribute__((aligned(16))) float lds[];
    run_phase<PH>(p, lds, blockIdx.x, gridDim.x);
}
template <int PH> static void launch_all(const P& p, hipStream_t stream) {
    if constexpr (PH < NPHASE) {
        static bool attr = false; if (!attr) { attr = true; (void)hipFuncSetAttribute((const void*)k_phase<PH>, hipFuncAttributeMaxDynamicSharedMemorySize, LDS_BYTES); }
        hipLaunchKernelGGL(k_phase<PH>, dim3(256), dim3(NTHREADS), LDS_BYTES, stream, p);
        launch_all<PH + 1>(p, stream);
    }
}
constexpr bool phase_empty(int ph) { return ph == 2 || ph == 4 || ph == 6; }
#ifndef PROBE_DUP_MASK
#define PROBE_DUP_MASK 0u
#endif
constexpr bool phase_dup(int ph) { return (PROBE_DUP_MASK >> ph) & 1u; }
template <int PH> DEV void mega_phases(const P& p, float* lds, const XcdBarrier& bar) {
    if constexpr (PH < NPHASE) {
        if constexpr (!phase_empty(PH)) {
            run_phase<PH>(p, lds, blockIdx.x, gridDim.x);
            if constexpr (phase_dup(PH)) { xcd_barrier(bar); run_phase<PH>(p, lds, blockIdx.x, gridDim.x); }
            if constexpr (PH + 1 < NPHASE) xcd_barrier(bar);
        }
        mega_phases<PH + 1>(p, lds, bar);
    }
}
__global__ __launch_bounds__(NTHREADS, 2) void k_mega(P p) {
    extern __shared__ __attribute__((aligned(16))) float lds[];
    if (threadIdx.x < 4) ((unsigned*)lds)[threadIdx.x] = 0u;
    __syncthreads();
    XcdBarrier bar = xcd_barrier_post(p.bar, (volatile LAS unsigned*)lds);
    mega_phases<0>(p, lds, bar);
}

extern "C" void kernel_launch(void* const* d_in, const int* in_sizes, int n_in, void* d_out, int out_size, void* d_ws, size_t ws_size, hipStream_t stream) {
    P p{};
    const float* const* in = (const float* const*)d_in;
    p.x = in[0]; p.ln_mix = in[1]; p.ln_ffn = in[2]; p.ln_final = in[3]; p.nsa_w_in = in[4]; p.nsa_cmp_pe = in[5]; p.nsa_cmp_w1 = in[6]; p.nsa_cmp_w2 = in[7]; p.nsa_w_out = in[8];
    p.ssd_w_in = in[9]; p.ssd_conv_w = in[10]; p.ssd_conv_b = in[11]; p.ssd_dt_bias = in[12]; p.ssd_a_log = in[13]; p.ssd_d = in[14]; p.ssd_norm = in[15]; p.ssd_w_out = in[16];
    p.moe_w_group = in[17]; p.moe_b_group = in[18]; p.moe_w_expert = in[19]; p.moe_b_expert = in[20]; p.moe_w_gate = in[21]; p.moe_w_up = in[22]; p.moe_w_down = in[23];
    p.out = (float*)d_out;
    char* w = (char*)d_ws; size_t off = 0;
    auto take = [&](size_t bytes) { char* r = w + off; off += (bytes + 255) & ~(size_t)255; return r; };
    p.bar = (unsigned*)take(XCD_BAR_WORDS * 4);
    p.wt_nsa_in = (bf16_t*)take((size_t)NSA_PROJ_P * D_MODEL * 2);
    p.wt_nsa_out = (bf16_t*)take((size_t)D_MODEL * 2048 * 2);
    p.wt_ssd_in = (bf16_t*)take((size_t)SSD_PROJ_P * D_MODEL * 2);
    p.wt_ssd_out = (bf16_t*)take((size_t)D_MODEL * SSD_DI * 2);
    p.wt_gu = (bf16_t*)take((size_t)2 * MOE_E * 2 * MOE_FF * D_MODEL * 2);
    p.wt_d = (bf16_t*)take((size_t)2 * MOE_E * D_MODEL * MOE_FF * 2);
    p.wt_cmp1 = (bf16_t*)take((size_t)2 * CMP_HIDDEN * 4096 * 2);
    p.wt_cmp2 = (bf16_t*)take((size_t)2 * 256 * CMP_HIDDEN * 2);
    p.xA = (float*)take((size_t)T * D_MODEL * 4);
    p.xB = (float*)take((size_t)T * D_MODEL * 4);
    p.hb16 = (bf16_t*)take((size_t)T * D_MODEL * 2);
    p.big = take(BIG_BYTES);
    p.rope = (float*)take((size_t)SEQ * 64 * 2 * 4);
    p.h1 = (float*)take((size_t)2 * 2032 * CMP_HIDDEN * 4);
    p.kvc = (float*)take((size_t)2 * 2032 * 128 * 4);
    p.selmask = (unsigned*)take((size_t)BATCH * NKV * SEQ * 4);
    p.cnt = (int*)take(64 * 4);
    p.list = (int*)take((size_t)MOE_E * T * 4);
    p.ew = (float*)take((size_t)T * 2 * 4);
    p.lw = (float*)take((size_t)MOE_E * T * 4);
    p.dtb = (float*)take((size_t)T * 64 * 4);
    p.wr = (float*)take((size_t)2 * D_MODEL * MOE_E * 4);
    p.wgq = (float*)take((size_t)2 * D_MODEL * MOE_G * 4);
    if (off > ws_size) { fprintf(stderr, "workspace too small: need %zu have %zu\n", off, ws_size); return; }
#if defined(MK_MULTI)
    launch_all<0>(p, stream);
#else
    static int grid = 0;
    if (!grid) {
        int dev = 0, cus = 0, per_cu = 0;
        (void)hipGetDevice(&dev);
        (void)hipDeviceGetAttribute(&cus, hipDeviceAttributeMultiprocessorCount, dev);
        (void)hipFuncSetAttribute((const void*)k_mega, hipFuncAttributeMaxDynamicSharedMemorySize, LDS_BYTES);
        (void)hipOccupancyMaxActiveBlocksPerMultiprocessor(&per_cu, k_mega, NTHREADS, LDS_BYTES);
        if (per_cu < 1) per_cu = 1;
        grid = cus * (per_cu < 1 ? per_cu : 1);
    }
    (void)hipMemsetAsync(p.bar, 0, XCD_BAR_WORDS * sizeof(unsigned), stream);
    hipLaunchKernelGGL(k_mega, dim3(grid), dim3(NTHREADS), LDS_BYTES, stream, p);
#endif
}
```
